# Optimizing an MI355X kernel written in HIP

```python
import numpy as np
import jax, jax.numpy as jnp
from jax import lax

D_MODEL = 1024
BATCH = 4
SEQ = 8192
DEPTH = 1

N_META = 16
CHUNK = 128
PAD = CHUNK - N_META
RET_HEADS = 4
RET_QK_DIM = 128
RET_V_DIM = 256
SWA_Q_HEADS = 16
SWA_KV_HEADS = 4
SWA_GROUP = SWA_Q_HEADS // SWA_KV_HEADS
SWA_HEAD_DIM = 64
SWA_WINDOW = 128
D_FF = 4 * D_MODEL
EPS = 1e-6
RET_QK_W = RET_HEADS * RET_QK_DIM
RET_V_W = RET_HEADS * RET_V_DIM
SWA_Q_W = SWA_Q_HEADS * SWA_HEAD_DIM
SWA_KV_W = SWA_KV_HEADS * SWA_HEAD_DIM
IN_SPLITS = (RET_QK_W, RET_QK_W, RET_V_W, RET_V_W, SWA_Q_W, SWA_KV_W, SWA_KV_W, D_MODEL, D_MODEL)
D_IN = 2 * RET_QK_W + 2 * RET_V_W + SWA_Q_W + 2 * SWA_KV_W + 2 * D_MODEL

kernel_name = 'hybrid_retention_swa_block'


def rms_norm(x, g):
    xf = x.astype(jnp.float32)
    y = xf * lax.rsqrt(jnp.mean(xf * xf, axis=-1, keepdims=True) + EPS)
    return (y * g.astype(jnp.float32)).astype(x.dtype)


def retention(q, k, v):
    B, Lp = q.shape[0], q.shape[1]
    nb = Lp // CHUNK
    log_gamma = jnp.log1p(-(2.0 ** (-5.0 - jnp.arange(RET_HEADS, dtype=jnp.float32))))
    idx = jnp.arange(CHUNK, dtype=jnp.float32)
    diff = idx[:, None] - idx[None, :]
    intra = jnp.where(diff >= 0, jnp.exp(log_gamma[:, None, None] * jnp.maximum(diff, 0.0)), 0.0)
    q_decay = jnp.exp(log_gamma[:, None] * (idx + 1.0))[:, :, None]
    k_decay = jnp.exp(log_gamma[:, None] * (CHUNK - 1.0 - idx))[:, :, None]
    chunk_decay = jnp.exp(log_gamma * CHUNK)[:, None, None]
    k = k * (RET_QK_DIM ** -0.5)
    to_chunks = lambda t: t.reshape(B, nb, CHUNK, RET_HEADS, t.shape[-1]).transpose(1, 0, 3, 2, 4)
    qc, kc, vc = to_chunks(q), to_chunks(k), to_chunks(v)

    def step(state, inp):
        qn, kn, vn = inp
        s = jnp.einsum('bhqd,bhkd->bhqk', qn, kn) * intra
        o = (jnp.einsum('bhqk,bhkv->bhqv', s, vn)
             + jnp.einsum('bhqd,bhdv->bhqv', qn * q_decay, state))
        state = chunk_decay * state + jnp.einsum('bhkd,bhkv->bhdv', kn * k_decay, vn)
        return state, o

    state0 = jnp.zeros((B, RET_HEADS, RET_QK_DIM, RET_V_DIM), jnp.float32)
    _, o = lax.scan(step, state0, (qc, kc, vc))
    return o.transpose(1, 0, 3, 2, 4).reshape(B, Lp, RET_HEADS, RET_V_DIM).astype(q.dtype)


def sliding_window_attention(q, k, v, q_norm_g, k_norm_g, sinks):
    B, Lp = q.shape[0], q.shape[1]
    nb = Lp // CHUNK
    q = rms_norm(q, q_norm_g) * (SWA_HEAD_DIM ** -0.5)
    k = rms_norm(k, k_norm_g)
    qb = jnp.moveaxis(q.reshape(B, nb, CHUNK, SWA_KV_HEADS, SWA_GROUP, SWA_HEAD_DIM), 1, 0)
    kb = k.reshape(B, nb, CHUNK, SWA_KV_HEADS, SWA_HEAD_DIM)
    vb = v.reshape(B, nb, CHUNK, SWA_KV_HEADS, SWA_HEAD_DIM)
    shift = lambda t: jnp.pad(t, ((0, 0), (1, 0), (0, 0), (0, 0), (0, 0)))[:, :-1]
    k_band = jnp.moveaxis(jnp.concatenate([shift(kb), kb], axis=2), 1, 0)
    v_band = jnp.moveaxis(jnp.concatenate([shift(vb), vb], axis=2), 1, 0)
    k_meta = k[:, PAD:CHUNK]
    v_meta = v[:, PAD:CHUNK]
    slopes = (2.0 ** (-8.0 * jnp.arange(1, SWA_Q_HEADS + 1, dtype=jnp.float32) / SWA_Q_HEADS)
              ).reshape(SWA_KV_HEADS, SWA_GROUP)[:, :, None, None]
    sink = sinks.astype(jnp.float32).reshape(SWA_KV_HEADS, SWA_GROUP)[:, :, None, None]
    is_meta = jnp.arange(N_META + 2 * CHUNK) < N_META

    def block(args):
        qn, kn, vn, n = args
        t = n * CHUNK + jnp.arange(CHUNK)
        s = jnp.concatenate([PAD + jnp.arange(N_META), (n - 1) * CHUNK + jnp.arange(2 * CHUNK)])
        dist = t[:, None] - s[None, :]
        valid = (dist >= 0) & (is_meta[None, :] | ((dist < SWA_WINDOW) & (s[None, :] >= CHUNK)))
        keys = jnp.concatenate([k_meta, kn], axis=1)
        vals = jnp.concatenate([v_meta, vn], axis=1)
        scores = (jnp.einsum('bqhgd,bkhd->bhgqk', qn, keys).astype(jnp.float32)
                  - slopes * dist.astype(jnp.float32))
        scores = jnp.where(valid, scores, -jnp.inf)
        m = jnp.maximum(jnp.max(scores, axis=-1, keepdims=True), sink)
        p = jnp.exp(scores - m)
        probs = p / (jnp.sum(p, axis=-1, keepdims=True) + jnp.exp(sink - m))
        return jnp.einsum('bhgqk,bkhd->bqhgd', probs.astype(vals.dtype), vals)

    out = lax.map(block, (qb, k_band, v_band, jnp.arange(nb, dtype=jnp.int32)))
    return jnp.moveaxis(out, 0, 1).reshape(B, Lp, SWA_Q_W)


def mixer_layer(h, mix_norm_g, w_in, ret_norm_g, q_norm_g, k_norm_g, sinks, w_ret_branch, w_swa_branch, w_out):
    B, L = h.shape[0], h.shape[1]
    Lp = L + PAD
    hn = rms_norm(h, mix_norm_g)
    proj = hn @ w_in
    split_points = np.cumsum(IN_SPLITS)[:-1].tolist()
    rq, rk, rv, rg, sq, sk, sv, gr, gs = jnp.split(proj, split_points, axis=-1)
    pad = lambda t, nh: jnp.pad(t, ((0, 0), (PAD, 0), (0, 0))).reshape(B, Lp, nh, -1)
    y_ret = retention(pad(rq, RET_HEADS), pad(rk, RET_HEADS), pad(rv, RET_HEADS))[:, PAD:]
    y_ret = rms_norm(y_ret, ret_norm_g).reshape(B, L, RET_V_W) * jax.nn.silu(rg)
    y_swa = sliding_window_attention(pad(sq, SWA_Q_HEADS), pad(sk, SWA_KV_HEADS), pad(sv, SWA_KV_HEADS),
                                     q_norm_g, k_norm_g, sinks)[:, PAD:]
    merged = (jax.nn.sigmoid(gr) * (y_ret @ w_ret_branch)
              + jax.nn.sigmoid(gs) * (y_swa @ w_swa_branch))
    return merged @ w_out


def setup_inputs(seed: int = 0) -> dict:
    key = jax.random.key(seed)
    ks = jax.random.split(key, 16)
    f = jnp.float32
    nrm = lambda k, shape, scale: jax.random.normal(k, shape, f) * scale
    return {
        'x': nrm(ks[0], (BATCH, SEQ, D_MODEL), 1.0),
        'meta_tokens': nrm(ks[1], (N_META, D_MODEL), 1.0),
        'mix_norm_g': 1.0 + nrm(ks[2], (DEPTH, D_MODEL), 0.02),
        'w_in': nrm(ks[3], (DEPTH, D_MODEL, D_IN), D_MODEL ** -0.5),
        'ret_norm_g': 1.0 + nrm(ks[4], (DEPTH, RET_HEADS, RET_V_DIM), 0.02),
        'q_norm_g': 1.0 + nrm(ks[5], (DEPTH, SWA_HEAD_DIM), 0.02),
        'k_norm_g': 1.0 + nrm(ks[6], (DEPTH, SWA_HEAD_DIM), 0.02),
        'sinks': nrm(ks[7], (DEPTH, SWA_Q_HEADS), 0.5),
        'w_ret_branch': nrm(ks[8], (DEPTH, RET_V_W, D_MODEL), RET_V_W ** -0.5),
        'w_swa_branch': nrm(ks[9], (DEPTH, SWA_Q_W, D_MODEL), SWA_Q_W ** -0.5),
        'w_out': nrm(ks[10], (DEPTH, D_MODEL, D_MODEL), D_MODEL ** -0.5),
        'mlp_norm_g': 1.0 + nrm(ks[11], (DEPTH, D_MODEL), 0.02),
        'w_up': nrm(ks[12], (DEPTH, D_MODEL, D_FF), D_MODEL ** -0.5),
        'w_down': nrm(ks[13], (DEPTH, D_FF, D_MODEL), D_FF ** -0.5),
    }


def reference(x, meta_tokens, mix_norm_g, w_in, ret_norm_g, q_norm_g, k_norm_g, sinks,
              w_ret_branch, w_swa_branch, w_out, mlp_norm_g, w_up, w_down):
    B = x.shape[0]
    meta = jnp.broadcast_to(meta_tokens[None].astype(x.dtype), (B, N_META, D_MODEL))
    h = jnp.concatenate([meta, x], axis=1)
    for layer in range(DEPTH):
        h = h + mixer_layer(h, mix_norm_g[layer], w_in[layer], ret_norm_g[layer], q_norm_g[layer],
                            k_norm_g[layer], sinks[layer], w_ret_branch[layer], w_swa_branch[layer],
                            w_out[layer])
        hn = rms_norm(h, mlp_norm_g[layer])
        h = h + jnp.square(jax.nn.relu(hn @ w_up[layer])) @ w_down[layer]
    return h[:, N_META:]
```

```cpp
#ifndef REP_MASK
#define REP_MASK 0
#endif
#include <hip/hip_runtime.h>
#include <hip/hip_cooperative_groups.h>
#include <cstdio>
#include <cstdint>
namespace cg = cooperative_groups;

#define LAS __attribute__((address_space(3)))
typedef unsigned short bf16_t;
typedef short bf16x8 __attribute__((ext_vector_type(8)));
typedef float f32x4 __attribute__((ext_vector_type(4)));
typedef unsigned u32x4 __attribute__((ext_vector_type(4)));
typedef unsigned u32x2 __attribute__((ext_vector_type(2)));

constexpr int NB = 4, SEQ = 8192, DM = 1024, NTOK = NB * SEQ, NMETA = 16, MROWS = NTOK + NMETA, MPAD = 33024, DIN = 6656, FF = 4096;
constexpr float EPS = 1e-6f;
constexpr int NTHREADS = 512;
constexpr int LDS_BYTES = 135168;

constexpr size_t SZ_WIN = (size_t)DIN * DM * 2, SZ_WSQ = (size_t)DM * DM * 2, SZ_WFF = (size_t)FF * DM * 2;
constexpr size_t OFF_WIN = 0, OFF_WRET = OFF_WIN + SZ_WIN, OFF_WSWA = OFF_WRET + SZ_WSQ, OFF_WOUT = OFF_WSWA + SZ_WSQ, OFF_WUP = OFF_WOUT + SZ_WSQ, OFF_WDN = OFF_WUP + SZ_WFF;
constexpr size_t OFF_RQ = OFF_WDN + SZ_WFF;
constexpr size_t OFF_RK = OFF_RQ + (size_t)MROWS * 512 * 2;
constexpr size_t OFF_RV = OFF_RK + (size_t)MROWS * 512 * 2;
constexpr size_t OFF_RG = OFF_RV + (size_t)MROWS * 1024 * 2;
constexpr size_t OFF_SQ = OFF_RG + (size_t)MROWS * 1024 * 2;
constexpr size_t OFF_SK = OFF_SQ + (size_t)MROWS * 1024 * 2;
constexpr size_t OFF_SV = OFF_SK + (size_t)MROWS * 256 * 2;
constexpr size_t OFF_GR = OFF_SV + (size_t)MROWS * 256 * 2;
constexpr size_t OFF_GS = OFF_GR + (size_t)MROWS * 1024;
constexpr size_t OFF_XR = OFF_GS + (size_t)MROWS * 1024;
constexpr size_t OFF_CTL = OFF_XR + (size_t)MROWS * 1024 * 2;
constexpr size_t OFF_RSTD = OFF_CTL + 16384 + (size_t)NTOK * 4;
constexpr size_t CTL_BYTES = 16384 + (size_t)NTOK * 4 + (size_t)MROWS * 4;
constexpr size_t OFF_SS = OFF_CTL + 16384;
constexpr size_t WS_NEED = OFF_CTL + CTL_BYTES;
constexpr size_t OFF_MERGED = OFF_RQ, OFF_HN2 = OFF_RV, OFF_YRET = OFF_SQ, OFF_U = OFF_RG;
static_assert(OFF_RK - OFF_RQ + OFF_RV - OFF_RK >= (size_t)NTOK * 1024 * 2, "MERGED fits");
static_assert(OFF_CTL - OFF_RG >= (size_t)NTOK * FF * 2, "U fits");
constexpr size_t DOUT_KVS = 0, DOUT_YSWA = (size_t)NTOK * 1024 * 2;

typedef __bf16 bf16x2_t __attribute__((ext_vector_type(2)));
typedef float f32x2_t __attribute__((ext_vector_type(2)));
__device__ __forceinline__ unsigned cvt_pk_bf16(float lo, float hi) { const f32x2_t v = {lo, hi}; const bf16x2_t b = __builtin_convertvector(v, bf16x2_t); return __builtin_bit_cast(unsigned, b); }
__device__ __forceinline__ unsigned cvt_pk_bf16_asm(float lo, float hi) { unsigned r; asm volatile("v_cvt_pk_bf16_f32 %0, %1, %2" : "=v"(r) : "v"(lo), "v"(hi)); return r; }
__device__ __forceinline__ float bf_lo(unsigned w) { return __uint_as_float(w << 16); }
__device__ __forceinline__ float bf_hi(unsigned w) { return __uint_as_float(w & 0xffff0000u); }
__device__ __forceinline__ float wave_sum(float v) {
#pragma unroll
    for (int o = 1; o < 64; o <<= 1) v += __shfl_xor(v, o);
    return v;
}
__device__ __forceinline__ float sigmoidf_(float x) { return __builtin_amdgcn_rcpf(1.0f + __builtin_amdgcn_exp2f(-1.4426950408889634f * x)); }

namespace pg8 {
constexpr int BM = 256, BK = 64, HALF = 128, HTB = HALF * BK * 2, STAGE_BYTES = 8 * HTB, NXCD = 8, WGM = 8;
__host__ __device__ __forceinline__ int lds_byte(int r, int c) { const int st = (r >> 4) * 2 + (c >> 5), rr = r & 15, cc = c & 31, ob = rr * 64 + cc * 2; return st * 1024 + (ob ^ (((ob >> 9) & 1) << 5)); }
__host__ __device__ __forceinline__ void stage_rc(int b, int& R, int& C) { const int st = b / 1024, sb = b % 1024, swz = sb ^ (((sb >> 9) & 1) << 5); R = (st >> 1) * 16 + swz / 64; C = (st & 1) * 32 + (swz % 64) / 2; }
__host__ __device__ __forceinline__ int perm32(int rho) { const int n = rho >> 4, i = rho & 15; return 8 * (i >> 2) + 4 * n + (i & 3); }

struct Unit { int pm, pn, seg; };
struct Gemm { const bf16_t* A; const bf16_t* Bt; const bf16_t* A2; const bf16_t* Bt2; int M, N, K; };

struct StaticOrder {
    int nM, nN, nwg, G, c;
    __device__ void init(int M, int N, int G_, int c_) { nM = M / BM; nN = N / BM; nwg = nM * nN; G = G_; c = c_; }
    __device__ bool tile(long L, Unit& u) const {
        if (L >= nwg) return false;
        int wgid = (int)L; { const int q = nwg / NXCD, r = nwg % NXCD, xcd = wgid % NXCD, off = wgid / NXCD; wgid = (xcd < r ? xcd * (q + 1) : r * (q + 1) + (xcd - r) * q) + off; }
        const int nig = WGM * nN, gid = wgid / nig, fm = gid * WGM, gsz = (nM - fm) < WGM ? (nM - fm) : WGM;
        u.pm = fm + ((wgid % nig) % gsz); u.pn = (wgid % nig) / gsz; u.seg = 0; return true;
    }
    __device__ bool next(int i, Unit& u) const { return tile((long)i * G + c, u); }
};
struct PairOrder {
    StaticOrder s;
    __device__ bool next(int i, Unit& u) const { const bool ok = s.tile((long)(i >> 1) * s.G + s.c, u); u.seg = i & 1; return ok; }
};

struct EpiProj {
    static constexpr bool PERM = true, HAS_MID = false;
    unsigned char* ws; const float* rstd;
    __device__ __forceinline__ void mid(f32x4 (&acc)[2][2][4][2], const Unit& u, int wr, int wc, int fr, int fq) const {}
    __device__ __forceinline__ void operator()(const f32x4 (&acc)[2][2][4][2], const Unit& u, int wr, int wc, int fr, int fq) const {
        const int pn = u.pn; size_t boff; int ld, ct;
        if (pn < 2) { boff = OFF_RQ; ld = 512; ct = pn; }
        else if (pn < 4) { boff = OFF_RK; ld = 512; ct = pn - 2; }
        else if (pn < 8) { boff = OFF_RV; ld = 1024; ct = pn - 4; }
        else if (pn < 12) { boff = OFF_RG; ld = 1024; ct = pn - 8; }
        else if (pn < 16) { boff = OFF_SQ; ld = 1024; ct = pn - 12; }
        else if (pn == 16) { boff = OFF_SK; ld = 256; ct = 0; }
        else if (pn == 17) { boff = OFF_SV; ld = 256; ct = 0; }
        else if (pn < 22) { boff = OFF_GR; ld = 1024; ct = pn - 18; }
        else { boff = OFF_GS; ld = 1024; ct = pn - 22; }
        bf16_t* base = (bf16_t*)(ws + boff);
        const int row0 = u.pm * BM + wr * 64 + fr, col0 = ct * 256 + wc * 32 + 8 * fq;
        if (pn >= 18) {
            unsigned char* gb = ws + boff;
#pragma unroll
            for (int ai = 0; ai < 2; ++ai)
#pragma unroll
                for (int m = 0; m < 4; ++m)
#pragma unroll
                    for (int bj = 0; bj < 2; ++bj) { const float rs = rstd[row0 + ai * HALF + m * 16]; const f32x4 v0 = acc[ai][bj][m][0] * rs, v1 = acc[ai][bj][m][1] * rs;
                        int w0 = __builtin_amdgcn_cvt_pk_fp8_f32(v0[0], v0[1], 0, false); w0 = __builtin_amdgcn_cvt_pk_fp8_f32(v0[2], v0[3], w0, true);
                        int w1 = __builtin_amdgcn_cvt_pk_fp8_f32(v1[0], v1[1], 0, false); w1 = __builtin_amdgcn_cvt_pk_fp8_f32(v1[2], v1[3], w1, true);
                        *(u32x2*)(gb + (size_t)(row0 + ai * HALF + m * 16) * 1024 + col0 + bj * HALF) = (u32x2){(unsigned)w0, (unsigned)w1}; }
            return;
        }
#pragma unroll
        for (int ai = 0; ai < 2; ++ai)
#pragma unroll
            for (int m = 0; m < 4; ++m) {
                bf16_t* rowp = base + (size_t)(row0 + ai * HALF + m * 16) * ld + col0; const float rs = rstd[row0 + ai * HALF + m * 16];
#pragma unroll
                for (int bj = 0; bj < 2; ++bj) { const f32x4 v0 = acc[ai][bj][m][0] * rs, v1 = acc[ai][bj][m][1] * rs;
                    u32x4 w; w.x = cvt_pk_bf16_asm(v0[0], v0[1]); w.y = cvt_pk_bf16_asm(v0[2], v0[3]); w.z = cvt_pk_bf16_asm(v1[0], v1[1]); w.w = cvt_pk_bf16_asm(v1[2], v1[3]);
                    *(u32x4*)(rowp + bj * HALF) = w; } }
    }
};
struct EpiMerged {
    static constexpr bool PERM = true, HAS_MID = true;
    const unsigned char *GR, *GS; bf16_t* O;
    __device__ __forceinline__ void mid(f32x4 (&acc)[2][2][4][2], const Unit& u, int wr, int wc, int fr, int fq) const {
        const int row0 = u.pm * BM + wr * 64 + fr, col0 = u.pn * BM + wc * 32 + 8 * fq;
#pragma unroll
        for (int ai = 0; ai < 2; ++ai)
#pragma unroll
            for (int m = 0; m < 4; ++m)
#pragma unroll
                for (int bj = 0; bj < 2; ++bj) { const size_t off = (size_t)(row0 + ai * HALF + m * 16) * DM + col0 + bj * HALF;
                    const u32x2 a = *(const u32x2*)(GR + off), b = *(const u32x2*)(GS + off);
#define MRG_R(ga, gb) ((1.0f + __builtin_amdgcn_exp2f(-1.4426950408889634f * (gb))) * __builtin_amdgcn_rcpf(1.0f + __builtin_amdgcn_exp2f(-1.4426950408889634f * (ga))))
#define F8(w, k) __builtin_amdgcn_cvt_f32_fp8((int)(w), (k))
                    f32x4 r0, r1;
                    r0[0] = MRG_R(F8(a.x, 0), F8(b.x, 0)); r0[1] = MRG_R(F8(a.x, 1), F8(b.x, 1)); r0[2] = MRG_R(F8(a.x, 2), F8(b.x, 2)); r0[3] = MRG_R(F8(a.x, 3), F8(b.x, 3));
                    r1[0] = MRG_R(F8(a.y, 0), F8(b.y, 0)); r1[1] = MRG_R(F8(a.y, 1), F8(b.y, 1)); r1[2] = MRG_R(F8(a.y, 2), F8(b.y, 2)); r1[3] = MRG_R(F8(a.y, 3), F8(b.y, 3));
#undef MRG_R
                    acc[ai][bj][m][0] = acc[ai][bj][m][0] * r0; acc[ai][bj][m][1] = acc[ai][bj][m][1] * r1; }
    }
    __device__ __forceinline__ void operator()(const f32x4 (&acc)[2][2][4][2], const Unit& u, int wr, int wc, int fr, int fq) const {
        const int row0 = u.pm * BM + wr * 64 + fr, col0 = u.pn * BM + wc * 32 + 8 * fq;
#pragma unroll
        for (int ai = 0; ai < 2; ++ai)
#pragma unroll
            for (int m = 0; m < 4; ++m)
#pragma unroll
                for (int bj = 0; bj < 2; ++bj) { const size_t off = (size_t)(row0 + ai * HALF + m * 16) * DM + col0 + bj * HALF;
                    const u32x2 b = *(const u32x2*)(GS + off); const f32x4 v0 = acc[ai][bj][m][0], v1 = acc[ai][bj][m][1];
                    u32x4 w;
                    w.x = cvt_pk_bf16_asm(v0[0] * sigmoidf_(F8(b.x, 0)), v0[1] * sigmoidf_(F8(b.x, 1))); w.y = cvt_pk_bf16_asm(v0[2] * sigmoidf_(F8(b.x, 2)), v0[3] * sigmoidf_(F8(b.x, 3)));
                    w.z = cvt_pk_bf16_asm(v1[0] * sigmoidf_(F8(b.y, 0)), v1[1] * sigmoidf_(F8(b.y, 1))); w.w = cvt_pk_bf16_asm(v1[2] * sigmoidf_(F8(b.y, 2)), v1[3] * sigmoidf_(F8(b.y, 3)));
#undef F8
                    *(u32x4*)(O + off) = w; }
    }
};
struct EpiRes {
    static constexpr bool PERM = true, HAS_MID = false;
    const float* res; float* out;
    __device__ __forceinline__ void mid(f32x4 (&acc)[2][2][4][2], const Unit& u, int wr, int wc, int fr, int fq) const {}
    __device__ __forceinline__ void operator()(const f32x4 (&acc)[2][2][4][2], const Unit& u, int wr, int wc, int fr, int fq) const {
        const int row0 = u.pm * BM + wr * 64 + fr, col0 = u.pn * BM + wc * 32 + 8 * fq;
#pragma unroll
        for (int ai = 0; ai < 2; ++ai)
#pragma unroll
            for (int m = 0; m < 4; ++m)
#pragma unroll
                for (int bj = 0; bj < 2; ++bj) { const size_t off = (size_t)(row0 + ai * HALF + m * 16) * DM + col0 + bj * HALF;
                    const f32x4 x0 = *(const f32x4*)(res + off), x1 = *(const f32x4*)(res + off + 4);
                    *(f32x4*)(out + off) = x0 + acc[ai][bj][m][0]; *(f32x4*)(out + off + 4) = x1 + acc[ai][bj][m][1]; }
    }
};
struct EpiResStat {
    static constexpr bool PERM = true, HAS_MID = false;
    const bf16_t* res; float* out; bf16_t* hb; float* ss;
    __device__ __forceinline__ void mid(f32x4 (&acc)[2][2][4][2], const Unit& u, int wr, int wc, int fr, int fq) const {}
    __device__ __forceinline__ void operator()(const f32x4 (&acc)[2][2][4][2], const Unit& u, int wr, int wc, int fr, int fq) const {
        const int row0 = u.pm * BM + wr * 64 + fr, col0 = u.pn * BM + wc * 32 + 8 * fq;
#pragma unroll
        for (int ai = 0; ai < 2; ++ai)
#pragma unroll
            for (int m = 0; m < 4; ++m) {
                float sq = 0.f;
#pragma unroll
                for (int bj = 0; bj < 2; ++bj) { const size_t off = (size_t)(row0 + ai * HALF + m * 16) * DM + col0 + bj * HALF;
                    const u32x4 xr = *(const u32x4*)(res + off);
                    const f32x4 h0 = (f32x4){bf_lo(xr.x), bf_hi(xr.x), bf_lo(xr.y), bf_hi(xr.y)} + acc[ai][bj][m][0], h1 = (f32x4){bf_lo(xr.z), bf_hi(xr.z), bf_lo(xr.w), bf_hi(xr.w)} + acc[ai][bj][m][1];
                    u32x4 w; w.x = cvt_pk_bf16_asm(h0[0], h0[1]); w.y = cvt_pk_bf16_asm(h0[2], h0[3]); w.z = cvt_pk_bf16_asm(h1[0], h1[1]); w.w = cvt_pk_bf16_asm(h1[2], h1[3]);
                    *(u32x4*)(hb + off) = w;
                    sq += (h0[0] * h0[0] + h0[1] * h0[1]) + (h0[2] * h0[2] + h0[3] * h0[3]) + (h1[0] * h1[0] + h1[1] * h1[1]) + (h1[2] * h1[2] + h1[3] * h1[3]); }
                sq += __shfl_xor(sq, 16); sq += __shfl_xor(sq, 32);
                if (fq == 0) atomicAdd(ss + row0 + ai * HALF + m * 16, sq);
            }
    }
};
struct EpiResBf {
    static constexpr bool PERM = true, HAS_MID = false;
    const bf16_t* hb; float* out;
    __device__ __forceinline__ void mid(f32x4 (&acc)[2][2][4][2], const Unit& u, int wr, int wc, int fr, int fq) const {}
    __device__ __forceinline__ void operator()(const f32x4 (&acc)[2][2][4][2], const Unit& u, int wr, int wc, int fr, int fq) const {
        const int row0 = u.pm * BM + wr * 64 + fr, col0 = u.pn * BM + wc * 32 + 8 * fq;
#pragma unroll
        for (int ai = 0; ai < 2; ++ai)
#pragma unroll
            for (int m = 0; m < 4; ++m)
#pragma unroll
                for (int bj = 0; bj < 2; ++bj) { const size_t off = (size_t)(row0 + ai * HALF + m * 16) * DM + col0 + bj * HALF;
                    const u32x4 h = *(const u32x4*)(hb + off);
                    const f32x4 x0 = (f32x4){bf_lo(h.x), bf_hi(h.x), bf_lo(h.y), bf_hi(h.y)}, x1 = (f32x4){bf_lo(h.z), bf_hi(h.z), bf_lo(h.w), bf_hi(h.w)};
                    *(f32x4*)(out + off) = x0 + acc[ai][bj][m][0]; *(f32x4*)(out + off + 4) = x1 + acc[ai][bj][m][1]; }
    }
};
struct EpiUp {
    static constexpr bool PERM = true, HAS_MID = false;
    bf16_t* O; const float* ss;
    __device__ __forceinline__ void mid(f32x4 (&acc)[2][2][4][2], const Unit& u, int wr, int wc, int fr, int fq) const {}
    __device__ __forceinline__ void operator()(const f32x4 (&acc)[2][2][4][2], const Unit& u, int wr, int wc, int fr, int fq) const {
        const int row0 = u.pm * BM + wr * 64 + fr, col0 = u.pn * BM + wc * 32 + 8 * fq;
#pragma unroll
        for (int ai = 0; ai < 2; ++ai)
#pragma unroll
            for (int m = 0; m < 4; ++m) {
                const float rstd = 1.f / sqrtf(ss[row0 + ai * HALF + m * 16] * (1.f / DM) + EPS);
#pragma unroll
                for (int bj = 0; bj < 2; ++bj) { const size_t off = (size_t)(row0 + ai * HALF + m * 16) * FF + col0 + bj * HALF;
                    f32x4 v0 = acc[ai][bj][m][0], v1 = acc[ai][bj][m][1];
#pragma unroll
                    for (int e = 0; e < 4; ++e) { const float a = fmaxf(v0[e] * rstd, 0.f), b = fmaxf(v1[e] * rstd, 0.f); v0[e] = a * a; v1[e] = b * b; }
                    u32x4 w; w.x = cvt_pk_bf16_asm(v0[0], v0[1]); w.y = cvt_pk_bf16_asm(v0[2], v0[3]); w.z = cvt_pk_bf16_asm(v1[0], v1[1]); w.w = cvt_pk_bf16_asm(v1[2], v1[3]);
                    *(u32x4*)(O + off) = w; }
            }
    }
};

template <class Epi, class Sched, bool ALIGN_EPI>
__device__ __forceinline__ void gemm_phase(LAS unsigned char* lds, const Gemm g, const Sched& S, const Epi& E) {
    int tid_ = threadIdx.x; asm volatile("" : "+v"(tid_));
    const int tid = tid_, wid = __builtin_amdgcn_readfirstlane(tid >> 6), lane = tid & 63, wr = wid >> 2, wc = wid & 3, fr = lane & 15, fq = lane >> 4;
    const int K = g.K, nt = K / BK;
    unsigned voffA[2], voffB[2];
#pragma unroll
    for (int i = 0; i < 2; ++i) { int R, C; stage_rc(tid * 16 + i * 8192, R, C); const int Rb = Epi::PERM ? ((R & ~31) + perm32(R & 31)) : R;
        voffA[i] = (unsigned)(R * K + C) * 2u; voffB[i] = (unsigned)(Rb * K + C) * 2u; }
    const size_t kstep = (size_t)(BK * 2);
    const size_t hstep = (size_t)HALF * K * 2;
    const size_t tstep = 2 * hstep;
    const unsigned ldsw = (unsigned)wid * 1024u;
    const int aoff = lds_byte(wr * 64 + fr, fq * 8), boff = lds_byte(wc * 32 + fr, fq * 8);
#define PG8_SA(b, h) (((b) * 2 + (h)) * HTB)
#define PG8_SB(b, h) ((4 + (b) * 2 + (h)) * HTB)
#define PG8_STAGE(bufoff, gbase, voff) do { _Pragma("unroll") for (int _i = 0; _i < 2; ++_i) \
        __builtin_amdgcn_global_load_lds((const unsigned*)((const char*)(gbase) + (voff)[_i]), (LAS unsigned*)(lds + (bufoff) + ldsw + _i * 8192), 16, 0, 0); } while (0)
#define PG8_LDA(dst, b, h) do { _Pragma("unroll") for (int m = 0; m < 4; ++m) _Pragma("unroll") for (int k = 0; k < 2; ++k) dst[m][k] = *(const LAS bf16x8*)(lds + PG8_SA(b, h) + aoff + m * 2048 + k * 1024); } while (0)
#define PG8_LDB(dst, b, h) do { _Pragma("unroll") for (int n = 0; n < 2; ++n) _Pragma("unroll") for (int k = 0; k < 2; ++k) dst[n][k] = *(const LAS bf16x8*)(lds + PG8_SB(b, h) + boff + n * 2048 + k * 1024); } while (0)
#define PG8_MMA(ai, bj, At, Bt) do { __builtin_amdgcn_s_setprio(1); _Pragma("unroll") for (int m = 0; m < 4; ++m) _Pragma("unroll") for (int n = 0; n < 2; ++n) _Pragma("unroll") for (int k = 0; k < 2; ++k) \
        acc[ai][bj][m][n] = __builtin_amdgcn_mfma_f32_16x16x32_bf16(Bt[n][k], At[m][k], acc[ai][bj][m][n], 0, 0, 0); __builtin_amdgcn_s_setprio(0); } while (0)
#define PG8_WAIT_V(n) asm volatile("s_waitcnt vmcnt(" #n ")" ::: "memory")
#define PG8_WAIT_L(n) asm volatile("s_waitcnt lgkmcnt(" #n ")" ::: "memory")
#define PG8_BAR __builtin_amdgcn_s_barrier()
#define PG8_SCHED __builtin_amdgcn_sched_barrier(0)
    Unit cur, nxt; int ui = 0;
    if (!S.next(0, cur)) return;
    f32x4 acc[2][2][4][2];
#pragma unroll
    for (int a = 0; a < 2; ++a)
#pragma unroll
        for (int b = 0; b < 2; ++b)
#pragma unroll
            for (int m = 0; m < 4; ++m)
#pragma unroll
                for (int n = 0; n < 2; ++n) acc[a][b][m][n] = (f32x4){0.f, 0.f, 0.f, 0.f};
    bf16x8 At[4][2], B0[2][2], B1[2][2];
    const char* cA = (const char*)(cur.seg ? g.A2 : g.A) + (size_t)cur.pm * tstep; const char* cB = (const char*)(cur.seg ? g.Bt2 : g.Bt) + (size_t)cur.pn * tstep;
    PG8_STAGE(PG8_SB(0, 0), cB, voffB); PG8_STAGE(PG8_SB(0, 1), cB + hstep, voffB); PG8_STAGE(PG8_SA(0, 0), cA, voffA); PG8_STAGE(PG8_SA(0, 1), cA + hstep, voffA);
    if (wr == 1) PG8_BAR;
    PG8_WAIT_V(2); PG8_BAR;
    PG8_STAGE(PG8_SB(1, 0), cB + kstep, voffB); PG8_STAGE(PG8_SA(1, 0), cA + kstep, voffA); PG8_STAGE(PG8_SB(1, 1), cB + hstep + kstep, voffB);
    PG8_WAIT_V(6); PG8_BAR;
    for (;;) {
        const bool has_next = S.next(ui + 1, nxt);
        const char* nA = has_next ? (const char*)(nxt.seg ? g.A2 : g.A) + (size_t)nxt.pm * tstep : cA; const char* nB = has_next ? (const char*)(nxt.seg ? g.Bt2 : g.Bt) + (size_t)nxt.pn * tstep : cB;
        for (int t = 0; t < nt; t += 2) {
            const bool last = (t == nt - 2);
            const char* a1 = cA + (size_t)(t + 1) * kstep;
            const char* a2 = last ? nA : cA + (size_t)(t + 2) * kstep; const char* b2 = last ? nB : cB + (size_t)(t + 2) * kstep;
            const char* a3 = a2 + kstep; const char* b3 = b2 + kstep;
            PG8_LDB(B0, 0, 0); PG8_LDB(B1, 0, 1); PG8_SCHED; PG8_LDA(At, 0, 0); PG8_STAGE(PG8_SA(1, 1), a1 + hstep, voffA);
            PG8_WAIT_V(8); PG8_WAIT_L(0); PG8_BAR; PG8_MMA(0, 0, At, B0); PG8_MMA(0, 1, At, B1); PG8_BAR; PG8_SCHED;
            PG8_LDA(At, 0, 1); PG8_STAGE(PG8_SB(0, 0), b2, voffB); PG8_STAGE(PG8_SB(0, 1), b2 + hstep, voffB); PG8_STAGE(PG8_SA(0, 0), a2, voffA);
            PG8_WAIT_V(8); PG8_WAIT_L(0); PG8_BAR; PG8_MMA(1, 0, At, B0); PG8_MMA(1, 1, At, B1); PG8_BAR; PG8_SCHED;
            PG8_LDB(B0, 1, 0); PG8_LDB(B1, 1, 1); PG8_SCHED; PG8_LDA(At, 1, 0); PG8_STAGE(PG8_SA(0, 1), a2 + hstep, voffA);
            PG8_WAIT_V(8); PG8_WAIT_L(0); PG8_BAR; PG8_MMA(0, 0, At, B0); PG8_MMA(0, 1, At, B1); PG8_BAR; PG8_SCHED;
            PG8_LDA(At, 1, 1); PG8_STAGE(PG8_SB(1, 0), b3, voffB); PG8_STAGE(PG8_SB(1, 1), b3 + hstep, voffB); PG8_STAGE(PG8_SA(1, 0), a3, voffA);
            PG8_WAIT_V(8); PG8_WAIT_L(0); PG8_BAR; PG8_MMA(1, 0, At, B0); PG8_MMA(1, 1, At, B1); PG8_BAR; PG8_SCHED;
        }
        if constexpr (ALIGN_EPI) { if (wr == 0) PG8_BAR; }
        bool keep = false;
        if constexpr (Epi::HAS_MID) keep = (cur.seg == 0);
        if (keep) E.mid(acc, cur, wr, wc, fr, fq); else E(acc, cur, wr, wc, fr, fq);
        if (!has_next) break;
        if (!keep) {
#pragma unroll
            for (int a = 0; a < 2; ++a)
#pragma unroll
                for (int b = 0; b < 2; ++b)
#pragma unroll
                    for (int m = 0; m < 4; ++m)
#pragma unroll
                        for (int n = 0; n < 2; ++n) acc[a][b][m][n] = (f32x4){0.f, 0.f, 0.f, 0.f};
        }
        cur = nxt; cA = nA; cB = nB; ++ui;
        if constexpr (ALIGN_EPI) { if (wr == 1) PG8_BAR; }
    }
    PG8_WAIT_V(0);
    if constexpr (!ALIGN_EPI) { if (wr == 0) PG8_BAR; }
    PG8_BAR;
#undef PG8_SA
#undef PG8_SB
#undef PG8_STAGE
#undef PG8_LDA
#undef PG8_LDB
#undef PG8_MMA
#undef PG8_WAIT_V
#undef PG8_WAIT_L
#undef PG8_BAR
#undef PG8_SCHED
}
}

struct Args {
    const float *x, *meta, *mix_g, *w_in, *ret_g, *q_g, *k_g, *sinks, *w_ret, *w_swa, *w_out, *mlp_g, *w_up, *w_down;
    float* out; unsigned char* ws;
};

__device__ __forceinline__ void p0_transpose_item(const float* W, int K, int N, bf16_t* WT, LAS float* scr, int item, int lane, const float* kgain = nullptr) {
    const int nblk = N / 32, kb = item / nblk, nb = item % nblk, k0 = 64 * kb, n0 = 32 * nb;
    float wv[32];
#pragma unroll
    for (int i = 0; i < 32; ++i) wv[i] = W[(size_t)(k0 + 2 * i + (lane >> 5)) * N + n0 + (lane & 31)];
#pragma unroll
    for (int i = 0; i < 32; ++i) { const int kk = 2 * i + (lane >> 5); float v = wv[i]; if (kgain) v *= kgain[k0 + kk]; scr[kk * 33 + (lane & 31)] = v; }
    asm volatile("s_waitcnt lgkmcnt(0)" ::: "memory");
    const int c = lane & 7;
#pragma unroll
    for (int j = 0; j < 4; ++j) { const int n = (lane >> 3) + 8 * j; const LAS float* s = scr + (8 * c) * 33 + n;
        u32x4 o; o.x = cvt_pk_bf16_asm(s[0 * 33], s[1 * 33]); o.y = cvt_pk_bf16_asm(s[2 * 33], s[3 * 33]); o.z = cvt_pk_bf16_asm(s[4 * 33], s[5 * 33]); o.w = cvt_pk_bf16_asm(s[6 * 33], s[7 * 33]);
        *(u32x4*)(WT + (size_t)(n0 + n) * K + k0 + 8 * c) = o; }
    asm volatile("s_waitcnt lgkmcnt(0)" ::: "memory");
}
__device__ __forceinline__ void rms_row_to_bf16(const float* xrow, const float* g, bf16_t* orow, int lane) {
    const f32x4* xr = (const f32x4*)xrow + lane; const f32x4* gr = (const f32x4*)g + lane;
    f32x4 v[4]; float s = 0.f;
#pragma unroll
    for (int j = 0; j < 4; ++j) { v[j] = xr[64 * j]; s += (v[j].x * v[j].x + v[j].y * v[j].y) + (v[j].z * v[j].z + v[j].w * v[j].w); }
    const float rstd = 1.f / sqrtf(wave_sum(s) * (1.f / DM) + EPS);
    u32x2* o8 = (u32x2*)orow + lane;
#pragma unroll
    for (int j = 0; j < 4; ++j) { const f32x4 gg = gr[64 * j]; u32x2 w; w.x = cvt_pk_bf16_asm(v[j].x * rstd * gg.x, v[j].y * rstd * gg.y); w.y = cvt_pk_bf16_asm(v[j].z * rstd * gg.z, v[j].w * rstd * gg.w); o8[64 * j] = w; }
}

__device__ __forceinline__ void tr_write8(LAS unsigned char* base, int RS, int col0, int pp, u32x4 r0, u32x4 r1) {
#define TRW(i, w0, w1) *(LAS unsigned*)(base + ((size_t)(col0 + (i)) * RS + 2 * pp) * 2) = ((i) & 1) ? (((w0) >> 16) | ((w1) & 0xffff0000u)) : (((w0) & 0xffffu) | ((w1) << 16))
    TRW(0, r0.x, r1.x); TRW(1, r0.x, r1.x); TRW(2, r0.y, r1.y); TRW(3, r0.y, r1.y); TRW(4, r0.z, r1.z); TRW(5, r0.z, r1.z); TRW(6, r0.w, r1.w); TRW(7, r0.w, r1.w);
#undef TRW
}

__device__ __forceinline__ int tr_off(int col, int RS, int slot) { return col * RS * 2 + ((slot ^ (2 * ((col >> 3) & 15))) << 3); }
__device__ __forceinline__ void tr_write8s(LAS unsigned char* base, int RS, int col0, int pp, u32x4 r0, u32x4 r1) {
    const int sw2 = 2 * ((col0 >> 3) & 15), po = (((pp >> 1) ^ sw2) << 3) + ((pp & 1) << 2);
#define TRW(i, w0, w1) *(LAS unsigned*)(base + (col0 + (i)) * RS * 2 + po) = ((i) & 1) ? (((w0) >> 16) | ((w1) & 0xffff0000u)) : (((w0) & 0xffffu) | ((w1) << 16))
    TRW(0, r0.x, r1.x); TRW(1, r0.x, r1.x); TRW(2, r0.y, r1.y); TRW(3, r0.y, r1.y); TRW(4, r0.z, r1.z); TRW(5, r0.z, r1.z); TRW(6, r0.w, r1.w); TRW(7, r0.w, r1.w);
#undef TRW
}
__device__ __forceinline__ u32x4 scale8(u32x4 r, float f) {
    u32x4 o; o.x = cvt_pk_bf16(bf_lo(r.x) * f, bf_hi(r.x) * f); o.y = cvt_pk_bf16(bf_lo(r.y) * f, bf_hi(r.y) * f); o.z = cvt_pk_bf16(bf_lo(r.z) * f, bf_hi(r.z) * f); o.w = cvt_pk_bf16(bf_lo(r.w) * f, bf_hi(r.w) * f); return o;
}
__device__ __forceinline__ bf16x8 as_frag(u32x4 v) { return __builtin_bit_cast(bf16x8, v); }
#define MFMA16(a, b, c) __builtin_amdgcn_mfma_f32_16x16x32_bf16((a), (b), (c), 0, 0, 0)

__device__ __forceinline__ long swa_key_row(int b, int c, int kk) {
    if (kk < 16) return (long)NTOK + kk;
    if (kk < 272) { const int s = (c - 1) * 128 + (kk - 16); if (s >= 128) return (long)b * SEQ + s - 128; }
    return -1;
}
__device__ __forceinline__ void swa_phase(LAS unsigned char* lds, const Args& p) {
    int tid_ = threadIdx.x; asm volatile("" : "+v"(tid_));
    const int tid = tid_, lane = tid & 63, w = __builtin_amdgcn_readfirstlane(tid >> 6), r = lane & 15, q = lane >> 4;
    const bf16_t* SQ = (const bf16_t*)(p.ws + OFF_SQ); const bf16_t* SK = (const bf16_t*)(p.ws + OFF_SK); const bf16_t* SV = (const bf16_t*)(p.ws + OFF_SV);
    bf16_t* YSWA = (bf16_t*)((unsigned char*)p.out + DOUT_YSWA);
    constexpr int KS = 72, VS = 296, K_OFF = 0, VT_OFF = 288 * KS * 2;
    constexpr float LOG2E = 1.4426950408889634f;
    const int kch = tid & 7, G = gridDim.x;
    const f32x4 kg0 = *(const f32x4*)(p.k_g + kch * 8), kg1 = *(const f32x4*)(p.k_g + kch * 8 + 4);
    u32x4 kraw[5], vraw[6];
#define SWA_LOAD_UNIT(uu) do { const int b_ = (uu) >> 8, c_ = 1 + (((uu) & 255) >> 2), kvh_ = (uu) & 3; \
        _Pragma("unroll") for (int it = 0; it < 5; ++it) { const int kk = (it * NTHREADS + tid) >> 3; const long row = swa_key_row(b_, c_, kk); \
            kraw[it] = (u32x4){0u, 0u, 0u, 0u}; if (row >= 0) kraw[it] = *(const u32x4*)(SK + (size_t)row * 256 + kvh_ * 64 + kch * 8); } \
        _Pragma("unroll") for (int it = 0; it < 3; ++it) { const int id = it * NTHREADS + tid, ch = id / 144, pp = id % 144; \
            _Pragma("unroll") for (int e = 0; e < 2; ++e) { const long row = (id < 1152) ? swa_key_row(b_, c_, 2 * pp + e) : -1; \
                vraw[2 * it + e] = (u32x4){0u, 0u, 0u, 0u}; if (row >= 0) vraw[2 * it + e] = *(const u32x4*)(SV + (size_t)row * 256 + kvh_ * 64 + ch * 8); } } } while (0)
    int u = blockIdx.x;
    if (u >= 1024) return;
    SWA_LOAD_UNIT(u);
    for (; u < 1024; u += G) {
        const int b = u >> 8, c = 1 + ((u & 255) >> 2), kvh = u & 3;
        __syncthreads();
#pragma unroll
        for (int it = 0; it < 5; ++it) {
            const int kk = (it * NTHREADS + tid) >> 3; const u32x4 raw = kraw[it];
            const float f0 = bf_lo(raw.x), f1 = bf_hi(raw.x), f2 = bf_lo(raw.y), f3 = bf_hi(raw.y), f4 = bf_lo(raw.z), f5 = bf_hi(raw.z), f6 = bf_lo(raw.w), f7 = bf_hi(raw.w);
            float ss = (f0 * f0 + f1 * f1) + (f2 * f2 + f3 * f3) + (f4 * f4 + f5 * f5) + (f6 * f6 + f7 * f7);
            ss += __shfl_xor(ss, 1); ss += __shfl_xor(ss, 2); ss += __shfl_xor(ss, 4);
            const float rstd = __builtin_amdgcn_rsqf(ss * (1.f / 64.f) + EPS);
            u32x4 o; o.x = cvt_pk_bf16(f0 * rstd * kg0.x, f1 * rstd * kg0.y); o.y = cvt_pk_bf16(f2 * rstd * kg0.z, f3 * rstd * kg0.w);
            o.z = cvt_pk_bf16(f4 * rstd * kg1.x, f5 * rstd * kg1.y); o.w = cvt_pk_bf16(f6 * rstd * kg1.z, f7 * rstd * kg1.w);
            if (kk < 288) *(LAS u32x4*)(lds + K_OFF + (kk * KS + kch * 8) * 2) = o;
        }
#pragma unroll
        for (int it = 0; it < 3; ++it) { const int id = it * NTHREADS + tid; if (id < 1152) tr_write8(lds + VT_OFF, VS, (id / 144) * 8, id % 144, vraw[2 * it], vraw[2 * it + 1]); }
        __syncthreads();
        const int qt = w, iq = 16 * qt + r;
        const size_t qrow = (size_t)b * SEQ + (size_t)(c - 1) * 128 + iq;
        u32x4 qa = *(const u32x4*)(SQ + qrow * 1024 + (kvh * 4) * 64 + 8 * q), qb = *(const u32x4*)(SQ + qrow * 1024 + (kvh * 4) * 64 + 32 + 8 * q);
        { const int un = (u + G < 1024) ? u + G : u; SWA_LOAD_UNIT(un); }
#pragma unroll 1
        for (int hl = 0; hl < 4; ++hl) {
            const int h = kvh * 4 + hl;
            bf16x8 Qf[2];
            {
                const u32x4 a = qa, bq = qb;
                const int hn = kvh * 4 + ((hl + 1) & 3);
                qa = *(const u32x4*)(SQ + qrow * 1024 + hn * 64 + 8 * q); qb = *(const u32x4*)(SQ + qrow * 1024 + hn * 64 + 32 + 8 * q);
                float fa[8] = {bf_lo(a.x), bf_hi(a.x), bf_lo(a.y), bf_hi(a.y), bf_lo(a.z), bf_hi(a.z), bf_lo(a.w), bf_hi(a.w)};
                float fb[8] = {bf_lo(bq.x), bf_hi(bq.x), bf_lo(bq.y), bf_hi(bq.y), bf_lo(bq.z), bf_hi(bq.z), bf_lo(bq.w), bf_hi(bq.w)};
                float ss = 0.f;
#pragma unroll
                for (int e = 0; e < 8; ++e) ss += fa[e] * fa[e] + fb[e] * fb[e];
                ss += __shfl_xor(ss, 16); ss += __shfl_xor(ss, 32);
                const float rs = (0.125f * LOG2E) * __builtin_amdgcn_rsqf(ss * (1.f / 64.f) + EPS);
                const f32x4 ga0 = *(const f32x4*)(p.q_g + 8 * q), ga1 = *(const f32x4*)(p.q_g + 8 * q + 4), gb0 = *(const f32x4*)(p.q_g + 32 + 8 * q), gb1 = *(const f32x4*)(p.q_g + 32 + 8 * q + 4);
                u32x4 oa, ob;
                oa.x = cvt_pk_bf16(fa[0] * rs * ga0.x, fa[1] * rs * ga0.y); oa.y = cvt_pk_bf16(fa[2] * rs * ga0.z, fa[3] * rs * ga0.w); oa.z = cvt_pk_bf16(fa[4] * rs * ga1.x, fa[5] * rs * ga1.y); oa.w = cvt_pk_bf16(fa[6] * rs * ga1.z, fa[7] * rs * ga1.w);
                ob.x = cvt_pk_bf16(fb[0] * rs * gb0.x, fb[1] * rs * gb0.y); ob.y = cvt_pk_bf16(fb[2] * rs * gb0.z, fb[3] * rs * gb0.w); ob.z = cvt_pk_bf16(fb[4] * rs * gb1.x, fb[5] * rs * gb1.y); ob.w = cvt_pk_bf16(fb[6] * rs * gb1.z, fb[7] * rs * gb1.w);
                Qf[0] = as_frag(oa); Qf[1] = as_frag(ob);
            }
            const float slope2 = exp2f(-0.5f * (float)(h + 1)) * LOG2E, sink2 = p.sinks[h] * LOG2E;
            const float bbase = -slope2 * (float)(144 + r - 4 * q), mbase = -slope2 * (float)(c * 128 + iq - 112 - 4 * q);
            const float sl1 = slope2, sl2 = 2.f * slope2, sl3 = 3.f * slope2;
            const int d0 = 144 + r - 4 * q;
            f32x4 sc[10]; float mx = -1e30f;
#pragma unroll
            for (int t = 0; t < 10; ++t) {
                const int kt = (t == 0) ? 0 : qt + t;
                f32x4 acc = (f32x4){0.f, 0.f, 0.f, 0.f};
#pragma unroll
                for (int ks = 0; ks < 2; ++ks) { const bf16x8 a = *(const LAS bf16x8*)(lds + K_OFF + ((16 * kt + r) * KS + 32 * ks + 8 * q) * 2); acc = MFMA16(a, Qf[ks], acc); }
                const float tb = (t == 0) ? mbase : bbase + slope2 * (float)(16 * t) + ((c == 1 && kt <= 8) ? -1e30f : 0.f);
                acc[0] += tb; acc[1] += tb + sl1; acc[2] += tb + sl2; acc[3] += tb + sl3;
                if (t == 1) {
#pragma unroll
                    for (int i = 0; i < 4; ++i) if (d0 - 16 - i >= 128) acc[i] = -1e30f;
                }
                if (t == 9) {
#pragma unroll
                    for (int i = 0; i < 4; ++i) if (d0 - 144 - i < 0) acc[i] = -1e30f;
                }
                mx = fmaxf(fmaxf(mx, fmaxf(acc[0], acc[1])), fmaxf(acc[2], acc[3]));
                sc[t] = acc;
                if (t == 4) __builtin_amdgcn_sched_barrier(0);
            }
            mx = fmaxf(mx, __shfl_xor(mx, 16)); mx = fmaxf(mx, __shfl_xor(mx, 32)); mx = fmaxf(mx, sink2);
            float sum = 0.f; u32x2 Pk[10];
#pragma unroll
            for (int t = 0; t < 10; ++t) { const float p0 = __builtin_amdgcn_exp2f(sc[t][0] - mx), p1 = __builtin_amdgcn_exp2f(sc[t][1] - mx), p2 = __builtin_amdgcn_exp2f(sc[t][2] - mx), p3 = __builtin_amdgcn_exp2f(sc[t][3] - mx);
                sum += (p0 + p1) + (p2 + p3); Pk[t].x = cvt_pk_bf16(p0, p1); Pk[t].y = cvt_pk_bf16(p2, p3); }
            sum += __shfl_xor(sum, 16); sum += __shfl_xor(sum, 32);
            const float inv = __builtin_amdgcn_rcpf(sum + __builtin_amdgcn_exp2f(sink2 - mx));
#pragma unroll 2
            for (int dt = 0; dt < 4; ++dt) {
                f32x4 acc = (f32x4){0.f, 0.f, 0.f, 0.f};
#pragma unroll
                for (int pr = 0; pr < 5; ++pr) {
                    const int t0 = 2 * pr, t1 = 2 * pr + 1, kt0 = (t0 == 0) ? 0 : qt + t0, kt1 = qt + t1;
                    const LAS unsigned char* vp = lds + VT_OFF + ((16 * dt + r) * VS + 4 * q) * 2;
                    const u32x2 a0 = *(const LAS u32x2*)(vp + 32 * kt0), a1 = *(const LAS u32x2*)(vp + 32 * kt1);
                    const u32x4 a = (u32x4){a0.x, a0.y, a1.x, a1.y}, bb = (u32x4){Pk[t0].x, Pk[t0].y, Pk[t1].x, Pk[t1].y};
                    acc = MFMA16(as_frag(a), as_frag(bb), acc);
                }
                u32x2 o; o.x = cvt_pk_bf16(acc[0] * inv, acc[1] * inv); o.y = cvt_pk_bf16(acc[2] * inv, acc[3] * inv);
                *(u32x2*)(YSWA + qrow * 1024 + h * 64 + 16 * dt + 4 * q) = o;
            }
        }
    }
#undef SWA_LOAD_UNIT
}

__device__ __forceinline__ size_t kvs_slot(int b, int n, int h) { return ((size_t)((b * 64 + n) * 4 + h)) * 32768; }
__device__ __forceinline__ void kvlocal_phase(LAS unsigned char* lds, const Args& p) {
    int tid_ = threadIdx.x; asm volatile("" : "+v"(tid_));
    const int tid = tid_, lane = tid & 63, w = __builtin_amdgcn_readfirstlane(tid >> 6), r = lane & 15, q = lane >> 4;
    const bf16_t* RK = (const bf16_t*)(p.ws + OFF_RK); const bf16_t* RV = (const bf16_t*)(p.ws + OFF_RV);
    bf16_t* KVS = (bf16_t*)((unsigned char*)p.out + DOUT_KVS);
    constexpr int RS = 136, KT_OFF = 0, VT_OFF = 128 * RS * 2;
    u32x4 kr[2][2], vr[4][2];
#define KV_LOAD_UNIT(uu) do { const int b_ = (uu) >> 8, n_ = ((uu) & 255) >> 2, h_ = (uu) & 3; \
        _Pragma("unroll") for (int it = 0; it < 2; ++it) { const int id = it * NTHREADS + tid, ch = id & 15, pr = id >> 4; \
            _Pragma("unroll") for (int e = 0; e < 2; ++e) { const int i = 2 * pr + e; long row; \
                if (n_ == 0) row = (i < 112) ? -1 : (long)NTOK + i - 112; else row = (long)b_ * SEQ + (n_ - 1) * 128 + i; \
                kr[it][e] = (u32x4){0u, 0u, 0u, 0u}; if (row >= 0) kr[it][e] = *(const u32x4*)(RK + (size_t)row * 512 + h_ * 128 + ch * 8); } } \
        _Pragma("unroll") for (int it = 0; it < 4; ++it) { const int id = it * NTHREADS + tid, ch = id & 31, pr = id >> 5; \
            _Pragma("unroll") for (int e = 0; e < 2; ++e) { const int i = 2 * pr + e; long row; \
                if (n_ == 0) row = (i < 112) ? -1 : (long)NTOK + i - 112; else row = (long)b_ * SEQ + (n_ - 1) * 128 + i; \
                vr[it][e] = (u32x4){0u, 0u, 0u, 0u}; if (row >= 0) vr[it][e] = *(const u32x4*)(RV + (size_t)row * 1024 + h_ * 256 + ch * 8); } } } while (0)
    int u = blockIdx.x;
    if (u >= 1024) return;
    const int G = gridDim.x;
    KV_LOAD_UNIT(u);
    for (; u < 1024; u += G) {
        const int b = u >> 8, n = (u & 255) >> 2, h = u & 3;
        const float lg2 = log2f(1.0f - exp2f(-5.0f - (float)h));
        __syncthreads();
#pragma unroll
        for (int it = 0; it < 2; ++it) { const int id = it * NTHREADS + tid, ch = id & 15, pr = id >> 4;
            const float f0 = 0.08838834764831845f * __builtin_amdgcn_exp2f(lg2 * (float)(127 - 2 * pr)), f1 = 0.08838834764831845f * __builtin_amdgcn_exp2f(lg2 * (float)(126 - 2 * pr));
            tr_write8s(lds + KT_OFF, RS, ch * 8, pr, scale8(kr[it][0], f0), scale8(kr[it][1], f1)); }
#pragma unroll
        for (int it = 0; it < 4; ++it) { const int id = it * NTHREADS + tid, ch = id & 31, pr = id >> 5;
            tr_write8s(lds + VT_OFF, RS, ch * 8, pr, vr[it][0], vr[it][1]); }
        __syncthreads();
        { const int un = (u + G < 1024) ? u + G : u; KV_LOAD_UNIT(un); }
        const int mt = w;
        bf16x8 a[4];
#pragma unroll
        for (int ks = 0; ks < 4; ++ks) a[ks] = *(const LAS bf16x8*)(lds + KT_OFF + tr_off(16 * mt + r, RS, 8 * ks + 2 * q));
        bf16_t* dst = KVS + kvs_slot(b, n, h);
#pragma unroll 4
        for (int nt = 0; nt < 16; ++nt) {
            f32x4 acc = (f32x4){0.f, 0.f, 0.f, 0.f};
#pragma unroll
            for (int ks = 0; ks < 4; ++ks) { const bf16x8 bb = *(const LAS bf16x8*)(lds + VT_OFF + tr_off(16 * nt + r, RS, 8 * ks + 2 * q)); acc = MFMA16(a[ks], bb, acc); }
            u32x2 o; o.x = cvt_pk_bf16(acc[0], acc[1]); o.y = cvt_pk_bf16(acc[2], acc[3]);
            *(u32x2*)(dst + (size_t)(16 * nt + r) * 128 + 16 * mt + 4 * q) = o;
        }
    }
#undef KV_LOAD_UNIT
}

__device__ __forceinline__ void scan_phase(const Args& p) {
    bf16_t* KVS = (bf16_t*)((unsigned char*)p.out + DOUT_KVS);
    for (int gid = blockIdx.x * NTHREADS + threadIdx.x; gid < 16 * 8192; gid += gridDim.x * NTHREADS) {
        const int bh = gid >> 13, b = bh >> 2, h = bh & 3, off = (gid & 8191) * 4;
        const float dec = exp2f(128.0f * log2f(1.0f - exp2f(-5.0f - (float)h)));
        float s0 = 0.f, s1 = 0.f, s2 = 0.f, s3 = 0.f;
        bf16_t* base = KVS + kvs_slot(b, 0, h) + off;
        for (int n0 = 0; n0 < 64; n0 += 16) {
            u32x2 v[16];
#pragma unroll
            for (int j = 0; j < 16; ++j) v[j] = *(const u32x2*)(base + (size_t)(n0 + j) * 4 * 32768);
#pragma unroll
            for (int j = 0; j < 16; ++j) {
                s0 = dec * s0 + bf_lo(v[j].x); s1 = dec * s1 + bf_hi(v[j].x); s2 = dec * s2 + bf_lo(v[j].y); s3 = dec * s3 + bf_hi(v[j].y);
                u32x2 o; o.x = cvt_pk_bf16(s0, s1); o.y = cvt_pk_bf16(s2, s3);
                *(u32x2*)(base + (size_t)(n0 + j) * 4 * 32768) = o;
            }
        }
    }
}

__device__ __forceinline__ void retout_phase(LAS unsigned char* lds, const Args& p) {
    int tid_ = threadIdx.x; asm volatile("" : "+v"(tid_));
    const int tid = tid_, lane = tid & 63, w = __builtin_amdgcn_readfirstlane(tid >> 6), r = lane & 15, q = lane >> 4;
    const bf16_t* RQ = (const bf16_t*)(p.ws + OFF_RQ); const bf16_t* RK = (const bf16_t*)(p.ws + OFF_RK); const bf16_t* RV = (const bf16_t*)(p.ws + OFF_RV); const bf16_t* RG = (const bf16_t*)(p.ws + OFF_RG);
    const bf16_t* KVS = (const bf16_t*)((unsigned char*)p.out + DOUT_KVS);
    bf16_t* YRET = (bf16_t*)(p.ws + OFF_YRET);
    constexpr int RS = 136, K_OFF = 0, SB = 128 * RS * 2, QSZ = 64 * RS * 2;
    const int G = gridDim.x, vch = tid & 7, vpr = tid >> 3, srow = tid >> 4, sch = tid & 15;
    const LAS unsigned char* vlb = lds + SB + r * RS * 2 + ((q ^ (2 * (r >> 3))) << 3);
    u32x4 kreg[4], vreg[2], sreg[2], qn[4];
#define RO_LOAD_KQ(uu) do { const int b_ = (uu) >> 8, c_ = 1 + (((uu) & 255) >> 2), h_ = (uu) & 3; const size_t tb_ = (size_t)b_ * SEQ + (size_t)(c_ - 1) * 128; \
        _Pragma("unroll") for (int it = 0; it < 4; ++it) kreg[it] = *(const u32x4*)(RK + (tb_ + 32 * it + srow) * 512 + h_ * 128 + sch * 8); } while (0)
#define RO_LOAD_Q(uu) do { const int b_ = (uu) >> 8, c_ = 1 + (((uu) & 255) >> 2), h_ = (uu) & 3; const size_t tb_ = (size_t)b_ * SEQ + (size_t)(c_ - 1) * 128; \
        _Pragma("unroll") for (int ks = 0; ks < 4; ++ks) qn[ks] = *(const u32x4*)(RQ + (tb_ + 16 * w + r) * 512 + h_ * 128 + 32 * ks + 8 * q); } while (0)
#define RO_LOAD_STAGE(uu, sg) do { const int b_ = (uu) >> 8, c_ = 1 + (((uu) & 255) >> 2), h_ = (uu) & 3; const size_t tb_ = (size_t)b_ * SEQ + (size_t)(c_ - 1) * 128; \
        const bf16_t* st_ = KVS + kvs_slot(b_, c_ - 1, h_) + (size_t)(64 * (sg)) * 128; \
        vreg[0] = *(const u32x4*)(RV + (tb_ + 2 * vpr) * 1024 + h_ * 256 + 64 * (sg) + vch * 8); vreg[1] = *(const u32x4*)(RV + (tb_ + 2 * vpr + 1) * 1024 + h_ * 256 + 64 * (sg) + vch * 8); \
        sreg[0] = *(const u32x4*)(st_ + (size_t)srow * 128 + sch * 8); sreg[1] = *(const u32x4*)(st_ + (size_t)(32 + srow) * 128 + sch * 8); } while (0)
#define RO_WRITE_K() do { _Pragma("unroll") for (int it = 0; it < 4; ++it) *(LAS u32x4*)(lds + K_OFF + ((32 * it + srow) * RS + sch * 8) * 2) = kreg[it]; } while (0)
#define RO_WRITE_STAGE(j) do { tr_write8s(lds + SB + 2 * (j) * QSZ, RS, vch * 8, vpr, vreg[0], vreg[1]); \
        *(LAS u32x4*)(lds + SB + (2 * (j) + 1) * QSZ + (srow * RS + sch * 8) * 2) = sreg[0]; *(LAS u32x4*)(lds + SB + (2 * (j) + 1) * QSZ + ((32 + srow) * RS + sch * 8) * 2) = sreg[1]; } while (0)
    int u = blockIdx.x;
    if (u >= 1024) return;
    RO_LOAD_KQ(u); RO_LOAD_Q(u); RO_LOAD_STAGE(u, 0);
    __syncthreads();
    RO_WRITE_K(); RO_WRITE_STAGE(0);
    __syncthreads();
    for (; u < 1024; u += G) {
        const int b = u >> 8, c = 1 + ((u & 255) >> 2), h = u & 3, un = (u + G < 1024) ? u + G : u;
        const size_t tokbase = (size_t)b * SEQ + (size_t)(c - 1) * 128;
        const float lg2 = log2f(1.0f - exp2f(-5.0f - (float)h));
        const int iq = 16 * w + r; const size_t qrow = tokbase + iq;
        bf16x8 Qd[4]; u32x2 Pk[8]; f32x4 o[16];
        {
#pragma unroll
            for (int kt = 0; kt < 8; ++kt) {
                {
                    f32x4 acc = (f32x4){0.f, 0.f, 0.f, 0.f};
#pragma unroll
                    for (int ks = 0; ks < 4; ++ks) { const bf16x8 a = *(const LAS bf16x8*)(lds + K_OFF + ((16 * kt + r) * RS + 32 * ks + 8 * q) * 2); acc = MFMA16(a, as_frag(qn[ks]), acc); }
#pragma unroll
                    for (int i = 0; i < 4; ++i) { const int d = iq - (16 * kt + 4 * q + i); acc[i] = (d >= 0) ? acc[i] * 0.08838834764831845f * __builtin_amdgcn_exp2f(lg2 * (float)d) : 0.f; }
                    Pk[kt].x = cvt_pk_bf16(acc[0], acc[1]); Pk[kt].y = cvt_pk_bf16(acc[2], acc[3]);
                }
                if (kt & 1) __builtin_amdgcn_sched_barrier(0);
            }
            const float qdec = __builtin_amdgcn_exp2f(lg2 * (float)(iq + 1));
#pragma unroll
            for (int ks = 0; ks < 4; ++ks) Qd[ks] = as_frag(scale8(qn[ks], qdec));
        }
#pragma unroll
        for (int sg = 0; sg < 4; ++sg) {
            if (sg < 3) RO_LOAD_STAGE(u, sg + 1); else { RO_LOAD_KQ(un); RO_LOAD_STAGE(un, 0); }
            const int bo = 2 * (sg & 1) * QSZ;
#pragma unroll
            for (int j = 0; j < 4; ++j) {
                f32x4 acc = (f32x4){0.f, 0.f, 0.f, 0.f};
#pragma unroll
                for (int ks = 0; ks < 4; ++ks) { const bf16x8 a = *(const LAS bf16x8*)(lds + SB + bo + QSZ + ((16 * j + r) * RS + 32 * ks + 8 * q) * 2); acc = MFMA16(a, Qd[ks], acc); }
#pragma unroll
                for (int kp = 0; kp < 4; ++kp) {
                    {
                        const u32x2 a0 = *(const LAS u32x2*)(vlb + bo + 16 * j * RS * 2 + ((((kp ^ (j >> 1)) << 3) | ((0 ^ (j & 1)) << 2)) << 3));
                        const u32x2 a1 = *(const LAS u32x2*)(vlb + bo + 16 * j * RS * 2 + ((((kp ^ (j >> 1)) << 3) | ((1 ^ (j & 1)) << 2)) << 3));
                        const u32x4 a = (u32x4){a0.x, a0.y, a1.x, a1.y}, bb = (u32x4){Pk[2 * kp].x, Pk[2 * kp].y, Pk[2 * kp + 1].x, Pk[2 * kp + 1].y};
                        acc = MFMA16(as_frag(a), as_frag(bb), acc);
                    }
                }
                o[sg * 4 + j] = acc;
                if (j & 1) __builtin_amdgcn_sched_barrier(0);
            }
            if (sg == 3) RO_WRITE_K();
            RO_WRITE_STAGE((sg + 1) & 1);
            __syncthreads();
        }
        RO_LOAD_Q(un);
        float ss = 0.f;
#pragma unroll
        for (int t = 0; t < 16; ++t) ss += (o[t][0] * o[t][0] + o[t][1] * o[t][1]) + (o[t][2] * o[t][2] + o[t][3] * o[t][3]);
        ss += __shfl_xor(ss, 16); ss += __shfl_xor(ss, 32);
        const float rstd = 1.f / sqrtf(ss * (1.f / 256.f) + EPS);
#pragma unroll
        for (int t = 0; t < 16; ++t) {
            const int dv = 16 * t + 4 * q;
            const f32x4 g = *(const f32x4*)(p.ret_g + h * 256 + dv);
            const u32x2 gg = *(const u32x2*)(RG + qrow * 1024 + h * 256 + dv);
            const float x0 = bf_lo(gg.x), x1 = bf_hi(gg.x), x2 = bf_lo(gg.y), x3 = bf_hi(gg.y);
            u32x2 ov; ov.x = cvt_pk_bf16(o[t][0] * rstd * g.x * x0 * sigmoidf_(x0), o[t][1] * rstd * g.y * x1 * sigmoidf_(x1));
            ov.y = cvt_pk_bf16(o[t][2] * rstd * g.z * x2 * sigmoidf_(x2), o[t][3] * rstd * g.w * x3 * sigmoidf_(x3));
            *(u32x2*)(YRET + qrow * 1024 + h * 256 + dv) = ov;
        }
    }
#undef RO_LOAD_KQ
#undef RO_LOAD_Q
#undef RO_LOAD_STAGE
#undef RO_WRITE_K
#undef RO_WRITE_STAGE
}

__device__ __forceinline__ void meta_proj(const Args& p, const bf16_t* XN, const bf16_t* WinT) {
    int tid_ = threadIdx.x; asm volatile("" : "+v"(tid_));
    const int tid = tid_, lane = tid & 63, r = lane & 15, q = lane >> 4;
    if ((tid >> 6) != 0) return;
    for (int t = blockIdx.x; t < 128; t += gridDim.x) {
        int ncol, ld, cl; size_t boff;
        if (t < 32) { ncol = 512 + 16 * t; boff = OFF_RK; ld = 512; cl = 16 * t; }
        else if (t < 96) { ncol = 1024 + 16 * (t - 32); boff = OFF_RV; ld = 1024; cl = 16 * (t - 32); }
        else if (t < 112) { ncol = 4096 + 16 * (t - 96); boff = OFF_SK; ld = 256; cl = 16 * (t - 96); }
        else { ncol = 4352 + 16 * (t - 112); boff = OFF_SV; ld = 256; cl = 16 * (t - 112); }
        const bf16_t* ap = WinT + (size_t)(ncol + r) * DM + 8 * q; const bf16_t* bp = XN + (size_t)(NTOK + r) * DM + 8 * q;
        f32x4 acc = (f32x4){0.f, 0.f, 0.f, 0.f};
#pragma unroll 8
        for (int ks = 0; ks < 32; ++ks) { const u32x4 a = *(const u32x4*)(ap + 32 * ks), b = *(const u32x4*)(bp + 32 * ks); acc = MFMA16(as_frag(a), as_frag(b), acc); }
        const float rs = ((const float*)(p.ws + OFF_RSTD))[NTOK + r];
        u32x2 o; o.x = cvt_pk_bf16(acc[0] * rs, acc[1] * rs); o.y = cvt_pk_bf16(acc[2] * rs, acc[3] * rs);
        *(u32x2*)((bf16_t*)(p.ws + boff) + (size_t)(NTOK + r) * ld + cl + 4 * q) = o;
    }
}

#define XB_TMO      128
#define XB_XCNT(j)  (256  + 64 * (j))
#define XB_XSUB(j)  (1280 + 64 * (j))
#define XB_XGEN(j)  (2304 + 64 * (j))
#define XB_TOP      3328
#define XB_TOPGEN   3392
#define XCD_BAR_WORDS 3456
#define XB_SPIN_CAP (1u << 22)
__device__ __forceinline__ unsigned xb_ld(unsigned* p)              { return __hip_atomic_load(p, __ATOMIC_RELAXED, __HIP_MEMORY_SCOPE_AGENT); }
__device__ __forceinline__ unsigned xb_add(unsigned* p, unsigned v) { return __hip_atomic_fetch_add(p, v, __ATOMIC_RELAXED, __HIP_MEMORY_SCOPE_AGENT); }
__device__ __forceinline__ unsigned xb_xcc_id() { return (unsigned)__builtin_amdgcn_s_getreg((3 << 11) | 20) & 0xFu; }
#define XB_SPIN(cond, bar) do { unsigned _sp = 0; while (cond) { __builtin_amdgcn_s_sleep(1); \
    if ((++_sp & 255u) == 0u) { if (xb_ld(&(bar)[XB_TMO])) break; if (_sp > XB_SPIN_CAP) { atomicAdd(&(bar)[XB_TMO], 1u); break; } } } } while (0)
struct XcdBarrier { unsigned* bar; unsigned x; volatile LAS unsigned* st; };
__device__ __forceinline__ XcdBarrier xcd_barrier_post(unsigned* bar, volatile LAS unsigned* st) {
    XcdBarrier b; b.bar = bar; b.x = xb_xcc_id(); b.st = st;
    if (threadIdx.x == 0) (void)xb_add(&bar[XB_XCNT(b.x)], 1u);
    return b;
}
__device__ __forceinline__ void xcd_barrier_complete(unsigned* bar, unsigned x, unsigned& nloc, unsigned& nx) {
    const unsigned G = gridDim.x * gridDim.y * gridDim.z;
    unsigned sum, cnt, mine, sp = 0u;
    for (;;) {
        sum = 0u; cnt = 0u; mine = 0u;
#pragma unroll
        for (unsigned j = 0; j < 16; ++j) { const unsigned c = xb_ld(&bar[XB_XCNT(j)]); sum += c; cnt += (c > 0u) ? 1u : 0u; mine = (j == x) ? c : mine; }
        if (sum == G) break;
        __builtin_amdgcn_s_sleep(1);
        if ((++sp & 255u) == 0u) { if (xb_ld(&bar[XB_TMO])) break; if (sp > XB_SPIN_CAP) { atomicAdd(&bar[XB_TMO], 1u); break; } }
    }
    nloc = mine > 0u ? mine : 1u; nx = cnt > 0u ? cnt : 1u;
}
__device__ __forceinline__ void xcd_barrier(const XcdBarrier& b) {
    asm volatile("s_waitcnt vmcnt(0)" ::: "memory");
    __syncthreads();
    if (threadIdx.x == 0) {
        unsigned* bar = b.bar;
        __builtin_amdgcn_s_waitcnt(0);
        unsigned nloc = b.st[0], nx = b.st[1];
        if (nloc == 0u) { xcd_barrier_complete(bar, b.x, nloc, nx); b.st[0] = nloc; b.st[1] = nx; }
        const unsigned old = xb_add(&bar[XB_XSUB(b.x)], 1u);
        const unsigned gen = old / nloc;
        if (old + 1u == (gen + 1u) * nloc) {
            __builtin_amdgcn_fence(__ATOMIC_RELEASE, "agent");
            asm volatile("s_waitcnt vmcnt(0)" ::: "memory");
            const unsigned og = xb_add(&bar[XB_TOP], 1u);
            const unsigned tg = og / nx;
            if (og + 1u == (tg + 1u) * nx) xb_add(&bar[XB_TOPGEN], 1u);
            else XB_SPIN(xb_ld(&bar[XB_TOPGEN]) == tg, bar);
            __builtin_amdgcn_fence(__ATOMIC_ACQUIRE, "agent");
            xb_add(&bar[XB_XGEN(b.x)], 1u);
            asm volatile("s_waitcnt vmcnt(0)" ::: "memory");
        } else {
            XB_SPIN(xb_ld(&bar[XB_XGEN(b.x)]) == gen, bar);
            __builtin_amdgcn_fence(__ATOMIC_ACQUIRE, "agent");
            asm volatile("s_waitcnt vmcnt(0)" ::: "memory");
        }
    }
    __syncthreads();
}

__device__ __forceinline__ void convert_slot(const Args& p, LAS unsigned char* lds, const int list) {
    const unsigned grp = (blockIdx.x >> 3) & 3u;
    if (grp == 0u) return;
    int tid_ = threadIdx.x; asm volatile("" : "+v"(tid_));
    const int tid = tid_, lane = tid & 63, wave = __builtin_amdgcn_readfirstlane(tid >> 6);
    constexpr int I_SQ = (DM / 64) * (DM / 32), I_UP = (DM / 64) * (FF / 32), I_DN = (FF / 64) * (DM / 32);
    const int total = list == 0 ? 3 * I_SQ + I_UP : I_DN;
    const int lo = grp == 1u ? 0 : (grp == 2u ? total / 6 : total / 2), hi = grp == 1u ? total / 6 : (grp == 2u ? total / 2 : total);
    const int j = (int)(((blockIdx.x >> 5) << 3) | (blockIdx.x & 7u));
    LAS float* scr = (LAS float*)(lds + wave * 16384);
    unsigned char* ws = p.ws;
    for (int it = lo + j * 8 + wave; it < hi; it += 512) {
        if (list == 0) {
            int r = it;
            if (r < I_SQ) { p0_transpose_item(p.w_ret, DM, DM, (bf16_t*)(ws + OFF_WRET), scr, r, lane); continue; } r -= I_SQ;
            if (r < I_SQ) { p0_transpose_item(p.w_swa, DM, DM, (bf16_t*)(ws + OFF_WSWA), scr, r, lane); continue; } r -= I_SQ;
            if (r < I_SQ) { p0_transpose_item(p.w_out, DM, DM, (bf16_t*)(ws + OFF_WOUT), scr, r, lane); continue; } r -= I_SQ;
            p0_transpose_item(p.w_up, DM, FF, (bf16_t*)(ws + OFF_WUP), scr, r, lane, p.mlp_g);
        } else p0_transpose_item(p.w_down, FF, DM, (bf16_t*)(ws + OFF_WDN), scr, it, lane);
    }
    __syncthreads();
}

__global__ void __launch_bounds__(NTHREADS, 2) fwd_megakernel(Args p) {
    extern __shared__ __attribute__((aligned(16))) unsigned char lds_raw[];
    LAS unsigned char* lds = (LAS unsigned char*)lds_raw;
    cg::grid_group grid = cg::this_grid();
    ((LAS unsigned*)(lds + 131072 + 64))[threadIdx.x & 15] = 0u;
    __syncthreads();
    XcdBarrier xbar = xcd_barrier_post((unsigned*)(p.ws + OFF_CTL), (volatile LAS unsigned*)(lds + 131072 + 64));
    grid.sync();
#define GRID_SYNC() xcd_barrier(xbar)
    const int tid = threadIdx.x, lane = tid & 63, wave = __builtin_amdgcn_readfirstlane(tid >> 6);
    const int G = gridDim.x, gw = blockIdx.x * 8 + wave, NGW = G * 8;
    unsigned char* ws = p.ws;
    bf16_t* WinT = (bf16_t*)(ws + OFF_WIN); bf16_t* WretT = (bf16_t*)(ws + OFF_WRET); bf16_t* WswaT = (bf16_t*)(ws + OFF_WSWA); bf16_t* WoutT = (bf16_t*)(ws + OFF_WOUT);
    bf16_t* WupT = (bf16_t*)(ws + OFF_WUP); bf16_t* WdnT = (bf16_t*)(ws + OFF_WDN);
    bf16_t* XN = (bf16_t*)(ws + OFF_XR);
    float* RSTD = (float*)(ws + OFF_RSTD);

    for (int rep = 0; rep < 1 + ((REP_MASK >> 0) & 1); ++rep) {
        LAS float* scr = (LAS float*)(lds + wave * 16384);
        constexpr int I_IN = (DM / 64) * (DIN / 32), I_SQ = (DM / 64) * (DM / 32), I_UP = (DM / 64) * (FF / 32), I_DN = (FF / 64) * (DM / 32);
        constexpr int NITEMS = I_IN + 3 * I_SQ + I_UP + I_DN;
        const bool split = (G == 256);
        for (int it = gw; it < (split ? I_IN : NITEMS); it += NGW) {
            int r = it;
            if (r < I_IN) { p0_transpose_item(p.w_in, DM, DIN, WinT, scr, r, lane, p.mix_g); continue; } r -= I_IN;
            if (r < I_SQ) { p0_transpose_item(p.w_ret, DM, DM, WretT, scr, r, lane); continue; } r -= I_SQ;
            if (r < I_SQ) { p0_transpose_item(p.w_swa, DM, DM, WswaT, scr, r, lane); continue; } r -= I_SQ;
            if (r < I_SQ) { p0_transpose_item(p.w_out, DM, DM, WoutT, scr, r, lane); continue; } r -= I_SQ;
            if (r < I_UP) { p0_transpose_item(p.w_up, DM, FF, WupT, scr, r, lane, p.mlp_g); continue; } r -= I_UP;
            p0_transpose_item(p.w_down, FF, DM, WdnT, scr, r, lane);
        }
        for (int m = gw; m < NTOK; m += 2 * NGW) {
            const int m2 = m + NGW;
            const f32x4* xa = (const f32x4*)(p.x + (size_t)m * DM) + lane; const f32x4* xb = (const f32x4*)(p.x + (size_t)(m2 < NTOK ? m2 : m) * DM) + lane; const f32x4* gr = (const f32x4*)p.mix_g + lane;
            f32x4 va[4], vb[4]; float sa = 0.f, sb = 0.f;
#pragma unroll
            for (int j = 0; j < 4; ++j) { va[j] = xa[64 * j]; vb[j] = xb[64 * j]; }
#pragma unroll
            for (int j = 0; j < 4; ++j) { sa += (va[j].x * va[j].x + va[j].y * va[j].y) + (va[j].z * va[j].z + va[j].w * va[j].w); sb += (vb[j].x * vb[j].x + vb[j].y * vb[j].y) + (vb[j].z * vb[j].z + vb[j].w * vb[j].w); }
            const float ra = 1.f / sqrtf(wave_sum(sa) * (1.f / DM) + EPS), rb = 1.f / sqrtf(wave_sum(sb) * (1.f / DM) + EPS);
            u32x2* oa = (u32x2*)(XN + (size_t)m * DM) + lane; u32x2* ob = (u32x2*)(XN + (size_t)m2 * DM) + lane;
            if (lane == 0) { RSTD[m] = ra; if (m2 < NTOK) RSTD[m2] = rb; }
#pragma unroll
            for (int j = 0; j < 4; ++j) {
                u32x2 wa; wa.x = cvt_pk_bf16_asm(va[j].x, va[j].y); wa.y = cvt_pk_bf16_asm(va[j].z, va[j].w); oa[64 * j] = wa;
                if (m2 < NTOK) { u32x2 wb; wb.x = cvt_pk_bf16_asm(vb[j].x, vb[j].y); wb.y = cvt_pk_bf16_asm(vb[j].z, vb[j].w); ob[64 * j] = wb; } }
        }
        if (gw < NMETA) {
            const f32x4* xa = (const f32x4*)(p.meta + (size_t)gw * DM) + lane; f32x4 va[4]; float sa = 0.f;
#pragma unroll
            for (int j = 0; j < 4; ++j) { va[j] = xa[64 * j]; sa += (va[j].x * va[j].x + va[j].y * va[j].y) + (va[j].z * va[j].z + va[j].w * va[j].w); }
            const float ra = 1.f / sqrtf(wave_sum(sa) * (1.f / DM) + EPS);
            if (lane == 0) RSTD[NTOK + gw] = ra;
            u32x2* oa = (u32x2*)(XN + (size_t)(NTOK + gw) * DM) + lane;
#pragma unroll
            for (int j = 0; j < 4; ++j) { u32x2 wa; wa.x = cvt_pk_bf16_asm(va[j].x, va[j].y); wa.y = cvt_pk_bf16_asm(va[j].z, va[j].w); oa[64 * j] = wa; }
        }
    }
    GRID_SYNC();
    {
        meta_proj(p, XN, WinT);
        if (G == 256) convert_slot(p, lds, 0);
        pg8::Gemm g{XN, WinT, XN, WinT, NTOK, DIN, DM}; pg8::StaticOrder S; S.init(NTOK, DIN, G, (int)blockIdx.x);
        pg8::EpiProj E{ws, (const float*)(ws + OFF_RSTD)};
        pg8::gemm_phase<pg8::EpiProj, pg8::StaticOrder, true>(lds, g, S, E);
    }
    GRID_SYNC();
    for (int rep = 0; rep < 1 + ((REP_MASK >> 1) & 1); ++rep) { swa_phase(lds, p); kvlocal_phase(lds, p); }
    GRID_SYNC();
    scan_phase(p);
    GRID_SYNC();
    for (int rep = 0; rep < 1 + ((REP_MASK >> 2) & 1); ++rep) retout_phase(lds, p);
    GRID_SYNC();
    {
        const bf16_t* YRET = (const bf16_t*)(ws + OFF_YRET); const bf16_t* YSWA = (const bf16_t*)((unsigned char*)p.out + DOUT_YSWA);
        pg8::Gemm g{YRET, WretT, YSWA, WswaT, NTOK, DM, DM}; pg8::PairOrder S; S.s.init(NTOK, DM, G, (int)blockIdx.x);
        pg8::EpiMerged E{(const unsigned char*)(ws + OFF_GR), (const unsigned char*)(ws + OFF_GS), (bf16_t*)(ws + OFF_MERGED)};
        pg8::gemm_phase<pg8::EpiMerged, pg8::PairOrder, true>(lds, g, S, E);
    }
    GRID_SYNC();
    {
        const bf16_t* MG = (const bf16_t*)(ws + OFF_MERGED);
        pg8::Gemm g{MG, WoutT, MG, WoutT, NTOK, DM, DM}; pg8::StaticOrder S; S.init(NTOK, DM, G, (int)blockIdx.x);
        pg8::EpiResStat E{(const bf16_t*)(ws + OFF_XR), p.out, (bf16_t*)(ws + OFF_HN2), (float*)(ws + OFF_SS)};
        pg8::gemm_phase<pg8::EpiResStat, pg8::StaticOrder, true>(lds, g, S, E);
    }
    GRID_SYNC();
    {
        const bf16_t* HN2 = (const bf16_t*)(ws + OFF_HN2);
        pg8::Gemm g{HN2, WupT, HN2, WupT, NTOK, FF, DM}; pg8::StaticOrder S; S.init(NTOK, FF, G, (int)blockIdx.x);
        pg8::EpiUp E{(bf16_t*)(ws + OFF_U), (const float*)(ws + OFF_SS)};
        if (G == 256) convert_slot(p, lds, 1);
        pg8::gemm_phase<pg8::EpiUp, pg8::StaticOrder, true>(lds, g, S, E);
    }
    GRID_SYNC();
    {
        const bf16_t* U = (const bf16_t*)(ws + OFF_U);
        pg8::Gemm g{U, WdnT, U, WdnT, NTOK, DM, FF}; pg8::StaticOrder S; S.init(NTOK, DM, G, (int)blockIdx.x);
        pg8::EpiResBf E{(const bf16_t*)(ws + OFF_HN2), p.out};
        pg8::gemm_phase<pg8::EpiResBf, pg8::StaticOrder, true>(lds, g, S, E);
    }
}

extern "C" void kernel_launch(void* const* d_in, const int* in_sizes, int n_in, void* d_out, int out_size, void* d_ws, size_t ws_size, hipStream_t stream) {
    static int grid = 0;
    if (grid == 0) {
        if (n_in != 14 || in_sizes[0] != NTOK * DM || out_size != NTOK * DM || ws_size < WS_NEED) {
            fprintf(stderr, "kernel_launch: unexpected shapes (n_in %d, in0 %d, out %d, ws %zu, need %zu); nothing launched\n", n_in, n_in > 0 ? in_sizes[0] : -1, out_size, ws_size, (size_t)WS_NEED); grid = -1; return; }
        int dev = 0, cus = 0, per_cu = 0;
        (void)hipGetDevice(&dev); (void)hipDeviceGetAttribute(&cus, hipDeviceAttributeMultiprocessorCount, dev);
        if (hipFuncSetAttribute((const void*)fwd_megakernel, hipFuncAttributeMaxDynamicSharedMemorySize, LDS_BYTES) != hipSuccess) { fprintf(stderr, "kernel_launch: hipFuncSetAttribute failed\n"); grid = -1; return; }
        if (hipOccupancyMaxActiveBlocksPerMultiprocessor(&per_cu, (const void*)fwd_megakernel, NTHREADS, LDS_BYTES) != hipSuccess || per_cu < 1) { fprintf(stderr, "kernel_launch: occupancy query gave %d\n", per_cu); per_cu = 1; }
        (void)hipGetLastError();
        grid = cus * per_cu;
    }
    if (grid < 0) return;
    Args a{};
    a.x = (const float*)d_in[0]; a.meta = (const float*)d_in[1]; a.mix_g = (const float*)d_in[2]; a.w_in = (const float*)d_in[3]; a.ret_g = (const float*)d_in[4];
    a.q_g = (const float*)d_in[5]; a.k_g = (const float*)d_in[6]; a.sinks = (const float*)d_in[7]; a.w_ret = (const float*)d_in[8]; a.w_swa = (const float*)d_in[9];
    a.w_out = (const float*)d_in[10]; a.mlp_g = (const float*)d_in[11]; a.w_up = (const float*)d_in[12]; a.w_down = (const float*)d_in[13];
    a.out = (float*)d_out; a.ws = (unsigned char*)d_ws;
    if (hipMemsetAsync((unsigned char*)d_ws + OFF_CTL, 0, CTL_BYTES, stream) != hipSuccess) { fprintf(stderr, "kernel_launch: memset failed\n"); return; }
    void* args[] = {&a};
    hipError_t e = hipLaunchCooperativeKernel((const void*)fwd_megakernel, dim3(grid), dim3(NTHREADS), args, LDS_BYTES, stream);
    if (e != hipSuccess) fprintf(stderr, "kernel_launch: cooperative launch failed: %s (grid %d)\n", hipGetErrorString(e), grid);
}
```

```cpp
#ifndef REP_MASK
#define REP_MASK 0
#endif
#include <hip/hip_runtime.h>
#include <hip/hip_cooperative_groups.h>
#include <cstdio>
#include <cstdint>
namespace cg = cooperative_groups;

#define LAS __attribute__((address_space(3)))
typedef unsigned short bf16_t;
typedef short bf16x8 __attribute__((ext_vector_type(8)));
typedef float f32x4 __attribute__((ext_vector_type(4)));
typedef unsigned u32x4 __attribute__((ext_vector_type(4)));
typedef unsigned u32x2 __attribute__((ext_vector_type(2)));

constexpr int NB = 4, SEQ = 8192, DM = 1024, NTOK = NB * SEQ, NMETA = 16, MROWS = NTOK + NMETA, MPAD = 33024, DIN = 6656, FF = 4096;
constexpr float EPS = 1e-6f;
constexpr int NTHREADS = 512;
constexpr int LDS_BYTES = 135168;

constexpr size_t SZ_WIN = (size_t)DIN * DM * 2, SZ_WSQ = (size_t)DM * DM * 2, SZ_WFF = (size_t)FF * DM * 2;
constexpr size_t OFF_WIN = 0, OFF_WRET = OFF_WIN + SZ_WIN, OFF_WSWA = OFF_WRET + SZ_WSQ, OFF_WOUT = OFF_WSWA + SZ_WSQ, OFF_WUP = OFF_WOUT + SZ_WSQ, OFF_WDN = OFF_WUP + SZ_WFF;
constexpr size_t OFF_RQ = OFF_WDN + SZ_WFF;
constexpr size_t OFF_RK = OFF_RQ + (size_t)MROWS * 512 * 2;
constexpr size_t OFF_RV = OFF_RK + (size_t)MROWS * 512 * 2;
constexpr size_t OFF_RG = OFF_RV + (size_t)MROWS * 1024 * 2;
constexpr size_t OFF_SQ = OFF_RG + (size_t)MROWS * 1024 * 2;
constexpr size_t OFF_SK = OFF_SQ + (size_t)MROWS * 1024 * 2;
constexpr size_t OFF_SV = OFF_SK + (size_t)MROWS * 256 * 2;
constexpr size_t OFF_GR = OFF_SV + (size_t)MROWS * 256 * 2;
constexpr size_t OFF_GS = OFF_GR + (size_t)MROWS * 1024 * 2;
constexpr size_t OFF_CTL = OFF_GS + (size_t)MROWS * 1024 * 2;
constexpr size_t CTL_BYTES = 16384 + (size_t)NTOK * 4;
constexpr size_t OFF_SS = OFF_CTL + 16384;
constexpr size_t WS_NEED = OFF_CTL + CTL_BYTES;
constexpr size_t OFF_MERGED = OFF_RQ, OFF_HN2 = OFF_RV, OFF_YRET = OFF_SQ, OFF_U = OFF_RG;
static_assert(OFF_RK - OFF_RQ + OFF_RV - OFF_RK >= (size_t)NTOK * 1024 * 2, "MERGED fits");
static_assert(OFF_CTL - OFF_RG >= (size_t)NTOK * FF * 2, "U fits");
static_assert((size_t)MPAD * DM * 2 <= (size_t)NTOK * DM * 4, "XN fits d_out");
constexpr size_t DOUT_KVS = 0, DOUT_YSWA = (size_t)NTOK * 1024 * 2;

typedef __bf16 bf16x2_t __attribute__((ext_vector_type(2)));
typedef float f32x2_t __attribute__((ext_vector_type(2)));
__device__ __forceinline__ unsigned cvt_pk_bf16(float lo, float hi) { const f32x2_t v = {lo, hi}; const bf16x2_t b = __builtin_convertvector(v, bf16x2_t); return __builtin_bit_cast(unsigned, b); }
__device__ __forceinline__ unsigned cvt_pk_bf16_asm(float lo, float hi) { unsigned r; asm volatile("v_cvt_pk_bf16_f32 %0, %1, %2" : "=v"(r) : "v"(lo), "v"(hi)); return r; }
__device__ __forceinline__ float bf_lo(unsigned w) { return __uint_as_float(w << 16); }
__device__ __forceinline__ float bf_hi(unsigned w) { return __uint_as_float(w & 0xffff0000u); }
__device__ __forceinline__ float wave_sum(float v) {
#pragma unroll
    for (int o = 1; o < 64; o <<= 1) v += __shfl_xor(v, o);
    return v;
}
__device__ __forceinline__ float sigmoidf_(float x) { return __builtin_amdgcn_rcpf(1.0f + __builtin_amdgcn_exp2f(-1.4426950408889634f * x)); }

namespace pg8 {
constexpr int BM = 256, BK = 64, HALF = 128, HTB = HALF * BK * 2, STAGE_BYTES = 8 * HTB, NXCD = 8, WGM = 8;
__host__ __device__ __forceinline__ int lds_byte(int r, int c) { const int st = (r >> 4) * 2 + (c >> 5), rr = r & 15, cc = c & 31, ob = rr * 64 + cc * 2; return st * 1024 + (ob ^ (((ob >> 9) & 1) << 5)); }
__host__ __device__ __forceinline__ void stage_rc(int b, int& R, int& C) { const int st = b / 1024, sb = b % 1024, swz = sb ^ (((sb >> 9) & 1) << 5); R = (st >> 1) * 16 + swz / 64; C = (st & 1) * 32 + (swz % 64) / 2; }
__host__ __device__ __forceinline__ int perm32(int rho) { const int n = rho >> 4, i = rho & 15; return 8 * (i >> 2) + 4 * n + (i & 3); }

struct Unit { int pm, pn, seg; };
struct Gemm { const bf16_t* A; const bf16_t* Bt; const bf16_t* A2; const bf16_t* Bt2; int M, N, K; };

struct StaticOrder {
    int nM, nN, nwg, G, c;
    __device__ void init(int M, int N, int G_, int c_) { nM = M / BM; nN = N / BM; nwg = nM * nN; G = G_; c = c_; }
    __device__ bool tile(long L, Unit& u) const {
        if (L >= nwg) return false;
        int wgid = (int)L; { const int q = nwg / NXCD, r = nwg % NXCD, xcd = wgid % NXCD, off = wgid / NXCD; wgid = (xcd < r ? xcd * (q + 1) : r * (q + 1) + (xcd - r) * q) + off; }
        const int nig = WGM * nN, gid = wgid / nig, fm = gid * WGM, gsz = (nM - fm) < WGM ? (nM - fm) : WGM;
        u.pm = fm + ((wgid % nig) % gsz); u.pn = (wgid % nig) / gsz; u.seg = 0; return true;
    }
    __device__ bool next(int i, Unit& u) const { return tile((long)i * G + c, u); }
};
struct PairOrder {
    StaticOrder s;
    __device__ bool next(int i, Unit& u) const { const bool ok = s.tile((long)(i >> 1) * s.G + s.c, u); u.seg = i & 1; return ok; }
};

struct EpiProj {
    static constexpr bool PERM = true, HAS_MID = false;
    unsigned char* ws;
    __device__ __forceinline__ void mid(f32x4 (&acc)[2][2][4][2], const Unit& u, int wr, int wc, int fr, int fq) const {}
    __device__ __forceinline__ void operator()(const f32x4 (&acc)[2][2][4][2], const Unit& u, int wr, int wc, int fr, int fq) const {
        const int pn = u.pn; size_t boff; int ld, ct;
        if (pn < 2) { boff = OFF_RQ; ld = 512; ct = pn; }
        else if (pn < 4) { boff = OFF_RK; ld = 512; ct = pn - 2; }
        else if (pn < 8) { boff = OFF_RV; ld = 1024; ct = pn - 4; }
        else if (pn < 12) { boff = OFF_RG; ld = 1024; ct = pn - 8; }
        else if (pn < 16) { boff = OFF_SQ; ld = 1024; ct = pn - 12; }
        else if (pn == 16) { boff = OFF_SK; ld = 256; ct = 0; }
        else if (pn == 17) { boff = OFF_SV; ld = 256; ct = 0; }
        else if (pn < 22) { boff = OFF_GR; ld = 1024; ct = pn - 18; }
        else { boff = OFF_GS; ld = 1024; ct = pn - 22; }
        bf16_t* base = (bf16_t*)(ws + boff);
        const int row0 = u.pm * BM + wr * 64 + fr, col0 = ct * 256 + wc * 32 + 8 * fq;
        if (pn >= 18) {
            unsigned char* gb = ws + boff;
#pragma unroll
            for (int ai = 0; ai < 2; ++ai)
#pragma unroll
                for (int m = 0; m < 4; ++m)
#pragma unroll
                    for (int bj = 0; bj < 2; ++bj) { const f32x4 v0 = acc[ai][bj][m][0], v1 = acc[ai][bj][m][1];
                        int w0 = __builtin_amdgcn_cvt_pk_fp8_f32(v0[0], v0[1], 0, false); w0 = __builtin_amdgcn_cvt_pk_fp8_f32(v0[2], v0[3], w0, true);
                        int w1 = __builtin_amdgcn_cvt_pk_fp8_f32(v1[0], v1[1], 0, false); w1 = __builtin_amdgcn_cvt_pk_fp8_f32(v1[2], v1[3], w1, true);
                        *(u32x2*)(gb + (size_t)(row0 + ai * HALF + m * 16) * 1024 + col0 + bj * HALF) = (u32x2){(unsigned)w0, (unsigned)w1}; }
            return;
        }
#pragma unroll
        for (int ai = 0; ai < 2; ++ai)
#pragma unroll
            for (int m = 0; m < 4; ++m) {
                bf16_t* rowp = base + (size_t)(row0 + ai * HALF + m * 16) * ld + col0;
#pragma unroll
                for (int bj = 0; bj < 2; ++bj) { const f32x4 v0 = acc[ai][bj][m][0], v1 = acc[ai][bj][m][1];
                    u32x4 w; w.x = cvt_pk_bf16_asm(v0[0], v0[1]); w.y = cvt_pk_bf16_asm(v0[2], v0[3]); w.z = cvt_pk_bf16_asm(v1[0], v1[1]); w.w = cvt_pk_bf16_asm(v1[2], v1[3]);
                    *(u32x4*)(rowp + bj * HALF) = w; } }
    }
};
struct EpiMerged {
    static constexpr bool PERM = true, HAS_MID = true;
    const unsigned char *GR, *GS; bf16_t* O;
    __device__ __forceinline__ void mid(f32x4 (&acc)[2][2][4][2], const Unit& u, int wr, int wc, int fr, int fq) const {
        const int row0 = u.pm * BM + wr * 64 + fr, col0 = u.pn * BM + wc * 32 + 8 * fq;
#pragma unroll
        for (int ai = 0; ai < 2; ++ai)
#pragma unroll
            for (int m = 0; m < 4; ++m)
#pragma unroll
                for (int bj = 0; bj < 2; ++bj) { const size_t off = (size_t)(row0 + ai * HALF + m * 16) * DM + col0 + bj * HALF;
                    const u32x2 a = *(const u32x2*)(GR + off), b = *(const u32x2*)(GS + off);
#define MRG_R(ga, gb) ((1.0f + __builtin_amdgcn_exp2f(-1.4426950408889634f * (gb))) * __builtin_amdgcn_rcpf(1.0f + __builtin_amdgcn_exp2f(-1.4426950408889634f * (ga))))
#define F8(w, k) __builtin_amdgcn_cvt_f32_fp8((int)(w), (k))
                    f32x4 r0, r1;
                    r0[0] = MRG_R(F8(a.x, 0), F8(b.x, 0)); r0[1] = MRG_R(F8(a.x, 1), F8(b.x, 1)); r0[2] = MRG_R(F8(a.x, 2), F8(b.x, 2)); r0[3] = MRG_R(F8(a.x, 3), F8(b.x, 3));
                    r1[0] = MRG_R(F8(a.y, 0), F8(b.y, 0)); r1[1] = MRG_R(F8(a.y, 1), F8(b.y, 1)); r1[2] = MRG_R(F8(a.y, 2), F8(b.y, 2)); r1[3] = MRG_R(F8(a.y, 3), F8(b.y, 3));
#undef MRG_R
                    acc[ai][bj][m][0] = acc[ai][bj][m][0] * r0; acc[ai][bj][m][1] = acc[ai][bj][m][1] * r1; }
    }
    __device__ __forceinline__ void operator()(const f32x4 (&acc)[2][2][4][2], const Unit& u, int wr, int wc, int fr, int fq) const {
        const int row0 = u.pm * BM + wr * 64 + fr, col0 = u.pn * BM + wc * 32 + 8 * fq;
#pragma unroll
        for (int ai = 0; ai < 2; ++ai)
#pragma unroll
            for (int m = 0; m < 4; ++m)
#pragma unroll
                for (int bj = 0; bj < 2; ++bj) { const size_t off = (size_t)(row0 + ai * HALF + m * 16) * DM + col0 + bj * HALF;
                    const u32x2 b = *(const u32x2*)(GS + off); const f32x4 v0 = acc[ai][bj][m][0], v1 = acc[ai][bj][m][1];
                    u32x4 w;
                    w.x = cvt_pk_bf16_asm(v0[0] * sigmoidf_(F8(b.x, 0)), v0[1] * sigmoidf_(F8(b.x, 1))); w.y = cvt_pk_bf16_asm(v0[2] * sigmoidf_(F8(b.x, 2)), v0[3] * sigmoidf_(F8(b.x, 3)));
                    w.z = cvt_pk_bf16_asm(v1[0] * sigmoidf_(F8(b.y, 0)), v1[1] * sigmoidf_(F8(b.y, 1))); w.w = cvt_pk_bf16_asm(v1[2] * sigmoidf_(F8(b.y, 2)), v1[3] * sigmoidf_(F8(b.y, 3)));
#undef F8
                    *(u32x4*)(O + off) = w; }
    }
};
struct EpiRes {
    static constexpr bool PERM = true, HAS_MID = false;
    const float* res; float* out;
    __device__ __forceinline__ void mid(f32x4 (&acc)[2][2][4][2], const Unit& u, int wr, int wc, int fr, int fq) const {}
    __device__ __forceinline__ void operator()(const f32x4 (&acc)[2][2][4][2], const Unit& u, int wr, int wc, int fr, int fq) const {
        const int row0 = u.pm * BM + wr * 64 + fr, col0 = u.pn * BM + wc * 32 + 8 * fq;
#pragma unroll
        for (int ai = 0; ai < 2; ++ai)
#pragma unroll
            for (int m = 0; m < 4; ++m)
#pragma unroll
                for (int bj = 0; bj < 2; ++bj) { const size_t off = (size_t)(row0 + ai * HALF + m * 16) * DM + col0 + bj * HALF;
                    const f32x4 x0 = *(const f32x4*)(res + off), x1 = *(const f32x4*)(res + off + 4);
                    *(f32x4*)(out + off) = x0 + acc[ai][bj][m][0]; *(f32x4*)(out + off + 4) = x1 + acc[ai][bj][m][1]; }
    }
};
struct EpiResStat {
    static constexpr bool PERM = true, HAS_MID = false;
    const float* res; float* out; bf16_t* hb; float* ss;
    __device__ __forceinline__ void mid(f32x4 (&acc)[2][2][4][2], const Unit& u, int wr, int wc, int fr, int fq) const {}
    __device__ __forceinline__ void operator()(const f32x4 (&acc)[2][2][4][2], const Unit& u, int wr, int wc, int fr, int fq) const {
        const int row0 = u.pm * BM + wr * 64 + fr, col0 = u.pn * BM + wc * 32 + 8 * fq;
#pragma unroll
        for (int ai = 0; ai < 2; ++ai)
#pragma unroll
            for (int m = 0; m < 4; ++m) {
                float sq = 0.f;
#pragma unroll
                for (int bj = 0; bj < 2; ++bj) { const size_t off = (size_t)(row0 + ai * HALF + m * 16) * DM + col0 + bj * HALF;
                    const f32x4 h0 = *(const f32x4*)(res + off) + acc[ai][bj][m][0], h1 = *(const f32x4*)(res + off + 4) + acc[ai][bj][m][1];
                    u32x4 w; w.x = cvt_pk_bf16_asm(h0[0], h0[1]); w.y = cvt_pk_bf16_asm(h0[2], h0[3]); w.z = cvt_pk_bf16_asm(h1[0], h1[1]); w.w = cvt_pk_bf16_asm(h1[2], h1[3]);
                    *(u32x4*)(hb + off) = w;
                    sq += (h0[0] * h0[0] + h0[1] * h0[1]) + (h0[2] * h0[2] + h0[3] * h0[3]) + (h1[0] * h1[0] + h1[1] * h1[1]) + (h1[2] * h1[2] + h1[3] * h1[3]); }
                sq += __shfl_xor(sq, 16); sq += __shfl_xor(sq, 32);
                if (fq == 0) atomicAdd(ss + row0 + ai * HALF + m * 16, sq);
            }
    }
};
struct EpiResBf {
    static constexpr bool PERM = true, HAS_MID = false;
    const bf16_t* hb; float* out;
    __device__ __forceinline__ void mid(f32x4 (&acc)[2][2][4][2], const Unit& u, int wr, int wc, int fr, int fq) const {}
    __device__ __forceinline__ void operator()(const f32x4 (&acc)[2][2][4][2], const Unit& u, int wr, int wc, int fr, int fq) const {
        const int row0 = u.pm * BM + wr * 64 + fr, col0 = u.pn * BM + wc * 32 + 8 * fq;
#pragma unroll
        for (int ai = 0; ai < 2; ++ai)
#pragma unroll
            for (int m = 0; m < 4; ++m)
#pragma unroll
                for (int bj = 0; bj < 2; ++bj) { const size_t off = (size_t)(row0 + ai * HALF + m * 16) * DM + col0 + bj * HALF;
                    const u32x4 h = *(const u32x4*)(hb + off);
                    const f32x4 x0 = (f32x4){bf_lo(h.x), bf_hi(h.x), bf_lo(h.y), bf_hi(h.y)}, x1 = (f32x4){bf_lo(h.z), bf_hi(h.z), bf_lo(h.w), bf_hi(h.w)};
                    *(f32x4*)(out + off) = x0 + acc[ai][bj][m][0]; *(f32x4*)(out + off + 4) = x1 + acc[ai][bj][m][1]; }
    }
};
struct EpiUp {
    static constexpr bool PERM = true, HAS_MID = false;
    bf16_t* O; const float* ss;
    __device__ __forceinline__ void mid(f32x4 (&acc)[2][2][4][2], const Unit& u, int wr, int wc, int fr, int fq) const {}
    __device__ __forceinline__ void operator()(const f32x4 (&acc)[2][2][4][2], const Unit& u, int wr, int wc, int fr, int fq) const {
        const int row0 = u.pm * BM + wr * 64 + fr, col0 = u.pn * BM + wc * 32 + 8 * fq;
#pragma unroll
        for (int ai = 0; ai < 2; ++ai)
#pragma unroll
            for (int m = 0; m < 4; ++m) {
                const float rstd = 1.f / sqrtf(ss[row0 + ai * HALF + m * 16] * (1.f / DM) + EPS);
#pragma unroll
                for (int bj = 0; bj < 2; ++bj) { const size_t off = (size_t)(row0 + ai * HALF + m * 16) * FF + col0 + bj * HALF;
                    f32x4 v0 = acc[ai][bj][m][0], v1 = acc[ai][bj][m][1];
#pragma unroll
                    for (int e = 0; e < 4; ++e) { const float a = fmaxf(v0[e] * rstd, 0.f), b = fmaxf(v1[e] * rstd, 0.f); v0[e] = a * a; v1[e] = b * b; }
                    u32x4 w; w.x = cvt_pk_bf16_asm(v0[0], v0[1]); w.y = cvt_pk_bf16_asm(v0[2], v0[3]); w.z = cvt_pk_bf16_asm(v1[0], v1[1]); w.w = cvt_pk_bf16_asm(v1[2], v1[3]);
                    *(u32x4*)(O + off) = w; }
            }
    }
};

template <class Epi, class Sched, bool ALIGN_EPI>
__device__ __forceinline__ void gemm_phase(LAS unsigned char* lds, const Gemm g, const Sched& S, const Epi& E) {
    int tid_ = threadIdx.x; asm volatile("" : "+v"(tid_));
    const int tid = tid_, wid = __builtin_amdgcn_readfirstlane(tid >> 6), lane = tid & 63, wr = wid >> 2, wc = wid & 3, fr = lane & 15, fq = lane >> 4;
    const int K = g.K, nt = K / BK;
    unsigned voffA[2], voffB[2];
#pragma unroll
    for (int i = 0; i < 2; ++i) { int R, C; stage_rc(tid * 16 + i * 8192, R, C); const int Rb = Epi::PERM ? ((R & ~31) + perm32(R & 31)) : R;
        voffA[i] = (unsigned)(R * K + C) * 2u; voffB[i] = (unsigned)(Rb * K + C) * 2u; }
    const size_t kstep = (size_t)(BK * 2);
    const size_t hstep = (size_t)HALF * K * 2;
    const size_t tstep = 2 * hstep;
    const unsigned ldsw = (unsigned)wid * 1024u;
    const int aoff = lds_byte(wr * 64 + fr, fq * 8), boff = lds_byte(wc * 32 + fr, fq * 8);
#define PG8_SA(b, h) (((b) * 2 + (h)) * HTB)
#define PG8_SB(b, h) ((4 + (b) * 2 + (h)) * HTB)
#define PG8_STAGE(bufoff, gbase, voff) do { _Pragma("unroll") for (int _i = 0; _i < 2; ++_i) \
        __builtin_amdgcn_global_load_lds((const unsigned*)((const char*)(gbase) + (voff)[_i]), (LAS unsigned*)(lds + (bufoff) + ldsw + _i * 8192), 16, 0, 0); } while (0)
#define PG8_LDA(dst, b, h) do { _Pragma("unroll") for (int m = 0; m < 4; ++m) _Pragma("unroll") for (int k = 0; k < 2; ++k) dst[m][k] = *(const LAS bf16x8*)(lds + PG8_SA(b, h) + aoff + m * 2048 + k * 1024); } while (0)
#define PG8_LDB(dst, b, h) do { _Pragma("unroll") for (int n = 0; n < 2; ++n) _Pragma("unroll") for (int k = 0; k < 2; ++k) dst[n][k] = *(const LAS bf16x8*)(lds + PG8_SB(b, h) + boff + n * 2048 + k * 1024); } while (0)
#define PG8_MMA(ai, bj, At, Bt) do { __builtin_amdgcn_s_setprio(1); _Pragma("unroll") for (int m = 0; m < 4; ++m) _Pragma("unroll") for (int n = 0; n < 2; ++n) _Pragma("unroll") for (int k = 0; k < 2; ++k) \
        acc[ai][bj][m][n] = __builtin_amdgcn_mfma_f32_16x16x32_bf16(Bt[n][k], At[m][k], acc[ai][bj][m][n], 0, 0, 0); __builtin_amdgcn_s_setprio(0); } while (0)
#define PG8_WAIT_V(n) asm volatile("s_waitcnt vmcnt(" #n ")" ::: "memory")
#define PG8_WAIT_L(n) asm volatile("s_waitcnt lgkmcnt(" #n ")" ::: "memory")
#define PG8_BAR __builtin_amdgcn_s_barrier()
#define PG8_SCHED __builtin_amdgcn_sched_barrier(0)
    Unit cur, nxt; int ui = 0;
    if (!S.next(0, cur)) return;
    f32x4 acc[2][2][4][2];
#pragma unroll
    for (int a = 0; a < 2; ++a)
#pragma unroll
        for (int b = 0; b < 2; ++b)
#pragma unroll
            for (int m = 0; m < 4; ++m)
#pragma unroll
                for (int n = 0; n < 2; ++n) acc[a][b][m][n] = (f32x4){0.f, 0.f, 0.f, 0.f};
    bf16x8 At[4][2], B0[2][2], B1[2][2];
    const char* cA = (const char*)(cur.seg ? g.A2 : g.A) + (size_t)cur.pm * tstep; const char* cB = (const char*)(cur.seg ? g.Bt2 : g.Bt) + (size_t)cur.pn * tstep;
    PG8_STAGE(PG8_SB(0, 0), cB, voffB); PG8_STAGE(PG8_SB(0, 1), cB + hstep, voffB); PG8_STAGE(PG8_SA(0, 0), cA, voffA); PG8_STAGE(PG8_SA(0, 1), cA + hstep, voffA);
    if (wr == 1) PG8_BAR;
    PG8_WAIT_V(2); PG8_BAR;
    PG8_STAGE(PG8_SB(1, 0), cB + kstep, voffB); PG8_STAGE(PG8_SA(1, 0), cA + kstep, voffA); PG8_STAGE(PG8_SB(1, 1), cB + hstep + kstep, voffB);
    PG8_WAIT_V(6); PG8_BAR;
    for (;;) {
        const bool has_next = S.next(ui + 1, nxt);
        const char* nA = has_next ? (const char*)(nxt.seg ? g.A2 : g.A) + (size_t)nxt.pm * tstep : cA; const char* nB = has_next ? (const char*)(nxt.seg ? g.Bt2 : g.Bt) + (size_t)nxt.pn * tstep : cB;
        for (int t = 0; t < nt; t += 2) {
            const bool last = (t == nt - 2);
            const char* a1 = cA + (size_t)(t + 1) * kstep;
            const char* a2 = last ? nA : cA + (size_t)(t + 2) * kstep; const char* b2 = last ? nB : cB + (size_t)(t + 2) * kstep;
            const char* a3 = a2 + kstep; const char* b3 = b2 + kstep;
            PG8_LDB(B0, 0, 0); PG8_LDB(B1, 0, 1); PG8_SCHED; PG8_LDA(At, 0, 0); PG8_STAGE(PG8_SA(1, 1), a1 + hstep, voffA);
            PG8_WAIT_V(8); PG8_WAIT_L(0); PG8_BAR; PG8_MMA(0, 0, At, B0); PG8_MMA(0, 1, At, B1); PG8_BAR; PG8_SCHED;
            PG8_LDA(At, 0, 1); PG8_STAGE(PG8_SB(0, 0), b2, voffB); PG8_STAGE(PG8_SB(0, 1), b2 + hstep, voffB); PG8_STAGE(PG8_SA(0, 0), a2, voffA);
            PG8_WAIT_V(8); PG8_WAIT_L(0); PG8_BAR; PG8_MMA(1, 0, At, B0); PG8_MMA(1, 1, At, B1); PG8_BAR; PG8_SCHED;
            PG8_LDB(B0, 1, 0); PG8_LDB(B1, 1, 1); PG8_SCHED; PG8_LDA(At, 1, 0); PG8_STAGE(PG8_SA(0, 1), a2 + hstep, voffA);
            PG8_WAIT_V(8); PG8_WAIT_L(0); PG8_BAR; PG8_MMA(0, 0, At, B0); PG8_MMA(0, 1, At, B1); PG8_BAR; PG8_SCHED;
            PG8_LDA(At, 1, 1); PG8_STAGE(PG8_SB(1, 0), b3, voffB); PG8_STAGE(PG8_SB(1, 1), b3 + hstep, voffB); PG8_STAGE(PG8_SA(1, 0), a3, voffA);
            PG8_WAIT_V(8); PG8_WAIT_L(0); PG8_BAR; PG8_MMA(1, 0, At, B0); PG8_MMA(1, 1, At, B1); PG8_BAR; PG8_SCHED;
        }
        if constexpr (ALIGN_EPI) { if (wr == 0) PG8_BAR; }
        bool keep = false;
        if constexpr (Epi::HAS_MID) keep = (cur.seg == 0);
        if (keep) E.mid(acc, cur, wr, wc, fr, fq); else E(acc, cur, wr, wc, fr, fq);
        if (!has_next) break;
        if (!keep) {
#pragma unroll
            for (int a = 0; a < 2; ++a)
#pragma unroll
                for (int b = 0; b < 2; ++b)
#pragma unroll
                    for (int m = 0; m < 4; ++m)
#pragma unroll
                        for (int n = 0; n < 2; ++n) acc[a][b][m][n] = (f32x4){0.f, 0.f, 0.f, 0.f};
        }
        cur = nxt; cA = nA; cB = nB; ++ui;
        if constexpr (ALIGN_EPI) { if (wr == 1) PG8_BAR; }
    }
    PG8_WAIT_V(0);
    if constexpr (!ALIGN_EPI) { if (wr == 0) PG8_BAR; }
    PG8_BAR;
#undef PG8_SA
#undef PG8_SB
#undef PG8_STAGE
#undef PG8_LDA
#undef PG8_LDB
#undef PG8_MMA
#undef PG8_WAIT_V
#undef PG8_WAIT_L
#undef PG8_BAR
#undef PG8_SCHED
}
}

struct Args {
    const float *x, *meta, *mix_g, *w_in, *ret_g, *q_g, *k_g, *sinks, *w_ret, *w_swa, *w_out, *mlp_g, *w_up, *w_down;
    float* out; unsigned char* ws;
};

__device__ __forceinline__ void p0_transpose_item(const float* W, int K, int N, bf16_t* WT, LAS float* scr, int item, int lane, const float* kgain = nullptr) {
    const int nblk = N / 32, kb = item / nblk, nb = item % nblk, k0 = 64 * kb, n0 = 32 * nb;
    float wv[32];
#pragma unroll
    for (int i = 0; i < 32; ++i) wv[i] = W[(size_t)(k0 + 2 * i + (lane >> 5)) * N + n0 + (lane & 31)];
#pragma unroll
    for (int i = 0; i < 32; ++i) { const int kk = 2 * i + (lane >> 5); float v = wv[i]; if (kgain) v *= kgain[k0 + kk]; scr[kk * 33 + (lane & 31)] = v; }
    asm volatile("s_waitcnt lgkmcnt(0)" ::: "memory");
    const int c = lane & 7;
#pragma unroll
    for (int j = 0; j < 4; ++j) { const int n = (lane >> 3) + 8 * j; const LAS float* s = scr + (8 * c) * 33 + n;
        u32x4 o; o.x = cvt_pk_bf16_asm(s[0 * 33], s[1 * 33]); o.y = cvt_pk_bf16_asm(s[2 * 33], s[3 * 33]); o.z = cvt_pk_bf16_asm(s[4 * 33], s[5 * 33]); o.w = cvt_pk_bf16_asm(s[6 * 33], s[7 * 33]);
        *(u32x4*)(WT + (size_t)(n0 + n) * K + k0 + 8 * c) = o; }
    asm volatile("s_waitcnt lgkmcnt(0)" ::: "memory");
}
__device__ __forceinline__ void rms_row_to_bf16(const float* xrow, const float* g, bf16_t* orow, int lane) {
    const f32x4* xr = (const f32x4*)xrow + lane; const f32x4* gr = (const f32x4*)g + lane;
    f32x4 v[4]; float s = 0.f;
#pragma unroll
    for (int j = 0; j < 4; ++j) { v[j] = xr[64 * j]; s += (v[j].x * v[j].x + v[j].y * v[j].y) + (v[j].z * v[j].z + v[j].w * v[j].w); }
    const float rstd = 1.f / sqrtf(wave_sum(s) * (1.f / DM) + EPS);
    u32x2* o8 = (u32x2*)orow + lane;
#pragma unroll
    for (int j = 0; j < 4; ++j) { const f32x4 gg = gr[64 * j]; u32x2 w; w.x = cvt_pk_bf16_asm(v[j].x * rstd * gg.x, v[j].y * rstd * gg.y); w.y = cvt_pk_bf16_asm(v[j].z * rstd * gg.z, v[j].w * rstd * gg.w); o8[64 * j] = w; }
}

__device__ __forceinline__ void tr_write8(LAS unsigned char* base, int RS, int col0, int pp, u32x4 r0, u32x4 r1) {
#define TRW(i, w0, w1) *(LAS unsigned*)(base + ((size_t)(col0 + (i)) * RS + 2 * pp) * 2) = ((i) & 1) ? (((w0) >> 16) | ((w1) & 0xffff0000u)) : (((w0) & 0xffffu) | ((w1) << 16))
    TRW(0, r0.x, r1.x); TRW(1, r0.x, r1.x); TRW(2, r0.y, r1.y); TRW(3, r0.y, r1.y); TRW(4, r0.z, r1.z); TRW(5, r0.z, r1.z); TRW(6, r0.w, r1.w); TRW(7, r0.w, r1.w);
#undef TRW
}

__device__ __forceinline__ int tr_off(int col, int RS, int slot) { return col * RS * 2 + ((slot ^ (2 * ((col >> 3) & 15))) << 3); }
__device__ __forceinline__ void tr_write8s(LAS unsigned char* base, int RS, int col0, int pp, u32x4 r0, u32x4 r1) {
    const int sw2 = 2 * ((col0 >> 3) & 15), po = (((pp >> 1) ^ sw2) << 3) + ((pp & 1) << 2);
#define TRW(i, w0, w1) *(LAS unsigned*)(base + (col0 + (i)) * RS * 2 + po) = ((i) & 1) ? (((w0) >> 16) | ((w1) & 0xffff0000u)) : (((w0) & 0xffffu) | ((w1) << 16))
    TRW(0, r0.x, r1.x); TRW(1, r0.x, r1.x); TRW(2, r0.y, r1.y); TRW(3, r0.y, r1.y); TRW(4, r0.z, r1.z); TRW(5, r0.z, r1.z); TRW(6, r0.w, r1.w); TRW(7, r0.w, r1.w);
#undef TRW
}
__device__ __forceinline__ u32x4 scale8(u32x4 r, float f) {
    u32x4 o; o.x = cvt_pk_bf16(bf_lo(r.x) * f, bf_hi(r.x) * f); o.y = cvt_pk_bf16(bf_lo(r.y) * f, bf_hi(r.y) * f); o.z = cvt_pk_bf16(bf_lo(r.z) * f, bf_hi(r.z) * f); o.w = cvt_pk_bf16(bf_lo(r.w) * f, bf_hi(r.w) * f); return o;
}
__device__ __forceinline__ bf16x8 as_frag(u32x4 v) { return __builtin_bit_cast(bf16x8, v); }
#define MFMA16(a, b, c) __builtin_amdgcn_mfma_f32_16x16x32_bf16((a), (b), (c), 0, 0, 0)

__device__ __forceinline__ long swa_key_row(int b, int c, int kk) {
    if (kk < 16) return (long)NTOK + kk;
    if (kk < 272) { const int s = (c - 1) * 128 + (kk - 16); if (s >= 128) return (long)b * SEQ + s - 128; }
    return -1;
}
__device__ __forceinline__ void swa_phase(LAS unsigned char* lds, const Args& p) {
    int tid_ = threadIdx.x; asm volatile("" : "+v"(tid_));
    const int tid = tid_, lane = tid & 63, w = __builtin_amdgcn_readfirstlane(tid >> 6), r = lane & 15, q = lane >> 4;
    const bf16_t* SQ = (const bf16_t*)(p.ws + OFF_SQ); const bf16_t* SK = (const bf16_t*)(p.ws + OFF_SK); const bf16_t* SV = (const bf16_t*)(p.ws + OFF_SV);
    bf16_t* YSWA = (bf16_t*)((unsigned char*)p.out + DOUT_YSWA);
    constexpr int KS = 72, VS = 296, K_OFF = 0, VT_OFF = 288 * KS * 2;
    constexpr float LOG2E = 1.4426950408889634f;
    const int kch = tid & 7, G = gridDim.x;
    const f32x4 kg0 = *(const f32x4*)(p.k_g + kch * 8), kg1 = *(const f32x4*)(p.k_g + kch * 8 + 4);
    u32x4 kraw[5], vraw[6];
#define SWA_LOAD_UNIT(uu) do { const int b_ = (uu) >> 8, c_ = 1 + (((uu) & 255) >> 2), kvh_ = (uu) & 3; \
        _Pragma("unroll") for (int it = 0; it < 5; ++it) { const int kk = (it * NTHREADS + tid) >> 3; const long row = swa_key_row(b_, c_, kk); \
            kraw[it] = (u32x4){0u, 0u, 0u, 0u}; if (row >= 0) kraw[it] = *(const u32x4*)(SK + (size_t)row * 256 + kvh_ * 64 + kch * 8); } \
        _Pragma("unroll") for (int it = 0; it < 3; ++it) { const int id = it * NTHREADS + tid, ch = id / 144, pp = id % 144; \
            _Pragma("unroll") for (int e = 0; e < 2; ++e) { const long row = (id < 1152) ? swa_key_row(b_, c_, 2 * pp + e) : -1; \
                vraw[2 * it + e] = (u32x4){0u, 0u, 0u, 0u}; if (row >= 0) vraw[2 * it + e] = *(const u32x4*)(SV + (size_t)row * 256 + kvh_ * 64 + ch * 8); } } } while (0)
    int u = blockIdx.x;
    if (u >= 1024) return;
    SWA_LOAD_UNIT(u);
    for (; u < 1024; u += G) {
        const int b = u >> 8, c = 1 + ((u & 255) >> 2), kvh = u & 3;
        __syncthreads();
#pragma unroll
        for (int it = 0; it < 5; ++it) {
            const int kk = (it * NTHREADS + tid) >> 3; const u32x4 raw = kraw[it];
            const float f0 = bf_lo(raw.x), f1 = bf_hi(raw.x), f2 = bf_lo(raw.y), f3 = bf_hi(raw.y), f4 = bf_lo(raw.z), f5 = bf_hi(raw.z), f6 = bf_lo(raw.w), f7 = bf_hi(raw.w);
            float ss = (f0 * f0 + f1 * f1) + (f2 * f2 + f3 * f3) + (f4 * f4 + f5 * f5) + (f6 * f6 + f7 * f7);
            ss += __shfl_xor(ss, 1); ss += __shfl_xor(ss, 2); ss += __shfl_xor(ss, 4);
            const float rstd = __builtin_amdgcn_rsqf(ss * (1.f / 64.f) + EPS);
            u32x4 o; o.x = cvt_pk_bf16(f0 * rstd * kg0.x, f1 * rstd * kg0.y); o.y = cvt_pk_bf16(f2 * rstd * kg0.z, f3 * rstd * kg0.w);
            o.z = cvt_pk_bf16(f4 * rstd * kg1.x, f5 * rstd * kg1.y); o.w = cvt_pk_bf16(f6 * rstd * kg1.z, f7 * rstd * kg1.w);
            if (kk < 288) *(LAS u32x4*)(lds + K_OFF + (kk * KS + kch * 8) * 2) = o;
        }
#pragma unroll
        for (int it = 0; it < 3; ++it) { const int id = it * NTHREADS + tid; if (id < 1152) tr_write8(lds + VT_OFF, VS, (id / 144) * 8, id % 144, vraw[2 * it], vraw[2 * it + 1]); }
        __syncthreads();
        const int qt = w, iq = 16 * qt + r;
        const size_t qrow = (size_t)b * SEQ + (size_t)(c - 1) * 128 + iq;
        u32x4 qa = *(const u32x4*)(SQ + qrow * 1024 + (kvh * 4) * 64 + 8 * q), qb = *(const u32x4*)(SQ + qrow * 1024 + (kvh * 4) * 64 + 32 + 8 * q);
        { const int un = (u + G < 1024) ? u + G : u; SWA_LOAD_UNIT(un); }
#pragma unroll 1
        for (int hl = 0; hl < 4; ++hl) {
            const int h = kvh * 4 + hl;
            bf16x8 Qf[2];
            {
                const u32x4 a = qa, bq = qb;
                const int hn = kvh * 4 + ((hl + 1) & 3);
                qa = *(const u32x4*)(SQ + qrow * 1024 + hn * 64 + 8 * q); qb = *(const u32x4*)(SQ + qrow * 1024 + hn * 64 + 32 + 8 * q);
                float fa[8] = {bf_lo(a.x), bf_hi(a.x), bf_lo(a.y), bf_hi(a.y), bf_lo(a.z), bf_hi(a.z), bf_lo(a.w), bf_hi(a.w)};
                float fb[8] = {bf_lo(bq.x), bf_hi(bq.x), bf_lo(bq.y), bf_hi(bq.y), bf_lo(bq.z), bf_hi(bq.z), bf_lo(bq.w), bf_hi(bq.w)};
                float ss = 0.f;
#pragma unroll
                for (int e = 0; e < 8; ++e) ss += fa[e] * fa[e] + fb[e] * fb[e];
                ss += __shfl_xor(ss, 16); ss += __shfl_xor(ss, 32);
                const float rs = (0.125f * LOG2E) * __builtin_amdgcn_rsqf(ss * (1.f / 64.f) + EPS);
                const f32x4 ga0 = *(const f32x4*)(p.q_g + 8 * q), ga1 = *(const f32x4*)(p.q_g + 8 * q + 4), gb0 = *(const f32x4*)(p.q_g + 32 + 8 * q), gb1 = *(const f32x4*)(p.q_g + 32 + 8 * q + 4);
                u32x4 oa, ob;
                oa.x = cvt_pk_bf16(fa[0] * rs * ga0.x, fa[1] * rs * ga0.y); oa.y = cvt_pk_bf16(fa[2] * rs * ga0.z, fa[3] * rs * ga0.w); oa.z = cvt_pk_bf16(fa[4] * rs * ga1.x, fa[5] * rs * ga1.y); oa.w = cvt_pk_bf16(fa[6] * rs * ga1.z, fa[7] * rs * ga1.w);
                ob.x = cvt_pk_bf16(fb[0] * rs * gb0.x, fb[1] * rs * gb0.y); ob.y = cvt_pk_bf16(fb[2] * rs * gb0.z, fb[3] * rs * gb0.w); ob.z = cvt_pk_bf16(fb[4] * rs * gb1.x, fb[5] * rs * gb1.y); ob.w = cvt_pk_bf16(fb[6] * rs * gb1.z, fb[7] * rs * gb1.w);
                Qf[0] = as_frag(oa); Qf[1] = as_frag(ob);
            }
            const float slope2 = exp2f(-0.5f * (float)(h + 1)) * LOG2E, sink2 = p.sinks[h] * LOG2E;
            const float bbase = -slope2 * (float)(144 + r - 4 * q), mbase = -slope2 * (float)(c * 128 + iq - 112 - 4 * q);
            const float sl1 = slope2, sl2 = 2.f * slope2, sl3 = 3.f * slope2;
            const int d0 = 144 + r - 4 * q;
            f32x4 sc[10]; float mx = -1e30f;
#pragma unroll
            for (int t = 0; t < 10; ++t) {
                const int kt = (t == 0) ? 0 : qt + t;
                f32x4 acc = (f32x4){0.f, 0.f, 0.f, 0.f};
#pragma unroll
                for (int ks = 0; ks < 2; ++ks) { const bf16x8 a = *(const LAS bf16x8*)(lds + K_OFF + ((16 * kt + r) * KS + 32 * ks + 8 * q) * 2); acc = MFMA16(a, Qf[ks], acc); }
                const float tb = (t == 0) ? mbase : bbase + slope2 * (float)(16 * t) + ((c == 1 && kt <= 8) ? -1e30f : 0.f);
                acc[0] += tb; acc[1] += tb + sl1; acc[2] += tb + sl2; acc[3] += tb + sl3;
                if (t == 1) {
#pragma unroll
                    for (int i = 0; i < 4; ++i) if (d0 - 16 - i >= 128) acc[i] = -1e30f;
                }
                if (t == 9) {
#pragma unroll
                    for (int i = 0; i < 4; ++i) if (d0 - 144 - i < 0) acc[i] = -1e30f;
                }
                mx = fmaxf(fmaxf(mx, fmaxf(acc[0], acc[1])), fmaxf(acc[2], acc[3]));
                sc[t] = acc;
                if (t == 4) __builtin_amdgcn_sched_barrier(0);
            }
            mx = fmaxf(mx, __shfl_xor(mx, 16)); mx = fmaxf(mx, __shfl_xor(mx, 32)); mx = fmaxf(mx, sink2);
            float sum = 0.f; u32x2 Pk[10];
#pragma unroll
            for (int t = 0; t < 10; ++t) { const float p0 = __builtin_amdgcn_exp2f(sc[t][0] - mx), p1 = __builtin_amdgcn_exp2f(sc[t][1] - mx), p2 = __builtin_amdgcn_exp2f(sc[t][2] - mx), p3 = __builtin_amdgcn_exp2f(sc[t][3] - mx);
                sum += (p0 + p1) + (p2 + p3); Pk[t].x = cvt_pk_bf16(p0, p1); Pk[t].y = cvt_pk_bf16(p2, p3); }
            sum += __shfl_xor(sum, 16); sum += __shfl_xor(sum, 32);
            const float inv = __builtin_amdgcn_rcpf(sum + __builtin_amdgcn_exp2f(sink2 - mx));
#pragma unroll 2
            for (int dt = 0; dt < 4; ++dt) {
                f32x4 acc = (f32x4){0.f, 0.f, 0.f, 0.f};
#pragma unroll
                for (int pr = 0; pr < 5; ++pr) {
                    const int t0 = 2 * pr, t1 = 2 * pr + 1, kt0 = (t0 == 0) ? 0 : qt + t0, kt1 = qt + t1;
                    const LAS unsigned char* vp = lds + VT_OFF + ((16 * dt + r) * VS + 4 * q) * 2;
                    const u32x2 a0 = *(const LAS u32x2*)(vp + 32 * kt0), a1 = *(const LAS u32x2*)(vp + 32 * kt1);
                    const u32x4 a = (u32x4){a0.x, a0.y, a1.x, a1.y}, bb = (u32x4){Pk[t0].x, Pk[t0].y, Pk[t1].x, Pk[t1].y};
                    acc = MFMA16(as_frag(a), as_frag(bb), acc);
                }
                u32x2 o; o.x = cvt_pk_bf16(acc[0] * inv, acc[1] * inv); o.y = cvt_pk_bf16(acc[2] * inv, acc[3] * inv);
                *(u32x2*)(YSWA + qrow * 1024 + h * 64 + 16 * dt + 4 * q) = o;
            }
        }
    }
#undef SWA_LOAD_UNIT
}

__device__ __forceinline__ size_t kvs_slot(int b, int n, int h) { return ((size_t)((b * 64 + n) * 4 + h)) * 32768; }
__device__ __forceinline__ void kvlocal_phase(LAS unsigned char* lds, const Args& p) {
    int tid_ = threadIdx.x; asm volatile("" : "+v"(tid_));
    const int tid = tid_, lane = tid & 63, w = __builtin_amdgcn_readfirstlane(tid >> 6), r = lane & 15, q = lane >> 4;
    const bf16_t* RK = (const bf16_t*)(p.ws + OFF_RK); const bf16_t* RV = (const bf16_t*)(p.ws + OFF_RV);
    bf16_t* KVS = (bf16_t*)((unsigned char*)p.out + DOUT_KVS);
    constexpr int RS = 136, KT_OFF = 0, VT_OFF = 128 * RS * 2;
    u32x4 kr[2][2], vr[4][2];
#define KV_LOAD_UNIT(uu) do { const int b_ = (uu) >> 8, n_ = ((uu) & 255) >> 2, h_ = (uu) & 3; \
        _Pragma("unroll") for (int it = 0; it < 2; ++it) { const int id = it * NTHREADS + tid, ch = id & 15, pr = id >> 4; \
            _Pragma("unroll") for (int e = 0; e < 2; ++e) { const int i = 2 * pr + e; long row; \
                if (n_ == 0) row = (i < 112) ? -1 : (long)NTOK + i - 112; else row = (long)b_ * SEQ + (n_ - 1) * 128 + i; \
                kr[it][e] = (u32x4){0u, 0u, 0u, 0u}; if (row >= 0) kr[it][e] = *(const u32x4*)(RK + (size_t)row * 512 + h_ * 128 + ch * 8); } } \
        _Pragma("unroll") for (int it = 0; it < 4; ++it) { const int id = it * NTHREADS + tid, ch = id & 31, pr = id >> 5; \
            _Pragma("unroll") for (int e = 0; e < 2; ++e) { const int i = 2 * pr + e; long row; \
                if (n_ == 0) row = (i < 112) ? -1 : (long)NTOK + i - 112; else row = (long)b_ * SEQ + (n_ - 1) * 128 + i; \
                vr[it][e] = (u32x4){0u, 0u, 0u, 0u}; if (row >= 0) vr[it][e] = *(const u32x4*)(RV + (size_t)row * 1024 + h_ * 256 + ch * 8); } } } while (0)
    int u = blockIdx.x;
    if (u >= 1024) return;
    const int G = gridDim.x;
    KV_LOAD_UNIT(u);
    for (; u < 1024; u += G) {
        const int b = u >> 8, n = (u & 255) >> 2, h = u & 3;
        const float lg2 = log2f(1.0f - exp2f(-5.0f - (float)h));
        __syncthreads();
#pragma unroll
        for (int it = 0; it < 2; ++it) { const int id = it * NTHREADS + tid, ch = id & 15, pr = id >> 4;
            const float f0 = 0.08838834764831845f * __builtin_amdgcn_exp2f(lg2 * (float)(127 - 2 * pr)), f1 = 0.08838834764831845f * __builtin_amdgcn_exp2f(lg2 * (float)(126 - 2 * pr));
            tr_write8s(lds + KT_OFF, RS, ch * 8, pr, scale8(kr[it][0], f0), scale8(kr[it][1], f1)); }
#pragma unroll
        for (int it = 0; it < 4; ++it) { const int id = it * NTHREADS + tid, ch = id & 31, pr = id >> 5;
            tr_write8s(lds + VT_OFF, RS, ch * 8, pr, vr[it][0], vr[it][1]); }
        __syncthreads();
        { const int un = (u + G < 1024) ? u + G : u; KV_LOAD_UNIT(un); }
        const int mt = w;
        bf16x8 a[4];
#pragma unroll
        for (int ks = 0; ks < 4; ++ks) a[ks] = *(const LAS bf16x8*)(lds + KT_OFF + tr_off(16 * mt + r, RS, 8 * ks + 2 * q));
        bf16_t* dst = KVS + kvs_slot(b, n, h);
#pragma unroll 4
        for (int nt = 0; nt < 16; ++nt) {
            f32x4 acc = (f32x4){0.f, 0.f, 0.f, 0.f};
#pragma unroll
            for (int ks = 0; ks < 4; ++ks) { const bf16x8 bb = *(const LAS bf16x8*)(lds + VT_OFF + tr_off(16 * nt + r, RS, 8 * ks + 2 * q)); acc = MFMA16(a[ks], bb, acc); }
            u32x2 o; o.x = cvt_pk_bf16(acc[0], acc[1]); o.y = cvt_pk_bf16(acc[2], acc[3]);
            *(u32x2*)(dst + (size_t)(16 * nt + r) * 128 + 16 * mt + 4 * q) = o;
        }
    }
#undef KV_LOAD_UNIT
}

__device__ __forceinline__ void scan_phase(const Args& p) {
    bf16_t* KVS = (bf16_t*)((unsigned char*)p.out + DOUT_KVS);
    for (int gid = blockIdx.x * NTHREADS + threadIdx.x; gid < 16 * 8192; gid += gridDim.x * NTHREADS) {
        const int bh = gid >> 13, b = bh >> 2, h = bh & 3, off = (gid & 8191) * 4;
        const float dec = exp2f(128.0f * log2f(1.0f - exp2f(-5.0f - (float)h)));
        float s0 = 0.f, s1 = 0.f, s2 = 0.f, s3 = 0.f;
        bf16_t* base = KVS + kvs_slot(b, 0, h) + off;
        for (int n0 = 0; n0 < 64; n0 += 16) {
            u32x2 v[16];
#pragma unroll
            for (int j = 0; j < 16; ++j) v[j] = *(const u32x2*)(base + (size_t)(n0 + j) * 4 * 32768);
#pragma unroll
            for (int j = 0; j < 16; ++j) {
                s0 = dec * s0 + bf_lo(v[j].x); s1 = dec * s1 + bf_hi(v[j].x); s2 = dec * s2 + bf_lo(v[j].y); s3 = dec * s3 + bf_hi(v[j].y);
                u32x2 o; o.x = cvt_pk_bf16(s0, s1); o.y = cvt_pk_bf16(s2, s3);
                *(u32x2*)(base + (size_t)(n0 + j) * 4 * 32768) = o;
            }
        }
    }
}

__device__ __forceinline__ void retout_phase(LAS unsigned char* lds, const Args& p) {
    int tid_ = threadIdx.x; asm volatile("" : "+v"(tid_));
    const int tid = tid_, lane = tid & 63, w = __builtin_amdgcn_readfirstlane(tid >> 6), r = lane & 15, q = lane >> 4;
    const bf16_t* RQ = (const bf16_t*)(p.ws + OFF_RQ); const bf16_t* RK = (const bf16_t*)(p.ws + OFF_RK); const bf16_t* RV = (const bf16_t*)(p.ws + OFF_RV); const bf16_t* RG = (const bf16_t*)(p.ws + OFF_RG);
    const bf16_t* KVS = (const bf16_t*)((unsigned char*)p.out + DOUT_KVS);
    bf16_t* YRET = (bf16_t*)(p.ws + OFF_YRET);
    constexpr int RS = 136, K_OFF = 0, SB = 128 * RS * 2, QSZ = 64 * RS * 2;
    const int G = gridDim.x, vch = tid & 7, vpr = tid >> 3, srow = tid >> 4, sch = tid & 15;
    const LAS unsigned char* vlb = lds + SB + r * RS * 2 + ((q ^ (2 * (r >> 3))) << 3);
    u32x4 kreg[4], vreg[2], sreg[2], qn[4];
#define RO_LOAD_KQ(uu) do { const int b_ = (uu) >> 8, c_ = 1 + (((uu) & 255) >> 2), h_ = (uu) & 3; const size_t tb_ = (size_t)b_ * SEQ + (size_t)(c_ - 1) * 128; \
        _Pragma("unroll") for (int it = 0; it < 4; ++it) kreg[it] = *(const u32x4*)(RK + (tb_ + 32 * it + srow) * 512 + h_ * 128 + sch * 8); } while (0)
#define RO_LOAD_Q(uu) do { const int b_ = (uu) >> 8, c_ = 1 + (((uu) & 255) >> 2), h_ = (uu) & 3; const size_t tb_ = (size_t)b_ * SEQ + (size_t)(c_ - 1) * 128; \
        _Pragma("unroll") for (int ks = 0; ks < 4; ++ks) qn[ks] = *(const u32x4*)(RQ + (tb_ + 16 * w + r) * 512 + h_ * 128 + 32 * ks + 8 * q); } while (0)
#define RO_LOAD_STAGE(uu, sg) do { const int b_ = (uu) >> 8, c_ = 1 + (((uu) & 255) >> 2), h_ = (uu) & 3; const size_t tb_ = (size_t)b_ * SEQ + (size_t)(c_ - 1) * 128; \
        const bf16_t* st_ = KVS + kvs_slot(b_, c_ - 1, h_) + (size_t)(64 * (sg)) * 128; \
        vreg[0] = *(const u32x4*)(RV + (tb_ + 2 * vpr) * 1024 + h_ * 256 + 64 * (sg) + vch * 8); vreg[1] = *(const u32x4*)(RV + (tb_ + 2 * vpr + 1) * 1024 + h_ * 256 + 64 * (sg) + vch * 8); \
        sreg[0] = *(const u32x4*)(st_ + (size_t)srow * 128 + sch * 8); sreg[1] = *(const u32x4*)(st_ + (size_t)(32 + srow) * 128 + sch * 8); } while (0)
#define RO_WRITE_K() do { _Pragma("unroll") for (int it = 0; it < 4; ++it) *(LAS u32x4*)(lds + K_OFF + ((32 * it + srow) * RS + sch * 8) * 2) = kreg[it]; } while (0)
#define RO_WRITE_STAGE(j) do { tr_write8s(lds + SB + 2 * (j) * QSZ, RS, vch * 8, vpr, vreg[0], vreg[1]); \
        *(LAS u32x4*)(lds + SB + (2 * (j) + 1) * QSZ + (srow * RS + sch * 8) * 2) = sreg[0]; *(LAS u32x4*)(lds + SB + (2 * (j) + 1) * QSZ + ((32 + srow) * RS + sch * 8) * 2) = sreg[1]; } while (0)
    int u = blockIdx.x;
    if (u >= 1024) return;
    RO_LOAD_KQ(u); RO_LOAD_Q(u); RO_LOAD_STAGE(u, 0);
    __syncthreads();
    RO_WRITE_K(); RO_WRITE_STAGE(0);
    __syncthreads();
    for (; u < 1024; u += G) {
        const int b = u >> 8, c = 1 + ((u & 255) >> 2), h = u & 3, un = (u + G < 1024) ? u + G : u;
        const size_t tokbase = (size_t)b * SEQ + (size_t)(c - 1) * 128;
        const float lg2 = log2f(1.0f - exp2f(-5.0f - (float)h));
        const int iq = 16 * w + r; const size_t qrow = tokbase + iq;
        bf16x8 Qd[4]; u32x2 Pk[8]; f32x4 o[16];
        {
#pragma unroll
            for (int kt = 0; kt < 8; ++kt) {
                {
                    f32x4 acc = (f32x4){0.f, 0.f, 0.f, 0.f};
#pragma unroll
                    for (int ks = 0; ks < 4; ++ks) { const bf16x8 a = *(const LAS bf16x8*)(lds + K_OFF + ((16 * kt + r) * RS + 32 * ks + 8 * q) * 2); acc = MFMA16(a, as_frag(qn[ks]), acc); }
#pragma unroll
                    for (int i = 0; i < 4; ++i) { const int d = iq - (16 * kt + 4 * q + i); acc[i] = (d >= 0) ? acc[i] * 0.08838834764831845f * __builtin_amdgcn_exp2f(lg2 * (float)d) : 0.f; }
                    Pk[kt].x = cvt_pk_bf16(acc[0], acc[1]); Pk[kt].y = cvt_pk_bf16(acc[2], acc[3]);
                }
                if (kt & 1) __builtin_amdgcn_sched_barrier(0);
            }
            const float qdec = __builtin_amdgcn_exp2f(lg2 * (float)(iq + 1));
#pragma unroll
            for (int ks = 0; ks < 4; ++ks) Qd[ks] = as_frag(scale8(qn[ks], qdec));
        }
#pragma unroll
        for (int sg = 0; sg < 4; ++sg) {
            if (sg < 3) RO_LOAD_STAGE(u, sg + 1); else { RO_LOAD_KQ(un); RO_LOAD_STAGE(un, 0); }
            const int bo = 2 * (sg & 1) * QSZ;
#pragma unroll
            for (int j = 0; j < 4; ++j) {
                f32x4 acc = (f32x4){0.f, 0.f, 0.f, 0.f};
#pragma unroll
                for (int ks = 0; ks < 4; ++ks) { const bf16x8 a = *(const LAS bf16x8*)(lds + SB + bo + QSZ + ((16 * j + r) * RS + 32 * ks + 8 * q) * 2); acc = MFMA16(a, Qd[ks], acc); }
#pragma unroll
                for (int kp = 0; kp < 4; ++kp) {
                    {
                        const u32x2 a0 = *(const LAS u32x2*)(vlb + bo + 16 * j * RS * 2 + ((((kp ^ (j >> 1)) << 3) | ((0 ^ (j & 1)) << 2)) << 3));
                        const u32x2 a1 = *(const LAS u32x2*)(vlb + bo + 16 * j * RS * 2 + ((((kp ^ (j >> 1)) << 3) | ((1 ^ (j & 1)) << 2)) << 3));
                        const u32x4 a = (u32x4){a0.x, a0.y, a1.x, a1.y}, bb = (u32x4){Pk[2 * kp].x, Pk[2 * kp].y, Pk[2 * kp + 1].x, Pk[2 * kp + 1].y};
                        acc = MFMA16(as_frag(a), as_frag(bb), acc);
                    }
                }
                o[sg * 4 + j] = acc;
                if (j & 1) __builtin_amdgcn_sched_barrier(0);
            }
            if (sg == 3) RO_WRITE_K();
            RO_WRITE_STAGE((sg + 1) & 1);
            __syncthreads();
        }
        RO_LOAD_Q(un);
        float ss = 0.f;
#pragma unroll
        for (int t = 0; t < 16; ++t) ss += (o[t][0] * o[t][0] + o[t][1] * o[t][1]) + (o[t][2] * o[t][2] + o[t][3] * o[t][3]);
        ss += __shfl_xor(ss, 16); ss += __shfl_xor(ss, 32);
        const float rstd = 1.f / sqrtf(ss * (1.f / 256.f) + EPS);
        const int qodd = q & 1;
#pragma unroll
        for (int tp = 0; tp < 8; ++tp) {
            const int t0 = 2 * tp, t1 = 2 * tp + 1;
            const int dvw = 32 * tp + (qodd ? 16 + 4 * (q - 1) : 4 * q);
            const u32x4 gw = *(const u32x4*)(RG + qrow * 1024 + h * 256 + dvw);
            const u32x2 sx = __builtin_amdgcn_permlane16_swap(gw.x, gw.z, false, false), sy = __builtin_amdgcn_permlane16_swap(gw.y, gw.w, false, false);
            const f32x4 g0 = *(const f32x4*)(p.ret_g + h * 256 + 16 * t0 + 4 * q), g1 = *(const f32x4*)(p.ret_g + h * 256 + 16 * t1 + 4 * q);
            u32x2 ov0, ov1;
            { const float x0 = bf_lo(sx.x), x1 = bf_hi(sx.x), x2 = bf_lo(sy.x), x3 = bf_hi(sy.x);
              ov0.x = cvt_pk_bf16(o[t0][0] * rstd * g0.x * x0 * sigmoidf_(x0), o[t0][1] * rstd * g0.y * x1 * sigmoidf_(x1));
              ov0.y = cvt_pk_bf16(o[t0][2] * rstd * g0.z * x2 * sigmoidf_(x2), o[t0][3] * rstd * g0.w * x3 * sigmoidf_(x3)); }
            { const float x0 = bf_lo(sx.y), x1 = bf_hi(sx.y), x2 = bf_lo(sy.y), x3 = bf_hi(sy.y);
              ov1.x = cvt_pk_bf16(o[t1][0] * rstd * g1.x * x0 * sigmoidf_(x0), o[t1][1] * rstd * g1.y * x1 * sigmoidf_(x1));
              ov1.y = cvt_pk_bf16(o[t1][2] * rstd * g1.z * x2 * sigmoidf_(x2), o[t1][3] * rstd * g1.w * x3 * sigmoidf_(x3)); }
            const u32x2 ox = __builtin_amdgcn_permlane16_swap(ov0.x, ov1.x, false, false), oy = __builtin_amdgcn_permlane16_swap(ov0.y, ov1.y, false, false);
            *(u32x4*)(YRET + qrow * 1024 + h * 256 + dvw) = (u32x4){ox.x, oy.x, ox.y, oy.y};
        }
    }
#undef RO_LOAD_KQ
#undef RO_LOAD_Q
#undef RO_LOAD_STAGE
#undef RO_WRITE_K
#undef RO_WRITE_STAGE
}

__device__ __forceinline__ void meta_proj(const Args& p, const bf16_t* XN, const bf16_t* WinT) {
    int tid_ = threadIdx.x; asm volatile("" : "+v"(tid_));
    const int tid = tid_, lane = tid & 63, r = lane & 15, q = lane >> 4;
    if ((tid >> 6) != 0) return;
    for (int t = blockIdx.x; t < 128; t += gridDim.x) {
        int ncol, ld, cl; size_t boff;
        if (t < 32) { ncol = 512 + 16 * t; boff = OFF_RK; ld = 512; cl = 16 * t; }
        else if (t < 96) { ncol = 1024 + 16 * (t - 32); boff = OFF_RV; ld = 1024; cl = 16 * (t - 32); }
        else if (t < 112) { ncol = 4096 + 16 * (t - 96); boff = OFF_SK; ld = 256; cl = 16 * (t - 96); }
        else { ncol = 4352 + 16 * (t - 112); boff = OFF_SV; ld = 256; cl = 16 * (t - 112); }
        const bf16_t* ap = WinT + (size_t)(ncol + r) * DM + 8 * q; const bf16_t* bp = XN + (size_t)(NTOK + r) * DM + 8 * q;
        f32x4 acc = (f32x4){0.f, 0.f, 0.f, 0.f};
#pragma unroll 8
        for (int ks = 0; ks < 32; ++ks) { const u32x4 a = *(const u32x4*)(ap + 32 * ks), b = *(const u32x4*)(bp + 32 * ks); acc = MFMA16(as_frag(a), as_frag(b), acc); }
        u32x2 o; o.x = cvt_pk_bf16(acc[0], acc[1]); o.y = cvt_pk_bf16(acc[2], acc[3]);
        *(u32x2*)((bf16_t*)(p.ws + boff) + (size_t)(NTOK + r) * ld + cl + 4 * q) = o;
    }
}

#define XB_TMO      128
#define XB_XCNT(j)  (256  + 64 * (j))
#define XB_XSUB(j)  (1280 + 64 * (j))
#define XB_XGEN(j)  (2304 + 64 * (j))
#define XB_TOP      3328
#define XB_TOPGEN   3392
#define XCD_BAR_WORDS 3456
#define XB_SPIN_CAP (1u << 22)
__device__ __forceinline__ unsigned xb_ld(unsigned* p)              { return __hip_atomic_load(p, __ATOMIC_RELAXED, __HIP_MEMORY_SCOPE_AGENT); }
__device__ __forceinline__ unsigned xb_add(unsigned* p, unsigned v) { return __hip_atomic_fetch_add(p, v, __ATOMIC_RELAXED, __HIP_MEMORY_SCOPE_AGENT); }
__device__ __forceinline__ unsigned xb_xcc_id() { return (unsigned)__builtin_amdgcn_s_getreg((3 << 11) | 20) & 0xFu; }
#define XB_SPIN(cond, bar) do { unsigned _sp = 0; while (cond) { __builtin_amdgcn_s_sleep(1); \
    if ((++_sp & 255u) == 0u) { if (xb_ld(&(bar)[XB_TMO])) break; if (_sp > XB_SPIN_CAP) { atomicAdd(&(bar)[XB_TMO], 1u); break; } } } } while (0)
struct XcdBarrier { unsigned* bar; unsigned x; volatile LAS unsigned* st; };
__device__ __forceinline__ XcdBarrier xcd_barrier_post(unsigned* bar, volatile LAS unsigned* st) {
    XcdBarrier b; b.bar = bar; b.x = xb_xcc_id(); b.st = st;
    if (threadIdx.x == 0) (void)xb_add(&bar[XB_XCNT(b.x)], 1u);
    return b;
}
__device__ __forceinline__ void xcd_barrier_complete(unsigned* bar, unsigned x, unsigned& nloc, unsigned& nx) {
    const unsigned G = gridDim.x * gridDim.y * gridDim.z;
    unsigned sum, cnt, mine, sp = 0u;
    for (;;) {
        sum = 0u; cnt = 0u; mine = 0u;
#pragma unroll
        for (unsigned j = 0; j < 16; ++j) { const unsigned c = xb_ld(&bar[XB_XCNT(j)]); sum += c; cnt += (c > 0u) ? 1u : 0u; mine = (j == x) ? c : mine; }
        if (sum == G) break;
        __builtin_amdgcn_s_sleep(1);
        if ((++sp & 255u) == 0u) { if (xb_ld(&bar[XB_TMO])) break; if (sp > XB_SPIN_CAP) { atomicAdd(&bar[XB_TMO], 1u); break; } }
    }
    nloc = mine > 0u ? mine : 1u; nx = cnt > 0u ? cnt : 1u;
}
__device__ __forceinline__ void xcd_barrier(const XcdBarrier& b) {
    asm volatile("s_waitcnt vmcnt(0)" ::: "memory");
    __syncthreads();
    if (threadIdx.x == 0) {
        unsigned* bar = b.bar;
        __builtin_amdgcn_s_waitcnt(0);
        unsigned nloc = b.st[0], nx = b.st[1];
        if (nloc == 0u) { xcd_barrier_complete(bar, b.x, nloc, nx); b.st[0] = nloc; b.st[1] = nx; }
        const unsigned old = xb_add(&bar[XB_XSUB(b.x)], 1u);
        const unsigned gen = old / nloc;
        if (old + 1u == (gen + 1u) * nloc) {
            __builtin_amdgcn_fence(__ATOMIC_RELEASE, "agent");
            asm volatile("s_waitcnt vmcnt(0)" ::: "memory");
            const unsigned og = xb_add(&bar[XB_TOP], 1u);
            const unsigned tg = og / nx;
            if (og + 1u == (tg + 1u) * nx) xb_add(&bar[XB_TOPGEN], 1u);
            else XB_SPIN(xb_ld(&bar[XB_TOPGEN]) == tg, bar);
            __builtin_amdgcn_fence(__ATOMIC_ACQUIRE, "agent");
            xb_add(&bar[XB_XGEN(b.x)], 1u);
            asm volatile("s_waitcnt vmcnt(0)" ::: "memory");
        } else {
            XB_SPIN(xb_ld(&bar[XB_XGEN(b.x)]) == gen, bar);
            __builtin_amdgcn_fence(__ATOMIC_ACQUIRE, "agent");
            asm volatile("s_waitcnt vmcnt(0)" ::: "memory");
        }
    }
    __syncthreads();
}

__device__ __forceinline__ void convert_slot(const Args& p, LAS unsigned char* lds, const int list) {
    const unsigned grp = (blockIdx.x >> 3) & 3u;
    if (grp == 0u) return;
    int tid_ = threadIdx.x; asm volatile("" : "+v"(tid_));
    const int tid = tid_, lane = tid & 63, wave = __builtin_amdgcn_readfirstlane(tid >> 6);
    constexpr int I_SQ = (DM / 64) * (DM / 32), I_UP = (DM / 64) * (FF / 32), I_DN = (FF / 64) * (DM / 32);
    const int total = list == 0 ? 3 * I_SQ + I_UP : I_DN;
    const int lo = grp == 1u ? 0 : (grp == 2u ? total / 6 : total / 2), hi = grp == 1u ? total / 6 : (grp == 2u ? total / 2 : total);
    const int j = (int)(((blockIdx.x >> 5) << 3) | (blockIdx.x & 7u));
    LAS float* scr = (LAS float*)(lds + wave * 16384);
    unsigned char* ws = p.ws;
    for (int it = lo + j * 8 + wave; it < hi; it += 512) {
        if (list == 0) {
            int r = it;
            if (r < I_SQ) { p0_transpose_item(p.w_ret, DM, DM, (bf16_t*)(ws + OFF_WRET), scr, r, lane); continue; } r -= I_SQ;
            if (r < I_SQ) { p0_transpose_item(p.w_swa, DM, DM, (bf16_t*)(ws + OFF_WSWA), scr, r, lane); continue; } r -= I_SQ;
            if (r < I_SQ) { p0_transpose_item(p.w_out, DM, DM, (bf16_t*)(ws + OFF_WOUT), scr, r, lane); continue; } r -= I_SQ;
            p0_transpose_item(p.w_up, DM, FF, (bf16_t*)(ws + OFF_WUP), scr, r, lane, p.mlp_g);
        } else p0_transpose_item(p.w_down, FF, DM, (bf16_t*)(ws + OFF_WDN), scr, it, lane);
    }
    __syncthreads();
}

__global__ void __launch_bounds__(NTHREADS, 2) fwd_megakernel(Args p) {
    extern __shared__ __attribute__((aligned(16))) unsigned char lds_raw[];
    LAS unsigned char* lds = (LAS unsigned char*)lds_raw;
    cg::grid_group grid = cg::this_grid();
    ((LAS unsigned*)(lds + 131072 + 64))[threadIdx.x & 15] = 0u;
    __syncthreads();
    XcdBarrier xbar = xcd_barrier_post((unsigned*)(p.ws + OFF_CTL), (volatile LAS unsigned*)(lds + 131072 + 64));
    grid.sync();
#define GRID_SYNC() xcd_barrier(xbar)
    const int tid = threadIdx.x, lane = tid & 63, wave = __builtin_amdgcn_readfirstlane(tid >> 6);
    const int G = gridDim.x, gw = blockIdx.x * 8 + wave, NGW = G * 8;
    unsigned char* ws = p.ws;
    bf16_t* WinT = (bf16_t*)(ws + OFF_WIN); bf16_t* WretT = (bf16_t*)(ws + OFF_WRET); bf16_t* WswaT = (bf16_t*)(ws + OFF_WSWA); bf16_t* WoutT = (bf16_t*)(ws + OFF_WOUT);
    bf16_t* WupT = (bf16_t*)(ws + OFF_WUP); bf16_t* WdnT = (bf16_t*)(ws + OFF_WDN);
    bf16_t* XN = (bf16_t*)p.out;

    for (int rep = 0; rep < 1 + ((REP_MASK >> 0) & 1); ++rep) {
        LAS float* scr = (LAS float*)(lds + wave * 16384);
        constexpr int I_IN = (DM / 64) * (DIN / 32), I_SQ = (DM / 64) * (DM / 32), I_UP = (DM / 64) * (FF / 32), I_DN = (FF / 64) * (DM / 32);
        constexpr int NITEMS = I_IN + 3 * I_SQ + I_UP + I_DN;
        const bool split = (G == 256);
        for (int it = gw; it < (split ? I_IN : NITEMS); it += NGW) {
            int r = it;
            if (r < I_IN) { p0_transpose_item(p.w_in, DM, DIN, WinT, scr, r, lane); continue; } r -= I_IN;
            if (r < I_SQ) { p0_transpose_item(p.w_ret, DM, DM, WretT, scr, r, lane); continue; } r -= I_SQ;
            if (r < I_SQ) { p0_transpose_item(p.w_swa, DM, DM, WswaT, scr, r, lane); continue; } r -= I_SQ;
            if (r < I_SQ) { p0_transpose_item(p.w_out, DM, DM, WoutT, scr, r, lane); continue; } r -= I_SQ;
            if (r < I_UP) { p0_transpose_item(p.w_up, DM, FF, WupT, scr, r, lane, p.mlp_g); continue; } r -= I_UP;
            p0_transpose_item(p.w_down, FF, DM, WdnT, scr, r, lane);
        }
        for (int m = gw; m < NTOK; m += 2 * NGW) {
            const int m2 = m + NGW;
            const f32x4* xa = (const f32x4*)(p.x + (size_t)m * DM) + lane; const f32x4* xb = (const f32x4*)(p.x + (size_t)(m2 < NTOK ? m2 : m) * DM) + lane; const f32x4* gr = (const f32x4*)p.mix_g + lane;
            f32x4 va[4], vb[4]; float sa = 0.f, sb = 0.f;
#pragma unroll
            for (int j = 0; j < 4; ++j) { va[j] = xa[64 * j]; vb[j] = xb[64 * j]; }
#pragma unroll
            for (int j = 0; j < 4; ++j) { sa += (va[j].x * va[j].x + va[j].y * va[j].y) + (va[j].z * va[j].z + va[j].w * va[j].w); sb += (vb[j].x * vb[j].x + vb[j].y * vb[j].y) + (vb[j].z * vb[j].z + vb[j].w * vb[j].w); }
            const float ra = 1.f / sqrtf(wave_sum(sa) * (1.f / DM) + EPS), rb = 1.f / sqrtf(wave_sum(sb) * (1.f / DM) + EPS);
            u32x2* oa = (u32x2*)(XN + (size_t)m * DM) + lane; u32x2* ob = (u32x2*)(XN + (size_t)m2 * DM) + lane;
#pragma unroll
            for (int j = 0; j < 4; ++j) { const f32x4 gg = gr[64 * j];
                u32x2 wa; wa.x = cvt_pk_bf16_asm(va[j].x * ra * gg.x, va[j].y * ra * gg.y); wa.y = cvt_pk_bf16_asm(va[j].z * ra * gg.z, va[j].w * ra * gg.w); oa[64 * j] = wa;
                if (m2 < NTOK) { u32x2 wb; wb.x = cvt_pk_bf16_asm(vb[j].x * rb * gg.x, vb[j].y * rb * gg.y); wb.y = cvt_pk_bf16_asm(vb[j].z * rb * gg.z, vb[j].w * rb * gg.w); ob[64 * j] = wb; } }
        }
        if (gw < NMETA) rms_row_to_bf16(p.meta + (size_t)gw * DM, p.mix_g, XN + (size_t)(NTOK + gw) * DM, lane);
    }
    GRID_SYNC();
    {
        meta_proj(p, XN, WinT);
        if (G == 256) convert_slot(p, lds, 0);
        pg8::Gemm g{XN, WinT, XN, WinT, NTOK, DIN, DM}; pg8::StaticOrder S; S.init(NTOK, DIN, G, (int)blockIdx.x);
        pg8::EpiProj E{ws};
        pg8::gemm_phase<pg8::EpiProj, pg8::StaticOrder, true>(lds, g, S, E);
    }
    GRID_SYNC();
    for (int rep = 0; rep < 1 + ((REP_MASK >> 1) & 1); ++rep) { swa_phase(lds, p); kvlocal_phase(lds, p); }
    GRID_SYNC();
    scan_phase(p);
    GRID_SYNC();
    for (int rep = 0; rep < 1 + ((REP_MASK >> 2) & 1); ++rep) retout_phase(lds, p);
    GRID_SYNC();
    {
        const bf16_t* YRET = (const bf16_t*)(ws + OFF_YRET); const bf16_t* YSWA = (const bf16_t*)((unsigned char*)p.out + DOUT_YSWA);
        pg8::Gemm g{YRET, WretT, YSWA, WswaT, NTOK, DM, DM}; pg8::PairOrder S; S.s.init(NTOK, DM, G, (int)blockIdx.x);
        pg8::EpiMerged E{(const unsigned char*)(ws + OFF_GR), (const unsigned char*)(ws + OFF_GS), (bf16_t*)(ws + OFF_MERGED)};
        pg8::gemm_phase<pg8::EpiMerged, pg8::PairOrder, true>(lds, g, S, E);
    }
    GRID_SYNC();
    {
        const bf16_t* MG = (const bf16_t*)(ws + OFF_MERGED);
        pg8::Gemm g{MG, WoutT, MG, WoutT, NTOK, DM, DM}; pg8::StaticOrder S; S.init(NTOK, DM, G, (int)blockIdx.x);
        pg8::EpiResStat E{p.x, p.out, (bf16_t*)(ws + OFF_HN2), (float*)(ws + OFF_SS)};
        pg8::gemm_phase<pg8::EpiResStat, pg8::StaticOrder, true>(lds, g, S, E);
    }
    GRID_SYNC();
    {
        const bf16_t* HN2 = (const bf16_t*)(ws + OFF_HN2);
        pg8::Gemm g{HN2, WupT, HN2, WupT, NTOK, FF, DM}; pg8::StaticOrder S; S.init(NTOK, FF, G, (int)blockIdx.x);
        pg8::EpiUp E{(bf16_t*)(ws + OFF_U), (const float*)(ws + OFF_SS)};
        if (G == 256) convert_slot(p, lds, 1);
        pg8::gemm_phase<pg8::EpiUp, pg8::StaticOrder, true>(lds, g, S, E);
    }
    GRID_SYNC();
    {
        const bf16_t* U = (const bf16_t*)(ws + OFF_U);
        pg8::Gemm g{U, WdnT, U, WdnT, NTOK, DM, FF}; pg8::StaticOrder S; S.init(NTOK, DM, G, (int)blockIdx.x);
        pg8::EpiResBf E{(const bf16_t*)(ws + OFF_HN2), p.out};
        pg8::gemm_phase<pg8::EpiResBf, pg8::StaticOrder, true>(lds, g, S, E);
    }
}

extern "C" void kernel_launch(void* const* d_in, const int* in_sizes, int n_in, void* d_out, int out_size, void* d_ws, size_t ws_size, hipStream_t stream) {
    static int grid = 0;
    if (grid == 0) {
        if (n_in != 14 || in_sizes[0] != NTOK * DM || out_size != NTOK * DM || ws_size < WS_NEED) {
            fprintf(stderr, "kernel_launch: unexpected shapes (n_in %d, in0 %d, out %d, ws %zu, need %zu); nothing launched\n", n_in, n_in > 0 ? in_sizes[0] : -1, out_size, ws_size, (size_t)WS_NEED); grid = -1; return; }
        int dev = 0, cus = 0, per_cu = 0;
        (void)hipGetDevice(&dev); (void)hipDeviceGetAttribute(&cus, hipDeviceAttributeMultiprocessorCount, dev);
        if (hipFuncSetAttribute((const void*)fwd_megakernel, hipFuncAttributeMaxDynamicSharedMemorySize, LDS_BYTES) != hipSuccess) { fprintf(stderr, "kernel_launch: hipFuncSetAttribute failed\n"); grid = -1; return; }
        if (hipOccupancyMaxActiveBlocksPerMultiprocessor(&per_cu, (const void*)fwd_megakernel, NTHREADS, LDS_BYTES) != hipSuccess || per_cu < 1) { fprintf(stderr, "kernel_launch: occupancy query gave %d\n", per_cu); per_cu = 1; }
        (void)hipGetLastError();
        grid = cus * per_cu;
    }
    if (grid < 0) return;
    Args a{};
    a.x = (const float*)d_in[0]; a.meta = (const float*)d_in[1]; a.mix_g = (const float*)d_in[2]; a.w_in = (const float*)d_in[3]; a.ret_g = (const float*)d_in[4];
    a.q_g = (const float*)d_in[5]; a.k_g = (const float*)d_in[6]; a.sinks = (const float*)d_in[7]; a.w_ret = (const float*)d_in[8]; a.w_swa = (const float*)d_in[9];
    a.w_out = (const float*)d_in[10]; a.mlp_g = (const float*)d_in[11]; a.w_up = (const float*)d_in[12]; a.w_down = (const float*)d_in[13];
    a.out = (float*)d_out; a.ws = (unsigned char*)d_ws;
    if (hipMemsetAsync((unsigned char*)d_ws + OFF_CTL, 0, CTL_BYTES, stream) != hipSuccess) { fprintf(stderr, "kernel_launch: memset failed\n"); return; }
    void* args[] = {&a};
    hipError_t e = hipLaunchCooperativeKernel((const void*)fwd_megakernel, dim3(grid), dim3(NTHREADS), args, LDS_BYTES, stream);
    if (e != hipSuccess) fprintf(stderr, "kernel_launch: cooperative launch failed: %s (grid %d)\n", hipGetErrorString(e), grid);
}
```

```cpp
#ifndef REP_MASK
#define REP_MASK 0
#endif
#include <hip/hip_runtime.h>
#include <hip/hip_cooperative_groups.h>
#include <cstdio>
#include <cstdint>
namespace cg = cooperative_groups;

#define LAS __attribute__((address_space(3)))
typedef unsigned short bf16_t;
typedef short bf16x8 __attribute__((ext_vector_type(8)));
typedef float f32x4 __attribute__((ext_vector_type(4)));
typedef unsigned u32x4 __attribute__((ext_vector_type(4)));
typedef unsigned u32x2 __attribute__((ext_vector_type(2)));

constexpr int NB = 4, SEQ = 8192, DM = 1024, NTOK = NB * SEQ, NMETA = 16, MROWS = NTOK + NMETA, MPAD = 33024, DIN = 6656, FF = 4096;
constexpr float EPS = 1e-6f;
constexpr int NTHREADS = 512;
constexpr int LDS_BYTES = 135168;

constexpr size_t SZ_WIN = (size_t)DIN * DM * 2, SZ_WSQ = (size_t)DM * DM * 2, SZ_WFF = (size_t)FF * DM * 2;
constexpr size_t OFF_WIN = 0, OFF_WRET = OFF_WIN + SZ_WIN, OFF_WSWA = OFF_WRET + SZ_WSQ, OFF_WOUT = OFF_WSWA + SZ_WSQ, OFF_WUP = OFF_WOUT + SZ_WSQ, OFF_WDN = OFF_WUP + SZ_WFF;
constexpr size_t OFF_RQ = OFF_WDN + SZ_WFF;
constexpr size_t OFF_RK = OFF_RQ + (size_t)MROWS * 512 * 2;
constexpr size_t OFF_RV = OFF_RK + (size_t)MROWS * 512 * 2;
constexpr size_t OFF_RG = OFF_RV + (size_t)MROWS * 1024 * 2;
constexpr size_t OFF_SQ = OFF_RG + (size_t)MROWS * 1024 * 2;
constexpr size_t OFF_SK = OFF_SQ + (size_t)MROWS * 1024 * 2;
constexpr size_t OFF_SV = OFF_SK + (size_t)MROWS * 256 * 2;
constexpr size_t OFF_GR = OFF_SV + (size_t)MROWS * 256 * 2;
constexpr size_t OFF_GS = OFF_GR + (size_t)MROWS * 1024 * 2;
constexpr size_t OFF_CTL = OFF_GS + (size_t)MROWS * 1024 * 2;
constexpr size_t CTL_BYTES = 16384 + (size_t)NTOK * 4;
constexpr size_t OFF_SS = OFF_CTL + 16384;
constexpr size_t WS_NEED = OFF_CTL + CTL_BYTES;
constexpr size_t OFF_MERGED = OFF_RQ, OFF_HN2 = OFF_RV, OFF_YRET = OFF_SQ, OFF_U = OFF_RG;
static_assert(OFF_RK - OFF_RQ + OFF_RV - OFF_RK >= (size_t)NTOK * 1024 * 2, "MERGED fits");
static_assert(OFF_CTL - OFF_RG >= (size_t)NTOK * FF * 2, "U fits");
static_assert((size_t)MPAD * DM * 2 <= (size_t)NTOK * DM * 4, "XN fits d_out");
constexpr size_t DOUT_KVS = 0, DOUT_YSWA = (size_t)NTOK * 1024 * 2;

typedef __bf16 bf16x2_t __attribute__((ext_vector_type(2)));
typedef float f32x2_t __attribute__((ext_vector_type(2)));
__device__ __forceinline__ unsigned cvt_pk_bf16(float lo, float hi) { const f32x2_t v = {lo, hi}; const bf16x2_t b = __builtin_convertvector(v, bf16x2_t); return __builtin_bit_cast(unsigned, b); }
__device__ __forceinline__ unsigned cvt_pk_bf16_asm(float lo, float hi) { unsigned r; asm volatile("v_cvt_pk_bf16_f32 %0, %1, %2" : "=v"(r) : "v"(lo), "v"(hi)); return r; }
__device__ __forceinline__ float bf_lo(unsigned w) { return __uint_as_float(w << 16); }
__device__ __forceinline__ float bf_hi(unsigned w) { return __uint_as_float(w & 0xffff0000u); }
__device__ __forceinline__ float wave_sum(float v) {
#pragma unroll
    for (int o = 1; o < 64; o <<= 1) v += __shfl_xor(v, o);
    return v;
}
__device__ __forceinline__ float sigmoidf_(float x) { return __builtin_amdgcn_rcpf(1.0f + __builtin_amdgcn_exp2f(-1.4426950408889634f * x)); }

namespace pg8 {
constexpr int BM = 256, BK = 64, HALF = 128, HTB = HALF * BK * 2, STAGE_BYTES = 8 * HTB, NXCD = 8, WGM = 8;
__host__ __device__ __forceinline__ int lds_byte(int r, int c) { const int st = (r >> 4) * 2 + (c >> 5), rr = r & 15, cc = c & 31, ob = rr * 64 + cc * 2; return st * 1024 + (ob ^ (((ob >> 9) & 1) << 5)); }
__host__ __device__ __forceinline__ void stage_rc(int b, int& R, int& C) { const int st = b / 1024, sb = b % 1024, swz = sb ^ (((sb >> 9) & 1) << 5); R = (st >> 1) * 16 + swz / 64; C = (st & 1) * 32 + (swz % 64) / 2; }
__host__ __device__ __forceinline__ int perm32(int rho) { const int n = rho >> 4, i = rho & 15; return 8 * (i >> 2) + 4 * n + (i & 3); }

struct Unit { int pm, pn, seg; };
struct Gemm { const bf16_t* A; const bf16_t* Bt; const bf16_t* A2; const bf16_t* Bt2; int M, N, K; };

struct StaticOrder {
    int nM, nN, nwg, G, c;
    __device__ void init(int M, int N, int G_, int c_) { nM = M / BM; nN = N / BM; nwg = nM * nN; G = G_; c = c_; }
    __device__ bool tile(long L, Unit& u) const {
        if (L >= nwg) return false;
        int wgid = (int)L; { const int q = nwg / NXCD, r = nwg % NXCD, xcd = wgid % NXCD, off = wgid / NXCD; wgid = (xcd < r ? xcd * (q + 1) : r * (q + 1) + (xcd - r) * q) + off; }
        const int nig = WGM * nN, gid = wgid / nig, fm = gid * WGM, gsz = (nM - fm) < WGM ? (nM - fm) : WGM;
        u.pm = fm + ((wgid % nig) % gsz); u.pn = (wgid % nig) / gsz; u.seg = 0; return true;
    }
    __device__ bool next(int i, Unit& u) const { return tile((long)i * G + c, u); }
};
struct PairOrder {
    StaticOrder s;
    __device__ bool next(int i, Unit& u) const { const bool ok = s.tile((long)(i >> 1) * s.G + s.c, u); u.seg = i & 1; return ok; }
};

struct EpiProj {
    static constexpr bool PERM = true, HAS_MID = false;
    unsigned char* ws;
    __device__ __forceinline__ void mid(f32x4 (&acc)[2][2][4][2], const Unit& u, int wr, int wc, int fr, int fq) const {}
    __device__ __forceinline__ void operator()(const f32x4 (&acc)[2][2][4][2], const Unit& u, int wr, int wc, int fr, int fq) const {
        const int pn = u.pn; size_t boff; int ld, ct;
        if (pn < 2) { boff = OFF_RQ; ld = 512; ct = pn; }
        else if (pn < 4) { boff = OFF_RK; ld = 512; ct = pn - 2; }
        else if (pn < 8) { boff = OFF_RV; ld = 1024; ct = pn - 4; }
        else if (pn < 12) { boff = OFF_RG; ld = 1024; ct = pn - 8; }
        else if (pn < 16) { boff = OFF_SQ; ld = 1024; ct = pn - 12; }
        else if (pn == 16) { boff = OFF_SK; ld = 256; ct = 0; }
        else if (pn == 17) { boff = OFF_SV; ld = 256; ct = 0; }
        else if (pn < 22) { boff = OFF_GR; ld = 1024; ct = pn - 18; }
        else { boff = OFF_GS; ld = 1024; ct = pn - 22; }
        bf16_t* base = (bf16_t*)(ws + boff);
        const int row0 = u.pm * BM + wr * 64 + fr, col0 = ct * 256 + wc * 32 + 8 * fq;
        if (pn >= 18) {
            unsigned char* gb = ws + boff;
#pragma unroll
            for (int ai = 0; ai < 2; ++ai)
#pragma unroll
                for (int m = 0; m < 4; ++m)
#pragma unroll
                    for (int bj = 0; bj < 2; ++bj) { const f32x4 v0 = acc[ai][bj][m][0], v1 = acc[ai][bj][m][1];
                        int w0 = __builtin_amdgcn_cvt_pk_fp8_f32(v0[0], v0[1], 0, false); w0 = __builtin_amdgcn_cvt_pk_fp8_f32(v0[2], v0[3], w0, true);
                        int w1 = __builtin_amdgcn_cvt_pk_fp8_f32(v1[0], v1[1], 0, false); w1 = __builtin_amdgcn_cvt_pk_fp8_f32(v1[2], v1[3], w1, true);
                        *(u32x2*)(gb + (size_t)(row0 + ai * HALF + m * 16) * 1024 + col0 + bj * HALF) = (u32x2){(unsigned)w0, (unsigned)w1}; }
            return;
        }
#pragma unroll
        for (int ai = 0; ai < 2; ++ai)
#pragma unroll
            for (int m = 0; m < 4; ++m) {
                bf16_t* rowp = base + (size_t)(row0 + ai * HALF + m * 16) * ld + col0;
#pragma unroll
                for (int bj = 0; bj < 2; ++bj) { const f32x4 v0 = acc[ai][bj][m][0], v1 = acc[ai][bj][m][1];
                    u32x4 w; w.x = cvt_pk_bf16_asm(v0[0], v0[1]); w.y = cvt_pk_bf16_asm(v0[2], v0[3]); w.z = cvt_pk_bf16_asm(v1[0], v1[1]); w.w = cvt_pk_bf16_asm(v1[2], v1[3]);
                    *(u32x4*)(rowp + bj * HALF) = w; } }
    }
};
struct EpiMerged {
    static constexpr bool PERM = true, HAS_MID = true;
    const unsigned char *GR, *GS; bf16_t* O;
    __device__ __forceinline__ void mid(f32x4 (&acc)[2][2][4][2], const Unit& u, int wr, int wc, int fr, int fq) const {
        const int row0 = u.pm * BM + wr * 64 + fr, col0 = u.pn * BM + wc * 32 + 8 * fq;
#pragma unroll
        for (int ai = 0; ai < 2; ++ai)
#pragma unroll
            for (int m = 0; m < 4; ++m)
#pragma unroll
                for (int bj = 0; bj < 2; ++bj) { const size_t off = (size_t)(row0 + ai * HALF + m * 16) * DM + col0 + bj * HALF;
                    const u32x2 a = *(const u32x2*)(GR + off), b = *(const u32x2*)(GS + off);
#define MRG_R(ga, gb) ((1.0f + __builtin_amdgcn_exp2f(-1.4426950408889634f * (gb))) * __builtin_amdgcn_rcpf(1.0f + __builtin_amdgcn_exp2f(-1.4426950408889634f * (ga))))
#define F8(w, k) __builtin_amdgcn_cvt_f32_fp8((int)(w), (k))
                    f32x4 r0, r1;
                    r0[0] = MRG_R(F8(a.x, 0), F8(b.x, 0)); r0[1] = MRG_R(F8(a.x, 1), F8(b.x, 1)); r0[2] = MRG_R(F8(a.x, 2), F8(b.x, 2)); r0[3] = MRG_R(F8(a.x, 3), F8(b.x, 3));
                    r1[0] = MRG_R(F8(a.y, 0), F8(b.y, 0)); r1[1] = MRG_R(F8(a.y, 1), F8(b.y, 1)); r1[2] = MRG_R(F8(a.y, 2), F8(b.y, 2)); r1[3] = MRG_R(F8(a.y, 3), F8(b.y, 3));
#undef MRG_R
                    acc[ai][bj][m][0] = acc[ai][bj][m][0] * r0; acc[ai][bj][m][1] = acc[ai][bj][m][1] * r1; }
    }
    __device__ __forceinline__ void operator()(const f32x4 (&acc)[2][2][4][2], const Unit& u, int wr, int wc, int fr, int fq) const {
        const int row0 = u.pm * BM + wr * 64 + fr, col0 = u.pn * BM + wc * 32 + 8 * fq;
#pragma unroll
        for (int ai = 0; ai < 2; ++ai)
#pragma unroll
            for (int m = 0; m < 4; ++m)
#pragma unroll
                for (int bj = 0; bj < 2; ++bj) { const size_t off = (size_t)(row0 + ai * HALF + m * 16) * DM + col0 + bj * HALF;
                    const u32x2 b = *(const u32x2*)(GS + off); const f32x4 v0 = acc[ai][bj][m][0], v1 = acc[ai][bj][m][1];
                    u32x4 w;
                    w.x = cvt_pk_bf16_asm(v0[0] * sigmoidf_(F8(b.x, 0)), v0[1] * sigmoidf_(F8(b.x, 1))); w.y = cvt_pk_bf16_asm(v0[2] * sigmoidf_(F8(b.x, 2)), v0[3] * sigmoidf_(F8(b.x, 3)));
                    w.z = cvt_pk_bf16_asm(v1[0] * sigmoidf_(F8(b.y, 0)), v1[1] * sigmoidf_(F8(b.y, 1))); w.w = cvt_pk_bf16_asm(v1[2] * sigmoidf_(F8(b.y, 2)), v1[3] * sigmoidf_(F8(b.y, 3)));
#undef F8
                    *(u32x4*)(O + off) = w; }
    }
};
struct EpiRes {
    static constexpr bool PERM = true, HAS_MID = false;
    const float* res; float* out;
    __device__ __forceinline__ void mid(f32x4 (&acc)[2][2][4][2], const Unit& u, int wr, int wc, int fr, int fq) const {}
    __device__ __forceinline__ void operator()(const f32x4 (&acc)[2][2][4][2], const Unit& u, int wr, int wc, int fr, int fq) const {
        const int row0 = u.pm * BM + wr * 64 + fr, col0 = u.pn * BM + wc * 32 + 8 * fq;
#pragma unroll
        for (int ai = 0; ai < 2; ++ai)
#pragma unroll
            for (int m = 0; m < 4; ++m)
#pragma unroll
                for (int bj = 0; bj < 2; ++bj) { const size_t off = (size_t)(row0 + ai * HALF + m * 16) * DM + col0 + bj * HALF;
                    const f32x4 x0 = *(const f32x4*)(res + off), x1 = *(const f32x4*)(res + off + 4);
                    *(f32x4*)(out + off) = x0 + acc[ai][bj][m][0]; *(f32x4*)(out + off + 4) = x1 + acc[ai][bj][m][1]; }
    }
};
struct EpiResStat {
    static constexpr bool PERM = true, HAS_MID = false;
    const float* res; float* out; bf16_t* hb; float* ss;
    __device__ __forceinline__ void mid(f32x4 (&acc)[2][2][4][2], const Unit& u, int wr, int wc, int fr, int fq) const {}
    __device__ __forceinline__ void operator()(const f32x4 (&acc)[2][2][4][2], const Unit& u, int wr, int wc, int fr, int fq) const {
        const int row0 = u.pm * BM + wr * 64 + fr, col0 = u.pn * BM + wc * 32 + 8 * fq;
#pragma unroll
        for (int ai = 0; ai < 2; ++ai)
#pragma unroll
            for (int m = 0; m < 4; ++m) {
                float sq = 0.f;
#pragma unroll
                for (int bj = 0; bj < 2; ++bj) { const size_t off = (size_t)(row0 + ai * HALF + m * 16) * DM + col0 + bj * HALF;
                    const f32x4 h0 = *(const f32x4*)(res + off) + acc[ai][bj][m][0], h1 = *(const f32x4*)(res + off + 4) + acc[ai][bj][m][1];
                    u32x4 w; w.x = cvt_pk_bf16_asm(h0[0], h0[1]); w.y = cvt_pk_bf16_asm(h0[2], h0[3]); w.z = cvt_pk_bf16_asm(h1[0], h1[1]); w.w = cvt_pk_bf16_asm(h1[2], h1[3]);
                    *(u32x4*)(hb + off) = w;
                    sq += (h0[0] * h0[0] + h0[1] * h0[1]) + (h0[2] * h0[2] + h0[3] * h0[3]) + (h1[0] * h1[0] + h1[1] * h1[1]) + (h1[2] * h1[2] + h1[3] * h1[3]); }
                sq += __shfl_xor(sq, 16); sq += __shfl_xor(sq, 32);
                if (fq == 0) atomicAdd(ss + row0 + ai * HALF + m * 16, sq);
            }
    }
};
struct EpiResBf {
    static constexpr bool PERM = true, HAS_MID = false;
    const bf16_t* hb; float* out;
    __device__ __forceinline__ void mid(f32x4 (&acc)[2][2][4][2], const Unit& u, int wr, int wc, int fr, int fq) const {}
    __device__ __forceinline__ void operator()(const f32x4 (&acc)[2][2][4][2], const Unit& u, int wr, int wc, int fr, int fq) const {
        const int row0 = u.pm * BM + wr * 64 + fr, col0 = u.pn * BM + wc * 32 + 8 * fq;
#pragma unroll
        for (int ai = 0; ai < 2; ++ai)
#pragma unroll
            for (int m = 0; m < 4; ++m)
#pragma unroll
                for (int bj = 0; bj < 2; ++bj) { const size_t off = (size_t)(row0 + ai * HALF + m * 16) * DM + col0 + bj * HALF;
                    const u32x4 h = *(const u32x4*)(hb + off);
                    const f32x4 x0 = (f32x4){bf_lo(h.x), bf_hi(h.x), bf_lo(h.y), bf_hi(h.y)}, x1 = (f32x4){bf_lo(h.z), bf_hi(h.z), bf_lo(h.w), bf_hi(h.w)};
                    *(f32x4*)(out + off) = x0 + acc[ai][bj][m][0]; *(f32x4*)(out + off + 4) = x1 + acc[ai][bj][m][1]; }
    }
};
struct EpiUp {
    static constexpr bool PERM = true, HAS_MID = false;
    bf16_t* O; const float* ss;
    __device__ __forceinline__ void mid(f32x4 (&acc)[2][2][4][2], const Unit& u, int wr, int wc, int fr, int fq) const {}
    __device__ __forceinline__ void operator()(const f32x4 (&acc)[2][2][4][2], const Unit& u, int wr, int wc, int fr, int fq) const {
        const int row0 = u.pm * BM + wr * 64 + fr, col0 = u.pn * BM + wc * 32 + 8 * fq;
#pragma unroll
        for (int ai = 0; ai < 2; ++ai)
#pragma unroll
            for (int m = 0; m < 4; ++m) {
                const float rstd = 1.f / sqrtf(ss[row0 + ai * HALF + m * 16] * (1.f / DM) + EPS);
#pragma unroll
                for (int bj = 0; bj < 2; ++bj) { const size_t off = (size_t)(row0 + ai * HALF + m * 16) * FF + col0 + bj * HALF;
                    f32x4 v0 = acc[ai][bj][m][0], v1 = acc[ai][bj][m][1];
#pragma unroll
                    for (int e = 0; e < 4; ++e) { const float a = fmaxf(v0[e] * rstd, 0.f), b = fmaxf(v1[e] * rstd, 0.f); v0[e] = a * a; v1[e] = b * b; }
                    u32x4 w; w.x = cvt_pk_bf16_asm(v0[0], v0[1]); w.y = cvt_pk_bf16_asm(v0[2], v0[3]); w.z = cvt_pk_bf16_asm(v1[0], v1[1]); w.w = cvt_pk_bf16_asm(v1[2], v1[3]);
                    *(u32x4*)(O + off) = w; }
            }
    }
};

template <class Epi, class Sched, bool ALIGN_EPI>
__device__ __forceinline__ void gemm_phase(LAS unsigned char* lds, const Gemm g, const Sched& S, const Epi& E) {
    int tid_ = threadIdx.x; asm volatile("" : "+v"(tid_));
    const int tid = tid_, wid = __builtin_amdgcn_readfirstlane(tid >> 6), lane = tid & 63, wr = wid >> 2, wc = wid & 3, fr = lane & 15, fq = lane >> 4;
    const int K = g.K, nt = K / BK;
    unsigned voffA[2], voffB[2];
#pragma unroll
    for (int i = 0; i < 2; ++i) { int R, C; stage_rc(tid * 16 + i * 8192, R, C); const int Rb = Epi::PERM ? ((R & ~31) + perm32(R & 31)) : R;
        voffA[i] = (unsigned)(R * K + C) * 2u; voffB[i] = (unsigned)(Rb * K + C) * 2u; }
    const size_t kstep = (size_t)(BK * 2);
    const size_t hstep = (size_t)HALF * K * 2;
    const size_t tstep = 2 * hstep;
    const unsigned ldsw = (unsigned)wid * 1024u;
    const int aoff = lds_byte(wr * 64 + fr, fq * 8), boff = lds_byte(wc * 32 + fr, fq * 8);
#define PG8_SA(b, h) (((b) * 2 + (h)) * HTB)
#define PG8_SB(b, h) ((4 + (b) * 2 + (h)) * HTB)
#define PG8_STAGE(bufoff, gbase, voff) do { _Pragma("unroll") for (int _i = 0; _i < 2; ++_i) \
        __builtin_amdgcn_global_load_lds((const unsigned*)((const char*)(gbase) + (voff)[_i]), (LAS unsigned*)(lds + (bufoff) + ldsw + _i * 8192), 16, 0, 0); } while (0)
#define PG8_LDA(dst, b, h) do { _Pragma("unroll") for (int m = 0; m < 4; ++m) _Pragma("unroll") for (int k = 0; k < 2; ++k) dst[m][k] = *(const LAS bf16x8*)(lds + PG8_SA(b, h) + aoff + m * 2048 + k * 1024); } while (0)
#define PG8_LDB(dst, b, h) do { _Pragma("unroll") for (int n = 0; n < 2; ++n) _Pragma("unroll") for (int k = 0; k < 2; ++k) dst[n][k] = *(const LAS bf16x8*)(lds + PG8_SB(b, h) + boff + n * 2048 + k * 1024); } while (0)
#define PG8_MMA(ai, bj, At, Bt) do { __builtin_amdgcn_s_setprio(1); _Pragma("unroll") for (int m = 0; m < 4; ++m) _Pragma("unroll") for (int n = 0; n < 2; ++n) _Pragma("unroll") for (int k = 0; k < 2; ++k) \
        acc[ai][bj][m][n] = __builtin_amdgcn_mfma_f32_16x16x32_bf16(Bt[n][k], At[m][k], acc[ai][bj][m][n], 0, 0, 0); __builtin_amdgcn_s_setprio(0); } while (0)
#define PG8_WAIT_V(n) asm volatile("s_waitcnt vmcnt(" #n ")" ::: "memory")
#define PG8_WAIT_L(n) asm volatile("s_waitcnt lgkmcnt(" #n ")" ::: "memory")
#define PG8_BAR __builtin_amdgcn_s_barrier()
#define PG8_SCHED __builtin_amdgcn_sched_barrier(0)
    Unit cur, nxt; int ui = 0;
    if (!S.next(0, cur)) return;
    f32x4 acc[2][2][4][2];
#pragma unroll
    for (int a = 0; a < 2; ++a)
#pragma unroll
        for (int b = 0; b < 2; ++b)
#pragma unroll
            for (int m = 0; m < 4; ++m)
#pragma unroll
                for (int n = 0; n < 2; ++n) acc[a][b][m][n] = (f32x4){0.f, 0.f, 0.f, 0.f};
    bf16x8 At[4][2], B0[2][2], B1[2][2];
    const char* cA = (const char*)(cur.seg ? g.A2 : g.A) + (size_t)cur.pm * tstep; const char* cB = (const char*)(cur.seg ? g.Bt2 : g.Bt) + (size_t)cur.pn * tstep;
    PG8_STAGE(PG8_SB(0, 0), cB, voffB); PG8_STAGE(PG8_SB(0, 1), cB + hstep, voffB); PG8_STAGE(PG8_SA(0, 0), cA, voffA); PG8_STAGE(PG8_SA(0, 1), cA + hstep, voffA);
    if (wr == 1) PG8_BAR;
    PG8_WAIT_V(2); PG8_BAR;
    PG8_STAGE(PG8_SB(1, 0), cB + kstep, voffB); PG8_STAGE(PG8_SA(1, 0), cA + kstep, voffA); PG8_STAGE(PG8_SB(1, 1), cB + hstep + kstep, voffB);
    PG8_WAIT_V(6); PG8_BAR;
    for (;;) {
        const bool has_next = S.next(ui + 1, nxt);
        const char* nA = has_next ? (const char*)(nxt.seg ? g.A2 : g.A) + (size_t)nxt.pm * tstep : cA; const char* nB = has_next ? (const char*)(nxt.seg ? g.Bt2 : g.Bt) + (size_t)nxt.pn * tstep : cB;
        for (int t = 0; t < nt; t += 2) {
            const bool last = (t == nt - 2);
            const char* a1 = cA + (size_t)(t + 1) * kstep;
            const char* a2 = last ? nA : cA + (size_t)(t + 2) * kstep; const char* b2 = last ? nB : cB + (size_t)(t + 2) * kstep;
            const char* a3 = a2 + kstep; const char* b3 = b2 + kstep;
            PG8_LDB(B0, 0, 0); PG8_LDB(B1, 0, 1); PG8_SCHED; PG8_LDA(At, 0, 0); PG8_STAGE(PG8_SA(1, 1), a1 + hstep, voffA);
            PG8_WAIT_V(8); PG8_WAIT_L(0); PG8_BAR; PG8_MMA(0, 0, At, B0); PG8_MMA(0, 1, At, B1); PG8_BAR; PG8_SCHED;
            PG8_LDA(At, 0, 1); PG8_STAGE(PG8_SB(0, 0), b2, voffB); PG8_STAGE(PG8_SB(0, 1), b2 + hstep, voffB); PG8_STAGE(PG8_SA(0, 0), a2, voffA);
            PG8_WAIT_V(8); PG8_WAIT_L(0); PG8_BAR; PG8_MMA(1, 0, At, B0); PG8_MMA(1, 1, At, B1); PG8_BAR; PG8_SCHED;
            PG8_LDB(B0, 1, 0); PG8_LDB(B1, 1, 1); PG8_SCHED; PG8_LDA(At, 1, 0); PG8_STAGE(PG8_SA(0, 1), a2 + hstep, voffA);
            PG8_WAIT_V(8); PG8_WAIT_L(0); PG8_BAR; PG8_MMA(0, 0, At, B0); PG8_MMA(0, 1, At, B1); PG8_BAR; PG8_SCHED;
            PG8_LDA(At, 1, 1); PG8_STAGE(PG8_SB(1, 0), b3, voffB); PG8_STAGE(PG8_SB(1, 1), b3 + hstep, voffB); PG8_STAGE(PG8_SA(1, 0), a3, voffA);
            PG8_WAIT_V(8); PG8_WAIT_L(0); PG8_BAR; PG8_MMA(1, 0, At, B0); PG8_MMA(1, 1, At, B1); PG8_BAR; PG8_SCHED;
        }
        if constexpr (ALIGN_EPI) { if (wr == 0) PG8_BAR; }
        bool keep = false;
        if constexpr (Epi::HAS_MID) keep = (cur.seg == 0);
        if (keep) E.mid(acc, cur, wr, wc, fr, fq); else E(acc, cur, wr, wc, fr, fq);
        if (!has_next) break;
        if (!keep) {
#pragma unroll
            for (int a = 0; a < 2; ++a)
#pragma unroll
                for (int b = 0; b < 2; ++b)
#pragma unroll
                    for (int m = 0; m < 4; ++m)
#pragma unroll
                        for (int n = 0; n < 2; ++n) acc[a][b][m][n] = (f32x4){0.f, 0.f, 0.f, 0.f};
        }
        cur = nxt; cA = nA; cB = nB; ++ui;
        if constexpr (ALIGN_EPI) { if (wr == 1) PG8_BAR; }
    }
    PG8_WAIT_V(0);
    if constexpr (!ALIGN_EPI) { if (wr == 0) PG8_BAR; }
    PG8_BAR;
#undef PG8_SA
#undef PG8_SB
#undef PG8_STAGE
#undef PG8_LDA
#undef PG8_LDB
#undef PG8_MMA
#undef PG8_WAIT_V
#undef PG8_WAIT_L
#undef PG8_BAR
#undef PG8_SCHED
}
}

struct Args {
    const float *x, *meta, *mix_g, *w_in, *ret_g, *q_g, *k_g, *sinks, *w_ret, *w_swa, *w_out, *mlp_g, *w_up, *w_down;
    float* out; unsigned char* ws;
};

__device__ __forceinline__ void p0_transpose_item(const float* W, int K, int N, bf16_t* WT, LAS float* scr, int item, int lane, const float* kgain = nullptr) {
    const int nblk = N / 32, kb = item / nblk, nb = item % nblk, k0 = 64 * kb, n0 = 32 * nb;
    float wv[32];
#pragma unroll
    for (int i = 0; i < 32; ++i) wv[i] = W[(size_t)(k0 + 2 * i + (lane >> 5)) * N + n0 + (lane & 31)];
#pragma unroll
    for (int i = 0; i < 32; ++i) { const int kk = 2 * i + (lane >> 5); float v = wv[i]; if (kgain) v *= kgain[k0 + kk]; scr[kk * 33 + (lane & 31)] = v; }
    asm volatile("s_waitcnt lgkmcnt(0)" ::: "memory");
    const int c = lane & 7;
#pragma unroll
    for (int j = 0; j < 4; ++j) { const int n = (lane >> 3) + 8 * j; const LAS float* s = scr + (8 * c) * 33 + n;
        u32x4 o; o.x = cvt_pk_bf16_asm(s[0 * 33], s[1 * 33]); o.y = cvt_pk_bf16_asm(s[2 * 33], s[3 * 33]); o.z = cvt_pk_bf16_asm(s[4 * 33], s[5 * 33]); o.w = cvt_pk_bf16_asm(s[6 * 33], s[7 * 33]);
        *(u32x4*)(WT + (size_t)(n0 + n) * K + k0 + 8 * c) = o; }
    asm volatile("s_waitcnt lgkmcnt(0)" ::: "memory");
}
__device__ __forceinline__ void rms_row_to_bf16(const float* xrow, const float* g, bf16_t* orow, int lane) {
    const f32x4* xr = (const f32x4*)xrow + lane; const f32x4* gr = (const f32x4*)g + lane;
    f32x4 v[4]; float s = 0.f;
#pragma unroll
    for (int j = 0; j < 4; ++j) { v[j] = xr[64 * j]; s += (v[j].x * v[j].x + v[j].y * v[j].y) + (v[j].z * v[j].z + v[j].w * v[j].w); }
    const float rstd = 1.f / sqrtf(wave_sum(s) * (1.f / DM) + EPS);
    u32x2* o8 = (u32x2*)orow + lane;
#pragma unroll
    for (int j = 0; j < 4; ++j) { const f32x4 gg = gr[64 * j]; u32x2 w; w.x = cvt_pk_bf16_asm(v[j].x * rstd * gg.x, v[j].y * rstd * gg.y); w.y = cvt_pk_bf16_asm(v[j].z * rstd * gg.z, v[j].w * rstd * gg.w); o8[64 * j] = w; }
}

__device__ __forceinline__ void tr_write8(LAS unsigned char* base, int RS, int col0, int pp, u32x4 r0, u32x4 r1) {
#define TRW(i, w0, w1) *(LAS unsigned*)(base + ((size_t)(col0 + (i)) * RS + 2 * pp) * 2) = ((i) & 1) ? (((w0) >> 16) | ((w1) & 0xffff0000u)) : (((w0) & 0xffffu) | ((w1) << 16))
    TRW(0, r0.x, r1.x); TRW(1, r0.x, r1.x); TRW(2, r0.y, r1.y); TRW(3, r0.y, r1.y); TRW(4, r0.z, r1.z); TRW(5, r0.z, r1.z); TRW(6, r0.w, r1.w); TRW(7, r0.w, r1.w);
#undef TRW
}

__device__ __forceinline__ int tr_off(int col, int RS, int slot) { return col * RS * 2 + ((slot ^ (2 * ((col >> 3) & 15))) << 3); }
__device__ __forceinline__ void tr_write8s(LAS unsigned char* base, int RS, int col0, int pp, u32x4 r0, u32x4 r1) {
    const int sw2 = 2 * ((col0 >> 3) & 15), po = (((pp >> 1) ^ sw2) << 3) + ((pp & 1) << 2);
#define TRW(i, w0, w1) *(LAS unsigned*)(base + (col0 + (i)) * RS * 2 + po) = ((i) & 1) ? (((w0) >> 16) | ((w1) & 0xffff0000u)) : (((w0) & 0xffffu) | ((w1) << 16))
    TRW(0, r0.x, r1.x); TRW(1, r0.x, r1.x); TRW(2, r0.y, r1.y); TRW(3, r0.y, r1.y); TRW(4, r0.z, r1.z); TRW(5, r0.z, r1.z); TRW(6, r0.w, r1.w); TRW(7, r0.w, r1.w);
#undef TRW
}
__device__ __forceinline__ u32x4 scale8(u32x4 r, float f) {
    u32x4 o; o.x = cvt_pk_bf16(bf_lo(r.x) * f, bf_hi(r.x) * f); o.y = cvt_pk_bf16(bf_lo(r.y) * f, bf_hi(r.y) * f); o.z = cvt_pk_bf16(bf_lo(r.z) * f, bf_hi(r.z) * f); o.w = cvt_pk_bf16(bf_lo(r.w) * f, bf_hi(r.w) * f); return o;
}
__device__ __forceinline__ bf16x8 as_frag(u32x4 v) { return __builtin_bit_cast(bf16x8, v); }
#define MFMA16(a, b, c) __builtin_amdgcn_mfma_f32_16x16x32_bf16((a), (b), (c), 0, 0, 0)

__device__ __forceinline__ long swa_key_row(int b, int c, int kk) {
    if (kk < 16) return (long)NTOK + kk;
    if (kk < 272) { const int s = (c - 1) * 128 + (kk - 16); if (s >= 128) return (long)b * SEQ + s - 128; }
    return -1;
}
__device__ __forceinline__ void swa_phase(LAS unsigned char* lds, const Args& p) {
    int tid_ = threadIdx.x; asm volatile("" : "+v"(tid_));
    const int tid = tid_, lane = tid & 63, w = __builtin_amdgcn_readfirstlane(tid >> 6), r = lane & 15, q = lane >> 4;
    const bf16_t* SQ = (const bf16_t*)(p.ws + OFF_SQ); const bf16_t* SK = (const bf16_t*)(p.ws + OFF_SK); const bf16_t* SV = (const bf16_t*)(p.ws + OFF_SV);
    bf16_t* YSWA = (bf16_t*)((unsigned char*)p.out + DOUT_YSWA);
    constexpr int KS = 72, VS = 296, K_OFF = 0, VT_OFF = 288 * KS * 2;
    constexpr float LOG2E = 1.4426950408889634f;
    const int kch = tid & 7, G = gridDim.x;
    const f32x4 kg0 = *(const f32x4*)(p.k_g + kch * 8), kg1 = *(const f32x4*)(p.k_g + kch * 8 + 4);
    u32x4 kraw[5], vraw[6];
#define SWA_LOAD_UNIT(uu) do { const int b_ = (uu) >> 8, c_ = 1 + (((uu) & 255) >> 2), kvh_ = (uu) & 3; \
        _Pragma("unroll") for (int it = 0; it < 5; ++it) { const int kk = (it * NTHREADS + tid) >> 3; const long row = swa_key_row(b_, c_, kk); \
            kraw[it] = (u32x4){0u, 0u, 0u, 0u}; if (row >= 0) kraw[it] = *(const u32x4*)(SK + (size_t)row * 256 + kvh_ * 64 + kch * 8); } \
        _Pragma("unroll") for (int it = 0; it < 3; ++it) { const int id = it * NTHREADS + tid, ch = id / 144, pp = id % 144; \
            _Pragma("unroll") for (int e = 0; e < 2; ++e) { const long row = (id < 1152) ? swa_key_row(b_, c_, 2 * pp + e) : -1; \
                vraw[2 * it + e] = (u32x4){0u, 0u, 0u, 0u}; if (row >= 0) vraw[2 * it + e] = *(const u32x4*)(SV + (size_t)row * 256 + kvh_ * 64 + ch * 8); } } } while (0)
    int u = blockIdx.x;
    if (u >= 1024) return;
    SWA_LOAD_UNIT(u);
    for (; u < 1024; u += G) {
        const int b = u >> 8, c = 1 + ((u & 255) >> 2), kvh = u & 3;
        __syncthreads();
#pragma unroll
        for (int it = 0; it < 5; ++it) {
            const int kk = (it * NTHREADS + tid) >> 3; const u32x4 raw = kraw[it];
            const float f0 = bf_lo(raw.x), f1 = bf_hi(raw.x), f2 = bf_lo(raw.y), f3 = bf_hi(raw.y), f4 = bf_lo(raw.z), f5 = bf_hi(raw.z), f6 = bf_lo(raw.w), f7 = bf_hi(raw.w);
            float ss = (f0 * f0 + f1 * f1) + (f2 * f2 + f3 * f3) + (f4 * f4 + f5 * f5) + (f6 * f6 + f7 * f7);
            ss += __shfl_xor(ss, 1); ss += __shfl_xor(ss, 2); ss += __shfl_xor(ss, 4);
            const float rstd = __builtin_amdgcn_rsqf(ss * (1.f / 64.f) + EPS);
            u32x4 o; o.x = cvt_pk_bf16(f0 * rstd * kg0.x, f1 * rstd * kg0.y); o.y = cvt_pk_bf16(f2 * rstd * kg0.z, f3 * rstd * kg0.w);
            o.z = cvt_pk_bf16(f4 * rstd * kg1.x, f5 * rstd * kg1.y); o.w = cvt_pk_bf16(f6 * rstd * kg1.z, f7 * rstd * kg1.w);
            if (kk < 288) *(LAS u32x4*)(lds + K_OFF + (kk * KS + kch * 8) * 2) = o;
        }
#pragma unroll
        for (int it = 0; it < 3; ++it) { const int id = it * NTHREADS + tid; if (id < 1152) tr_write8(lds + VT_OFF, VS, (id / 144) * 8, id % 144, vraw[2 * it], vraw[2 * it + 1]); }
        __syncthreads();
        const int qt = w, iq = 16 * qt + r;
        const size_t qrow = (size_t)b * SEQ + (size_t)(c - 1) * 128 + iq;
        u32x4 qa = *(const u32x4*)(SQ + qrow * 1024 + (kvh * 4) * 64 + 8 * q), qb = *(const u32x4*)(SQ + qrow * 1024 + (kvh * 4) * 64 + 32 + 8 * q);
        { const int un = (u + G < 1024) ? u + G : u; SWA_LOAD_UNIT(un); }
#pragma unroll 1
        for (int hl = 0; hl < 4; ++hl) {
            const int h = kvh * 4 + hl;
            bf16x8 Qf[2];
            {
                const u32x4 a = qa, bq = qb;
                const int hn = kvh * 4 + ((hl + 1) & 3);
                qa = *(const u32x4*)(SQ + qrow * 1024 + hn * 64 + 8 * q); qb = *(const u32x4*)(SQ + qrow * 1024 + hn * 64 + 32 + 8 * q);
                float fa[8] = {bf_lo(a.x), bf_hi(a.x), bf_lo(a.y), bf_hi(a.y), bf_lo(a.z), bf_hi(a.z), bf_lo(a.w), bf_hi(a.w)};
                float fb[8] = {bf_lo(bq.x), bf_hi(bq.x), bf_lo(bq.y), bf_hi(bq.y), bf_lo(bq.z), bf_hi(bq.z), bf_lo(bq.w), bf_hi(bq.w)};
                float ss = 0.f;
#pragma unroll
                for (int e = 0; e < 8; ++e) ss += fa[e] * fa[e] + fb[e] * fb[e];
                ss += __shfl_xor(ss, 16); ss += __shfl_xor(ss, 32);
                const float rs = (0.125f * LOG2E) * __builtin_amdgcn_rsqf(ss * (1.f / 64.f) + EPS);
                const f32x4 ga0 = *(const f32x4*)(p.q_g + 8 * q), ga1 = *(const f32x4*)(p.q_g + 8 * q + 4), gb0 = *(const f32x4*)(p.q_g + 32 + 8 * q), gb1 = *(const f32x4*)(p.q_g + 32 + 8 * q + 4);
                u32x4 oa, ob;
                oa.x = cvt_pk_bf16(fa[0] * rs * ga0.x, fa[1] * rs * ga0.y); oa.y = cvt_pk_bf16(fa[2] * rs * ga0.z, fa[3] * rs * ga0.w); oa.z = cvt_pk_bf16(fa[4] * rs * ga1.x, fa[5] * rs * ga1.y); oa.w = cvt_pk_bf16(fa[6] * rs * ga1.z, fa[7] * rs * ga1.w);
                ob.x = cvt_pk_bf16(fb[0] * rs * gb0.x, fb[1] * rs * gb0.y); ob.y = cvt_pk_bf16(fb[2] * rs * gb0.z, fb[3] * rs * gb0.w); ob.z = cvt_pk_bf16(fb[4] * rs * gb1.x, fb[5] * rs * gb1.y); ob.w = cvt_pk_bf16(fb[6] * rs * gb1.z, fb[7] * rs * gb1.w);
                Qf[0] = as_frag(oa); Qf[1] = as_frag(ob);
            }
            const float slope2 = exp2f(-0.5f * (float)(h + 1)) * LOG2E, sink2 = p.sinks[h] * LOG2E;
            const float bbase = -slope2 * (float)(144 + r - 4 * q), mbase = -slope2 * (float)(c * 128 + iq - 112 - 4 * q);
            const float sl1 = slope2, sl2 = 2.f * slope2, sl3 = 3.f * slope2;
            const int d0 = 144 + r - 4 * q;
            f32x4 sc[10]; float mx = -1e30f;
#pragma unroll
            for (int t = 0; t < 10; ++t) {
                const int kt = (t == 0) ? 0 : qt + t;
                f32x4 acc = (f32x4){0.f, 0.f, 0.f, 0.f};
#pragma unroll
                for (int ks = 0; ks < 2; ++ks) { const bf16x8 a = *(const LAS bf16x8*)(lds + K_OFF + ((16 * kt + r) * KS + 32 * ks + 8 * q) * 2); acc = MFMA16(a, Qf[ks], acc); }
                const float tb = (t == 0) ? mbase : bbase + slope2 * (float)(16 * t) + ((c == 1 && kt <= 8) ? -1e30f : 0.f);
                acc[0] += tb; acc[1] += tb + sl1; acc[2] += tb + sl2; acc[3] += tb + sl3;
                if (t == 1) {
#pragma unroll
                    for (int i = 0; i < 4; ++i) if (d0 - 16 - i >= 128) acc[i] = -1e30f;
                }
                if (t == 9) {
#pragma unroll
                    for (int i = 0; i < 4; ++i) if (d0 - 144 - i < 0) acc[i] = -1e30f;
                }
                mx = fmaxf(fmaxf(mx, fmaxf(acc[0], acc[1])), fmaxf(acc[2], acc[3]));
                sc[t] = acc;
                if (t == 4) __builtin_amdgcn_sched_barrier(0);
            }
            mx = fmaxf(mx, __shfl_xor(mx, 16)); mx = fmaxf(mx, __shfl_xor(mx, 32)); mx = fmaxf(mx, sink2);
            float sum = 0.f; u32x2 Pk[10];
#pragma unroll
            for (int t = 0; t < 10; ++t) { const float p0 = __builtin_amdgcn_exp2f(sc[t][0] - mx), p1 = __builtin_amdgcn_exp2f(sc[t][1] - mx), p2 = __builtin_amdgcn_exp2f(sc[t][2] - mx), p3 = __builtin_amdgcn_exp2f(sc[t][3] - mx);
                sum += (p0 + p1) + (p2 + p3); Pk[t].x = cvt_pk_bf16(p0, p1); Pk[t].y = cvt_pk_bf16(p2, p3); }
            sum += __shfl_xor(sum, 16); sum += __shfl_xor(sum, 32);
            const float inv = __builtin_amdgcn_rcpf(sum + __builtin_amdgcn_exp2f(sink2 - mx));
#pragma unroll 1
            for (int dtp = 0; dtp < 2; ++dtp) {
                u32x2 ov[2];
#pragma unroll
                for (int e = 0; e < 2; ++e) {
                    const int dt = 2 * dtp + e;
                    f32x4 acc = (f32x4){0.f, 0.f, 0.f, 0.f};
#pragma unroll
                    for (int pr = 0; pr < 5; ++pr) {
                        const int t0 = 2 * pr, t1 = 2 * pr + 1, kt0 = (t0 == 0) ? 0 : qt + t0, kt1 = qt + t1;
                        const LAS unsigned char* vp = lds + VT_OFF + ((16 * dt + r) * VS + 4 * q) * 2;
                        const u32x2 a0 = *(const LAS u32x2*)(vp + 32 * kt0), a1 = *(const LAS u32x2*)(vp + 32 * kt1);
                        const u32x4 a = (u32x4){a0.x, a0.y, a1.x, a1.y}, bb = (u32x4){Pk[t0].x, Pk[t0].y, Pk[t1].x, Pk[t1].y};
                        acc = MFMA16(as_frag(a), as_frag(bb), acc);
                    }
                    ov[e].x = cvt_pk_bf16(acc[0] * inv, acc[1] * inv); ov[e].y = cvt_pk_bf16(acc[2] * inv, acc[3] * inv);
                }
                const int dw = 32 * dtp + ((q & 1) ? 16 + 4 * (q - 1) : 4 * q);
                const u32x2 ox = __builtin_amdgcn_permlane16_swap(ov[0].x, ov[1].x, false, false), oy = __builtin_amdgcn_permlane16_swap(ov[0].y, ov[1].y, false, false);
                *(u32x4*)(YSWA + qrow * 1024 + h * 64 + dw) = (u32x4){ox.x, oy.x, ox.y, oy.y};
            }
        }
    }
#undef SWA_LOAD_UNIT
}

__device__ __forceinline__ size_t kvs_slot(int b, int n, int h) { return ((size_t)((b * 64 + n) * 4 + h)) * 32768; }
__device__ __forceinline__ void kvlocal_phase(LAS unsigned char* lds, const Args& p) {
    int tid_ = threadIdx.x; asm volatile("" : "+v"(tid_));
    const int tid = tid_, lane = tid & 63, w = __builtin_amdgcn_readfirstlane(tid >> 6), r = lane & 15, q = lane >> 4;
    const bf16_t* RK = (const bf16_t*)(p.ws + OFF_RK); const bf16_t* RV = (const bf16_t*)(p.ws + OFF_RV);
    bf16_t* KVS = (bf16_t*)((unsigned char*)p.out + DOUT_KVS);
    constexpr int RS = 136, KT_OFF = 0, VT_OFF = 128 * RS * 2;
    u32x4 kr[2][2], vr[4][2];
#define KV_LOAD_UNIT(uu) do { const int b_ = (uu) >> 8, n_ = ((uu) & 255) >> 2, h_ = (uu) & 3; \
        _Pragma("unroll") for (int it = 0; it < 2; ++it) { const int id = it * NTHREADS + tid, ch = id & 15, pr = id >> 4; \
            _Pragma("unroll") for (int e = 0; e < 2; ++e) { const int i = 2 * pr + e; long row; \
                if (n_ == 0) row = (i < 112) ? -1 : (long)NTOK + i - 112; else row = (long)b_ * SEQ + (n_ - 1) * 128 + i; \
                kr[it][e] = (u32x4){0u, 0u, 0u, 0u}; if (row >= 0) kr[it][e] = *(const u32x4*)(RK + (size_t)row * 512 + h_ * 128 + ch * 8); } } \
        _Pragma("unroll") for (int it = 0; it < 4; ++it) { const int id = it * NTHREADS + tid, ch = id & 31, pr = id >> 5; \
            _Pragma("unroll") for (int e = 0; e < 2; ++e) { const int i = 2 * pr + e; long row; \
                if (n_ == 0) row = (i < 112) ? -1 : (long)NTOK + i - 112; else row = (long)b_ * SEQ + (n_ - 1) * 128 + i; \
                vr[it][e] = (u32x4){0u, 0u, 0u, 0u}; if (row >= 0) vr[it][e] = *(const u32x4*)(RV + (size_t)row * 1024 + h_ * 256 + ch * 8); } } } while (0)
    int u = blockIdx.x;
    if (u >= 1024) return;
    const int G = gridDim.x;
    KV_LOAD_UNIT(u);
    for (; u < 1024; u += G) {
        const int b = u >> 8, n = (u & 255) >> 2, h = u & 3;
        const float lg2 = log2f(1.0f - exp2f(-5.0f - (float)h));
        __syncthreads();
#pragma unroll
        for (int it = 0; it < 2; ++it) { const int id = it * NTHREADS + tid, ch = id & 15, pr = id >> 4;
            const float f0 = 0.08838834764831845f * __builtin_amdgcn_exp2f(lg2 * (float)(127 - 2 * pr)), f1 = 0.08838834764831845f * __builtin_amdgcn_exp2f(lg2 * (float)(126 - 2 * pr));
            tr_write8s(lds + KT_OFF, RS, ch * 8, pr, scale8(kr[it][0], f0), scale8(kr[it][1], f1)); }
#pragma unroll
        for (int it = 0; it < 4; ++it) { const int id = it * NTHREADS + tid, ch = id & 31, pr = id >> 5;
            tr_write8s(lds + VT_OFF, RS, ch * 8, pr, vr[it][0], vr[it][1]); }
        __syncthreads();
        { const int un = (u + G < 1024) ? u + G : u; KV_LOAD_UNIT(un); }
        const int mt = w;
        bf16x8 a[4];
#pragma unroll
        for (int ks = 0; ks < 4; ++ks) a[ks] = *(const LAS bf16x8*)(lds + KT_OFF + tr_off(16 * mt + r, RS, 8 * ks + 2 * q));
        bf16_t* dst = KVS + kvs_slot(b, n, h);
#pragma unroll 2
        for (int ntp = 0; ntp < 8; ++ntp) {
            u32x2 ov[2];
#pragma unroll
            for (int e = 0; e < 2; ++e) {
                const int nt = 2 * ntp + e;
                f32x4 acc = (f32x4){0.f, 0.f, 0.f, 0.f};
#pragma unroll
                for (int ks = 0; ks < 4; ++ks) { const bf16x8 bb = *(const LAS bf16x8*)(lds + VT_OFF + tr_off(16 * nt + r, RS, 8 * ks + 2 * q)); acc = MFMA16(a[ks], bb, acc); }
                ov[e].x = cvt_pk_bf16(acc[0], acc[1]); ov[e].y = cvt_pk_bf16(acc[2], acc[3]);
            }
            const u32x2 ox = __builtin_amdgcn_permlane16_swap(ov[0].x, ov[1].x, false, false), oy = __builtin_amdgcn_permlane16_swap(ov[0].y, ov[1].y, false, false);
            const int row = 16 * (2 * ntp + (q & 1)) + r, dk0 = 16 * mt + 4 * (q & ~1);
            *(u32x4*)(dst + (size_t)row * 128 + dk0) = (u32x4){ox.x, oy.x, ox.y, oy.y};
        }
    }
#undef KV_LOAD_UNIT
}

__device__ __forceinline__ void scan_phase(const Args& p) {
    bf16_t* KVS = (bf16_t*)((unsigned char*)p.out + DOUT_KVS);
    for (int gid = blockIdx.x * NTHREADS + threadIdx.x; gid < 16 * 8192; gid += gridDim.x * NTHREADS) {
        const int bh = gid >> 13, b = bh >> 2, h = bh & 3, off = (gid & 8191) * 4;
        const float dec = exp2f(128.0f * log2f(1.0f - exp2f(-5.0f - (float)h)));
        float s0 = 0.f, s1 = 0.f, s2 = 0.f, s3 = 0.f;
        bf16_t* base = KVS + kvs_slot(b, 0, h) + off;
        for (int n0 = 0; n0 < 64; n0 += 16) {
            u32x2 v[16];
#pragma unroll
            for (int j = 0; j < 16; ++j) v[j] = *(const u32x2*)(base + (size_t)(n0 + j) * 4 * 32768);
#pragma unroll
            for (int j = 0; j < 16; ++j) {
                s0 = dec * s0 + bf_lo(v[j].x); s1 = dec * s1 + bf_hi(v[j].x); s2 = dec * s2 + bf_lo(v[j].y); s3 = dec * s3 + bf_hi(v[j].y);
                u32x2 o; o.x = cvt_pk_bf16(s0, s1); o.y = cvt_pk_bf16(s2, s3);
                *(u32x2*)(base + (size_t)(n0 + j) * 4 * 32768) = o;
            }
        }
    }
}

__device__ __forceinline__ void retout_phase(LAS unsigned char* lds, const Args& p) {
    int tid_ = threadIdx.x; asm volatile("" : "+v"(tid_));
    const int tid = tid_, lane = tid & 63, w = __builtin_amdgcn_readfirstlane(tid >> 6), r = lane & 15, q = lane >> 4;
    const bf16_t* RQ = (const bf16_t*)(p.ws + OFF_RQ); const bf16_t* RK = (const bf16_t*)(p.ws + OFF_RK); const bf16_t* RV = (const bf16_t*)(p.ws + OFF_RV); const bf16_t* RG = (const bf16_t*)(p.ws + OFF_RG);
    const bf16_t* KVS = (const bf16_t*)((unsigned char*)p.out + DOUT_KVS);
    bf16_t* YRET = (bf16_t*)(p.ws + OFF_YRET);
    constexpr int RS = 136, K_OFF = 0, SB = 128 * RS * 2, QSZ = 64 * RS * 2;
    const int G = gridDim.x, vch = tid & 7, vpr = tid >> 3, srow = tid >> 4, sch = tid & 15;
    const LAS unsigned char* vlb = lds + SB + r * RS * 2 + ((q ^ (2 * (r >> 3))) << 3);
    u32x4 kreg[4], vreg[2], sreg[2], qn[4];
#define RO_LOAD_KQ(uu) do { const int b_ = (uu) >> 8, c_ = 1 + (((uu) & 255) >> 2), h_ = (uu) & 3; const size_t tb_ = (size_t)b_ * SEQ + (size_t)(c_ - 1) * 128; \
        _Pragma("unroll") for (int it = 0; it < 4; ++it) kreg[it] = *(const u32x4*)(RK + (tb_ + 32 * it + srow) * 512 + h_ * 128 + sch * 8); } while (0)
#define RO_LOAD_Q(uu) do { const int b_ = (uu) >> 8, c_ = 1 + (((uu) & 255) >> 2), h_ = (uu) & 3; const size_t tb_ = (size_t)b_ * SEQ + (size_t)(c_ - 1) * 128; \
        _Pragma("unroll") for (int ks = 0; ks < 4; ++ks) qn[ks] = *(const u32x4*)(RQ + (tb_ + 16 * w + r) * 512 + h_ * 128 + 32 * ks + 8 * q); } while (0)
#define RO_LOAD_STAGE(uu, sg) do { const int b_ = (uu) >> 8, c_ = 1 + (((uu) & 255) >> 2), h_ = (uu) & 3; const size_t tb_ = (size_t)b_ * SEQ + (size_t)(c_ - 1) * 128; \
        const bf16_t* st_ = KVS + kvs_slot(b_, c_ - 1, h_) + (size_t)(64 * (sg)) * 128; \
        vreg[0] = *(const u32x4*)(RV + (tb_ + 2 * vpr) * 1024 + h_ * 256 + 64 * (sg) + vch * 8); vreg[1] = *(const u32x4*)(RV + (tb_ + 2 * vpr + 1) * 1024 + h_ * 256 + 64 * (sg) + vch * 8); \
        sreg[0] = *(const u32x4*)(st_ + (size_t)srow * 128 + sch * 8); sreg[1] = *(const u32x4*)(st_ + (size_t)(32 + srow) * 128 + sch * 8); } while (0)
#define RO_WRITE_K() do { _Pragma("unroll") for (int it = 0; it < 4; ++it) *(LAS u32x4*)(lds + K_OFF + ((32 * it + srow) * RS + sch * 8) * 2) = kreg[it]; } while (0)
#define RO_WRITE_STAGE(j) do { tr_write8s(lds + SB + 2 * (j) * QSZ, RS, vch * 8, vpr, vreg[0], vreg[1]); \
        *(LAS u32x4*)(lds + SB + (2 * (j) + 1) * QSZ + (srow * RS + sch * 8) * 2) = sreg[0]; *(LAS u32x4*)(lds + SB + (2 * (j) + 1) * QSZ + ((32 + srow) * RS + sch * 8) * 2) = sreg[1]; } while (0)
    int u = blockIdx.x;
    if (u >= 1024) return;
    RO_LOAD_KQ(u); RO_LOAD_Q(u); RO_LOAD_STAGE(u, 0);
    __syncthreads();
    RO_WRITE_K(); RO_WRITE_STAGE(0);
    __syncthreads();
    for (; u < 1024; u += G) {
        const int b = u >> 8, c = 1 + ((u & 255) >> 2), h = u & 3, un = (u + G < 1024) ? u + G : u;
        const size_t tokbase = (size_t)b * SEQ + (size_t)(c - 1) * 128;
        const float lg2 = log2f(1.0f - exp2f(-5.0f - (float)h));
        const int iq = 16 * w + r; const size_t qrow = tokbase + iq;
        bf16x8 Qd[4]; u32x2 Pk[8]; f32x4 o[16];
        {
#pragma unroll
            for (int kt = 0; kt < 8; ++kt) {
                {
                    f32x4 acc = (f32x4){0.f, 0.f, 0.f, 0.f};
#pragma unroll
                    for (int ks = 0; ks < 4; ++ks) { const bf16x8 a = *(const LAS bf16x8*)(lds + K_OFF + ((16 * kt + r) * RS + 32 * ks + 8 * q) * 2); acc = MFMA16(a, as_frag(qn[ks]), acc); }
#pragma unroll
                    for (int i = 0; i < 4; ++i) { const int d = iq - (16 * kt + 4 * q + i); acc[i] = (d >= 0) ? acc[i] * 0.08838834764831845f * __builtin_amdgcn_exp2f(lg2 * (float)d) : 0.f; }
                    Pk[kt].x = cvt_pk_bf16(acc[0], acc[1]); Pk[kt].y = cvt_pk_bf16(acc[2], acc[3]);
                }
                if (kt & 1) __builtin_amdgcn_sched_barrier(0);
            }
            const float qdec = __builtin_amdgcn_exp2f(lg2 * (float)(iq + 1));
#pragma unroll
            for (int ks = 0; ks < 4; ++ks) Qd[ks] = as_frag(scale8(qn[ks], qdec));
        }
#pragma unroll
        for (int sg = 0; sg < 4; ++sg) {
            if (sg < 3) RO_LOAD_STAGE(u, sg + 1); else { RO_LOAD_KQ(un); RO_LOAD_STAGE(un, 0); }
            const int bo = 2 * (sg & 1) * QSZ;
#pragma unroll
            for (int j = 0; j < 4; ++j) {
                f32x4 acc = (f32x4){0.f, 0.f, 0.f, 0.f};
#pragma unroll
                for (int ks = 0; ks < 4; ++ks) { const bf16x8 a = *(const LAS bf16x8*)(lds + SB + bo + QSZ + ((16 * j + r) * RS + 32 * ks + 8 * q) * 2); acc = MFMA16(a, Qd[ks], acc); }
#pragma unroll
                for (int kp = 0; kp < 4; ++kp) {
                    {
                        const u32x2 a0 = *(const LAS u32x2*)(vlb + bo + 16 * j * RS * 2 + ((((kp ^ (j >> 1)) << 3) | ((0 ^ (j & 1)) << 2)) << 3));
                        const u32x2 a1 = *(const LAS u32x2*)(vlb + bo + 16 * j * RS * 2 + ((((kp ^ (j >> 1)) << 3) | ((1 ^ (j & 1)) << 2)) << 3));
                        const u32x4 a = (u32x4){a0.x, a0.y, a1.x, a1.y}, bb = (u32x4){Pk[2 * kp].x, Pk[2 * kp].y, Pk[2 * kp + 1].x, Pk[2 * kp + 1].y};
                        acc = MFMA16(as_frag(a), as_frag(bb), acc);
                    }
                }
                o[sg * 4 + j] = acc;
                if (j & 1) __builtin_amdgcn_sched_barrier(0);
            }
            if (sg == 3) RO_WRITE_K();
            RO_WRITE_STAGE((sg + 1) & 1);
            __syncthreads();
        }
        RO_LOAD_Q(un);
        float ss = 0.f;
#pragma unroll
        for (int t = 0; t < 16; ++t) ss += (o[t][0] * o[t][0] + o[t][1] * o[t][1]) + (o[t][2] * o[t][2] + o[t][3] * o[t][3]);
        ss += __shfl_xor(ss, 16); ss += __shfl_xor(ss, 32);
        const float rstd = 1.f / sqrtf(ss * (1.f / 256.f) + EPS);
        const int qodd = q & 1;
#pragma unroll
        for (int tp = 0; tp < 8; ++tp) {
            const int t0 = 2 * tp, t1 = 2 * tp + 1;
            const int dvw = 32 * tp + (qodd ? 16 + 4 * (q - 1) : 4 * q);
            const u32x4 gw = *(const u32x4*)(RG + qrow * 1024 + h * 256 + dvw);
            const u32x2 sx = __builtin_amdgcn_permlane16_swap(gw.x, gw.z, false, false), sy = __builtin_amdgcn_permlane16_swap(gw.y, gw.w, false, false);
            const f32x4 g0 = *(const f32x4*)(p.ret_g + h * 256 + 16 * t0 + 4 * q), g1 = *(const f32x4*)(p.ret_g + h * 256 + 16 * t1 + 4 * q);
            u32x2 ov0, ov1;
            { const float x0 = bf_lo(sx.x), x1 = bf_hi(sx.x), x2 = bf_lo(sy.x), x3 = bf_hi(sy.x);
              ov0.x = cvt_pk_bf16(o[t0][0] * rstd * g0.x * x0 * sigmoidf_(x0), o[t0][1] * rstd * g0.y * x1 * sigmoidf_(x1));
              ov0.y = cvt_pk_bf16(o[t0][2] * rstd * g0.z * x2 * sigmoidf_(x2), o[t0][3] * rstd * g0.w * x3 * sigmoidf_(x3)); }
            { const float x0 = bf_lo(sx.y), x1 = bf_hi(sx.y), x2 = bf_lo(sy.y), x3 = bf_hi(sy.y);
              ov1.x = cvt_pk_bf16(o[t1][0] * rstd * g1.x * x0 * sigmoidf_(x0), o[t1][1] * rstd * g1.y * x1 * sigmoidf_(x1));
              ov1.y = cvt_pk_bf16(o[t1][2] * rstd * g1.z * x2 * sigmoidf_(x2), o[t1][3] * rstd * g1.w * x3 * sigmoidf_(x3)); }
            const u32x2 ox = __builtin_amdgcn_permlane16_swap(ov0.x, ov1.x, false, false), oy = __builtin_amdgcn_permlane16_swap(ov0.y, ov1.y, false, false);
            *(u32x4*)(YRET + qrow * 1024 + h * 256 + dvw) = (u32x4){ox.x, oy.x, ox.y, oy.y};
        }
    }
#undef RO_LOAD_KQ
#undef RO_LOAD_Q
#undef RO_LOAD_STAGE
#undef RO_WRITE_K
#undef RO_WRITE_STAGE
}

__device__ __forceinline__ void meta_proj(const Args& p, const bf16_t* XN, const bf16_t* WinT) {
    int tid_ = threadIdx.x; asm volatile("" : "+v"(tid_));
    const int tid = tid_, lane = tid & 63, r = lane & 15, q = lane >> 4;
    if ((tid >> 6) != 0) return;
    for (int t = blockIdx.x; t < 128; t += gridDim.x) {
        int ncol, ld, cl; size_t boff;
        if (t < 32) { ncol = 512 + 16 * t; boff = OFF_RK; ld = 512; cl = 16 * t; }
        else if (t < 96) { ncol = 1024 + 16 * (t - 32); boff = OFF_RV; ld = 1024; cl = 16 * (t - 32); }
        else if (t < 112) { ncol = 4096 + 16 * (t - 96); boff = OFF_SK; ld = 256; cl = 16 * (t - 96); }
        else { ncol = 4352 + 16 * (t - 112); boff = OFF_SV; ld = 256; cl = 16 * (t - 112); }
        const bf16_t* ap = WinT + (size_t)(ncol + r) * DM + 8 * q; const bf16_t* bp = XN + (size_t)(NTOK + r) * DM + 8 * q;
        f32x4 acc = (f32x4){0.f, 0.f, 0.f, 0.f};
#pragma unroll 8
        for (int ks = 0; ks < 32; ++ks) { const u32x4 a = *(const u32x4*)(ap + 32 * ks), b = *(const u32x4*)(bp + 32 * ks); acc = MFMA16(as_frag(a), as_frag(b), acc); }
        u32x2 o; o.x = cvt_pk_bf16(acc[0], acc[1]); o.y = cvt_pk_bf16(acc[2], acc[3]);
        *(u32x2*)((bf16_t*)(p.ws + boff) + (size_t)(NTOK + r) * ld + cl + 4 * q) = o;
    }
}

#define XB_TMO      128
#define XB_XCNT(j)  (256  + 64 * (j))
#define XB_XSUB(j)  (1280 + 64 * (j))
#define XB_XGEN(j)  (2304 + 64 * (j))
#define XB_TOP      3328
#define XB_TOPGEN   3392
#define XCD_BAR_WORDS 3456
#define XB_SPIN_CAP (1u << 22)
__device__ __forceinline__ unsigned xb_ld(unsigned* p)              { return __hip_atomic_load(p, __ATOMIC_RELAXED, __HIP_MEMORY_SCOPE_AGENT); }
__device__ __forceinline__ unsigned xb_add(unsigned* p, unsigned v) { return __hip_atomic_fetch_add(p, v, __ATOMIC_RELAXED, __HIP_MEMORY_SCOPE_AGENT); }
__device__ __forceinline__ unsigned xb_xcc_id() { return (unsigned)__builtin_amdgcn_s_getreg((3 << 11) | 20) & 0xFu; }
#define XB_SPIN(cond, bar) do { unsigned _sp = 0; while (cond) { __builtin_amdgcn_s_sleep(1); \
    if ((++_sp & 255u) == 0u) { if (xb_ld(&(bar)[XB_TMO])) break; if (_sp > XB_SPIN_CAP) { atomicAdd(&(bar)[XB_TMO], 1u); break; } } } } while (0)
struct XcdBarrier { unsigned* bar; unsigned x; volatile LAS unsigned* st; };
__device__ __forceinline__ XcdBarrier xcd_barrier_post(unsigned* bar, volatile LAS unsigned* st) {
    XcdBarrier b; b.bar = bar; b.x = xb_xcc_id(); b.st = st;
    if (threadIdx.x == 0) (void)xb_add(&bar[XB_XCNT(b.x)], 1u);
    return b;
}
__device__ __forceinline__ void xcd_barrier_complete(unsigned* bar, unsigned x, unsigned& nloc, unsigned& nx) {
    const unsigned G = gridDim.x * gridDim.y * gridDim.z;
    unsigned sum, cnt, mine, sp = 0u;
    for (;;) {
        sum = 0u; cnt = 0u; mine = 0u;
#pragma unroll
        for (unsigned j = 0; j < 16; ++j) { const unsigned c = xb_ld(&bar[XB_XCNT(j)]); sum += c; cnt += (c > 0u) ? 1u : 0u; mine = (j == x) ? c : mine; }
        if (sum == G) break;
        __builtin_amdgcn_s_sleep(1);
        if ((++sp & 255u) == 0u) { if (xb_ld(&bar[XB_TMO])) break; if (sp > XB_SPIN_CAP) { atomicAdd(&bar[XB_TMO], 1u); break; } }
    }
    nloc = mine > 0u ? mine : 1u; nx = cnt > 0u ? cnt : 1u;
}
__device__ __forceinline__ void xcd_barrier(const XcdBarrier& b) {
    asm volatile("s_waitcnt vmcnt(0)" ::: "memory");
    __syncthreads();
    if (threadIdx.x == 0) {
        unsigned* bar = b.bar;
        __builtin_amdgcn_s_waitcnt(0);
        unsigned nloc = b.st[0], nx = b.st[1];
        if (nloc == 0u) { xcd_barrier_complete(bar, b.x, nloc, nx); b.st[0] = nloc; b.st[1] = nx; }
        const unsigned old = xb_add(&bar[XB_XSUB(b.x)], 1u);
        const unsigned gen = old / nloc;
        if (old + 1u == (gen + 1u) * nloc) {
            __builtin_amdgcn_fence(__ATOMIC_RELEASE, "agent");
            asm volatile("s_waitcnt vmcnt(0)" ::: "memory");
            const unsigned og = xb_add(&bar[XB_TOP], 1u);
            const unsigned tg = og / nx;
            if (og + 1u == (tg + 1u) * nx) xb_add(&bar[XB_TOPGEN], 1u);
            else XB_SPIN(xb_ld(&bar[XB_TOPGEN]) == tg, bar);
            __builtin_amdgcn_fence(__ATOMIC_ACQUIRE, "agent");
            xb_add(&bar[XB_XGEN(b.x)], 1u);
            asm volatile("s_waitcnt vmcnt(0)" ::: "memory");
        } else {
            XB_SPIN(xb_ld(&bar[XB_XGEN(b.x)]) == gen, bar);
            __builtin_amdgcn_fence(__ATOMIC_ACQUIRE, "agent");
            asm volatile("s_waitcnt vmcnt(0)" ::: "memory");
        }
    }
    __syncthreads();
}

__device__ __forceinline__ void convert_slot(const Args& p, LAS unsigned char* lds, const int list) {
    const unsigned grp = (blockIdx.x >> 3) & 3u;
    if (grp == 0u) return;
    int tid_ = threadIdx.x; asm volatile("" : "+v"(tid_));
    const int tid = tid_, lane = tid & 63, wave = __builtin_amdgcn_readfirstlane(tid >> 6);
    constexpr int I_SQ = (DM / 64) * (DM / 32), I_UP = (DM / 64) * (FF / 32), I_DN = (FF / 64) * (DM / 32);
    const int total = list == 0 ? 3 * I_SQ + I_UP : I_DN;
    const int lo = grp == 1u ? 0 : (grp == 2u ? total / 6 : total / 2), hi = grp == 1u ? total / 6 : (grp == 2u ? total / 2 : total);
    const int j = (int)(((blockIdx.x >> 5) << 3) | (blockIdx.x & 7u));
    LAS float* scr = (LAS float*)(lds + wave * 16384);
    unsigned char* ws = p.ws;
    for (int it = lo + j * 8 + wave; it < hi; it += 512) {
        if (list == 0) {
            int r = it;
            if (r < I_SQ) { p0_transpose_item(p.w_ret, DM, DM, (bf16_t*)(ws + OFF_WRET), scr, r, lane); continue; } r -= I_SQ;
            if (r < I_SQ) { p0_transpose_item(p.w_swa, DM, DM, (bf16_t*)(ws + OFF_WSWA), scr, r, lane); continue; } r -= I_SQ;
            if (r < I_SQ) { p0_transpose_item(p.w_out, DM, DM, (bf16_t*)(ws + OFF_WOUT), scr, r, lane); continue; } r -= I_SQ;
            p0_transpose_item(p.w_up, DM, FF, (bf16_t*)(ws + OFF_WUP), scr, r, lane, p.mlp_g);
        } else p0_transpose_item(p.w_down, FF, DM, (bf16_t*)(ws + OFF_WDN), scr, it, lane);
    }
    __syncthreads();
}

__global__ void __launch_bounds__(NTHREADS, 2) fwd_megakernel(Args p) {
    extern __shared__ __attribute__((aligned(16))) unsigned char lds_raw[];
    LAS unsigned char* lds = (LAS unsigned char*)lds_raw;
    cg::grid_group grid = cg::this_grid();
    ((LAS unsigned*)(lds + 131072 + 64))[threadIdx.x & 15] = 0u;
    __syncthreads();
    XcdBarrier xbar = xcd_barrier_post((unsigned*)(p.ws + OFF_CTL), (volatile LAS unsigned*)(lds + 131072 + 64));
    grid.sync();
#define GRID_SYNC() xcd_barrier(xbar)
    const int tid = threadIdx.x, lane = tid & 63, wave = __builtin_amdgcn_readfirstlane(tid >> 6);
    const int G = gridDim.x, gw = blockIdx.x * 8 + wave, NGW = G * 8;
    unsigned char* ws = p.ws;
    bf16_t* WinT = (bf16_t*)(ws + OFF_WIN); bf16_t* WretT = (bf16_t*)(ws + OFF_WRET); bf16_t* WswaT = (bf16_t*)(ws + OFF_WSWA); bf16_t* WoutT = (bf16_t*)(ws + OFF_WOUT);
    bf16_t* WupT = (bf16_t*)(ws + OFF_WUP); bf16_t* WdnT = (bf16_t*)(ws + OFF_WDN);
    bf16_t* XN = (bf16_t*)p.out;

    for (int rep = 0; rep < 1 + ((REP_MASK >> 0) & 1); ++rep) {
        LAS float* scr = (LAS float*)(lds + wave * 16384);
        constexpr int I_IN = (DM / 64) * (DIN / 32), I_SQ = (DM / 64) * (DM / 32), I_UP = (DM / 64) * (FF / 32), I_DN = (FF / 64) * (DM / 32);
        constexpr int NITEMS = I_IN + 3 * I_SQ + I_UP + I_DN;
        const bool split = (G == 256);
        for (int it = gw; it < (split ? I_IN : NITEMS); it += NGW) {
            int r = it;
            if (r < I_IN) { p0_transpose_item(p.w_in, DM, DIN, WinT, scr, r, lane); continue; } r -= I_IN;
            if (r < I_SQ) { p0_transpose_item(p.w_ret, DM, DM, WretT, scr, r, lane); continue; } r -= I_SQ;
            if (r < I_SQ) { p0_transpose_item(p.w_swa, DM, DM, WswaT, scr, r, lane); continue; } r -= I_SQ;
            if (r < I_SQ) { p0_transpose_item(p.w_out, DM, DM, WoutT, scr, r, lane); continue; } r -= I_SQ;
            if (r < I_UP) { p0_transpose_item(p.w_up, DM, FF, WupT, scr, r, lane, p.mlp_g); continue; } r -= I_UP;
            p0_transpose_item(p.w_down, FF, DM, WdnT, scr, r, lane);
        }
        for (int m = gw; m < NTOK; m += 2 * NGW) {
            const int m2 = m + NGW;
            const f32x4* xa = (const f32x4*)(p.x + (size_t)m * DM) + lane; const f32x4* xb = (const f32x4*)(p.x + (size_t)(m2 < NTOK ? m2 : m) * DM) + lane; const f32x4* gr = (const f32x4*)p.mix_g + lane;
            f32x4 va[4], vb[4]; float sa = 0.f, sb = 0.f;
#pragma unroll
            for (int j = 0; j < 4; ++j) { va[j] = xa[64 * j]; vb[j] = xb[64 * j]; }
#pragma unroll
            for (int j = 0; j < 4; ++j) { sa += (va[j].x * va[j].x + va[j].y * va[j].y) + (va[j].z * va[j].z + va[j].w * va[j].w); sb += (vb[j].x * vb[j].x + vb[j].y * vb[j].y) + (vb[j].z * vb[j].z + vb[j].w * vb[j].w); }
            const float ra = 1.f / sqrtf(wave_sum(sa) * (1.f / DM) + EPS), rb = 1.f / sqrtf(wave_sum(sb) * (1.f / DM) + EPS);
            u32x2* oa = (u32x2*)(XN + (size_t)m * DM) + lane; u32x2* ob = (u32x2*)(XN + (size_t)m2 * DM) + lane;
#pragma unroll
            for (int j = 0; j < 4; ++j) { const f32x4 gg = gr[64 * j];
                u32x2 wa; wa.x = cvt_pk_bf16_asm(va[j].x * ra * gg.x, va[j].y * ra * gg.y); wa.y = cvt_pk_bf16_asm(va[j].z * ra * gg.z, va[j].w * ra * gg.w); oa[64 * j] = wa;
                if (m2 < NTOK) { u32x2 wb; wb.x = cvt_pk_bf16_asm(vb[j].x * rb * gg.x, vb[j].y * rb * gg.y); wb.y = cvt_pk_bf16_asm(vb[j].z * rb * gg.z, vb[j].w * rb * gg.w); ob[64 * j] = wb; } }
        }
        if (gw < NMETA) rms_row_to_bf16(p.meta + (size_t)gw * DM, p.mix_g, XN + (size_t)(NTOK + gw) * DM, lane);
    }
    GRID_SYNC();
    {
        meta_proj(p, XN, WinT);
        if (G == 256) convert_slot(p, lds, 0);
        pg8::Gemm g{XN, WinT, XN, WinT, NTOK, DIN, DM}; pg8::StaticOrder S; S.init(NTOK, DIN, G, (int)blockIdx.x);
        pg8::EpiProj E{ws};
        pg8::gemm_phase<pg8::EpiProj, pg8::StaticOrder, true>(lds, g, S, E);
    }
    GRID_SYNC();
    for (int rep = 0; rep < 1 + ((REP_MASK >> 1) & 1); ++rep) { swa_phase(lds, p); kvlocal_phase(lds, p); }
    GRID_SYNC();
    scan_phase(p);
    GRID_SYNC();
    for (int rep = 0; rep < 1 + ((REP_MASK >> 2) & 1); ++rep) retout_phase(lds, p);
    GRID_SYNC();
    {
        const bf16_t* YRET = (const bf16_t*)(ws + OFF_YRET); const bf16_t* YSWA = (const bf16_t*)((unsigned char*)p.out + DOUT_YSWA);
        pg8::Gemm g{YRET, WretT, YSWA, WswaT, NTOK, DM, DM}; pg8::PairOrder S; S.s.init(NTOK, DM, G, (int)blockIdx.x);
        pg8::EpiMerged E{(const unsigned char*)(ws + OFF_GR), (const unsigned char*)(ws + OFF_GS), (bf16_t*)(ws + OFF_MERGED)};
        pg8::gemm_phase<pg8::EpiMerged, pg8::PairOrder, true>(lds, g, S, E);
    }
    GRID_SYNC();
    {
        const bf16_t* MG = (const bf16_t*)(ws + OFF_MERGED);
        pg8::Gemm g{MG, WoutT, MG, WoutT, NTOK, DM, DM}; pg8::StaticOrder S; S.init(NTOK, DM, G, (int)blockIdx.x);
        pg8::EpiResStat E{p.x, p.out, (bf16_t*)(ws + OFF_HN2), (float*)(ws + OFF_SS)};
        pg8::gemm_phase<pg8::EpiResStat, pg8::StaticOrder, true>(lds, g, S, E);
    }
    GRID_SYNC();
    {
        const bf16_t* HN2 = (const bf16_t*)(ws + OFF_HN2);
        pg8::Gemm g{HN2, WupT, HN2, WupT, NTOK, FF, DM}; pg8::StaticOrder S; S.init(NTOK, FF, G, (int)blockIdx.x);
        pg8::EpiUp E{(bf16_t*)(ws + OFF_U), (const float*)(ws + OFF_SS)};
        if (G == 256) convert_slot(p, lds, 1);
        pg8::gemm_phase<pg8::EpiUp, pg8::StaticOrder, true>(lds, g, S, E);
    }
    GRID_SYNC();
    {
        const bf16_t* U = (const bf16_t*)(ws + OFF_U);
        pg8::Gemm g{U, WdnT, U, WdnT, NTOK, DM, FF}; pg8::StaticOrder S; S.init(NTOK, DM, G, (int)blockIdx.x);
        pg8::EpiResBf E{(const bf16_t*)(ws + OFF_HN2), p.out};
        pg8::gemm_phase<pg8::EpiResBf, pg8::StaticOrder, true>(lds, g, S, E);
    }
}

extern "C" void kernel_launch(void* const* d_in, const int* in_sizes, int n_in, void* d_out, int out_size, void* d_ws, size_t ws_size, hipStream_t stream) {
    static int grid = 0;
    if (grid == 0) {
        if (n_in != 14 || in_sizes[0] != NTOK * DM || out_size != NTOK * DM || ws_size < WS_NEED) {
            fprintf(stderr, "kernel_launch: unexpected shapes (n_in %d, in0 %d, out %d, ws %zu, need %zu); nothing launched\n", n_in, n_in > 0 ? in_sizes[0] : -1, out_size, ws_size, (size_t)WS_NEED); grid = -1; return; }
        int dev = 0, cus = 0, per_cu = 0;
        (void)hipGetDevice(&dev); (void)hipDeviceGetAttribute(&cus, hipDeviceAttributeMultiprocessorCount, dev);
        if (hipFuncSetAttribute((const void*)fwd_megakernel, hipFuncAttributeMaxDynamicSharedMemorySize, LDS_BYTES) != hipSuccess) { fprintf(stderr, "kernel_launch: hipFuncSetAttribute failed\n"); grid = -1; return; }
        if (hipOccupancyMaxActiveBlocksPerMultiprocessor(&per_cu, (const void*)fwd_megakernel, NTHREADS, LDS_BYTES) != hipSuccess || per_cu < 1) { fprintf(stderr, "kernel_launch: occupancy query gave %d\n", per_cu); per_cu = 1; }
        (void)hipGetLastError();
        grid = cus * per_cu;
    }
    if (grid < 0) return;
    Args a{};
    a.x = (const float*)d_in[0]; a.meta = (const float*)d_in[1]; a.mix_g = (const float*)d_in[2]; a.w_in = (const float*)d_in[3]; a.ret_g = (const float*)d_in[4];
    a.q_g = (const float*)d_in[5]; a.k_g = (const float*)d_in[6]; a.sinks = (const float*)d_in[7]; a.w_ret = (const float*)d_in[8]; a.w_swa = (const float*)d_in[9];
    a.w_out = (const float*)d_in[10]; a.mlp_g = (const float*)d_in[11]; a.w_up = (const float*)d_in[12]; a.w_down = (const float*)d_in[13];
    a.out = (float*)d_out; a.ws = (unsigned char*)d_ws;
    if (hipMemsetAsync((unsigned char*)d_ws + OFF_CTL, 0, CTL_BYTES, stream) != hipSuccess) { fprintf(stderr, "kernel_launch: memset failed\n"); return; }
    void* args[] = {&a};
    hipError_t e = hipLaunchCooperativeKernel((const void*)fwd_megakernel, dim3(grid), dim3(NTHREADS), args, LDS_BYTES, stream);
    if (e != hipSuccess) fprintf(stderr, "kernel_launch: cooperative launch failed: %s (grid %d)\n", hipGetErrorString(e), grid);
}
```

```cpp
#ifndef REP_MASK
#define REP_MASK 0
#endif
#include <hip/hip_runtime.h>
#include <hip/hip_cooperative_groups.h>
#include <cstdio>
#include <cstdint>
namespace cg = cooperative_groups;

#define LAS __attribute__((address_space(3)))
typedef unsigned short bf16_t;
typedef short bf16x8 __attribute__((ext_vector_type(8)));
typedef float f32x4 __attribute__((ext_vector_type(4)));
typedef unsigned u32x4 __attribute__((ext_vector_type(4)));
typedef unsigned u32x2 __attribute__((ext_vector_type(2)));

constexpr int NB = 4, SEQ = 8192, DM = 1024, NTOK = NB * SEQ, NMETA = 16, MROWS = NTOK + NMETA, MPAD = 33024, DIN = 6656, FF = 4096;
constexpr float EPS = 1e-6f;
constexpr int NTHREADS = 512;
constexpr int LDS_BYTES = 135168;

constexpr size_t SZ_WIN = (size_t)DIN * DM * 2, SZ_WSQ = (size_t)DM * DM * 2, SZ_WFF = (size_t)FF * DM * 2;
constexpr size_t OFF_WIN = 0, OFF_WRET = OFF_WIN + SZ_WIN, OFF_WSWA = OFF_WRET + SZ_WSQ, OFF_WOUT = OFF_WSWA + SZ_WSQ, OFF_WUP = OFF_WOUT + SZ_WSQ, OFF_WDN = OFF_WUP + SZ_WFF;
constexpr size_t OFF_RQ = OFF_WDN + SZ_WFF;
constexpr size_t OFF_RK = OFF_RQ + (size_t)MROWS * 512 * 2;
constexpr size_t OFF_RV = OFF_RK + (size_t)MROWS * 512 * 2;
constexpr size_t OFF_RG = OFF_RV + (size_t)MROWS * 1024 * 2;
constexpr size_t OFF_SQ = OFF_RG + (size_t)MROWS * 1024 * 2;
constexpr size_t OFF_SK = OFF_SQ + (size_t)MROWS * 1024 * 2;
constexpr size_t OFF_SV = OFF_SK + (size_t)MROWS * 256 * 2;
constexpr size_t OFF_GR = OFF_SV + (size_t)MROWS * 256 * 2;
constexpr size_t OFF_GS = OFF_GR + (size_t)MROWS * 1024 * 2;
constexpr size_t OFF_CTL = OFF_GS + (size_t)MROWS * 1024 * 2;
constexpr size_t CTL_BYTES = 16384 + (size_t)NTOK * 4;
constexpr size_t OFF_SS = OFF_CTL + 16384;
constexpr size_t WS_NEED = OFF_CTL + CTL_BYTES;
constexpr size_t OFF_MERGED = OFF_RQ, OFF_HN2 = OFF_RV, OFF_YRET = OFF_SQ, OFF_U = OFF_RG;
static_assert(OFF_RK - OFF_RQ + OFF_RV - OFF_RK >= (size_t)NTOK * 1024 * 2, "MERGED fits");
static_assert(OFF_CTL - OFF_RG >= (size_t)NTOK * FF * 2, "U fits");
static_assert((size_t)MPAD * DM * 2 <= (size_t)NTOK * DM * 4, "XN fits d_out");
constexpr size_t DOUT_KVS = 0, DOUT_YSWA = (size_t)NTOK * 1024 * 2;

typedef __bf16 bf16x2_t __attribute__((ext_vector_type(2)));
typedef float f32x2_t __attribute__((ext_vector_type(2)));
__device__ __forceinline__ unsigned cvt_pk_bf16(float lo, float hi) { const f32x2_t v = {lo, hi}; const bf16x2_t b = __builtin_convertvector(v, bf16x2_t); return __builtin_bit_cast(unsigned, b); }
__device__ __forceinline__ unsigned cvt_pk_bf16_asm(float lo, float hi) { unsigned r; asm volatile("v_cvt_pk_bf16_f32 %0, %1, %2" : "=v"(r) : "v"(lo), "v"(hi)); return r; }
__device__ __forceinline__ float bf_lo(unsigned w) { return __uint_as_float(w << 16); }
__device__ __forceinline__ float bf_hi(unsigned w) { return __uint_as_float(w & 0xffff0000u); }
__device__ __forceinline__ float wave_sum(float v) {
#pragma unroll
    for (int o = 1; o < 64; o <<= 1) v += __shfl_xor(v, o);
    return v;
}
__device__ __forceinline__ float sigmoidf_(float x) { return __builtin_amdgcn_rcpf(1.0f + __builtin_amdgcn_exp2f(-1.4426950408889634f * x)); }

namespace pg8 {
constexpr int BM = 256, BK = 64, HALF = 128, HTB = HALF * BK * 2, STAGE_BYTES = 8 * HTB, NXCD = 8, WGM = 8;
__host__ __device__ __forceinline__ int lds_byte(int r, int c) { const int st = (r >> 4) * 2 + (c >> 5), rr = r & 15, cc = c & 31, ob = rr * 64 + cc * 2; return st * 1024 + (ob ^ (((ob >> 9) & 1) << 5)); }
__host__ __device__ __forceinline__ void stage_rc(int b, int& R, int& C) { const int st = b / 1024, sb = b % 1024, swz = sb ^ (((sb >> 9) & 1) << 5); R = (st >> 1) * 16 + swz / 64; C = (st & 1) * 32 + (swz % 64) / 2; }
__host__ __device__ __forceinline__ int perm32(int rho) { const int n = rho >> 4, i = rho & 15; return 8 * (i >> 2) + 4 * n + (i & 3); }

struct Unit { int pm, pn, seg; };
struct Gemm { const bf16_t* A; const bf16_t* Bt; const bf16_t* A2; const bf16_t* Bt2; int M, N, K; };

struct StaticOrder {
    int nM, nN, nwg, G, c;
    __device__ void init(int M, int N, int G_, int c_) { nM = M / BM; nN = N / BM; nwg = nM * nN; G = G_; c = c_; }
    __device__ bool tile(long L, Unit& u) const {
        if (L >= nwg) return false;
        int wgid = (int)L; { const int q = nwg / NXCD, r = nwg % NXCD, xcd = wgid % NXCD, off = wgid / NXCD; wgid = (xcd < r ? xcd * (q + 1) : r * (q + 1) + (xcd - r) * q) + off; }
        const int nig = WGM * nN, gid = wgid / nig, fm = gid * WGM, gsz = (nM - fm) < WGM ? (nM - fm) : WGM;
        u.pm = fm + ((wgid % nig) % gsz); u.pn = (wgid % nig) / gsz; u.seg = 0; return true;
    }
    __device__ bool next(int i, Unit& u) const { return tile((long)i * G + c, u); }
};
struct PairOrder {
    StaticOrder s;
    __device__ bool next(int i, Unit& u) const { const bool ok = s.tile((long)(i >> 1) * s.G + s.c, u); u.seg = i & 1; return ok; }
};

struct EpiProj {
    static constexpr bool PERM = true, HAS_MID = false;
    unsigned char* ws;
    __device__ __forceinline__ void mid(f32x4 (&acc)[2][2][4][2], const Unit& u, int wr, int wc, int fr, int fq) const {}
    __device__ __forceinline__ void operator()(const f32x4 (&acc)[2][2][4][2], const Unit& u, int wr, int wc, int fr, int fq) const {
        const int pn = u.pn; size_t boff; int ld, ct;
        if (pn < 2) { boff = OFF_RQ; ld = 512; ct = pn; }
        else if (pn < 4) { boff = OFF_RK; ld = 512; ct = pn - 2; }
        else if (pn < 8) { boff = OFF_RV; ld = 1024; ct = pn - 4; }
        else if (pn < 12) { boff = OFF_RG; ld = 1024; ct = pn - 8; }
        else if (pn < 16) { boff = OFF_SQ; ld = 1024; ct = pn - 12; }
        else if (pn == 16) { boff = OFF_SK; ld = 256; ct = 0; }
        else if (pn == 17) { boff = OFF_SV; ld = 256; ct = 0; }
        else if (pn < 22) { boff = OFF_GR; ld = 1024; ct = pn - 18; }
        else { boff = OFF_GS; ld = 1024; ct = pn - 22; }
        bf16_t* base = (bf16_t*)(ws + boff);
        const int row0 = u.pm * BM + wr * 64 + fr, col0 = ct * 256 + wc * 32 + 8 * fq;
        if (pn >= 18) {
            unsigned char* gb = ws + boff;
            const int colw = ct * 256 + wc * 32 + ((fq & 1) ? HALF + 8 * (fq - 1) : 8 * fq);
#pragma unroll
            for (int ai = 0; ai < 2; ++ai)
#pragma unroll
                for (int m = 0; m < 4; ++m) {
                    unsigned w[2][2];
#pragma unroll
                    for (int bj = 0; bj < 2; ++bj) { const f32x4 v0 = acc[ai][bj][m][0], v1 = acc[ai][bj][m][1];
                        int w0 = __builtin_amdgcn_cvt_pk_fp8_f32(v0[0], v0[1], 0, false); w0 = __builtin_amdgcn_cvt_pk_fp8_f32(v0[2], v0[3], w0, true);
                        int w1 = __builtin_amdgcn_cvt_pk_fp8_f32(v1[0], v1[1], 0, false); w1 = __builtin_amdgcn_cvt_pk_fp8_f32(v1[2], v1[3], w1, true);
                        w[bj][0] = (unsigned)w0; w[bj][1] = (unsigned)w1; }
                    const u32x2 sx = __builtin_amdgcn_permlane16_swap(w[0][0], w[1][0], false, false), sy = __builtin_amdgcn_permlane16_swap(w[0][1], w[1][1], false, false);
                    *(u32x4*)(gb + (size_t)(row0 + ai * HALF + m * 16) * 1024 + colw) = (u32x4){sx.x, sy.x, sx.y, sy.y};
                }
            return;
        }
#pragma unroll
        for (int ai = 0; ai < 2; ++ai)
#pragma unroll
            for (int m = 0; m < 4; ++m) {
                bf16_t* rowp = base + (size_t)(row0 + ai * HALF + m * 16) * ld + col0;
#pragma unroll
                for (int bj = 0; bj < 2; ++bj) { const f32x4 v0 = acc[ai][bj][m][0], v1 = acc[ai][bj][m][1];
                    u32x4 w; w.x = cvt_pk_bf16_asm(v0[0], v0[1]); w.y = cvt_pk_bf16_asm(v0[2], v0[3]); w.z = cvt_pk_bf16_asm(v1[0], v1[1]); w.w = cvt_pk_bf16_asm(v1[2], v1[3]);
                    *(u32x4*)(rowp + bj * HALF) = w; } }
    }
};
struct EpiMerged {
    static constexpr bool PERM = true, HAS_MID = true;
    const unsigned char *GR, *GS; bf16_t* O;
#define F8(w, k) __builtin_amdgcn_cvt_f32_fp8((int)(w), (k))
    __device__ __forceinline__ void mid(f32x4 (&acc)[2][2][4][2], const Unit& u, int wr, int wc, int fr, int fq) const {
        const int row0 = u.pm * BM + wr * 64 + fr, colw = u.pn * BM + wc * 32 + ((fq & 1) ? HALF + 8 * (fq - 1) : 8 * fq);
#pragma unroll
        for (int ai = 0; ai < 2; ++ai)
#pragma unroll
            for (int m = 0; m < 4; ++m) { const size_t off = (size_t)(row0 + ai * HALF + m * 16) * DM + colw;
                const u32x4 ga = *(const u32x4*)(GR + off), gb = *(const u32x4*)(GS + off);
                const u32x2 ax = __builtin_amdgcn_permlane16_swap(ga.x, ga.z, false, false), ay = __builtin_amdgcn_permlane16_swap(ga.y, ga.w, false, false);
                const u32x2 bx = __builtin_amdgcn_permlane16_swap(gb.x, gb.z, false, false), by = __builtin_amdgcn_permlane16_swap(gb.y, gb.w, false, false);
#define MRG_R(ga_, gb_) ((1.0f + __builtin_amdgcn_exp2f(-1.4426950408889634f * (gb_))) * __builtin_amdgcn_rcpf(1.0f + __builtin_amdgcn_exp2f(-1.4426950408889634f * (ga_))))
#pragma unroll
                for (int bj = 0; bj < 2; ++bj) { const unsigned a0 = bj ? ax.y : ax.x, a1 = bj ? ay.y : ay.x, b0 = bj ? bx.y : bx.x, b1 = bj ? by.y : by.x;
                    f32x4 r0, r1;
                    r0[0] = MRG_R(F8(a0, 0), F8(b0, 0)); r0[1] = MRG_R(F8(a0, 1), F8(b0, 1)); r0[2] = MRG_R(F8(a0, 2), F8(b0, 2)); r0[3] = MRG_R(F8(a0, 3), F8(b0, 3));
                    r1[0] = MRG_R(F8(a1, 0), F8(b1, 0)); r1[1] = MRG_R(F8(a1, 1), F8(b1, 1)); r1[2] = MRG_R(F8(a1, 2), F8(b1, 2)); r1[3] = MRG_R(F8(a1, 3), F8(b1, 3));
                    acc[ai][bj][m][0] = acc[ai][bj][m][0] * r0; acc[ai][bj][m][1] = acc[ai][bj][m][1] * r1; }
#undef MRG_R
            }
    }
    __device__ __forceinline__ void operator()(const f32x4 (&acc)[2][2][4][2], const Unit& u, int wr, int wc, int fr, int fq) const {
        const int row0 = u.pm * BM + wr * 64 + fr, col0 = u.pn * BM + wc * 32 + 8 * fq, colw = u.pn * BM + wc * 32 + ((fq & 1) ? HALF + 8 * (fq - 1) : 8 * fq);
#pragma unroll
        for (int ai = 0; ai < 2; ++ai)
#pragma unroll
            for (int m = 0; m < 4; ++m) { const size_t rowoff = (size_t)(row0 + ai * HALF + m * 16) * DM;
                const u32x4 gb = *(const u32x4*)(GS + rowoff + colw);
                const u32x2 bx = __builtin_amdgcn_permlane16_swap(gb.x, gb.z, false, false), by = __builtin_amdgcn_permlane16_swap(gb.y, gb.w, false, false);
#pragma unroll
                for (int bj = 0; bj < 2; ++bj) { const unsigned b0 = bj ? bx.y : bx.x, b1 = bj ? by.y : by.x; const f32x4 v0 = acc[ai][bj][m][0], v1 = acc[ai][bj][m][1];
                    u32x4 w;
                    w.x = cvt_pk_bf16_asm(v0[0] * sigmoidf_(F8(b0, 0)), v0[1] * sigmoidf_(F8(b0, 1))); w.y = cvt_pk_bf16_asm(v0[2] * sigmoidf_(F8(b0, 2)), v0[3] * sigmoidf_(F8(b0, 3)));
                    w.z = cvt_pk_bf16_asm(v1[0] * sigmoidf_(F8(b1, 0)), v1[1] * sigmoidf_(F8(b1, 1))); w.w = cvt_pk_bf16_asm(v1[2] * sigmoidf_(F8(b1, 2)), v1[3] * sigmoidf_(F8(b1, 3)));
                    *(u32x4*)(O + rowoff + col0 + bj * HALF) = w; }
            }
    }
#undef F8
};
struct EpiRes {
    static constexpr bool PERM = true, HAS_MID = false;
    const float* res; float* out;
    __device__ __forceinline__ void mid(f32x4 (&acc)[2][2][4][2], const Unit& u, int wr, int wc, int fr, int fq) const {}
    __device__ __forceinline__ void operator()(const f32x4 (&acc)[2][2][4][2], const Unit& u, int wr, int wc, int fr, int fq) const {
        const int row0 = u.pm * BM + wr * 64 + fr, col0 = u.pn * BM + wc * 32 + 8 * fq;
#pragma unroll
        for (int ai = 0; ai < 2; ++ai)
#pragma unroll
            for (int m = 0; m < 4; ++m)
#pragma unroll
                for (int bj = 0; bj < 2; ++bj) { const size_t off = (size_t)(row0 + ai * HALF + m * 16) * DM + col0 + bj * HALF;
                    const f32x4 x0 = *(const f32x4*)(res + off), x1 = *(const f32x4*)(res + off + 4);
                    *(f32x4*)(out + off) = x0 + acc[ai][bj][m][0]; *(f32x4*)(out + off + 4) = x1 + acc[ai][bj][m][1]; }
    }
};
struct EpiResStat {
    static constexpr bool PERM = true, HAS_MID = false;
    const float* res; float* out; bf16_t* hb; float* ss;
    __device__ __forceinline__ void mid(f32x4 (&acc)[2][2][4][2], const Unit& u, int wr, int wc, int fr, int fq) const {}
    __device__ __forceinline__ void operator()(const f32x4 (&acc)[2][2][4][2], const Unit& u, int wr, int wc, int fr, int fq) const {
        const int row0 = u.pm * BM + wr * 64 + fr, col0 = u.pn * BM + wc * 32 + 8 * fq;
#pragma unroll
        for (int ai = 0; ai < 2; ++ai)
#pragma unroll
            for (int m = 0; m < 4; ++m) {
                float sq = 0.f;
#pragma unroll
                for (int bj = 0; bj < 2; ++bj) { const size_t off = (size_t)(row0 + ai * HALF + m * 16) * DM + col0 + bj * HALF;
                    const f32x4 h0 = *(const f32x4*)(res + off) + acc[ai][bj][m][0], h1 = *(const f32x4*)(res + off + 4) + acc[ai][bj][m][1];
                    u32x4 w; w.x = cvt_pk_bf16_asm(h0[0], h0[1]); w.y = cvt_pk_bf16_asm(h0[2], h0[3]); w.z = cvt_pk_bf16_asm(h1[0], h1[1]); w.w = cvt_pk_bf16_asm(h1[2], h1[3]);
                    *(u32x4*)(hb + off) = w;
                    sq += (h0[0] * h0[0] + h0[1] * h0[1]) + (h0[2] * h0[2] + h0[3] * h0[3]) + (h1[0] * h1[0] + h1[1] * h1[1]) + (h1[2] * h1[2] + h1[3] * h1[3]); }
                sq += __shfl_xor(sq, 16); sq += __shfl_xor(sq, 32);
                if (fq == 0) atomicAdd(ss + row0 + ai * HALF + m * 16, sq);
            }
    }
};
struct EpiResBf {
    static constexpr bool PERM = true, HAS_MID = false;
    const bf16_t* hb; float* out;
    __device__ __forceinline__ void mid(f32x4 (&acc)[2][2][4][2], const Unit& u, int wr, int wc, int fr, int fq) const {}
    __device__ __forceinline__ void operator()(const f32x4 (&acc)[2][2][4][2], const Unit& u, int wr, int wc, int fr, int fq) const {
        const int row0 = u.pm * BM + wr * 64 + fr, col0 = u.pn * BM + wc * 32 + 8 * fq;
#pragma unroll
        for (int ai = 0; ai < 2; ++ai)
#pragma unroll
            for (int m = 0; m < 4; ++m)
#pragma unroll
                for (int bj = 0; bj < 2; ++bj) { const size_t off = (size_t)(row0 + ai * HALF + m * 16) * DM + col0 + bj * HALF;
                    const u32x4 h = *(const u32x4*)(hb + off);
                    const f32x4 x0 = (f32x4){bf_lo(h.x), bf_hi(h.x), bf_lo(h.y), bf_hi(h.y)}, x1 = (f32x4){bf_lo(h.z), bf_hi(h.z), bf_lo(h.w), bf_hi(h.w)};
                    *(f32x4*)(out + off) = x0 + acc[ai][bj][m][0]; *(f32x4*)(out + off + 4) = x1 + acc[ai][bj][m][1]; }
    }
};
struct EpiUp {
    static constexpr bool PERM = true, HAS_MID = false;
    bf16_t* O; const float* ss;
    __device__ __forceinline__ void mid(f32x4 (&acc)[2][2][4][2], const Unit& u, int wr, int wc, int fr, int fq) const {}
    __device__ __forceinline__ void operator()(const f32x4 (&acc)[2][2][4][2], const Unit& u, int wr, int wc, int fr, int fq) const {
        const int row0 = u.pm * BM + wr * 64 + fr, col0 = u.pn * BM + wc * 32 + 8 * fq;
#pragma unroll
        for (int ai = 0; ai < 2; ++ai)
#pragma unroll
            for (int m = 0; m < 4; ++m) {
                const float rstd = 1.f / sqrtf(ss[row0 + ai * HALF + m * 16] * (1.f / DM) + EPS);
#pragma unroll
                for (int bj = 0; bj < 2; ++bj) { const size_t off = (size_t)(row0 + ai * HALF + m * 16) * FF + col0 + bj * HALF;
                    f32x4 v0 = acc[ai][bj][m][0], v1 = acc[ai][bj][m][1];
#pragma unroll
                    for (int e = 0; e < 4; ++e) { const float a = fmaxf(v0[e] * rstd, 0.f), b = fmaxf(v1[e] * rstd, 0.f); v0[e] = a * a; v1[e] = b * b; }
                    u32x4 w; w.x = cvt_pk_bf16_asm(v0[0], v0[1]); w.y = cvt_pk_bf16_asm(v0[2], v0[3]); w.z = cvt_pk_bf16_asm(v1[0], v1[1]); w.w = cvt_pk_bf16_asm(v1[2], v1[3]);
                    *(u32x4*)(O + off) = w; }
            }
    }
};

template <class Epi, class Sched, bool ALIGN_EPI>
__device__ __forceinline__ void gemm_phase(LAS unsigned char* lds, const Gemm g, const Sched& S, const Epi& E) {
    int tid_ = threadIdx.x; asm volatile("" : "+v"(tid_));
    const int tid = tid_, wid = __builtin_amdgcn_readfirstlane(tid >> 6), lane = tid & 63, wr = wid >> 2, wc = wid & 3, fr = lane & 15, fq = lane >> 4;
    const int K = g.K, nt = K / BK;
    unsigned voffA[2], voffB[2];
#pragma unroll
    for (int i = 0; i < 2; ++i) { int R, C; stage_rc(tid * 16 + i * 8192, R, C); const int Rb = Epi::PERM ? ((R & ~31) + perm32(R & 31)) : R;
        voffA[i] = (unsigned)(R * K + C) * 2u; voffB[i] = (unsigned)(Rb * K + C) * 2u; }
    const size_t kstep = (size_t)(BK * 2);
    const size_t hstep = (size_t)HALF * K * 2;
    const size_t tstep = 2 * hstep;
    const unsigned ldsw = (unsigned)wid * 1024u;
    const int aoff = lds_byte(wr * 64 + fr, fq * 8), boff = lds_byte(wc * 32 + fr, fq * 8);
#define PG8_SA(b, h) (((b) * 2 + (h)) * HTB)
#define PG8_SB(b, h) ((4 + (b) * 2 + (h)) * HTB)
#define PG8_STAGE(bufoff, gbase, voff) do { _Pragma("unroll") for (int _i = 0; _i < 2; ++_i) \
        __builtin_amdgcn_global_load_lds((const unsigned*)((const char*)(gbase) + (voff)[_i]), (LAS unsigned*)(lds + (bufoff) + ldsw + _i * 8192), 16, 0, 0); } while (0)
#define PG8_LDA(dst, b, h) do { _Pragma("unroll") for (int m = 0; m < 4; ++m) _Pragma("unroll") for (int k = 0; k < 2; ++k) dst[m][k] = *(const LAS bf16x8*)(lds + PG8_SA(b, h) + aoff + m * 2048 + k * 1024); } while (0)
#define PG8_LDB(dst, b, h) do { _Pragma("unroll") for (int n = 0; n < 2; ++n) _Pragma("unroll") for (int k = 0; k < 2; ++k) dst[n][k] = *(const LAS bf16x8*)(lds + PG8_SB(b, h) + boff + n * 2048 + k * 1024); } while (0)
#define PG8_MMA(ai, bj, At, Bt) do { __builtin_amdgcn_s_setprio(1); _Pragma("unroll") for (int m = 0; m < 4; ++m) _Pragma("unroll") for (int n = 0; n < 2; ++n) _Pragma("unroll") for (int k = 0; k < 2; ++k) \
        acc[ai][bj][m][n] = __builtin_amdgcn_mfma_f32_16x16x32_bf16(Bt[n][k], At[m][k], acc[ai][bj][m][n], 0, 0, 0); __builtin_amdgcn_s_setprio(0); } while (0)
#define PG8_WAIT_V(n) asm volatile("s_waitcnt vmcnt(" #n ")" ::: "memory")
#define PG8_WAIT_L(n) asm volatile("s_waitcnt lgkmcnt(" #n ")" ::: "memory")
#define PG8_BAR __builtin_amdgcn_s_barrier()
#define PG8_SCHED __builtin_amdgcn_sched_barrier(0)
    Unit cur, nxt; int ui = 0;
    if (!S.next(0, cur)) return;
    f32x4 acc[2][2][4][2];
#pragma unroll
    for (int a = 0; a < 2; ++a)
#pragma unroll
        for (int b = 0; b < 2; ++b)
#pragma unroll
            for (int m = 0; m < 4; ++m)
#pragma unroll
                for (int n = 0; n < 2; ++n) acc[a][b][m][n] = (f32x4){0.f, 0.f, 0.f, 0.f};
    bf16x8 At[4][2], B0[2][2], B1[2][2];
    const char* cA = (const char*)(cur.seg ? g.A2 : g.A) + (size_t)cur.pm * tstep; const char* cB = (const char*)(cur.seg ? g.Bt2 : g.Bt) + (size_t)cur.pn * tstep;
    PG8_STAGE(PG8_SB(0, 0), cB, voffB); PG8_STAGE(PG8_SB(0, 1), cB + hstep, voffB); PG8_STAGE(PG8_SA(0, 0), cA, voffA); PG8_STAGE(PG8_SA(0, 1), cA + hstep, voffA);
    if (wr == 1) PG8_BAR;
    PG8_WAIT_V(2); PG8_BAR;
    PG8_STAGE(PG8_SB(1, 0), cB + kstep, voffB); PG8_STAGE(PG8_SA(1, 0), cA + kstep, voffA); PG8_STAGE(PG8_SB(1, 1), cB + hstep + kstep, voffB);
    PG8_WAIT_V(6); PG8_BAR;
    for (;;) {
        const bool has_next = S.next(ui + 1, nxt);
        const char* nA = has_next ? (const char*)(nxt.seg ? g.A2 : g.A) + (size_t)nxt.pm * tstep : cA; const char* nB = has_next ? (const char*)(nxt.seg ? g.Bt2 : g.Bt) + (size_t)nxt.pn * tstep : cB;
        for (int t = 0; t < nt; t += 2) {
            const bool last = (t == nt - 2);
            const char* a1 = cA + (size_t)(t + 1) * kstep;
            const char* a2 = last ? nA : cA + (size_t)(t + 2) * kstep; const char* b2 = last ? nB : cB + (size_t)(t + 2) * kstep;
            const char* a3 = a2 + kstep; const char* b3 = b2 + kstep;
            PG8_LDB(B0, 0, 0); PG8_LDB(B1, 0, 1); PG8_SCHED; PG8_LDA(At, 0, 0); PG8_STAGE(PG8_SA(1, 1), a1 + hstep, voffA);
            PG8_WAIT_V(8); PG8_WAIT_L(0); PG8_BAR; PG8_MMA(0, 0, At, B0); PG8_MMA(0, 1, At, B1); PG8_BAR; PG8_SCHED;
            PG8_LDA(At, 0, 1); PG8_STAGE(PG8_SB(0, 0), b2, voffB); PG8_STAGE(PG8_SB(0, 1), b2 + hstep, voffB); PG8_STAGE(PG8_SA(0, 0), a2, voffA);
            PG8_WAIT_V(8); PG8_WAIT_L(0); PG8_BAR; PG8_MMA(1, 0, At, B0); PG8_MMA(1, 1, At, B1); PG8_BAR; PG8_SCHED;
            PG8_LDB(B0, 1, 0); PG8_LDB(B1, 1, 1); PG8_SCHED; PG8_LDA(At, 1, 0); PG8_STAGE(PG8_SA(0, 1), a2 + hstep, voffA);
            PG8_WAIT_V(8); PG8_WAIT_L(0); PG8_BAR; PG8_MMA(0, 0, At, B0); PG8_MMA(0, 1, At, B1); PG8_BAR; PG8_SCHED;
            PG8_LDA(At, 1, 1); PG8_STAGE(PG8_SB(1, 0), b3, voffB); PG8_STAGE(PG8_SB(1, 1), b3 + hstep, voffB); PG8_STAGE(PG8_SA(1, 0), a3, voffA);
            PG8_WAIT_V(8); PG8_WAIT_L(0); PG8_BAR; PG8_MMA(1, 0, At, B0); PG8_MMA(1, 1, At, B1); PG8_BAR; PG8_SCHED;
        }
        if constexpr (ALIGN_EPI) { if (wr == 0) PG8_BAR; }
        bool keep = false;
        if constexpr (Epi::HAS_MID) keep = (cur.seg == 0);
        if (keep) E.mid(acc, cur, wr, wc, fr, fq); else E(acc, cur, wr, wc, fr, fq);
        if (!has_next) break;
        if (!keep) {
#pragma unroll
            for (int a = 0; a < 2; ++a)
#pragma unroll
                for (int b = 0; b < 2; ++b)
#pragma unroll
                    for (int m = 0; m < 4; ++m)
#pragma unroll
                        for (int n = 0; n < 2; ++n) acc[a][b][m][n] = (f32x4){0.f, 0.f, 0.f, 0.f};
        }
        cur = nxt; cA = nA; cB = nB; ++ui;
        if constexpr (ALIGN_EPI) { if (wr == 1) PG8_BAR; }
    }
    PG8_WAIT_V(0);
    if constexpr (!ALIGN_EPI) { if (wr == 0) PG8_BAR; }
    PG8_BAR;
#undef PG8_SA
#undef PG8_SB
#undef PG8_STAGE
#undef PG8_LDA
#undef PG8_LDB
#undef PG8_MMA
#undef PG8_WAIT_V
#undef PG8_WAIT_L
#undef PG8_BAR
#undef PG8_SCHED
}
}

struct Args {
    const float *x, *meta, *mix_g, *w_in, *ret_g, *q_g, *k_g, *sinks, *w_ret, *w_swa, *w_out, *mlp_g, *w_up, *w_down;
    float* out; unsigned char* ws;
};

__device__ __forceinline__ void p0_transpose_item(const float* W, int K, int N, bf16_t* WT, LAS float* scr, int item, int lane, const float* kgain = nullptr) {
    const int nblk = N / 32, kb = item / nblk, nb = item % nblk, k0 = 64 * kb, n0 = 32 * nb;
    float wv[32];
#pragma unroll
    for (int i = 0; i < 32; ++i) wv[i] = W[(size_t)(k0 + 2 * i + (lane >> 5)) * N + n0 + (lane & 31)];
#pragma unroll
    for (int i = 0; i < 32; ++i) { const int kk = 2 * i + (lane >> 5); float v = wv[i]; if (kgain) v *= kgain[k0 + kk]; scr[kk * 33 + (lane & 31)] = v; }
    asm volatile("s_waitcnt lgkmcnt(0)" ::: "memory");
    const int c = lane & 7;
#pragma unroll
    for (int j = 0; j < 4; ++j) { const int n = (lane >> 3) + 8 * j; const LAS float* s = scr + (8 * c) * 33 + n;
        u32x4 o; o.x = cvt_pk_bf16_asm(s[0 * 33], s[1 * 33]); o.y = cvt_pk_bf16_asm(s[2 * 33], s[3 * 33]); o.z = cvt_pk_bf16_asm(s[4 * 33], s[5 * 33]); o.w = cvt_pk_bf16_asm(s[6 * 33], s[7 * 33]);
        *(u32x4*)(WT + (size_t)(n0 + n) * K + k0 + 8 * c) = o; }
    asm volatile("s_waitcnt lgkmcnt(0)" ::: "memory");
}
__device__ __forceinline__ void rms_row_to_bf16(const float* xrow, const float* g, bf16_t* orow, int lane) {
    const f32x4* xr = (const f32x4*)xrow + lane; const f32x4* gr = (const f32x4*)g + lane;
    f32x4 v[4]; float s = 0.f;
#pragma unroll
    for (int j = 0; j < 4; ++j) { v[j] = xr[64 * j]; s += (v[j].x * v[j].x + v[j].y * v[j].y) + (v[j].z * v[j].z + v[j].w * v[j].w); }
    const float rstd = 1.f / sqrtf(wave_sum(s) * (1.f / DM) + EPS);
    u32x2* o8 = (u32x2*)orow + lane;
#pragma unroll
    for (int j = 0; j < 4; ++j) { const f32x4 gg = gr[64 * j]; u32x2 w; w.x = cvt_pk_bf16_asm(v[j].x * rstd * gg.x, v[j].y * rstd * gg.y); w.y = cvt_pk_bf16_asm(v[j].z * rstd * gg.z, v[j].w * rstd * gg.w); o8[64 * j] = w; }
}

__device__ __forceinline__ void tr_write8(LAS unsigned char* base, int RS, int col0, int pp, u32x4 r0, u32x4 r1) {
#define TRW(i, w0, w1) *(LAS unsigned*)(base + ((size_t)(col0 + (i)) * RS + 2 * pp) * 2) = ((i) & 1) ? (((w0) >> 16) | ((w1) & 0xffff0000u)) : (((w0) & 0xffffu) | ((w1) << 16))
    TRW(0, r0.x, r1.x); TRW(1, r0.x, r1.x); TRW(2, r0.y, r1.y); TRW(3, r0.y, r1.y); TRW(4, r0.z, r1.z); TRW(5, r0.z, r1.z); TRW(6, r0.w, r1.w); TRW(7, r0.w, r1.w);
#undef TRW
}

__device__ __forceinline__ int tr_off(int col, int RS, int slot) { return col * RS * 2 + ((slot ^ (2 * ((col >> 3) & 15))) << 3); }
__device__ __forceinline__ void tr_write8s(LAS unsigned char* base, int RS, int col0, int pp, u32x4 r0, u32x4 r1) {
    const int sw2 = 2 * ((col0 >> 3) & 15), po = (((pp >> 1) ^ sw2) << 3) + ((pp & 1) << 2);
#define TRW(i, w0, w1) *(LAS unsigned*)(base + (col0 + (i)) * RS * 2 + po) = ((i) & 1) ? (((w0) >> 16) | ((w1) & 0xffff0000u)) : (((w0) & 0xffffu) | ((w1) << 16))
    TRW(0, r0.x, r1.x); TRW(1, r0.x, r1.x); TRW(2, r0.y, r1.y); TRW(3, r0.y, r1.y); TRW(4, r0.z, r1.z); TRW(5, r0.z, r1.z); TRW(6, r0.w, r1.w); TRW(7, r0.w, r1.w);
#undef TRW
}
__device__ __forceinline__ u32x4 scale8(u32x4 r, float f) {
    u32x4 o; o.x = cvt_pk_bf16(bf_lo(r.x) * f, bf_hi(r.x) * f); o.y = cvt_pk_bf16(bf_lo(r.y) * f, bf_hi(r.y) * f); o.z = cvt_pk_bf16(bf_lo(r.z) * f, bf_hi(r.z) * f); o.w = cvt_pk_bf16(bf_lo(r.w) * f, bf_hi(r.w) * f); return o;
}
__device__ __forceinline__ bf16x8 as_frag(u32x4 v) { return __builtin_bit_cast(bf16x8, v); }
#define MFMA16(a, b, c) __builtin_amdgcn_mfma_f32_16x16x32_bf16((a), (b), (c), 0, 0, 0)

__device__ __forceinline__ long swa_key_row(int b, int c, int kk) {
    if (kk < 16) return (long)NTOK + kk;
    if (kk < 272) { const int s = (c - 1) * 128 + (kk - 16); if (s >= 128) return (long)b * SEQ + s - 128; }
    return -1;
}
__device__ __forceinline__ void swa_phase(LAS unsigned char* lds, const Args& p) {
    int tid_ = threadIdx.x; asm volatile("" : "+v"(tid_));
    const int tid = tid_, lane = tid & 63, w = __builtin_amdgcn_readfirstlane(tid >> 6), r = lane & 15, q = lane >> 4;
    const bf16_t* SQ = (const bf16_t*)(p.ws + OFF_SQ); const bf16_t* SK = (const bf16_t*)(p.ws + OFF_SK); const bf16_t* SV = (const bf16_t*)(p.ws + OFF_SV);
    bf16_t* YSWA = (bf16_t*)((unsigned char*)p.out + DOUT_YSWA);
    constexpr int KS = 72, VS = 296, K_OFF = 0, VT_OFF = 288 * KS * 2;
    constexpr float LOG2E = 1.4426950408889634f;
    const int kch = tid & 7, G = gridDim.x;
    const f32x4 kg0 = *(const f32x4*)(p.k_g + kch * 8), kg1 = *(const f32x4*)(p.k_g + kch * 8 + 4);
    u32x4 kraw[5], vraw[6];
#define SWA_LOAD_UNIT(uu) do { const int b_ = (uu) >> 8, c_ = 1 + (((uu) & 255) >> 2), kvh_ = (uu) & 3; \
        _Pragma("unroll") for (int it = 0; it < 5; ++it) { const int kk = (it * NTHREADS + tid) >> 3; const long row = swa_key_row(b_, c_, kk); \
            kraw[it] = (u32x4){0u, 0u, 0u, 0u}; if (row >= 0) kraw[it] = *(const u32x4*)(SK + (size_t)row * 256 + kvh_ * 64 + kch * 8); } \
        _Pragma("unroll") for (int it = 0; it < 3; ++it) { const int id = it * NTHREADS + tid, ch = id / 144, pp = id % 144; \
            _Pragma("unroll") for (int e = 0; e < 2; ++e) { const long row = (id < 1152) ? swa_key_row(b_, c_, 2 * pp + e) : -1; \
                vraw[2 * it + e] = (u32x4){0u, 0u, 0u, 0u}; if (row >= 0) vraw[2 * it + e] = *(const u32x4*)(SV + (size_t)row * 256 + kvh_ * 64 + ch * 8); } } } while (0)
    int u = blockIdx.x;
    if (u >= 1024) return;
    SWA_LOAD_UNIT(u);
    for (; u < 1024; u += G) {
        const int b = u >> 8, c = 1 + ((u & 255) >> 2), kvh = u & 3;
        __syncthreads();
#pragma unroll
        for (int it = 0; it < 5; ++it) {
            const int kk = (it * NTHREADS + tid) >> 3; const u32x4 raw = kraw[it];
            const float f0 = bf_lo(raw.x), f1 = bf_hi(raw.x), f2 = bf_lo(raw.y), f3 = bf_hi(raw.y), f4 = bf_lo(raw.z), f5 = bf_hi(raw.z), f6 = bf_lo(raw.w), f7 = bf_hi(raw.w);
            float ss = (f0 * f0 + f1 * f1) + (f2 * f2 + f3 * f3) + (f4 * f4 + f5 * f5) + (f6 * f6 + f7 * f7);
            ss += __shfl_xor(ss, 1); ss += __shfl_xor(ss, 2); ss += __shfl_xor(ss, 4);
            const float rstd = __builtin_amdgcn_rsqf(ss * (1.f / 64.f) + EPS);
            u32x4 o; o.x = cvt_pk_bf16(f0 * rstd * kg0.x, f1 * rstd * kg0.y); o.y = cvt_pk_bf16(f2 * rstd * kg0.z, f3 * rstd * kg0.w);
            o.z = cvt_pk_bf16(f4 * rstd * kg1.x, f5 * rstd * kg1.y); o.w = cvt_pk_bf16(f6 * rstd * kg1.z, f7 * rstd * kg1.w);
            if (kk < 288) *(LAS u32x4*)(lds + K_OFF + (kk * KS + kch * 8) * 2) = o;
        }
#pragma unroll
        for (int it = 0; it < 3; ++it) { const int id = it * NTHREADS + tid; if (id < 1152) tr_write8(lds + VT_OFF, VS, (id / 144) * 8, id % 144, vraw[2 * it], vraw[2 * it + 1]); }
        __syncthreads();
        const int qt = w, iq = 16 * qt + r;
        const size_t qrow = (size_t)b * SEQ + (size_t)(c - 1) * 128 + iq;
        u32x4 qa = *(const u32x4*)(SQ + qrow * 1024 + (kvh * 4) * 64 + 8 * q), qb = *(const u32x4*)(SQ + qrow * 1024 + (kvh * 4) * 64 + 32 + 8 * q);
        { const int un = (u + G < 1024) ? u + G : u; SWA_LOAD_UNIT(un); }
#pragma unroll 1
        for (int hl = 0; hl < 4; ++hl) {
            const int h = kvh * 4 + hl;
            bf16x8 Qf[2];
            {
                const u32x4 a = qa, bq = qb;
                const int hn = kvh * 4 + ((hl + 1) & 3);
                qa = *(const u32x4*)(SQ + qrow * 1024 + hn * 64 + 8 * q); qb = *(const u32x4*)(SQ + qrow * 1024 + hn * 64 + 32 + 8 * q);
                float fa[8] = {bf_lo(a.x), bf_hi(a.x), bf_lo(a.y), bf_hi(a.y), bf_lo(a.z), bf_hi(a.z), bf_lo(a.w), bf_hi(a.w)};
                float fb[8] = {bf_lo(bq.x), bf_hi(bq.x), bf_lo(bq.y), bf_hi(bq.y), bf_lo(bq.z), bf_hi(bq.z), bf_lo(bq.w), bf_hi(bq.w)};
                float ss = 0.f;
#pragma unroll
                for (int e = 0; e < 8; ++e) ss += fa[e] * fa[e] + fb[e] * fb[e];
                ss += __shfl_xor(ss, 16); ss += __shfl_xor(ss, 32);
                const float rs = (0.125f * LOG2E) * __builtin_amdgcn_rsqf(ss * (1.f / 64.f) + EPS);
                const f32x4 ga0 = *(const f32x4*)(p.q_g + 8 * q), ga1 = *(const f32x4*)(p.q_g + 8 * q + 4), gb0 = *(const f32x4*)(p.q_g + 32 + 8 * q), gb1 = *(const f32x4*)(p.q_g + 32 + 8 * q + 4);
                u32x4 oa, ob;
                oa.x = cvt_pk_bf16(fa[0] * rs * ga0.x, fa[1] * rs * ga0.y); oa.y = cvt_pk_bf16(fa[2] * rs * ga0.z, fa[3] * rs * ga0.w); oa.z = cvt_pk_bf16(fa[4] * rs * ga1.x, fa[5] * rs * ga1.y); oa.w = cvt_pk_bf16(fa[6] * rs * ga1.z, fa[7] * rs * ga1.w);
                ob.x = cvt_pk_bf16(fb[0] * rs * gb0.x, fb[1] * rs * gb0.y); ob.y = cvt_pk_bf16(fb[2] * rs * gb0.z, fb[3] * rs * gb0.w); ob.z = cvt_pk_bf16(fb[4] * rs * gb1.x, fb[5] * rs * gb1.y); ob.w = cvt_pk_bf16(fb[6] * rs * gb1.z, fb[7] * rs * gb1.w);
                Qf[0] = as_frag(oa); Qf[1] = as_frag(ob);
            }
            const float slope2 = exp2f(-0.5f * (float)(h + 1)) * LOG2E, sink2 = p.sinks[h] * LOG2E;
            const float bbase = -slope2 * (float)(144 + r - 4 * q), mbase = -slope2 * (float)(c * 128 + iq - 112 - 4 * q);
            const float sl1 = slope2, sl2 = 2.f * slope2, sl3 = 3.f * slope2;
            const int d0 = 144 + r - 4 * q;
            f32x4 sc[10]; float mx = -1e30f;
#pragma unroll
            for (int t = 0; t < 10; ++t) {
                const int kt = (t == 0) ? 0 : qt + t;
                f32x4 acc = (f32x4){0.f, 0.f, 0.f, 0.f};
#pragma unroll
                for (int ks = 0; ks < 2; ++ks) { const bf16x8 a = *(const LAS bf16x8*)(lds + K_OFF + ((16 * kt + r) * KS + 32 * ks + 8 * q) * 2); acc = MFMA16(a, Qf[ks], acc); }
                const float tb = (t == 0) ? mbase : bbase + slope2 * (float)(16 * t) + ((c == 1 && kt <= 8) ? -1e30f : 0.f);
                acc[0] += tb; acc[1] += tb + sl1; acc[2] += tb + sl2; acc[3] += tb + sl3;
                if (t == 1) {
#pragma unroll
                    for (int i = 0; i < 4; ++i) if (d0 - 16 - i >= 128) acc[i] = -1e30f;
                }
                if (t == 9) {
#pragma unroll
                    for (int i = 0; i < 4; ++i) if (d0 - 144 - i < 0) acc[i] = -1e30f;
                }
                mx = fmaxf(fmaxf(mx, fmaxf(acc[0], acc[1])), fmaxf(acc[2], acc[3]));
                sc[t] = acc;
                if (t == 4) __builtin_amdgcn_sched_barrier(0);
            }
            mx = fmaxf(mx, __shfl_xor(mx, 16)); mx = fmaxf(mx, __shfl_xor(mx, 32)); mx = fmaxf(mx, sink2);
            float sum = 0.f; u32x2 Pk[10];
#pragma unroll
            for (int t = 0; t < 10; ++t) { const float p0 = __builtin_amdgcn_exp2f(sc[t][0] - mx), p1 = __builtin_amdgcn_exp2f(sc[t][1] - mx), p2 = __builtin_amdgcn_exp2f(sc[t][2] - mx), p3 = __builtin_amdgcn_exp2f(sc[t][3] - mx);
                sum += (p0 + p1) + (p2 + p3); Pk[t].x = cvt_pk_bf16(p0, p1); Pk[t].y = cvt_pk_bf16(p2, p3); }
            sum += __shfl_xor(sum, 16); sum += __shfl_xor(sum, 32);
            const float inv = __builtin_amdgcn_rcpf(sum + __builtin_amdgcn_exp2f(sink2 - mx));
#pragma unroll 1
            for (int dtp = 0; dtp < 2; ++dtp) {
                u32x2 ov[2];
#pragma unroll
                for (int e = 0; e < 2; ++e) {
                    const int dt = 2 * dtp + e;
                    f32x4 acc = (f32x4){0.f, 0.f, 0.f, 0.f};
#pragma unroll
                    for (int pr = 0; pr < 5; ++pr) {
                        const int t0 = 2 * pr, t1 = 2 * pr + 1, kt0 = (t0 == 0) ? 0 : qt + t0, kt1 = qt + t1;
                        const LAS unsigned char* vp = lds + VT_OFF + ((16 * dt + r) * VS + 4 * q) * 2;
                        const u32x2 a0 = *(const LAS u32x2*)(vp + 32 * kt0), a1 = *(const LAS u32x2*)(vp + 32 * kt1);
                        const u32x4 a = (u32x4){a0.x, a0.y, a1.x, a1.y}, bb = (u32x4){Pk[t0].x, Pk[t0].y, Pk[t1].x, Pk[t1].y};
                        acc = MFMA16(as_frag(a), as_frag(bb), acc);
                    }
                    ov[e].x = cvt_pk_bf16(acc[0] * inv, acc[1] * inv); ov[e].y = cvt_pk_bf16(acc[2] * inv, acc[3] * inv);
                }
                const int dw = 32 * dtp + ((q & 1) ? 16 + 4 * (q - 1) : 4 * q);
                const u32x2 ox = __builtin_amdgcn_permlane16_swap(ov[0].x, ov[1].x, false, false), oy = __builtin_amdgcn_permlane16_swap(ov[0].y, ov[1].y, false, false);
                *(u32x4*)(YSWA + qrow * 1024 + h * 64 + dw) = (u32x4){ox.x, oy.x, ox.y, oy.y};
            }
        }
    }
#undef SWA_LOAD_UNIT
}

__device__ __forceinline__ size_t kvs_slot(int b, int n, int h) { return ((size_t)((b * 64 + n) * 4 + h)) * 32768; }
__device__ __forceinline__ void kvlocal_phase(LAS unsigned char* lds, const Args& p) {
    int tid_ = threadIdx.x; asm volatile("" : "+v"(tid_));
    const int tid = tid_, lane = tid & 63, w = __builtin_amdgcn_readfirstlane(tid >> 6), r = lane & 15, q = lane >> 4;
    const bf16_t* RK = (const bf16_t*)(p.ws + OFF_RK); const bf16_t* RV = (const bf16_t*)(p.ws + OFF_RV);
    bf16_t* KVS = (bf16_t*)((unsigned char*)p.out + DOUT_KVS);
    constexpr int RS = 136, KT_OFF = 0, VT_OFF = 128 * RS * 2;
    u32x4 kr[2][2], vr[4][2];
#define KV_LOAD_UNIT(uu) do { const int b_ = (uu) >> 8, n_ = ((uu) & 255) >> 2, h_ = (uu) & 3; \
        _Pragma("unroll") for (int it = 0; it < 2; ++it) { const int id = it * NTHREADS + tid, ch = id & 15, pr = id >> 4; \
            _Pragma("unroll") for (int e = 0; e < 2; ++e) { const int i = 2 * pr + e; long row; \
                if (n_ == 0) row = (i < 112) ? -1 : (long)NTOK + i - 112; else row = (long)b_ * SEQ + (n_ - 1) * 128 + i; \
                kr[it][e] = (u32x4){0u, 0u, 0u, 0u}; if (row >= 0) kr[it][e] = *(const u32x4*)(RK + (size_t)row * 512 + h_ * 128 + ch * 8); } } \
        _Pragma("unroll") for (int it = 0; it < 4; ++it) { const int id = it * NTHREADS + tid, ch = id & 31, pr = id >> 5; \
            _Pragma("unroll") for (int e = 0; e < 2; ++e) { const int i = 2 * pr + e; long row; \
                if (n_ == 0) row = (i < 112) ? -1 : (long)NTOK + i - 112; else row = (long)b_ * SEQ + (n_ - 1) * 128 + i; \
                vr[it][e] = (u32x4){0u, 0u, 0u, 0u}; if (row >= 0) vr[it][e] = *(const u32x4*)(RV + (size_t)row * 1024 + h_ * 256 + ch * 8); } } } while (0)
    int u = blockIdx.x;
    if (u >= 1024) return;
    const int G = gridDim.x;
    KV_LOAD_UNIT(u);
    for (; u < 1024; u += G) {
        const int b = u >> 8, n = (u & 255) >> 2, h = u & 3;
        const float lg2 = log2f(1.0f - exp2f(-5.0f - (float)h));
        __syncthreads();
#pragma unroll
        for (int it = 0; it < 2; ++it) { const int id = it * NTHREADS + tid, ch = id & 15, pr = id >> 4;
            const float f0 = 0.08838834764831845f * __builtin_amdgcn_exp2f(lg2 * (float)(127 - 2 * pr)), f1 = 0.08838834764831845f * __builtin_amdgcn_exp2f(lg2 * (float)(126 - 2 * pr));
            tr_write8s(lds + KT_OFF, RS, ch * 8, pr, scale8(kr[it][0], f0), scale8(kr[it][1], f1)); }
#pragma unroll
        for (int it = 0; it < 4; ++it) { const int id = it * NTHREADS + tid, ch = id & 31, pr = id >> 5;
            tr_write8s(lds + VT_OFF, RS, ch * 8, pr, vr[it][0], vr[it][1]); }
        __syncthreads();
        { const int un = (u + G < 1024) ? u + G : u; KV_LOAD_UNIT(un); }
        const int mt = w;
        bf16x8 a[4];
#pragma unroll
        for (int ks = 0; ks < 4; ++ks) a[ks] = *(const LAS bf16x8*)(lds + KT_OFF + tr_off(16 * mt + r, RS, 8 * ks + 2 * q));
        bf16_t* dst = KVS + kvs_slot(b, n, h);
#pragma unroll 2
        for (int ntp = 0; ntp < 8; ++ntp) {
            u32x2 ov[2];
#pragma unroll
            for (int e = 0; e < 2; ++e) {
                const int nt = 2 * ntp + e;
                f32x4 acc = (f32x4){0.f, 0.f, 0.f, 0.f};
#pragma unroll
                for (int ks = 0; ks < 4; ++ks) { const bf16x8 bb = *(const LAS bf16x8*)(lds + VT_OFF + tr_off(16 * nt + r, RS, 8 * ks + 2 * q)); acc = MFMA16(a[ks], bb, acc); }
                ov[e].x = cvt_pk_bf16(acc[0], acc[1]); ov[e].y = cvt_pk_bf16(acc[2], acc[3]);
            }
            const u32x2 ox = __builtin_amdgcn_permlane16_swap(ov[0].x, ov[1].x, false, false), oy = __builtin_amdgcn_permlane16_swap(ov[0].y, ov[1].y, false, false);
            const int row = 16 * (2 * ntp + (q & 1)) + r, dk0 = 16 * mt + 4 * (q & ~1);
            *(u32x4*)(dst + (size_t)row * 128 + dk0) = (u32x4){ox.x, oy.x, ox.y, oy.y};
        }
    }
#undef KV_LOAD_UNIT
}

__device__ __forceinline__ void scan_phase(const Args& p) {
    bf16_t* KVS = (bf16_t*)((unsigned char*)p.out + DOUT_KVS);
    for (int gid = blockIdx.x * NTHREADS + threadIdx.x; gid < 16 * 8192; gid += gridDim.x * NTHREADS) {
        const int bh = gid >> 13, b = bh >> 2, h = bh & 3, off = (gid & 8191) * 4;
        const float dec = exp2f(128.0f * log2f(1.0f - exp2f(-5.0f - (float)h)));
        float s0 = 0.f, s1 = 0.f, s2 = 0.f, s3 = 0.f;
        bf16_t* base = KVS + kvs_slot(b, 0, h) + off;
        for (int n0 = 0; n0 < 64; n0 += 16) {
            u32x2 v[16];
#pragma unroll
            for (int j = 0; j < 16; ++j) v[j] = *(const u32x2*)(base + (size_t)(n0 + j) * 4 * 32768);
#pragma unroll
            for (int j = 0; j < 16; ++j) {
                s0 = dec * s0 + bf_lo(v[j].x); s1 = dec * s1 + bf_hi(v[j].x); s2 = dec * s2 + bf_lo(v[j].y); s3 = dec * s3 + bf_hi(v[j].y);
                u32x2 o; o.x = cvt_pk_bf16(s0, s1); o.y = cvt_pk_bf16(s2, s3);
                *(u32x2*)(base + (size_t)(n0 + j) * 4 * 32768) = o;
            }
        }
    }
}

__device__ __forceinline__ void retout_phase(LAS unsigned char* lds, const Args& p) {
    int tid_ = threadIdx.x; asm volatile("" : "+v"(tid_));
    const int tid = tid_, lane = tid & 63, w = __builtin_amdgcn_readfirstlane(tid >> 6), r = lane & 15, q = lane >> 4;
    const bf16_t* RQ = (const bf16_t*)(p.ws + OFF_RQ); const bf16_t* RK = (const bf16_t*)(p.ws + OFF_RK); const bf16_t* RV = (const bf16_t*)(p.ws + OFF_RV); const bf16_t* RG = (const bf16_t*)(p.ws + OFF_RG);
    const bf16_t* KVS = (const bf16_t*)((unsigned char*)p.out + DOUT_KVS);
    bf16_t* YRET = (bf16_t*)(p.ws + OFF_YRET);
    constexpr int RS = 136, K_OFF = 0, SB = 128 * RS * 2, QSZ = 64 * RS * 2;
    const int G = gridDim.x, vch = tid & 7, vpr = tid >> 3, srow = tid >> 4, sch = tid & 15;
    const LAS unsigned char* vlb = lds + SB + r * RS * 2 + ((q ^ (2 * (r >> 3))) << 3);
    u32x4 kreg[4], vreg[2], sreg[2], qn[4];
#define RO_LOAD_KQ(uu) do { const int b_ = (uu) >> 8, c_ = 1 + (((uu) & 255) >> 2), h_ = (uu) & 3; const size_t tb_ = (size_t)b_ * SEQ + (size_t)(c_ - 1) * 128; \
        _Pragma("unroll") for (int it = 0; it < 4; ++it) kreg[it] = *(const u32x4*)(RK + (tb_ + 32 * it + srow) * 512 + h_ * 128 + sch * 8); } while (0)
#define RO_LOAD_Q(uu) do { const int b_ = (uu) >> 8, c_ = 1 + (((uu) & 255) >> 2), h_ = (uu) & 3; const size_t tb_ = (size_t)b_ * SEQ + (size_t)(c_ - 1) * 128; \
        _Pragma("unroll") for (int ks = 0; ks < 4; ++ks) qn[ks] = *(const u32x4*)(RQ + (tb_ + 16 * w + r) * 512 + h_ * 128 + 32 * ks + 8 * q); } while (0)
#define RO_LOAD_STAGE(uu, sg) do { const int b_ = (uu) >> 8, c_ = 1 + (((uu) & 255) >> 2), h_ = (uu) & 3; const size_t tb_ = (size_t)b_ * SEQ + (size_t)(c_ - 1) * 128; \
        const bf16_t* st_ = KVS + kvs_slot(b_, c_ - 1, h_) + (size_t)(64 * (sg)) * 128; \
        vreg[0] = *(const u32x4*)(RV + (tb_ + 2 * vpr) * 1024 + h_ * 256 + 64 * (sg) + vch * 8); vreg[1] = *(const u32x4*)(RV + (tb_ + 2 * vpr + 1) * 1024 + h_ * 256 + 64 * (sg) + vch * 8); \
        sreg[0] = *(const u32x4*)(st_ + (size_t)srow * 128 + sch * 8); sreg[1] = *(const u32x4*)(st_ + (size_t)(32 + srow) * 128 + sch * 8); } while (0)
#define RO_WRITE_K() do { _Pragma("unroll") for (int it = 0; it < 4; ++it) *(LAS u32x4*)(lds + K_OFF + ((32 * it + srow) * RS + sch * 8) * 2) = kreg[it]; } while (0)
#define RO_WRITE_STAGE(j) do { tr_write8s(lds + SB + 2 * (j) * QSZ, RS, vch * 8, vpr, vreg[0], vreg[1]); \
        *(LAS u32x4*)(lds + SB + (2 * (j) + 1) * QSZ + (srow * RS + sch * 8) * 2) = sreg[0]; *(LAS u32x4*)(lds + SB + (2 * (j) + 1) * QSZ + ((32 + srow) * RS + sch * 8) * 2) = sreg[1]; } while (0)
    int u = blockIdx.x;
    if (u >= 1024) return;
    RO_LOAD_KQ(u); RO_LOAD_Q(u); RO_LOAD_STAGE(u, 0);
    __syncthreads();
    RO_WRITE_K(); RO_WRITE_STAGE(0);
    __syncthreads();
    for (; u < 1024; u += G) {
        const int b = u >> 8, c = 1 + ((u & 255) >> 2), h = u & 3, un = (u + G < 1024) ? u + G : u;
        const size_t tokbase = (size_t)b * SEQ + (size_t)(c - 1) * 128;
        const float lg2 = log2f(1.0f - exp2f(-5.0f - (float)h));
        const int iq = 16 * w + r; const size_t qrow = tokbase + iq;
        bf16x8 Qd[4]; u32x2 Pk[8]; f32x4 o[16];
        {
#pragma unroll
            for (int kt = 0; kt < 8; ++kt) {
                {
                    f32x4 acc = (f32x4){0.f, 0.f, 0.f, 0.f};
#pragma unroll
                    for (int ks = 0; ks < 4; ++ks) { const bf16x8 a = *(const LAS bf16x8*)(lds + K_OFF + ((16 * kt + r) * RS + 32 * ks + 8 * q) * 2); acc = MFMA16(a, as_frag(qn[ks]), acc); }
#pragma unroll
                    for (int i = 0; i < 4; ++i) { const int d = iq - (16 * kt + 4 * q + i); acc[i] = (d >= 0) ? acc[i] * 0.08838834764831845f * __builtin_amdgcn_exp2f(lg2 * (float)d) : 0.f; }
                    Pk[kt].x = cvt_pk_bf16(acc[0], acc[1]); Pk[kt].y = cvt_pk_bf16(acc[2], acc[3]);
                }
                if (kt & 1) __builtin_amdgcn_sched_barrier(0);
            }
            const float qdec = __builtin_amdgcn_exp2f(lg2 * (float)(iq + 1));
#pragma unroll
            for (int ks = 0; ks < 4; ++ks) Qd[ks] = as_frag(scale8(qn[ks], qdec));
        }
#pragma unroll
        for (int sg = 0; sg < 4; ++sg) {
            if (sg < 3) RO_LOAD_STAGE(u, sg + 1); else { RO_LOAD_KQ(un); RO_LOAD_STAGE(un, 0); }
            const int bo = 2 * (sg & 1) * QSZ;
#pragma unroll
            for (int j = 0; j < 4; ++j) {
                f32x4 acc = (f32x4){0.f, 0.f, 0.f, 0.f};
#pragma unroll
                for (int ks = 0; ks < 4; ++ks) { const bf16x8 a = *(const LAS bf16x8*)(lds + SB + bo + QSZ + ((16 * j + r) * RS + 32 * ks + 8 * q) * 2); acc = MFMA16(a, Qd[ks], acc); }
#pragma unroll
                for (int kp = 0; kp < 4; ++kp) {
                    {
                        const u32x2 a0 = *(const LAS u32x2*)(vlb + bo + 16 * j * RS * 2 + ((((kp ^ (j >> 1)) << 3) | ((0 ^ (j & 1)) << 2)) << 3));
                        const u32x2 a1 = *(const LAS u32x2*)(vlb + bo + 16 * j * RS * 2 + ((((kp ^ (j >> 1)) << 3) | ((1 ^ (j & 1)) << 2)) << 3));
                        const u32x4 a = (u32x4){a0.x, a0.y, a1.x, a1.y}, bb = (u32x4){Pk[2 * kp].x, Pk[2 * kp].y, Pk[2 * kp + 1].x, Pk[2 * kp + 1].y};
                        acc = MFMA16(as_frag(a), as_frag(bb), acc);
                    }
                }
                o[sg * 4 + j] = acc;
                if (j & 1) __builtin_amdgcn_sched_barrier(0);
            }
            if (sg == 3) RO_WRITE_K();
            RO_WRITE_STAGE((sg + 1) & 1);
            __syncthreads();
        }
        RO_LOAD_Q(un);
        float ss = 0.f;
#pragma unroll
        for (int t = 0; t < 16; ++t) ss += (o[t][0] * o[t][0] + o[t][1] * o[t][1]) + (o[t][2] * o[t][2] + o[t][3] * o[t][3]);
        ss += __shfl_xor(ss, 16); ss += __shfl_xor(ss, 32);
        const float rstd = 1.f / sqrtf(ss * (1.f / 256.f) + EPS);
        const int qodd = q & 1;
#pragma unroll
        for (int tp = 0; tp < 8; ++tp) {
            const int t0 = 2 * tp, t1 = 2 * tp + 1;
            const int dvw = 32 * tp + (qodd ? 16 + 4 * (q - 1) : 4 * q);
            const u32x4 gw = *(const u32x4*)(RG + qrow * 1024 + h * 256 + dvw);
            const u32x2 sx = __builtin_amdgcn_permlane16_swap(gw.x, gw.z, false, false), sy = __builtin_amdgcn_permlane16_swap(gw.y, gw.w, false, false);
            const f32x4 g0 = *(const f32x4*)(p.ret_g + h * 256 + 16 * t0 + 4 * q), g1 = *(const f32x4*)(p.ret_g + h * 256 + 16 * t1 + 4 * q);
            u32x2 ov0, ov1;
            { const float x0 = bf_lo(sx.x), x1 = bf_hi(sx.x), x2 = bf_lo(sy.x), x3 = bf_hi(sy.x);
              ov0.x = cvt_pk_bf16(o[t0][0] * rstd * g0.x * x0 * sigmoidf_(x0), o[t0][1] * rstd * g0.y * x1 * sigmoidf_(x1));
              ov0.y = cvt_pk_bf16(o[t0][2] * rstd * g0.z * x2 * sigmoidf_(x2), o[t0][3] * rstd * g0.w * x3 * sigmoidf_(x3)); }
            { const float x0 = bf_lo(sx.y), x1 = bf_hi(sx.y), x2 = bf_lo(sy.y), x3 = bf_hi(sy.y);
              ov1.x = cvt_pk_bf16(o[t1][0] * rstd * g1.x * x0 * sigmoidf_(x0), o[t1][1] * rstd * g1.y * x1 * sigmoidf_(x1));
              ov1.y = cvt_pk_bf16(o[t1][2] * rstd * g1.z * x2 * sigmoidf_(x2), o[t1][3] * rstd * g1.w * x3 * sigmoidf_(x3)); }
            const u32x2 ox = __builtin_amdgcn_permlane16_swap(ov0.x, ov1.x, false, false), oy = __builtin_amdgcn_permlane16_swap(ov0.y, ov1.y, false, false);
            *(u32x4*)(YRET + qrow * 1024 + h * 256 + dvw) = (u32x4){ox.x, oy.x, ox.y, oy.y};
        }
    }
#undef RO_LOAD_KQ
#undef RO_LOAD_Q
#undef RO_LOAD_STAGE
#undef RO_WRITE_K
#undef RO_WRITE_STAGE
}

__device__ __forceinline__ void meta_proj(const Args& p, const bf16_t* XN, const bf16_t* WinT) {
    int tid_ = threadIdx.x; asm volatile("" : "+v"(tid_));
    const int tid = tid_, lane = tid & 63, r = lane & 15, q = lane >> 4;
    if ((tid >> 6) != 0) return;
    for (int t = blockIdx.x; t < 128; t += gridDim.x) {
        int ncol, ld, cl; size_t boff;
        if (t < 32) { ncol = 512 + 16 * t; boff = OFF_RK; ld = 512; cl = 16 * t; }
        else if (t < 96) { ncol = 1024 + 16 * (t - 32); boff = OFF_RV; ld = 1024; cl = 16 * (t - 32); }
        else if (t < 112) { ncol = 4096 + 16 * (t - 96); boff = OFF_SK; ld = 256; cl = 16 * (t - 96); }
        else { ncol = 4352 + 16 * (t - 112); boff = OFF_SV; ld = 256; cl = 16 * (t - 112); }
        const bf16_t* ap = WinT + (size_t)(ncol + r) * DM + 8 * q; const bf16_t* bp = XN + (size_t)(NTOK + r) * DM + 8 * q;
        f32x4 acc = (f32x4){0.f, 0.f, 0.f, 0.f};
#pragma unroll 8
        for (int ks = 0; ks < 32; ++ks) { const u32x4 a = *(const u32x4*)(ap + 32 * ks), b = *(const u32x4*)(bp + 32 * ks); acc = MFMA16(as_frag(a), as_frag(b), acc); }
        u32x2 o; o.x = cvt_pk_bf16(acc[0], acc[1]); o.y = cvt_pk_bf16(acc[2], acc[3]);
        *(u32x2*)((bf16_t*)(p.ws + boff) + (size_t)(NTOK + r) * ld + cl + 4 * q) = o;
    }
}

#define XB_TMO      128
#define XB_XCNT(j)  (256  + 64 * (j))
#define XB_XSUB(j)  (1280 + 64 * (j))
#define XB_XGEN(j)  (2304 + 64 * (j))
#define XB_TOP      3328
#define XB_TOPGEN   3392
#define XCD_BAR_WORDS 3456
#define XB_SPIN_CAP (1u << 22)
__device__ __forceinline__ unsigned xb_ld(unsigned* p)              { return __hip_atomic_load(p, __ATOMIC_RELAXED, __HIP_MEMORY_SCOPE_AGENT); }
__device__ __forceinline__ unsigned xb_add(unsigned* p, unsigned v) { return __hip_atomic_fetch_add(p, v, __ATOMIC_RELAXED, __HIP_MEMORY_SCOPE_AGENT); }
__device__ __forceinline__ unsigned xb_xcc_id() { return (unsigned)__builtin_amdgcn_s_getreg((3 << 11) | 20) & 0xFu; }
#define XB_SPIN(cond, bar) do { unsigned _sp = 0; while (cond) { __builtin_amdgcn_s_sleep(1); \
    if ((++_sp & 255u) == 0u) { if (xb_ld(&(bar)[XB_TMO])) break; if (_sp > XB_SPIN_CAP) { atomicAdd(&(bar)[XB_TMO], 1u); break; } } } } while (0)
struct XcdBarrier { unsigned* bar; unsigned x; volatile LAS unsigned* st; };
__device__ __forceinline__ XcdBarrier xcd_barrier_post(unsigned* bar, volatile LAS unsigned* st) {
    XcdBarrier b; b.bar = bar; b.x = xb_xcc_id(); b.st = st;
    if (threadIdx.x == 0) (void)xb_add(&bar[XB_XCNT(b.x)], 1u);
    return b;
}
__device__ __forceinline__ void xcd_barrier_complete(unsigned* bar, unsigned x, unsigned& nloc, unsigned& nx) {
    const unsigned G = gridDim.x * gridDim.y * gridDim.z;
    unsigned sum, cnt, mine, sp = 0u;
    for (;;) {
        sum = 0u; cnt = 0u; mine = 0u;
#pragma unroll
        for (unsigned j = 0; j < 16; ++j) { const unsigned c = xb_ld(&bar[XB_XCNT(j)]); sum += c; cnt += (c > 0u) ? 1u : 0u; mine = (j == x) ? c : mine; }
        if (sum == G) break;
        __builtin_amdgcn_s_sleep(1);
        if ((++sp & 255u) == 0u) { if (xb_ld(&bar[XB_TMO])) break; if (sp > XB_SPIN_CAP) { atomicAdd(&bar[XB_TMO], 1u); break; } }
    }
    nloc = mine > 0u ? mine : 1u; nx = cnt > 0u ? cnt : 1u;
}
__device__ __forceinline__ void xcd_barrier(const XcdBarrier& b) {
    asm volatile("s_waitcnt vmcnt(0)" ::: "memory");
    __syncthreads();
    if (threadIdx.x == 0) {
        unsigned* bar = b.bar;
        __builtin_amdgcn_s_waitcnt(0);
        unsigned nloc = b.st[0], nx = b.st[1];
        if (nloc == 0u) { xcd_barrier_complete(bar, b.x, nloc, nx); b.st[0] = nloc; b.st[1] = nx; }
        const unsigned old = xb_add(&bar[XB_XSUB(b.x)], 1u);
        const unsigned gen = old / nloc;
        if (old + 1u == (gen + 1u) * nloc) {
            __builtin_amdgcn_fence(__ATOMIC_RELEASE, "agent");
            asm volatile("s_waitcnt vmcnt(0)" ::: "memory");
            const unsigned og = xb_add(&bar[XB_TOP], 1u);
            const unsigned tg = og / nx;
            if (og + 1u == (tg + 1u) * nx) xb_add(&bar[XB_TOPGEN], 1u);
            else XB_SPIN(xb_ld(&bar[XB_TOPGEN]) == tg, bar);
            __builtin_amdgcn_fence(__ATOMIC_ACQUIRE, "agent");
            xb_add(&bar[XB_XGEN(b.x)], 1u);
            asm volatile("s_waitcnt vmcnt(0)" ::: "memory");
        } else {
            XB_SPIN(xb_ld(&bar[XB_XGEN(b.x)]) == gen, bar);
            __builtin_amdgcn_fence(__ATOMIC_ACQUIRE, "agent");
            asm volatile("s_waitcnt vmcnt(0)" ::: "memory");
        }
    }
    __syncthreads();
}

__device__ __forceinline__ void convert_slot(const Args& p, LAS unsigned char* lds, const int list) {
    const unsigned grp = (blockIdx.x >> 3) & 3u;
    if (grp == 0u) return;
    int tid_ = threadIdx.x; asm volatile("" : "+v"(tid_));
    const int tid = tid_, lane = tid & 63, wave = __builtin_amdgcn_readfirstlane(tid >> 6);
    constexpr int I_SQ = (DM / 64) * (DM / 32), I_UP = (DM / 64) * (FF / 32), I_DN = (FF / 64) * (DM / 32);
    const int total = list == 0 ? 3 * I_SQ + I_UP : I_DN;
    const int lo = grp == 1u ? 0 : (grp == 2u ? total / 6 : total / 2), hi = grp == 1u ? total / 6 : (grp == 2u ? total / 2 : total);
    const int j = (int)(((blockIdx.x >> 5) << 3) | (blockIdx.x & 7u));
    LAS float* scr = (LAS float*)(lds + wave * 16384);
    unsigned char* ws = p.ws;
    for (int it = lo + j * 8 + wave; it < hi; it += 512) {
        if (list == 0) {
            int r = it;
            if (r < I_SQ) { p0_transpose_item(p.w_ret, DM, DM, (bf16_t*)(ws + OFF_WRET), scr, r, lane); continue; } r -= I_SQ;
            if (r < I_SQ) { p0_transpose_item(p.w_swa, DM, DM, (bf16_t*)(ws + OFF_WSWA), scr, r, lane); continue; } r -= I_SQ;
            if (r < I_SQ) { p0_transpose_item(p.w_out, DM, DM, (bf16_t*)(ws + OFF_WOUT), scr, r, lane); continue; } r -= I_SQ;
            p0_transpose_item(p.w_up, DM, FF, (bf16_t*)(ws + OFF_WUP), scr, r, lane, p.mlp_g);
        } else p0_transpose_item(p.w_down, FF, DM, (bf16_t*)(ws + OFF_WDN), scr, it, lane);
    }
    __syncthreads();
}

__global__ void __launch_bounds__(NTHREADS, 2) fwd_megakernel(Args p) {
    extern __shared__ __attribute__((aligned(16))) unsigned char lds_raw[];
    LAS unsigned char* lds = (LAS unsigned char*)lds_raw;
    cg::grid_group grid = cg::this_grid();
    ((LAS unsigned*)(lds + 131072 + 64))[threadIdx.x & 15] = 0u;
    __syncthreads();
    XcdBarrier xbar = xcd_barrier_post((unsigned*)(p.ws + OFF_CTL), (volatile LAS unsigned*)(lds + 131072 + 64));
    grid.sync();
#define GRID_SYNC() xcd_barrier(xbar)
    const int tid = threadIdx.x, lane = tid & 63, wave = __builtin_amdgcn_readfirstlane(tid >> 6);
    const int G = gridDim.x, gw = blockIdx.x * 8 + wave, NGW = G * 8;
    unsigned char* ws = p.ws;
    bf16_t* WinT = (bf16_t*)(ws + OFF_WIN); bf16_t* WretT = (bf16_t*)(ws + OFF_WRET); bf16_t* WswaT = (bf16_t*)(ws + OFF_WSWA); bf16_t* WoutT = (bf16_t*)(ws + OFF_WOUT);
    bf16_t* WupT = (bf16_t*)(ws + OFF_WUP); bf16_t* WdnT = (bf16_t*)(ws + OFF_WDN);
    bf16_t* XN = (bf16_t*)p.out;

    for (int rep = 0; rep < 1 + ((REP_MASK >> 0) & 1); ++rep) {
        LAS float* scr = (LAS float*)(lds + wave * 16384);
        constexpr int I_IN = (DM / 64) * (DIN / 32), I_SQ = (DM / 64) * (DM / 32), I_UP = (DM / 64) * (FF / 32), I_DN = (FF / 64) * (DM / 32);
        constexpr int NITEMS = I_IN + 3 * I_SQ + I_UP + I_DN;
        const bool split = (G == 256);
        for (int it = gw; it < (split ? I_IN : NITEMS); it += NGW) {
            int r = it;
            if (r < I_IN) { p0_transpose_item(p.w_in, DM, DIN, WinT, scr, r, lane); continue; } r -= I_IN;
            if (r < I_SQ) { p0_transpose_item(p.w_ret, DM, DM, WretT, scr, r, lane); continue; } r -= I_SQ;
            if (r < I_SQ) { p0_transpose_item(p.w_swa, DM, DM, WswaT, scr, r, lane); continue; } r -= I_SQ;
            if (r < I_SQ) { p0_transpose_item(p.w_out, DM, DM, WoutT, scr, r, lane); continue; } r -= I_SQ;
            if (r < I_UP) { p0_transpose_item(p.w_up, DM, FF, WupT, scr, r, lane, p.mlp_g); continue; } r -= I_UP;
            p0_transpose_item(p.w_down, FF, DM, WdnT, scr, r, lane);
        }
        for (int m = gw; m < NTOK; m += 2 * NGW) {
            const int m2 = m + NGW;
            const f32x4* xa = (const f32x4*)(p.x + (size_t)m * DM) + lane; const f32x4* xb = (const f32x4*)(p.x + (size_t)(m2 < NTOK ? m2 : m) * DM) + lane; const f32x4* gr = (const f32x4*)p.mix_g + lane;
            f32x4 va[4], vb[4]; float sa = 0.f, sb = 0.f;
#pragma unroll
            for (int j = 0; j < 4; ++j) { va[j] = xa[64 * j]; vb[j] = xb[64 * j]; }
#pragma unroll
            for (int j = 0; j < 4; ++j) { sa += (va[j].x * va[j].x + va[j].y * va[j].y) + (va[j].z * va[j].z + va[j].w * va[j].w); sb += (vb[j].x * vb[j].x + vb[j].y * vb[j].y) + (vb[j].z * vb[j].z + vb[j].w * vb[j].w); }
            const float ra = 1.f / sqrtf(wave_sum(sa) * (1.f / DM) + EPS), rb = 1.f / sqrtf(wave_sum(sb) * (1.f / DM) + EPS);
            u32x2* oa = (u32x2*)(XN + (size_t)m * DM) + lane; u32x2* ob = (u32x2*)(XN + (size_t)m2 * DM) + lane;
#pragma unroll
            for (int j = 0; j < 4; ++j) { const f32x4 gg = gr[64 * j];
                u32x2 wa; wa.x = cvt_pk_bf16_asm(va[j].x * ra * gg.x, va[j].y * ra * gg.y); wa.y = cvt_pk_bf16_asm(va[j].z * ra * gg.z, va[j].w * ra * gg.w); oa[64 * j] = wa;
                if (m2 < NTOK) { u32x2 wb; wb.x = cvt_pk_bf16_asm(vb[j].x * rb * gg.x, vb[j].y * rb * gg.y); wb.y = cvt_pk_bf16_asm(vb[j].z * rb * gg.z, vb[j].w * rb * gg.w); ob[64 * j] = wb; } }
        }
        if (gw < NMETA) rms_row_to_bf16(p.meta + (size_t)gw * DM, p.mix_g, XN + (size_t)(NTOK + gw) * DM, lane);
    }
    GRID_SYNC();
    {
        meta_proj(p, XN, WinT);
        if (G == 256) convert_slot(p, lds, 0);
        pg8::Gemm g{XN, WinT, XN, WinT, NTOK, DIN, DM}; pg8::StaticOrder S; S.init(NTOK, DIN, G, (int)blockIdx.x);
        pg8::EpiProj E{ws};
        pg8::gemm_phase<pg8::EpiProj, pg8::StaticOrder, true>(lds, g, S, E);
    }
    GRID_SYNC();
    for (int rep = 0; rep < 1 + ((REP_MASK >> 1) & 1); ++rep) { swa_phase(lds, p); kvlocal_phase(lds, p); }
    GRID_SYNC();
    scan_phase(p);
    GRID_SYNC();
    for (int rep = 0; rep < 1 + ((REP_MASK >> 2) & 1); ++rep) retout_phase(lds, p);
    GRID_SYNC();
    {
        const bf16_t* YRET = (const bf16_t*)(ws + OFF_YRET); const bf16_t* YSWA = (const bf16_t*)((unsigned char*)p.out + DOUT_YSWA);
        pg8::Gemm g{YRET, WretT, YSWA, WswaT, NTOK, DM, DM}; pg8::PairOrder S; S.s.init(NTOK, DM, G, (int)blockIdx.x);
        pg8::EpiMerged E{(const unsigned char*)(ws + OFF_GR), (const unsigned char*)(ws + OFF_GS), (bf16_t*)(ws + OFF_MERGED)};
        pg8::gemm_phase<pg8::EpiMerged, pg8::PairOrder, true>(lds, g, S, E);
    }
    GRID_SYNC();
    {
        const bf16_t* MG = (const bf16_t*)(ws + OFF_MERGED);
        pg8::Gemm g{MG, WoutT, MG, WoutT, NTOK, DM, DM}; pg8::StaticOrder S; S.init(NTOK, DM, G, (int)blockIdx.x);
        pg8::EpiResStat E{p.x, p.out, (bf16_t*)(ws + OFF_HN2), (float*)(ws + OFF_SS)};
        pg8::gemm_phase<pg8::EpiResStat, pg8::StaticOrder, true>(lds, g, S, E);
    }
    GRID_SYNC();
    {
        const bf16_t* HN2 = (const bf16_t*)(ws + OFF_HN2);
        pg8::Gemm g{HN2, WupT, HN2, WupT, NTOK, FF, DM}; pg8::StaticOrder S; S.init(NTOK, FF, G, (int)blockIdx.x);
        pg8::EpiUp E{(bf16_t*)(ws + OFF_U), (const float*)(ws + OFF_SS)};
        if (G == 256) convert_slot(p, lds, 1);
        pg8::gemm_phase<pg8::EpiUp, pg8::StaticOrder, true>(lds, g, S, E);
    }
    GRID_SYNC();
    {
        const bf16_t* U = (const bf16_t*)(ws + OFF_U);
        pg8::Gemm g{U, WdnT, U, WdnT, NTOK, DM, FF}; pg8::StaticOrder S; S.init(NTOK, DM, G, (int)blockIdx.x);
        pg8::EpiResBf E{(const bf16_t*)(ws + OFF_HN2), p.out};
        pg8::gemm_phase<pg8::EpiResBf, pg8::StaticOrder, true>(lds, g, S, E);
    }
}

extern "C" void kernel_launch(void* const* d_in, const int* in_sizes, int n_in, void* d_out, int out_size, void* d_ws, size_t ws_size, hipStream_t stream) {
    static int grid = 0;
    if (grid == 0) {
        if (n_in != 14 || in_sizes[0] != NTOK * DM || out_size != NTOK * DM || ws_size < WS_NEED) {
            fprintf(stderr, "kernel_launch: unexpected shapes (n_in %d, in0 %d, out %d, ws %zu, need %zu); nothing launched\n", n_in, n_in > 0 ? in_sizes[0] : -1, out_size, ws_size, (size_t)WS_NEED); grid = -1; return; }
        int dev = 0, cus = 0, per_cu = 0;
        (void)hipGetDevice(&dev); (void)hipDeviceGetAttribute(&cus, hipDeviceAttributeMultiprocessorCount, dev);
        if (hipFuncSetAttribute((const void*)fwd_megakernel, hipFuncAttributeMaxDynamicSharedMemorySize, LDS_BYTES) != hipSuccess) { fprintf(stderr, "kernel_launch: hipFuncSetAttribute failed\n"); grid = -1; return; }
        if (hipOccupancyMaxActiveBlocksPerMultiprocessor(&per_cu, (const void*)fwd_megakernel, NTHREADS, LDS_BYTES) != hipSuccess || per_cu < 1) { fprintf(stderr, "kernel_launch: occupancy query gave %d\n", per_cu); per_cu = 1; }
        (void)hipGetLastError();
        grid = cus * per_cu;
    }
    if (grid < 0) return;
    Args a{};
    a.x = (const float*)d_in[0]; a.meta = (const float*)d_in[1]; a.mix_g = (const float*)d_in[2]; a.w_in = (const float*)d_in[3]; a.ret_g = (const float*)d_in[4];
    a.q_g = (const float*)d_in[5]; a.k_g = (const float*)d_in[6]; a.sinks = (const float*)d_in[7]; a.w_ret = (const float*)d_in[8]; a.w_swa = (const float*)d_in[9];
    a.w_out = (const float*)d_in[10]; a.mlp_g = (const float*)d_in[11]; a.w_up = (const float*)d_in[12]; a.w_down = (const float*)d_in[13];
    a.out = (float*)d_out; a.ws = (unsigned char*)d_ws;
    if (hipMemsetAsync((unsigned char*)d_ws + OFF_CTL, 0, CTL_BYTES, stream) != hipSuccess) { fprintf(stderr, "kernel_launch: memset failed\n"); return; }
    void* args[] = {&a};
    hipError_t e = hipLaunchCooperativeKernel((const void*)fwd_megakernel, dim3(grid), dim3(NTHREADS), args, LDS_BYTES, stream);
    if (e != hipSuccess) fprintf(stderr, "kernel_launch: cooperative launch failed: %s (grid %d)\n", hipGetErrorString(e), grid);
}
```

```cpp
#ifndef REP_MASK
#define REP_MASK 0
#endif
#include <hip/hip_runtime.h>
#include <hip/hip_cooperative_groups.h>
#include <cstdio>
#include <cstdint>
namespace cg = cooperative_groups;

#define LAS __attribute__((address_space(3)))
typedef unsigned short bf16_t;
typedef short bf16x8 __attribute__((ext_vector_type(8)));
typedef float f32x4 __attribute__((ext_vector_type(4)));
typedef unsigned u32x4 __attribute__((ext_vector_type(4)));
typedef unsigned u32x2 __attribute__((ext_vector_type(2)));

constexpr int NB = 4, SEQ = 8192, DM = 1024, NTOK = NB * SEQ, NMETA = 16, MROWS = NTOK + NMETA, MPAD = 33024, DIN = 6656, FF = 4096;
constexpr float EPS = 1e-6f;
constexpr int NTHREADS = 512;
constexpr int LDS_BYTES = 135168;

constexpr size_t SZ_WIN = (size_t)DIN * DM * 2, SZ_WSQ = (size_t)DM * DM * 2, SZ_WFF = (size_t)FF * DM * 2;
constexpr size_t OFF_WIN = 0, OFF_WRET = OFF_WIN + SZ_WIN, OFF_WSWA = OFF_WRET + SZ_WSQ, OFF_WOUT = OFF_WSWA + SZ_WSQ, OFF_WUP = OFF_WOUT + SZ_WSQ, OFF_WDN = OFF_WUP + SZ_WFF;
constexpr size_t OFF_RQ = OFF_WDN + SZ_WFF;
constexpr size_t OFF_RK = OFF_RQ + (size_t)MROWS * 512 * 2;
constexpr size_t OFF_RV = OFF_RK + (size_t)MROWS * 512 * 2;
constexpr size_t OFF_RG = OFF_RV + (size_t)MROWS * 1024 * 2;
constexpr size_t OFF_SQ = OFF_RG + (size_t)MROWS * 1024 * 2;
constexpr size_t OFF_SK = OFF_SQ + (size_t)MROWS * 1024 * 2;
constexpr size_t OFF_SV = OFF_SK + (size_t)MROWS * 256 * 2;
constexpr size_t OFF_GR = OFF_SV + (size_t)MROWS * 256 * 2;
constexpr size_t OFF_GS = OFF_GR + (size_t)MROWS * 1024 * 2;
constexpr size_t OFF_CTL = OFF_GS + (size_t)MROWS * 1024 * 2;
constexpr size_t CTL_BYTES = 16384 + (size_t)NTOK * 4;
constexpr size_t OFF_SS = OFF_CTL + 16384;
constexpr size_t WS_NEED = OFF_CTL + CTL_BYTES;
constexpr size_t OFF_MERGED = OFF_RQ, OFF_HN2 = OFF_RV, OFF_YRET = OFF_SQ, OFF_U = OFF_RG;
static_assert(OFF_RK - OFF_RQ + OFF_RV - OFF_RK >= (size_t)NTOK * 1024 * 2, "MERGED fits");
static_assert(OFF_CTL - OFF_RG >= (size_t)NTOK * FF * 2, "U fits");
static_assert((size_t)MPAD * DM * 2 <= (size_t)NTOK * DM * 4, "XN fits d_out");
constexpr size_t DOUT_KVS = 0, DOUT_YSWA = (size_t)NTOK * 1024 * 2;

typedef __bf16 bf16x2_t __attribute__((ext_vector_type(2)));
typedef float f32x2_t __attribute__((ext_vector_type(2)));
__device__ __forceinline__ unsigned cvt_pk_bf16(float lo, float hi) { const f32x2_t v = {lo, hi}; const bf16x2_t b = __builtin_convertvector(v, bf16x2_t); return __builtin_bit_cast(unsigned, b); }
__device__ __forceinline__ unsigned cvt_pk_bf16_asm(float lo, float hi) { unsigned r; asm volatile("v_cvt_pk_bf16_f32 %0, %1, %2" : "=v"(r) : "v"(lo), "v"(hi)); return r; }
__device__ __forceinline__ float bf_lo(unsigned w) { return __uint_as_float(w << 16); }
__device__ __forceinline__ float bf_hi(unsigned w) { return __uint_as_float(w & 0xffff0000u); }
__device__ __forceinline__ float wave_sum(float v) {
#pragma unroll
    for (int o = 1; o < 64; o <<= 1) v += __shfl_xor(v, o);
    return v;
}
__device__ __forceinline__ float sigmoidf_(float x) { return __builtin_amdgcn_rcpf(1.0f + __builtin_amdgcn_exp2f(-1.4426950408889634f * x)); }

namespace pg8 {
constexpr int BM = 256, BK = 64, HALF = 128, HTB = HALF * BK * 2, STAGE_BYTES = 8 * HTB, NXCD = 8, WGM = 8;
__host__ __device__ __forceinline__ int lds_byte(int r, int c) { const int st = (r >> 4) * 2 + (c >> 5), rr = r & 15, cc = c & 31, ob = rr * 64 + cc * 2; return st * 1024 + (ob ^ (((ob >> 9) & 1) << 5)); }
__host__ __device__ __forceinline__ void stage_rc(int b, int& R, int& C) { const int st = b / 1024, sb = b % 1024, swz = sb ^ (((sb >> 9) & 1) << 5); R = (st >> 1) * 16 + swz / 64; C = (st & 1) * 32 + (swz % 64) / 2; }
__host__ __device__ __forceinline__ int perm32(int rho) { const int n = rho >> 4, i = rho & 15; return 8 * (i >> 2) + 4 * n + (i & 3); }

struct Unit { int pm, pn, seg; };
struct Gemm { const bf16_t* A; const bf16_t* Bt; const bf16_t* A2; const bf16_t* Bt2; int M, N, K; };

struct StaticOrder {
    int nM, nN, nwg, G, c;
    __device__ void init(int M, int N, int G_, int c_) { nM = M / BM; nN = N / BM; nwg = nM * nN; G = G_; c = c_; }
    __device__ bool tile(long L, Unit& u) const {
        if (L >= nwg) return false;
        int wgid = (int)L; { const int q = nwg / NXCD, r = nwg % NXCD, xcd = wgid % NXCD, off = wgid / NXCD; wgid = (xcd < r ? xcd * (q + 1) : r * (q + 1) + (xcd - r) * q) + off; }
        const int nig = WGM * nN, gid = wgid / nig, fm = gid * WGM, gsz = (nM - fm) < WGM ? (nM - fm) : WGM;
        u.pm = fm + ((wgid % nig) % gsz); u.pn = (wgid % nig) / gsz; u.seg = 0; return true;
    }
    __device__ bool next(int i, Unit& u) const { return tile((long)i * G + c, u); }
};
struct PairOrder {
    StaticOrder s;
    __device__ bool next(int i, Unit& u) const { const bool ok = s.tile((long)(i >> 1) * s.G + s.c, u); u.seg = i & 1; return ok; }
};

struct EpiProj {
    static constexpr bool PERM = true, HAS_MID = false;
    unsigned char* ws;
    __device__ __forceinline__ void mid(f32x4 (&acc)[2][2][4][2], const Unit& u, int wr, int wc, int fr, int fq) const {}
    __device__ __forceinline__ void operator()(const f32x4 (&acc)[2][2][4][2], const Unit& u, int wr, int wc, int fr, int fq) const {
        const int pn = u.pn; size_t boff; int ld, ct;
        if (pn < 2) { boff = OFF_RQ; ld = 512; ct = pn; }
        else if (pn < 4) { boff = OFF_RK; ld = 512; ct = pn - 2; }
        else if (pn < 8) { boff = OFF_RV; ld = 1024; ct = pn - 4; }
        else if (pn < 12) { boff = OFF_RG; ld = 1024; ct = pn - 8; }
        else if (pn < 16) { boff = OFF_SQ; ld = 1024; ct = pn - 12; }
        else if (pn == 16) { boff = OFF_SK; ld = 256; ct = 0; }
        else if (pn == 17) { boff = OFF_SV; ld = 256; ct = 0; }
        else if (pn < 22) { boff = OFF_GR; ld = 1024; ct = pn - 18; }
        else { boff = OFF_GS; ld = 1024; ct = pn - 22; }
        bf16_t* base = (bf16_t*)(ws + boff);
        const int row0 = u.pm * BM + wr * 64 + fr, col0 = ct * 256 + wc * 32 + 8 * fq;
        if (pn >= 18) {
            unsigned char* gb = ws + boff;
            const int colw = ct * 256 + wc * 32 + ((fq & 1) ? HALF + 8 * (fq - 1) : 8 * fq);
#pragma unroll
            for (int ai = 0; ai < 2; ++ai)
#pragma unroll
                for (int m = 0; m < 4; ++m) {
                    unsigned w[2][2];
#pragma unroll
                    for (int bj = 0; bj < 2; ++bj) { const f32x4 v0 = acc[ai][bj][m][0], v1 = acc[ai][bj][m][1];
                        int w0 = __builtin_amdgcn_cvt_pk_fp8_f32(v0[0], v0[1], 0, false); w0 = __builtin_amdgcn_cvt_pk_fp8_f32(v0[2], v0[3], w0, true);
                        int w1 = __builtin_amdgcn_cvt_pk_fp8_f32(v1[0], v1[1], 0, false); w1 = __builtin_amdgcn_cvt_pk_fp8_f32(v1[2], v1[3], w1, true);
                        w[bj][0] = (unsigned)w0; w[bj][1] = (unsigned)w1; }
                    const u32x2 sx = __builtin_amdgcn_permlane16_swap(w[0][0], w[1][0], false, false), sy = __builtin_amdgcn_permlane16_swap(w[0][1], w[1][1], false, false);
                    *(u32x4*)(gb + (size_t)(row0 + ai * HALF + m * 16) * 1024 + colw) = (u32x4){sx.x, sy.x, sx.y, sy.y};
                }
            return;
        }
#pragma unroll
        for (int ai = 0; ai < 2; ++ai)
#pragma unroll
            for (int m = 0; m < 4; ++m) {
                bf16_t* rowp = base + (size_t)(row0 + ai * HALF + m * 16) * ld + col0;
#pragma unroll
                for (int bj = 0; bj < 2; ++bj) { const f32x4 v0 = acc[ai][bj][m][0], v1 = acc[ai][bj][m][1];
                    u32x4 w; w.x = cvt_pk_bf16_asm(v0[0], v0[1]); w.y = cvt_pk_bf16_asm(v0[2], v0[3]); w.z = cvt_pk_bf16_asm(v1[0], v1[1]); w.w = cvt_pk_bf16_asm(v1[2], v1[3]);
                    *(u32x4*)(rowp + bj * HALF) = w; } }
    }
};
struct EpiMerged {
    static constexpr bool PERM = true, HAS_MID = true;
    const unsigned char *GR, *GS; bf16_t* O;
#define F8(w, k) __builtin_amdgcn_cvt_f32_fp8((int)(w), (k))
    __device__ __forceinline__ void mid(f32x4 (&acc)[2][2][4][2], const Unit& u, int wr, int wc, int fr, int fq) const {
        const int row0 = u.pm * BM + wr * 64 + fr, colw = u.pn * BM + wc * 32 + ((fq & 1) ? HALF + 8 * (fq - 1) : 8 * fq);
#pragma unroll
        for (int ai = 0; ai < 2; ++ai)
#pragma unroll
            for (int m = 0; m < 4; ++m) { const size_t off = (size_t)(row0 + ai * HALF + m * 16) * DM + colw;
                const u32x4 ga = *(const u32x4*)(GR + off), gb = *(const u32x4*)(GS + off);
                const u32x2 ax = __builtin_amdgcn_permlane16_swap(ga.x, ga.z, false, false), ay = __builtin_amdgcn_permlane16_swap(ga.y, ga.w, false, false);
                const u32x2 bx = __builtin_amdgcn_permlane16_swap(gb.x, gb.z, false, false), by = __builtin_amdgcn_permlane16_swap(gb.y, gb.w, false, false);
#define MRG_R(ga_, gb_) ((1.0f + __builtin_amdgcn_exp2f(-1.4426950408889634f * (gb_))) * __builtin_amdgcn_rcpf(1.0f + __builtin_amdgcn_exp2f(-1.4426950408889634f * (ga_))))
#pragma unroll
                for (int bj = 0; bj < 2; ++bj) { const unsigned a0 = bj ? ax.y : ax.x, a1 = bj ? ay.y : ay.x, b0 = bj ? bx.y : bx.x, b1 = bj ? by.y : by.x;
                    f32x4 r0, r1;
                    r0[0] = MRG_R(F8(a0, 0), F8(b0, 0)); r0[1] = MRG_R(F8(a0, 1), F8(b0, 1)); r0[2] = MRG_R(F8(a0, 2), F8(b0, 2)); r0[3] = MRG_R(F8(a0, 3), F8(b0, 3));
                    r1[0] = MRG_R(F8(a1, 0), F8(b1, 0)); r1[1] = MRG_R(F8(a1, 1), F8(b1, 1)); r1[2] = MRG_R(F8(a1, 2), F8(b1, 2)); r1[3] = MRG_R(F8(a1, 3), F8(b1, 3));
                    acc[ai][bj][m][0] = acc[ai][bj][m][0] * r0; acc[ai][bj][m][1] = acc[ai][bj][m][1] * r1; }
#undef MRG_R
            }
    }
    __device__ __forceinline__ void operator()(const f32x4 (&acc)[2][2][4][2], const Unit& u, int wr, int wc, int fr, int fq) const {
        const int row0 = u.pm * BM + wr * 64 + fr, col0 = u.pn * BM + wc * 32 + 8 * fq, colw = u.pn * BM + wc * 32 + ((fq & 1) ? HALF + 8 * (fq - 1) : 8 * fq);
#pragma unroll
        for (int ai = 0; ai < 2; ++ai)
#pragma unroll
            for (int m = 0; m < 4; ++m) { const size_t rowoff = (size_t)(row0 + ai * HALF + m * 16) * DM;
                const u32x4 gb = *(const u32x4*)(GS + rowoff + colw);
                const u32x2 bx = __builtin_amdgcn_permlane16_swap(gb.x, gb.z, false, false), by = __builtin_amdgcn_permlane16_swap(gb.y, gb.w, false, false);
#pragma unroll
                for (int bj = 0; bj < 2; ++bj) { const unsigned b0 = bj ? bx.y : bx.x, b1 = bj ? by.y : by.x; const f32x4 v0 = acc[ai][bj][m][0], v1 = acc[ai][bj][m][1];
                    u32x4 w;
                    w.x = cvt_pk_bf16_asm(v0[0] * sigmoidf_(F8(b0, 0)), v0[1] * sigmoidf_(F8(b0, 1))); w.y = cvt_pk_bf16_asm(v0[2] * sigmoidf_(F8(b0, 2)), v0[3] * sigmoidf_(F8(b0, 3)));
                    w.z = cvt_pk_bf16_asm(v1[0] * sigmoidf_(F8(b1, 0)), v1[1] * sigmoidf_(F8(b1, 1))); w.w = cvt_pk_bf16_asm(v1[2] * sigmoidf_(F8(b1, 2)), v1[3] * sigmoidf_(F8(b1, 3)));
                    *(u32x4*)(O + rowoff + col0 + bj * HALF) = w; }
            }
    }
#undef F8
};
struct EpiRes {
    static constexpr bool PERM = true, HAS_MID = false;
    const float* res; float* out;
    __device__ __forceinline__ void mid(f32x4 (&acc)[2][2][4][2], const Unit& u, int wr, int wc, int fr, int fq) const {}
    __device__ __forceinline__ void operator()(const f32x4 (&acc)[2][2][4][2], const Unit& u, int wr, int wc, int fr, int fq) const {
        const int row0 = u.pm * BM + wr * 64 + fr, col0 = u.pn * BM + wc * 32 + 8 * fq;
#pragma unroll
        for (int ai = 0; ai < 2; ++ai)
#pragma unroll
            for (int m = 0; m < 4; ++m)
#pragma unroll
                for (int bj = 0; bj < 2; ++bj) { const size_t off = (size_t)(row0 + ai * HALF + m * 16) * DM + col0 + bj * HALF;
                    const f32x4 x0 = *(const f32x4*)(res + off), x1 = *(const f32x4*)(res + off + 4);
                    *(f32x4*)(out + off) = x0 + acc[ai][bj][m][0]; *(f32x4*)(out + off + 4) = x1 + acc[ai][bj][m][1]; }
    }
};
struct EpiResStat {
    static constexpr bool PERM = true, HAS_MID = false;
    const float* res; float* out; bf16_t* hb; float* ss;
    __device__ __forceinline__ void mid(f32x4 (&acc)[2][2][4][2], const Unit& u, int wr, int wc, int fr, int fq) const {}
    __device__ __forceinline__ void operator()(const f32x4 (&acc)[2][2][4][2], const Unit& u, int wr, int wc, int fr, int fq) const {
        const int row0 = u.pm * BM + wr * 64 + fr, col0 = u.pn * BM + wc * 32 + 8 * fq;
#pragma unroll
        for (int ai = 0; ai < 2; ++ai)
#pragma unroll
            for (int m = 0; m < 4; ++m) {
                float sq = 0.f;
#pragma unroll
                for (int bj = 0; bj < 2; ++bj) { const size_t off = (size_t)(row0 + ai * HALF + m * 16) * DM + col0 + bj * HALF;
                    const f32x4 h0 = *(const f32x4*)(res + off) + acc[ai][bj][m][0], h1 = *(const f32x4*)(res + off + 4) + acc[ai][bj][m][1];
                    u32x4 w; w.x = cvt_pk_bf16_asm(h0[0], h0[1]); w.y = cvt_pk_bf16_asm(h0[2], h0[3]); w.z = cvt_pk_bf16_asm(h1[0], h1[1]); w.w = cvt_pk_bf16_asm(h1[2], h1[3]);
                    *(u32x4*)(hb + off) = w;
                    sq += (h0[0] * h0[0] + h0[1] * h0[1]) + (h0[2] * h0[2] + h0[3] * h0[3]) + (h1[0] * h1[0] + h1[1] * h1[1]) + (h1[2] * h1[2] + h1[3] * h1[3]); }
                sq += __shfl_xor(sq, 16); sq += __shfl_xor(sq, 32);
                if (fq == 0) atomicAdd(ss + row0 + ai * HALF + m * 16, sq);
            }
    }
};
struct EpiResBf {
    static constexpr bool PERM = true, HAS_MID = false;
    const bf16_t* hb; float* out;
    __device__ __forceinline__ void mid(f32x4 (&acc)[2][2][4][2], const Unit& u, int wr, int wc, int fr, int fq) const {}
    __device__ __forceinline__ void operator()(const f32x4 (&acc)[2][2][4][2], const Unit& u, int wr, int wc, int fr, int fq) const {
        const int row0 = u.pm * BM + wr * 64 + fr, col0 = u.pn * BM + wc * 32 + 8 * fq;
#pragma unroll
        for (int ai = 0; ai < 2; ++ai)
#pragma unroll
            for (int m = 0; m < 4; ++m)
#pragma unroll
                for (int bj = 0; bj < 2; ++bj) { const size_t off = (size_t)(row0 + ai * HALF + m * 16) * DM + col0 + bj * HALF;
                    const u32x4 h = *(const u32x4*)(hb + off);
                    const f32x4 x0 = (f32x4){bf_lo(h.x), bf_hi(h.x), bf_lo(h.y), bf_hi(h.y)}, x1 = (f32x4){bf_lo(h.z), bf_hi(h.z), bf_lo(h.w), bf_hi(h.w)};
                    *(f32x4*)(out + off) = x0 + acc[ai][bj][m][0]; *(f32x4*)(out + off + 4) = x1 + acc[ai][bj][m][1]; }
    }
};
struct EpiUp {
    static constexpr bool PERM = true, HAS_MID = false;
    bf16_t* O; const float* ss;
    __device__ __forceinline__ void mid(f32x4 (&acc)[2][2][4][2], const Unit& u, int wr, int wc, int fr, int fq) const {}
    __device__ __forceinline__ void operator()(const f32x4 (&acc)[2][2][4][2], const Unit& u, int wr, int wc, int fr, int fq) const {
        const int row0 = u.pm * BM + wr * 64 + fr, col0 = u.pn * BM + wc * 32 + 8 * fq;
#pragma unroll
        for (int ai = 0; ai < 2; ++ai)
#pragma unroll
            for (int m = 0; m < 4; ++m) {
                const float rstd = 1.f / sqrtf(ss[row0 + ai * HALF + m * 16] * (1.f / DM) + EPS);
#pragma unroll
                for (int bj = 0; bj < 2; ++bj) { const size_t off = (size_t)(row0 + ai * HALF + m * 16) * FF + col0 + bj * HALF;
                    f32x4 v0 = acc[ai][bj][m][0], v1 = acc[ai][bj][m][1];
#pragma unroll
                    for (int e = 0; e < 4; ++e) { const float a = fmaxf(v0[e] * rstd, 0.f), b = fmaxf(v1[e] * rstd, 0.f); v0[e] = a * a; v1[e] = b * b; }
                    u32x4 w; w.x = cvt_pk_bf16_asm(v0[0], v0[1]); w.y = cvt_pk_bf16_asm(v0[2], v0[3]); w.z = cvt_pk_bf16_asm(v1[0], v1[1]); w.w = cvt_pk_bf16_asm(v1[2], v1[3]);
                    *(u32x4*)(O + off) = w; }
            }
    }
};

template <class Epi, class Sched, bool ALIGN_EPI>
__device__ __forceinline__ void gemm_phase(LAS unsigned char* lds, const Gemm g, const Sched& S, const Epi& E) {
    int tid_ = threadIdx.x; asm volatile("" : "+v"(tid_));
    const int tid = tid_, wid = __builtin_amdgcn_readfirstlane(tid >> 6), lane = tid & 63, wr = wid >> 2, wc = wid & 3, fr = lane & 15, fq = lane >> 4;
    const int K = g.K, nt = K / BK;
    unsigned voffA[2], voffB[2];
#pragma unroll
    for (int i = 0; i < 2; ++i) { int R, C; stage_rc(tid * 16 + i * 8192, R, C); const int Rb = Epi::PERM ? ((R & ~31) + perm32(R & 31)) : R;
        voffA[i] = (unsigned)(R * K + C) * 2u; voffB[i] = (unsigned)(Rb * K + C) * 2u; }
    const size_t kstep = (size_t)(BK * 2);
    const size_t hstep = (size_t)HALF * K * 2;
    const size_t tstep = 2 * hstep;
    const unsigned ldsw = (unsigned)wid * 1024u;
    const int aoff = lds_byte(wr * 64 + fr, fq * 8), boff = lds_byte(wc * 32 + fr, fq * 8);
#define PG8_SA(b, h) (((b) * 2 + (h)) * HTB)
#define PG8_SB(b, h) ((4 + (b) * 2 + (h)) * HTB)
#define PG8_STAGE(bufoff, gbase, voff) do { _Pragma("unroll") for (int _i = 0; _i < 2; ++_i) \
        __builtin_amdgcn_global_load_lds((const unsigned*)((const char*)(gbase) + (voff)[_i]), (LAS unsigned*)(lds + (bufoff) + ldsw + _i * 8192), 16, 0, 0); } while (0)
#define PG8_LDA(dst, b, h) do { _Pragma("unroll") for (int m = 0; m < 4; ++m) _Pragma("unroll") for (int k = 0; k < 2; ++k) dst[m][k] = *(const LAS bf16x8*)(lds + PG8_SA(b, h) + aoff + m * 2048 + k * 1024); } while (0)
#define PG8_LDB(dst, b, h) do { _Pragma("unroll") for (int n = 0; n < 2; ++n) _Pragma("unroll") for (int k = 0; k < 2; ++k) dst[n][k] = *(const LAS bf16x8*)(lds + PG8_SB(b, h) + boff + n * 2048 + k * 1024); } while (0)
#define PG8_MMA(ai, bj, At, Bt) do { __builtin_amdgcn_s_setprio(1); _Pragma("unroll") for (int m = 0; m < 4; ++m) _Pragma("unroll") for (int n = 0; n < 2; ++n) _Pragma("unroll") for (int k = 0; k < 2; ++k) \
        acc[ai][bj][m][n] = __builtin_amdgcn_mfma_f32_16x16x32_bf16(Bt[n][k], At[m][k], acc[ai][bj][m][n], 0, 0, 0); __builtin_amdgcn_s_setprio(0); } while (0)
#define PG8_WAIT_V(n) asm volatile("s_waitcnt vmcnt(" #n ")" ::: "memory")
#define PG8_WAIT_L(n) asm volatile("s_waitcnt lgkmcnt(" #n ")" ::: "memory")
#define PG8_BAR __builtin_amdgcn_s_barrier()
#define PG8_SCHED __builtin_amdgcn_sched_barrier(0)
    Unit cur, nxt; int ui = 0;
    if (!S.next(0, cur)) return;
    f32x4 acc[2][2][4][2];
#pragma unroll
    for (int a = 0; a < 2; ++a)
#pragma unroll
        for (int b = 0; b < 2; ++b)
#pragma unroll
            for (int m = 0; m < 4; ++m)
#pragma unroll
                for (int n = 0; n < 2; ++n) acc[a][b][m][n] = (f32x4){0.f, 0.f, 0.f, 0.f};
    bf16x8 At[4][2], B0[2][2], B1[2][2];
    const char* cA = (const char*)(cur.seg ? g.A2 : g.A) + (size_t)cur.pm * tstep; const char* cB = (const char*)(cur.seg ? g.Bt2 : g.Bt) + (size_t)cur.pn * tstep;
    PG8_STAGE(PG8_SB(0, 0), cB, voffB); PG8_STAGE(PG8_SB(0, 1), cB + hstep, voffB); PG8_STAGE(PG8_SA(0, 0), cA, voffA); PG8_STAGE(PG8_SA(0, 1), cA + hstep, voffA);
    if (wr == 1) PG8_BAR;
    PG8_WAIT_V(2); PG8_BAR;
    PG8_STAGE(PG8_SB(1, 0), cB + kstep, voffB); PG8_STAGE(PG8_SA(1, 0), cA + kstep, voffA); PG8_STAGE(PG8_SB(1, 1), cB + hstep + kstep, voffB);
    PG8_WAIT_V(6); PG8_BAR;
    for (;;) {
        const bool has_next = S.next(ui + 1, nxt);
        const char* nA = has_next ? (const char*)(nxt.seg ? g.A2 : g.A) + (size_t)nxt.pm * tstep : cA; const char* nB = has_next ? (const char*)(nxt.seg ? g.Bt2 : g.Bt) + (size_t)nxt.pn * tstep : cB;
        for (int t = 0; t < nt; t += 2) {
            const bool last = (t == nt - 2);
            const char* a1 = cA + (size_t)(t + 1) * kstep;
            const char* a2 = last ? nA : cA + (size_t)(t + 2) * kstep; const char* b2 = last ? nB : cB + (size_t)(t + 2) * kstep;
            const char* a3 = a2 + kstep; const char* b3 = b2 + kstep;
            PG8_LDB(B0, 0, 0); PG8_LDB(B1, 0, 1); PG8_SCHED; PG8_LDA(At, 0, 0); PG8_STAGE(PG8_SA(1, 1), a1 + hstep, voffA);
            PG8_WAIT_V(8); PG8_WAIT_L(0); PG8_BAR; PG8_MMA(0, 0, At, B0); PG8_MMA(0, 1, At, B1); PG8_BAR; PG8_SCHED;
            PG8_LDA(At, 0, 1); PG8_STAGE(PG8_SB(0, 0), b2, voffB); PG8_STAGE(PG8_SB(0, 1), b2 + hstep, voffB); PG8_STAGE(PG8_SA(0, 0), a2, voffA);
            PG8_WAIT_V(8); PG8_WAIT_L(0); PG8_BAR; PG8_MMA(1, 0, At, B0); PG8_MMA(1, 1, At, B1); PG8_BAR; PG8_SCHED;
            PG8_LDB(B0, 1, 0); PG8_LDB(B1, 1, 1); PG8_SCHED; PG8_LDA(At, 1, 0); PG8_STAGE(PG8_SA(0, 1), a2 + hstep, voffA);
            PG8_WAIT_V(8); PG8_WAIT_L(0); PG8_BAR; PG8_MMA(0, 0, At, B0); PG8_MMA(0, 1, At, B1); PG8_BAR; PG8_SCHED;
            PG8_LDA(At, 1, 1); PG8_STAGE(PG8_SB(1, 0), b3, voffB); PG8_STAGE(PG8_SB(1, 1), b3 + hstep, voffB); PG8_STAGE(PG8_SA(1, 0), a3, voffA);
            PG8_WAIT_V(8); PG8_WAIT_L(0); PG8_BAR; PG8_MMA(1, 0, At, B0); PG8_MMA(1, 1, At, B1); PG8_BAR; PG8_SCHED;
        }
        if constexpr (ALIGN_EPI) { if (wr == 0) PG8_BAR; }
        bool keep = false;
        if constexpr (Epi::HAS_MID) keep = (cur.seg == 0);
        if (keep) E.mid(acc, cur, wr, wc, fr, fq); else E(acc, cur, wr, wc, fr, fq);
        if (!has_next) break;
        if (!keep) {
#pragma unroll
            for (int a = 0; a < 2; ++a)
#pragma unroll
                for (int b = 0; b < 2; ++b)
#pragma unroll
                    for (int m = 0; m < 4; ++m)
#pragma unroll
                        for (int n = 0; n < 2; ++n) acc[a][b][m][n] = (f32x4){0.f, 0.f, 0.f, 0.f};
        }
        cur = nxt; cA = nA; cB = nB; ++ui;
        if constexpr (ALIGN_EPI) { if (wr == 1) PG8_BAR; }
    }
    PG8_WAIT_V(0);
    if constexpr (!ALIGN_EPI) { if (wr == 0) PG8_BAR; }
    PG8_BAR;
#undef PG8_SA
#undef PG8_SB
#undef PG8_STAGE
#undef PG8_LDA
#undef PG8_LDB
#undef PG8_MMA
#undef PG8_WAIT_V
#undef PG8_WAIT_L
#undef PG8_BAR
#undef PG8_SCHED
}
}

struct Args {
    const float *x, *meta, *mix_g, *w_in, *ret_g, *q_g, *k_g, *sinks, *w_ret, *w_swa, *w_out, *mlp_g, *w_up, *w_down;
    float* out; unsigned char* ws;
};

__device__ __forceinline__ void p0_transpose_item(const float* W, int K, int N, bf16_t* WT, LAS float* scr, int item, int lane, const float* kgain = nullptr) {
    const int nblk = N / 32, kb = item / nblk, nb = item % nblk, k0 = 64 * kb, n0 = 32 * nb;
    f32x4 wv[8];
#pragma unroll
    for (int i = 0; i < 8; ++i) wv[i] = *(const f32x4*)(W + (size_t)(k0 + 8 * i + (lane >> 3)) * N + n0 + 4 * (lane & 7));
#pragma unroll
    for (int i = 0; i < 8; ++i) { const int kk = 8 * i + (lane >> 3); f32x4 v = wv[i]; if (kgain) v = v * kgain[k0 + kk];
        LAS float* d = scr + kk * 33 + 4 * (lane & 7); d[0] = v.x; d[1] = v.y; d[2] = v.z; d[3] = v.w; }
    asm volatile("s_waitcnt lgkmcnt(0)" ::: "memory");
    const int c = lane & 7;
#pragma unroll
    for (int j = 0; j < 4; ++j) { const int n = (lane >> 3) + 8 * j; const LAS float* s = scr + (8 * c) * 33 + n;
        u32x4 o; o.x = cvt_pk_bf16_asm(s[0 * 33], s[1 * 33]); o.y = cvt_pk_bf16_asm(s[2 * 33], s[3 * 33]); o.z = cvt_pk_bf16_asm(s[4 * 33], s[5 * 33]); o.w = cvt_pk_bf16_asm(s[6 * 33], s[7 * 33]);
        *(u32x4*)(WT + (size_t)(n0 + n) * K + k0 + 8 * c) = o; }
    asm volatile("s_waitcnt lgkmcnt(0)" ::: "memory");
}
__device__ __forceinline__ void rms_row_to_bf16(const float* xrow, const float* g, bf16_t* orow, int lane) {
    const f32x4* xr = (const f32x4*)xrow + lane; const f32x4* gr = (const f32x4*)g + lane;
    f32x4 v[4]; float s = 0.f;
#pragma unroll
    for (int j = 0; j < 4; ++j) { v[j] = xr[64 * j]; s += (v[j].x * v[j].x + v[j].y * v[j].y) + (v[j].z * v[j].z + v[j].w * v[j].w); }
    const float rstd = 1.f / sqrtf(wave_sum(s) * (1.f / DM) + EPS);
    u32x2* o8 = (u32x2*)orow + lane;
#pragma unroll
    for (int j = 0; j < 4; ++j) { const f32x4 gg = gr[64 * j]; u32x2 w; w.x = cvt_pk_bf16_asm(v[j].x * rstd * gg.x, v[j].y * rstd * gg.y); w.y = cvt_pk_bf16_asm(v[j].z * rstd * gg.z, v[j].w * rstd * gg.w); o8[64 * j] = w; }
}

__device__ __forceinline__ void tr_write8(LAS unsigned char* base, int RS, int col0, int pp, u32x4 r0, u32x4 r1) {
#define TRW(i, w0, w1) *(LAS unsigned*)(base + ((size_t)(col0 + (i)) * RS + 2 * pp) * 2) = ((i) & 1) ? (((w0) >> 16) | ((w1) & 0xffff0000u)) : (((w0) & 0xffffu) | ((w1) << 16))
    TRW(0, r0.x, r1.x); TRW(1, r0.x, r1.x); TRW(2, r0.y, r1.y); TRW(3, r0.y, r1.y); TRW(4, r0.z, r1.z); TRW(5, r0.z, r1.z); TRW(6, r0.w, r1.w); TRW(7, r0.w, r1.w);
#undef TRW
}

__device__ __forceinline__ int tr_off(int col, int RS, int slot) { return col * RS * 2 + ((slot ^ (2 * ((col >> 3) & 15))) << 3); }
__device__ __forceinline__ void tr_write8s(LAS unsigned char* base, int RS, int col0, int pp, u32x4 r0, u32x4 r1) {
    const int sw2 = 2 * ((col0 >> 3) & 15), po = (((pp >> 1) ^ sw2) << 3) + ((pp & 1) << 2);
#define TRW(i, w0, w1) *(LAS unsigned*)(base + (col0 + (i)) * RS * 2 + po) = ((i) & 1) ? (((w0) >> 16) | ((w1) & 0xffff0000u)) : (((w0) & 0xffffu) | ((w1) << 16))
    TRW(0, r0.x, r1.x); TRW(1, r0.x, r1.x); TRW(2, r0.y, r1.y); TRW(3, r0.y, r1.y); TRW(4, r0.z, r1.z); TRW(5, r0.z, r1.z); TRW(6, r0.w, r1.w); TRW(7, r0.w, r1.w);
#undef TRW
}
__device__ __forceinline__ u32x4 scale8(u32x4 r, float f) {
    u32x4 o; o.x = cvt_pk_bf16(bf_lo(r.x) * f, bf_hi(r.x) * f); o.y = cvt_pk_bf16(bf_lo(r.y) * f, bf_hi(r.y) * f); o.z = cvt_pk_bf16(bf_lo(r.z) * f, bf_hi(r.z) * f); o.w = cvt_pk_bf16(bf_lo(r.w) * f, bf_hi(r.w) * f); return o;
}
__device__ __forceinline__ bf16x8 as_frag(u32x4 v) { return __builtin_bit_cast(bf16x8, v); }
#define MFMA16(a, b, c) __builtin_amdgcn_mfma_f32_16x16x32_bf16((a), (b), (c), 0, 0, 0)

__device__ __forceinline__ long swa_key_row(int b, int c, int kk) {
    if (kk < 16) return (long)NTOK + kk;
    if (kk < 272) { const int s = (c - 1) * 128 + (kk - 16); if (s >= 128) return (long)b * SEQ + s - 128; }
    return -1;
}
__device__ __forceinline__ void swa_phase(LAS unsigned char* lds, const Args& p) {
    int tid_ = threadIdx.x; asm volatile("" : "+v"(tid_));
    const int tid = tid_, lane = tid & 63, w = __builtin_amdgcn_readfirstlane(tid >> 6), r = lane & 15, q = lane >> 4;
    const bf16_t* SQ = (const bf16_t*)(p.ws + OFF_SQ); const bf16_t* SK = (const bf16_t*)(p.ws + OFF_SK); const bf16_t* SV = (const bf16_t*)(p.ws + OFF_SV);
    bf16_t* YSWA = (bf16_t*)((unsigned char*)p.out + DOUT_YSWA);
    constexpr int KS = 72, VS = 296, K_OFF = 0, VT_OFF = 288 * KS * 2;
    constexpr float LOG2E = 1.4426950408889634f;
    const int kch = tid & 7, G = gridDim.x;
    const f32x4 kg0 = *(const f32x4*)(p.k_g + kch * 8), kg1 = *(const f32x4*)(p.k_g + kch * 8 + 4);
    u32x4 kraw[5], vraw[6];
#define SWA_LOAD_UNIT(uu) do { const int b_ = (uu) >> 8, c_ = 1 + (((uu) & 255) >> 2), kvh_ = (uu) & 3; \
        _Pragma("unroll") for (int it = 0; it < 5; ++it) { const int kk = (it * NTHREADS + tid) >> 3; const long row = swa_key_row(b_, c_, kk); \
            kraw[it] = (u32x4){0u, 0u, 0u, 0u}; if (row >= 0) kraw[it] = *(const u32x4*)(SK + (size_t)row * 256 + kvh_ * 64 + kch * 8); } \
        _Pragma("unroll") for (int it = 0; it < 3; ++it) { const int id = it * NTHREADS + tid, ch = id / 144, pp = id % 144; \
            _Pragma("unroll") for (int e = 0; e < 2; ++e) { const long row = (id < 1152) ? swa_key_row(b_, c_, 2 * pp + e) : -1; \
                vraw[2 * it + e] = (u32x4){0u, 0u, 0u, 0u}; if (row >= 0) vraw[2 * it + e] = *(const u32x4*)(SV + (size_t)row * 256 + kvh_ * 64 + ch * 8); } } } while (0)
    int u = blockIdx.x;
    if (u >= 1024) return;
    SWA_LOAD_UNIT(u);
    for (; u < 1024; u += G) {
        const int b = u >> 8, c = 1 + ((u & 255) >> 2), kvh = u & 3;
        __syncthreads();
#pragma unroll
        for (int it = 0; it < 5; ++it) {
            const int kk = (it * NTHREADS + tid) >> 3; const u32x4 raw = kraw[it];
            const float f0 = bf_lo(raw.x), f1 = bf_hi(raw.x), f2 = bf_lo(raw.y), f3 = bf_hi(raw.y), f4 = bf_lo(raw.z), f5 = bf_hi(raw.z), f6 = bf_lo(raw.w), f7 = bf_hi(raw.w);
            float ss = (f0 * f0 + f1 * f1) + (f2 * f2 + f3 * f3) + (f4 * f4 + f5 * f5) + (f6 * f6 + f7 * f7);
            ss += __shfl_xor(ss, 1); ss += __shfl_xor(ss, 2); ss += __shfl_xor(ss, 4);
            const float rstd = __builtin_amdgcn_rsqf(ss * (1.f / 64.f) + EPS);
            u32x4 o; o.x = cvt_pk_bf16(f0 * rstd * kg0.x, f1 * rstd * kg0.y); o.y = cvt_pk_bf16(f2 * rstd * kg0.z, f3 * rstd * kg0.w);
            o.z = cvt_pk_bf16(f4 * rstd * kg1.x, f5 * rstd * kg1.y); o.w = cvt_pk_bf16(f6 * rstd * kg1.z, f7 * rstd * kg1.w);
            if (kk < 288) *(LAS u32x4*)(lds + K_OFF + (kk * KS + kch * 8) * 2) = o;
        }
#pragma unroll
        for (int it = 0; it < 3; ++it) { const int id = it * NTHREADS + tid; if (id < 1152) tr_write8(lds + VT_OFF, VS, (id / 144) * 8, id % 144, vraw[2 * it], vraw[2 * it + 1]); }
        __syncthreads();
        const int qt = w, iq = 16 * qt + r;
        const size_t qrow = (size_t)b * SEQ + (size_t)(c - 1) * 128 + iq;
        u32x4 qa = *(const u32x4*)(SQ + qrow * 1024 + (kvh * 4) * 64 + 8 * q), qb = *(const u32x4*)(SQ + qrow * 1024 + (kvh * 4) * 64 + 32 + 8 * q);
        { const int un = (u + G < 1024) ? u + G : u; SWA_LOAD_UNIT(un); }
#pragma unroll 1
        for (int hl = 0; hl < 4; ++hl) {
            const int h = kvh * 4 + hl;
            bf16x8 Qf[2];
            {
                const u32x4 a = qa, bq = qb;
                const int hn = kvh * 4 + ((hl + 1) & 3);
                qa = *(const u32x4*)(SQ + qrow * 1024 + hn * 64 + 8 * q); qb = *(const u32x4*)(SQ + qrow * 1024 + hn * 64 + 32 + 8 * q);
                float fa[8] = {bf_lo(a.x), bf_hi(a.x), bf_lo(a.y), bf_hi(a.y), bf_lo(a.z), bf_hi(a.z), bf_lo(a.w), bf_hi(a.w)};
                float fb[8] = {bf_lo(bq.x), bf_hi(bq.x), bf_lo(bq.y), bf_hi(bq.y), bf_lo(bq.z), bf_hi(bq.z), bf_lo(bq.w), bf_hi(bq.w)};
                float ss = 0.f;
#pragma unroll
                for (int e = 0; e < 8; ++e) ss += fa[e] * fa[e] + fb[e] * fb[e];
                ss += __shfl_xor(ss, 16); ss += __shfl_xor(ss, 32);
                const float rs = (0.125f * LOG2E) * __builtin_amdgcn_rsqf(ss * (1.f / 64.f) + EPS);
                const f32x4 ga0 = *(const f32x4*)(p.q_g + 8 * q), ga1 = *(const f32x4*)(p.q_g + 8 * q + 4), gb0 = *(const f32x4*)(p.q_g + 32 + 8 * q), gb1 = *(const f32x4*)(p.q_g + 32 + 8 * q + 4);
                u32x4 oa, ob;
                oa.x = cvt_pk_bf16(fa[0] * rs * ga0.x, fa[1] * rs * ga0.y); oa.y = cvt_pk_bf16(fa[2] * rs * ga0.z, fa[3] * rs * ga0.w); oa.z = cvt_pk_bf16(fa[4] * rs * ga1.x, fa[5] * rs * ga1.y); oa.w = cvt_pk_bf16(fa[6] * rs * ga1.z, fa[7] * rs * ga1.w);
                ob.x = cvt_pk_bf16(fb[0] * rs * gb0.x, fb[1] * rs * gb0.y); ob.y = cvt_pk_bf16(fb[2] * rs * gb0.z, fb[3] * rs * gb0.w); ob.z = cvt_pk_bf16(fb[4] * rs * gb1.x, fb[5] * rs * gb1.y); ob.w = cvt_pk_bf16(fb[6] * rs * gb1.z, fb[7] * rs * gb1.w);
                Qf[0] = as_frag(oa); Qf[1] = as_frag(ob);
            }
            const float slope2 = exp2f(-0.5f * (float)(h + 1)) * LOG2E, sink2 = p.sinks[h] * LOG2E;
            const float bbase = -slope2 * (float)(144 + r - 4 * q), mbase = -slope2 * (float)(c * 128 + iq - 112 - 4 * q);
            const float sl1 = slope2, sl2 = 2.f * slope2, sl3 = 3.f * slope2;
            const int d0 = 144 + r - 4 * q;
            f32x4 sc[10]; float mx = -1e30f;
#pragma unroll
            for (int t = 0; t < 10; ++t) {
                const int kt = (t == 0) ? 0 : qt + t;
                f32x4 acc = (f32x4){0.f, 0.f, 0.f, 0.f};
#pragma unroll
                for (int ks = 0; ks < 2; ++ks) { const bf16x8 a = *(const LAS bf16x8*)(lds + K_OFF + ((16 * kt + r) * KS + 32 * ks + 8 * q) * 2); acc = MFMA16(a, Qf[ks], acc); }
                const float tb = (t == 0) ? mbase : bbase + slope2 * (float)(16 * t) + ((c == 1 && kt <= 8) ? -1e30f : 0.f);
                acc[0] += tb; acc[1] += tb + sl1; acc[2] += tb + sl2; acc[3] += tb + sl3;
                if (t == 1) {
#pragma unroll
                    for (int i = 0; i < 4; ++i) if (d0 - 16 - i >= 128) acc[i] = -1e30f;
                }
                if (t == 9) {
#pragma unroll
                    for (int i = 0; i < 4; ++i) if (d0 - 144 - i < 0) acc[i] = -1e30f;
                }
                mx = fmaxf(fmaxf(mx, fmaxf(acc[0], acc[1])), fmaxf(acc[2], acc[3]));
                sc[t] = acc;
                if (t == 4) __builtin_amdgcn_sched_barrier(0);
            }
            mx = fmaxf(mx, __shfl_xor(mx, 16)); mx = fmaxf(mx, __shfl_xor(mx, 32)); mx = fmaxf(mx, sink2);
            float sum = 0.f; u32x2 Pk[10];
#pragma unroll
            for (int t = 0; t < 10; ++t) { const float p0 = __builtin_amdgcn_exp2f(sc[t][0] - mx), p1 = __builtin_amdgcn_exp2f(sc[t][1] - mx), p2 = __builtin_amdgcn_exp2f(sc[t][2] - mx), p3 = __builtin_amdgcn_exp2f(sc[t][3] - mx);
                sum += (p0 + p1) + (p2 + p3); Pk[t].x = cvt_pk_bf16(p0, p1); Pk[t].y = cvt_pk_bf16(p2, p3); }
            sum += __shfl_xor(sum, 16); sum += __shfl_xor(sum, 32);
            const float inv = __builtin_amdgcn_rcpf(sum + __builtin_amdgcn_exp2f(sink2 - mx));
#pragma unroll 1
            for (int dtp = 0; dtp < 2; ++dtp) {
                u32x2 ov[2];
#pragma unroll
                for (int e = 0; e < 2; ++e) {
                    const int dt = 2 * dtp + e;
                    f32x4 acc = (f32x4){0.f, 0.f, 0.f, 0.f};
#pragma unroll
                    for (int pr = 0; pr < 5; ++pr) {
                        const int t0 = 2 * pr, t1 = 2 * pr + 1, kt0 = (t0 == 0) ? 0 : qt + t0, kt1 = qt + t1;
                        const LAS unsigned char* vp = lds + VT_OFF + ((16 * dt + r) * VS + 4 * q) * 2;
                        const u32x2 a0 = *(const LAS u32x2*)(vp + 32 * kt0), a1 = *(const LAS u32x2*)(vp + 32 * kt1);
                        const u32x4 a = (u32x4){a0.x, a0.y, a1.x, a1.y}, bb = (u32x4){Pk[t0].x, Pk[t0].y, Pk[t1].x, Pk[t1].y};
                        acc = MFMA16(as_frag(a), as_frag(bb), acc);
                    }
                    ov[e].x = cvt_pk_bf16(acc[0] * inv, acc[1] * inv); ov[e].y = cvt_pk_bf16(acc[2] * inv, acc[3] * inv);
                }
                const int dw = 32 * dtp + ((q & 1) ? 16 + 4 * (q - 1) : 4 * q);
                const u32x2 ox = __builtin_amdgcn_permlane16_swap(ov[0].x, ov[1].x, false, false), oy = __builtin_amdgcn_permlane16_swap(ov[0].y, ov[1].y, false, false);
                *(u32x4*)(YSWA + qrow * 1024 + h * 64 + dw) = (u32x4){ox.x, oy.x, ox.y, oy.y};
            }
        }
    }
#undef SWA_LOAD_UNIT
}

__device__ __forceinline__ size_t kvs_slot(int b, int n, int h) { return ((size_t)((b * 64 + n) * 4 + h)) * 32768; }
__device__ __forceinline__ void kvlocal_phase(LAS unsigned char* lds, const Args& p) {
    int tid_ = threadIdx.x; asm volatile("" : "+v"(tid_));
    const int tid = tid_, lane = tid & 63, w = __builtin_amdgcn_readfirstlane(tid >> 6), r = lane & 15, q = lane >> 4;
    const bf16_t* RK = (const bf16_t*)(p.ws + OFF_RK); const bf16_t* RV = (const bf16_t*)(p.ws + OFF_RV);
    bf16_t* KVS = (bf16_t*)((unsigned char*)p.out + DOUT_KVS);
    constexpr int RS = 136, KT_OFF = 0, VT_OFF = 128 * RS * 2;
    u32x4 kr[2][2], vr[4][2];
#define KV_LOAD_UNIT(uu) do { const int b_ = (uu) >> 8, n_ = ((uu) & 255) >> 2, h_ = (uu) & 3; \
        _Pragma("unroll") for (int it = 0; it < 2; ++it) { const int id = it * NTHREADS + tid, ch = id & 15, pr = id >> 4; \
            _Pragma("unroll") for (int e = 0; e < 2; ++e) { const int i = 2 * pr + e; long row; \
                if (n_ == 0) row = (i < 112) ? -1 : (long)NTOK + i - 112; else row = (long)b_ * SEQ + (n_ - 1) * 128 + i; \
                kr[it][e] = (u32x4){0u, 0u, 0u, 0u}; if (row >= 0) kr[it][e] = *(const u32x4*)(RK + (size_t)row * 512 + h_ * 128 + ch * 8); } } \
        _Pragma("unroll") for (int it = 0; it < 4; ++it) { const int id = it * NTHREADS + tid, ch = id & 31, pr = id >> 5; \
            _Pragma("unroll") for (int e = 0; e < 2; ++e) { const int i = 2 * pr + e; long row; \
                if (n_ == 0) row = (i < 112) ? -1 : (long)NTOK + i - 112; else row = (long)b_ * SEQ + (n_ - 1) * 128 + i; \
                vr[it][e] = (u32x4){0u, 0u, 0u, 0u}; if (row >= 0) vr[it][e] = *(const u32x4*)(RV + (size_t)row * 1024 + h_ * 256 + ch * 8); } } } while (0)
    int u = blockIdx.x;
    if (u >= 1024) return;
    const int G = gridDim.x;
    KV_LOAD_UNIT(u);
    for (; u < 1024; u += G) {
        const int b = u >> 8, n = (u & 255) >> 2, h = u & 3;
        const float lg2 = log2f(1.0f - exp2f(-5.0f - (float)h));
        __syncthreads();
#pragma unroll
        for (int it = 0; it < 2; ++it) { const int id = it * NTHREADS + tid, ch = id & 15, pr = id >> 4;
            const float f0 = 0.08838834764831845f * __builtin_amdgcn_exp2f(lg2 * (float)(127 - 2 * pr)), f1 = 0.08838834764831845f * __builtin_amdgcn_exp2f(lg2 * (float)(126 - 2 * pr));
            tr_write8s(lds + KT_OFF, RS, ch * 8, pr, scale8(kr[it][0], f0), scale8(kr[it][1], f1)); }
#pragma unroll
        for (int it = 0; it < 4; ++it) { const int id = it * NTHREADS + tid, ch = id & 31, pr = id >> 5;
            tr_write8s(lds + VT_OFF, RS, ch * 8, pr, vr[it][0], vr[it][1]); }
        __syncthreads();
        { const int un = (u + G < 1024) ? u + G : u; KV_LOAD_UNIT(un); }
        const int mt = w;
        bf16x8 a[4];
#pragma unroll
        for (int ks = 0; ks < 4; ++ks) a[ks] = *(const LAS bf16x8*)(lds + KT_OFF + tr_off(16 * mt + r, RS, 8 * ks + 2 * q));
        bf16_t* dst = KVS + kvs_slot(b, n, h);
#pragma unroll 2
        for (int ntp = 0; ntp < 8; ++ntp) {
            u32x2 ov[2];
#pragma unroll
            for (int e = 0; e < 2; ++e) {
                const int nt = 2 * ntp + e;
                f32x4 acc = (f32x4){0.f, 0.f, 0.f, 0.f};
#pragma unroll
                for (int ks = 0; ks < 4; ++ks) { const bf16x8 bb = *(const LAS bf16x8*)(lds + VT_OFF + tr_off(16 * nt + r, RS, 8 * ks + 2 * q)); acc = MFMA16(a[ks], bb, acc); }
                ov[e].x = cvt_pk_bf16(acc[0], acc[1]); ov[e].y = cvt_pk_bf16(acc[2], acc[3]);
            }
            const u32x2 ox = __builtin_amdgcn_permlane16_swap(ov[0].x, ov[1].x, false, false), oy = __builtin_amdgcn_permlane16_swap(ov[0].y, ov[1].y, false, false);
            const int row = 16 * (2 * ntp + (q & 1)) + r, dk0 = 16 * mt + 4 * (q & ~1);
            *(u32x4*)(dst + (size_t)row * 128 + dk0) = (u32x4){ox.x, oy.x, ox.y, oy.y};
        }
    }
#undef KV_LOAD_UNIT
}

__device__ __forceinline__ void scan_phase(const Args& p) {
    bf16_t* KVS = (bf16_t*)((unsigned char*)p.out + DOUT_KVS);
    for (int gid = blockIdx.x * NTHREADS + threadIdx.x; gid < 16 * 8192; gid += gridDim.x * NTHREADS) {
        const int bh = gid >> 13, b = bh >> 2, h = bh & 3, off = (gid & 8191) * 4;
        const float dec = exp2f(128.0f * log2f(1.0f - exp2f(-5.0f - (float)h)));
        float s0 = 0.f, s1 = 0.f, s2 = 0.f, s3 = 0.f;
        bf16_t* base = KVS + kvs_slot(b, 0, h) + off;
        for (int n0 = 0; n0 < 64; n0 += 16) {
            u32x2 v[16];
#pragma unroll
            for (int j = 0; j < 16; ++j) v[j] = *(const u32x2*)(base + (size_t)(n0 + j) * 4 * 32768);
#pragma unroll
            for (int j = 0; j < 16; ++j) {
                s0 = dec * s0 + bf_lo(v[j].x); s1 = dec * s1 + bf_hi(v[j].x); s2 = dec * s2 + bf_lo(v[j].y); s3 = dec * s3 + bf_hi(v[j].y);
                u32x2 o; o.x = cvt_pk_bf16(s0, s1); o.y = cvt_pk_bf16(s2, s3);
                *(u32x2*)(base + (size_t)(n0 + j) * 4 * 32768) = o;
            }
        }
    }
}

__device__ __forceinline__ void retout_phase(LAS unsigned char* lds, const Args& p) {
    int tid_ = threadIdx.x; asm volatile("" : "+v"(tid_));
    const int tid = tid_, lane = tid & 63, w = __builtin_amdgcn_readfirstlane(tid >> 6), r = lane & 15, q = lane >> 4;
    const bf16_t* RQ = (const bf16_t*)(p.ws + OFF_RQ); const bf16_t* RK = (const bf16_t*)(p.ws + OFF_RK); const bf16_t* RV = (const bf16_t*)(p.ws + OFF_RV); const bf16_t* RG = (const bf16_t*)(p.ws + OFF_RG);
    const bf16_t* KVS = (const bf16_t*)((unsigned char*)p.out + DOUT_KVS);
    bf16_t* YRET = (bf16_t*)(p.ws + OFF_YRET);
    constexpr int RS = 136, K_OFF = 0, SB = 128 * RS * 2, QSZ = 64 * RS * 2;
    const int G = gridDim.x, vch = tid & 7, vpr = tid >> 3, srow = tid >> 4, sch = tid & 15;
    const LAS unsigned char* vlb = lds + SB + r * RS * 2 + ((q ^ (2 * (r >> 3))) << 3);
    u32x4 kreg[4], vreg[2], sreg[2], qn[4];
#define RO_LOAD_KQ(uu) do { const int b_ = (uu) >> 8, c_ = 1 + (((uu) & 255) >> 2), h_ = (uu) & 3; const size_t tb_ = (size_t)b_ * SEQ + (size_t)(c_ - 1) * 128; \
        _Pragma("unroll") for (int it = 0; it < 4; ++it) kreg[it] = *(const u32x4*)(RK + (tb_ + 32 * it + srow) * 512 + h_ * 128 + sch * 8); } while (0)
#define RO_LOAD_Q(uu) do { const int b_ = (uu) >> 8, c_ = 1 + (((uu) & 255) >> 2), h_ = (uu) & 3; const size_t tb_ = (size_t)b_ * SEQ + (size_t)(c_ - 1) * 128; \
        _Pragma("unroll") for (int ks = 0; ks < 4; ++ks) qn[ks] = *(const u32x4*)(RQ + (tb_ + 16 * w + r) * 512 + h_ * 128 + 32 * ks + 8 * q); } while (0)
#define RO_LOAD_STAGE(uu, sg) do { const int b_ = (uu) >> 8, c_ = 1 + (((uu) & 255) >> 2), h_ = (uu) & 3; const size_t tb_ = (size_t)b_ * SEQ + (size_t)(c_ - 1) * 128; \
        const bf16_t* st_ = KVS + kvs_slot(b_, c_ - 1, h_) + (size_t)(64 * (sg)) * 128; \
        vreg[0] = *(const u32x4*)(RV + (tb_ + 2 * vpr) * 1024 + h_ * 256 + 64 * (sg) + vch * 8); vreg[1] = *(const u32x4*)(RV + (tb_ + 2 * vpr + 1) * 1024 + h_ * 256 + 64 * (sg) + vch * 8); \
        sreg[0] = *(const u32x4*)(st_ + (size_t)srow * 128 + sch * 8); sreg[1] = *(const u32x4*)(st_ + (size_t)(32 + srow) * 128 + sch * 8); } while (0)
#define RO_WRITE_K() do { _Pragma("unroll") for (int it = 0; it < 4; ++it) *(LAS u32x4*)(lds + K_OFF + ((32 * it + srow) * RS + sch * 8) * 2) = kreg[it]; } while (0)
#define RO_WRITE_STAGE(j) do { tr_write8s(lds + SB + 2 * (j) * QSZ, RS, vch * 8, vpr, vreg[0], vreg[1]); \
        *(LAS u32x4*)(lds + SB + (2 * (j) + 1) * QSZ + (srow * RS + sch * 8) * 2) = sreg[0]; *(LAS u32x4*)(lds + SB + (2 * (j) + 1) * QSZ + ((32 + srow) * RS + sch * 8) * 2) = sreg[1]; } while (0)
    int u = blockIdx.x;
    if (u >= 1024) return;
    RO_LOAD_KQ(u); RO_LOAD_Q(u); RO_LOAD_STAGE(u, 0);
    __syncthreads();
    RO_WRITE_K(); RO_WRITE_STAGE(0);
    __syncthreads();
    for (; u < 1024; u += G) {
        const int b = u >> 8, c = 1 + ((u & 255) >> 2), h = u & 3, un = (u + G < 1024) ? u + G : u;
        const size_t tokbase = (size_t)b * SEQ + (size_t)(c - 1) * 128;
        const float lg2 = log2f(1.0f - exp2f(-5.0f - (float)h));
        const int iq = 16 * w + r; const size_t qrow = tokbase + iq;
        bf16x8 Qd[4]; u32x2 Pk[8]; f32x4 o[16];
        {
#pragma unroll
            for (int kt = 0; kt < 8; ++kt) {
                {
                    f32x4 acc = (f32x4){0.f, 0.f, 0.f, 0.f};
#pragma unroll
                    for (int ks = 0; ks < 4; ++ks) { const bf16x8 a = *(const LAS bf16x8*)(lds + K_OFF + ((16 * kt + r) * RS + 32 * ks + 8 * q) * 2); acc = MFMA16(a, as_frag(qn[ks]), acc); }
#pragma unroll
                    for (int i = 0; i < 4; ++i) { const int d = iq - (16 * kt + 4 * q + i); acc[i] = (d >= 0) ? acc[i] * 0.08838834764831845f * __builtin_amdgcn_exp2f(lg2 * (float)d) : 0.f; }
                    Pk[kt].x = cvt_pk_bf16(acc[0], acc[1]); Pk[kt].y = cvt_pk_bf16(acc[2], acc[3]);
                }
                if (kt & 1) __builtin_amdgcn_sched_barrier(0);
            }
            const float qdec = __builtin_amdgcn_exp2f(lg2 * (float)(iq + 1));
#pragma unroll
            for (int ks = 0; ks < 4; ++ks) Qd[ks] = as_frag(scale8(qn[ks], qdec));
        }
#pragma unroll
        for (int sg = 0; sg < 4; ++sg) {
            if (sg < 3) RO_LOAD_STAGE(u, sg + 1); else { RO_LOAD_KQ(un); RO_LOAD_STAGE(un, 0); }
            const int bo = 2 * (sg & 1) * QSZ;
#pragma unroll
            for (int j = 0; j < 4; ++j) {
                f32x4 acc = (f32x4){0.f, 0.f, 0.f, 0.f};
#pragma unroll
                for (int ks = 0; ks < 4; ++ks) { const bf16x8 a = *(const LAS bf16x8*)(lds + SB + bo + QSZ + ((16 * j + r) * RS + 32 * ks + 8 * q) * 2); acc = MFMA16(a, Qd[ks], acc); }
#pragma unroll
                for (int kp = 0; kp < 4; ++kp) {
                    {
                        const u32x2 a0 = *(const LAS u32x2*)(vlb + bo + 16 * j * RS * 2 + ((((kp ^ (j >> 1)) << 3) | ((0 ^ (j & 1)) << 2)) << 3));
                        const u32x2 a1 = *(const LAS u32x2*)(vlb + bo + 16 * j * RS * 2 + ((((kp ^ (j >> 1)) << 3) | ((1 ^ (j & 1)) << 2)) << 3));
                        const u32x4 a = (u32x4){a0.x, a0.y, a1.x, a1.y}, bb = (u32x4){Pk[2 * kp].x, Pk[2 * kp].y, Pk[2 * kp + 1].x, Pk[2 * kp + 1].y};
                        acc = MFMA16(as_frag(a), as_frag(bb), acc);
                    }
                }
                o[sg * 4 + j] = acc;
                if (j & 1) __builtin_amdgcn_sched_barrier(0);
            }
            if (sg == 3) RO_WRITE_K();
            RO_WRITE_STAGE((sg + 1) & 1);
            __syncthreads();
        }
        RO_LOAD_Q(un);
        float ss = 0.f;
#pragma unroll
        for (int t = 0; t < 16; ++t) ss += (o[t][0] * o[t][0] + o[t][1] * o[t][1]) + (o[t][2] * o[t][2] + o[t][3] * o[t][3]);
        ss += __shfl_xor(ss, 16); ss += __shfl_xor(ss, 32);
        const float rstd = 1.f / sqrtf(ss * (1.f / 256.f) + EPS);
        const int qodd = q & 1;
#pragma unroll
        for (int tp = 0; tp < 8; ++tp) {
            const int t0 = 2 * tp, t1 = 2 * tp + 1;
            const int dvw = 32 * tp + (qodd ? 16 + 4 * (q - 1) : 4 * q);
            const u32x4 gw = *(const u32x4*)(RG + qrow * 1024 + h * 256 + dvw);
            const u32x2 sx = __builtin_amdgcn_permlane16_swap(gw.x, gw.z, false, false), sy = __builtin_amdgcn_permlane16_swap(gw.y, gw.w, false, false);
            const f32x4 g0 = *(const f32x4*)(p.ret_g + h * 256 + 16 * t0 + 4 * q), g1 = *(const f32x4*)(p.ret_g + h * 256 + 16 * t1 + 4 * q);
            u32x2 ov0, ov1;
            { const float x0 = bf_lo(sx.x), x1 = bf_hi(sx.x), x2 = bf_lo(sy.x), x3 = bf_hi(sy.x);
              ov0.x = cvt_pk_bf16(o[t0][0] * rstd * g0.x * x0 * sigmoidf_(x0), o[t0][1] * rstd * g0.y * x1 * sigmoidf_(x1));
              ov0.y = cvt_pk_bf16(o[t0][2] * rstd * g0.z * x2 * sigmoidf_(x2), o[t0][3] * rstd * g0.w * x3 * sigmoidf_(x3)); }
            { const float x0 = bf_lo(sx.y), x1 = bf_hi(sx.y), x2 = bf_lo(sy.y), x3 = bf_hi(sy.y);
              ov1.x = cvt_pk_bf16(o[t1][0] * rstd * g1.x * x0 * sigmoidf_(x0), o[t1][1] * rstd * g1.y * x1 * sigmoidf_(x1));
              ov1.y = cvt_pk_bf16(o[t1][2] * rstd * g1.z * x2 * sigmoidf_(x2), o[t1][3] * rstd * g1.w * x3 * sigmoidf_(x3)); }
            const u32x2 ox = __builtin_amdgcn_permlane16_swap(ov0.x, ov1.x, false, false), oy = __builtin_amdgcn_permlane16_swap(ov0.y, ov1.y, false, false);
            *(u32x4*)(YRET + qrow * 1024 + h * 256 + dvw) = (u32x4){ox.x, oy.x, ox.y, oy.y};
        }
    }
#undef RO_LOAD_KQ
#undef RO_LOAD_Q
#undef RO_LOAD_STAGE
#undef RO_WRITE_K
#undef RO_WRITE_STAGE
}

__device__ __forceinline__ void meta_proj(const Args& p, const bf16_t* XN, const bf16_t* WinT) {
    int tid_ = threadIdx.x; asm volatile("" : "+v"(tid_));
    const int tid = tid_, lane = tid & 63, r = lane & 15, q = lane >> 4;
    if ((tid >> 6) != 0) return;
    for (int t = blockIdx.x; t < 128; t += gridDim.x) {
        int ncol, ld, cl; size_t boff;
        if (t < 32) { ncol = 512 + 16 * t; boff = OFF_RK; ld = 512; cl = 16 * t; }
        else if (t < 96) { ncol = 1024 + 16 * (t - 32); boff = OFF_RV; ld = 1024; cl = 16 * (t - 32); }
        else if (t < 112) { ncol = 4096 + 16 * (t - 96); boff = OFF_SK; ld = 256; cl = 16 * (t - 96); }
        else { ncol = 4352 + 16 * (t - 112); boff = OFF_SV; ld = 256; cl = 16 * (t - 112); }
        const bf16_t* ap = WinT + (size_t)(ncol + r) * DM + 8 * q; const bf16_t* bp = XN + (size_t)(NTOK + r) * DM + 8 * q;
        f32x4 acc = (f32x4){0.f, 0.f, 0.f, 0.f};
#pragma unroll 8
        for (int ks = 0; ks < 32; ++ks) { const u32x4 a = *(const u32x4*)(ap + 32 * ks), b = *(const u32x4*)(bp + 32 * ks); acc = MFMA16(as_frag(a), as_frag(b), acc); }
        u32x2 o; o.x = cvt_pk_bf16(acc[0], acc[1]); o.y = cvt_pk_bf16(acc[2], acc[3]);
        *(u32x2*)((bf16_t*)(p.ws + boff) + (size_t)(NTOK + r) * ld + cl + 4 * q) = o;
    }
}

#define XB_TMO      128
#define XB_XCNT(j)  (256  + 64 * (j))
#define XB_XSUB(j)  (1280 + 64 * (j))
#define XB_XGEN(j)  (2304 + 64 * (j))
#define XB_TOP      3328
#define XB_TOPGEN   3392
#define XCD_BAR_WORDS 3456
#define XB_SPIN_CAP (1u << 22)
__device__ __forceinline__ unsigned xb_ld(unsigned* p)              { return __hip_atomic_load(p, __ATOMIC_RELAXED, __HIP_MEMORY_SCOPE_AGENT); }
__device__ __forceinline__ unsigned xb_add(unsigned* p, unsigned v) { return __hip_atomic_fetch_add(p, v, __ATOMIC_RELAXED, __HIP_MEMORY_SCOPE_AGENT); }
__device__ __forceinline__ unsigned xb_xcc_id() { return (unsigned)__builtin_amdgcn_s_getreg((3 << 11) | 20) & 0xFu; }
#define XB_SPIN(cond, bar) do { unsigned _sp = 0; while (cond) { __builtin_amdgcn_s_sleep(1); \
    if ((++_sp & 255u) == 0u) { if (xb_ld(&(bar)[XB_TMO])) break; if (_sp > XB_SPIN_CAP) { atomicAdd(&(bar)[XB_TMO], 1u); break; } } } } while (0)
struct XcdBarrier { unsigned* bar; unsigned x; volatile LAS unsigned* st; };
__device__ __forceinline__ XcdBarrier xcd_barrier_post(unsigned* bar, volatile LAS unsigned* st) {
    XcdBarrier b; b.bar = bar; b.x = xb_xcc_id(); b.st = st;
    if (threadIdx.x == 0) (void)xb_add(&bar[XB_XCNT(b.x)], 1u);
    return b;
}
__device__ __forceinline__ void xcd_barrier_complete(unsigned* bar, unsigned x, unsigned& nloc, unsigned& nx) {
    const unsigned G = gridDim.x * gridDim.y * gridDim.z;
    unsigned sum, cnt, mine, sp = 0u;
    for (;;) {
        sum = 0u; cnt = 0u; mine = 0u;
#pragma unroll
        for (unsigned j = 0; j < 16; ++j) { const unsigned c = xb_ld(&bar[XB_XCNT(j)]); sum += c; cnt += (c > 0u) ? 1u : 0u; mine = (j == x) ? c : mine; }
        if (sum == G) break;
        __builtin_amdgcn_s_sleep(1);
        if ((++sp & 255u) == 0u) { if (xb_ld(&bar[XB_TMO])) break; if (sp > XB_SPIN_CAP) { atomicAdd(&bar[XB_TMO], 1u); break; } }
    }
    nloc = mine > 0u ? mine : 1u; nx = cnt > 0u ? cnt : 1u;
}
__device__ __forceinline__ void xcd_barrier(const XcdBarrier& b) {
    asm volatile("s_waitcnt vmcnt(0)" ::: "memory");
    __syncthreads();
    if (threadIdx.x == 0) {
        unsigned* bar = b.bar;
        __builtin_amdgcn_s_waitcnt(0);
        unsigned nloc = b.st[0], nx = b.st[1];
        if (nloc == 0u) { xcd_barrier_complete(bar, b.x, nloc, nx); b.st[0] = nloc; b.st[1] = nx; }
        const unsigned old = xb_add(&bar[XB_XSUB(b.x)], 1u);
        const unsigned gen = old / nloc;
        if (old + 1u == (gen + 1u) * nloc) {
            __builtin_amdgcn_fence(__ATOMIC_RELEASE, "agent");
            asm volatile("s_waitcnt vmcnt(0)" ::: "memory");
            const unsigned og = xb_add(&bar[XB_TOP], 1u);
            const unsigned tg = og / nx;
            if (og + 1u == (tg + 1u) * nx) xb_add(&bar[XB_TOPGEN], 1u);
            else XB_SPIN(xb_ld(&bar[XB_TOPGEN]) == tg, bar);
            __builtin_amdgcn_fence(__ATOMIC_ACQUIRE, "agent");
            xb_add(&bar[XB_XGEN(b.x)], 1u);
            asm volatile("s_waitcnt vmcnt(0)" ::: "memory");
        } else {
            XB_SPIN(xb_ld(&bar[XB_XGEN(b.x)]) == gen, bar);
            __builtin_amdgcn_fence(__ATOMIC_ACQUIRE, "agent");
            asm volatile("s_waitcnt vmcnt(0)" ::: "memory");
        }
    }
    __syncthreads();
}

__device__ __forceinline__ void convert_slot(const Args& p, LAS unsigned char* lds, const int list) {
    const unsigned grp = (blockIdx.x >> 3) & 3u;
    if (grp == 0u) return;
    int tid_ = threadIdx.x; asm volatile("" : "+v"(tid_));
    const int tid = tid_, lane = tid & 63, wave = __builtin_amdgcn_readfirstlane(tid >> 6);
    constexpr int I_SQ = (DM / 64) * (DM / 32), I_UP = (DM / 64) * (FF / 32), I_DN = (FF / 64) * (DM / 32);
    const int total = list == 0 ? 3 * I_SQ + I_UP : I_DN;
    const int lo = grp == 1u ? 0 : (grp == 2u ? total / 6 : total / 2), hi = grp == 1u ? total / 6 : (grp == 2u ? total / 2 : total);
    const int j = (int)(((blockIdx.x >> 5) << 3) | (blockIdx.x & 7u));
    LAS float* scr = (LAS float*)(lds + wave * 16384);
    unsigned char* ws = p.ws;
    for (int it = lo + j * 8 + wave; it < hi; it += 512) {
        if (list == 0) {
            int r = it;
            if (r < I_SQ) { p0_transpose_item(p.w_ret, DM, DM, (bf16_t*)(ws + OFF_WRET), scr, r, lane); continue; } r -= I_SQ;
            if (r < I_SQ) { p0_transpose_item(p.w_swa, DM, DM, (bf16_t*)(ws + OFF_WSWA), scr, r, lane); continue; } r -= I_SQ;
            if (r < I_SQ) { p0_transpose_item(p.w_out, DM, DM, (bf16_t*)(ws + OFF_WOUT), scr, r, lane); continue; } r -= I_SQ;
            p0_transpose_item(p.w_up, DM, FF, (bf16_t*)(ws + OFF_WUP), scr, r, lane, p.mlp_g);
        } else p0_transpose_item(p.w_down, FF, DM, (bf16_t*)(ws + OFF_WDN), scr, it, lane);
    }
    __syncthreads();
}

__global__ void __launch_bounds__(NTHREADS, 2) fwd_megakernel(Args p) {
    extern __shared__ __attribute__((aligned(16))) unsigned char lds_raw[];
    LAS unsigned char* lds = (LAS unsigned char*)lds_raw;
    cg::grid_group grid = cg::this_grid();
    ((LAS unsigned*)(lds + 131072 + 64))[threadIdx.x & 15] = 0u;
    __syncthreads();
    XcdBarrier xbar = xcd_barrier_post((unsigned*)(p.ws + OFF_CTL), (volatile LAS unsigned*)(lds + 131072 + 64));
    grid.sync();
#define GRID_SYNC() xcd_barrier(xbar)
    const int tid = threadIdx.x, lane = tid & 63, wave = __builtin_amdgcn_readfirstlane(tid >> 6);
    const int G = gridDim.x, gw = blockIdx.x * 8 + wave, NGW = G * 8;
    unsigned char* ws = p.ws;
    bf16_t* WinT = (bf16_t*)(ws + OFF_WIN); bf16_t* WretT = (bf16_t*)(ws + OFF_WRET); bf16_t* WswaT = (bf16_t*)(ws + OFF_WSWA); bf16_t* WoutT = (bf16_t*)(ws + OFF_WOUT);
    bf16_t* WupT = (bf16_t*)(ws + OFF_WUP); bf16_t* WdnT = (bf16_t*)(ws + OFF_WDN);
    bf16_t* XN = (bf16_t*)p.out;

    for (int rep = 0; rep < 1 + ((REP_MASK >> 0) & 1); ++rep) {
        LAS float* scr = (LAS float*)(lds + wave * 16384);
        constexpr int I_IN = (DM / 64) * (DIN / 32), I_SQ = (DM / 64) * (DM / 32), I_UP = (DM / 64) * (FF / 32), I_DN = (FF / 64) * (DM / 32);
        constexpr int NITEMS = I_IN + 3 * I_SQ + I_UP + I_DN;
        const bool split = (G == 256);
        for (int it = gw; it < (split ? I_IN : NITEMS); it += NGW) {
            int r = it;
            if (r < I_IN) { p0_transpose_item(p.w_in, DM, DIN, WinT, scr, r, lane); continue; } r -= I_IN;
            if (r < I_SQ) { p0_transpose_item(p.w_ret, DM, DM, WretT, scr, r, lane); continue; } r -= I_SQ;
            if (r < I_SQ) { p0_transpose_item(p.w_swa, DM, DM, WswaT, scr, r, lane); continue; } r -= I_SQ;
            if (r < I_SQ) { p0_transpose_item(p.w_out, DM, DM, WoutT, scr, r, lane); continue; } r -= I_SQ;
            if (r < I_UP) { p0_transpose_item(p.w_up, DM, FF, WupT, scr, r, lane, p.mlp_g); continue; } r -= I_UP;
            p0_transpose_item(p.w_down, FF, DM, WdnT, scr, r, lane);
        }
        for (int m = gw; m < NTOK; m += 2 * NGW) {
            const int m2 = m + NGW;
            const f32x4* xa = (const f32x4*)(p.x + (size_t)m * DM) + 2 * lane; const f32x4* xb = (const f32x4*)(p.x + (size_t)(m2 < NTOK ? m2 : m) * DM) + 2 * lane; const f32x4* gr = (const f32x4*)p.mix_g + 2 * lane;
            f32x4 va[4], vb[4]; float sa = 0.f, sb = 0.f;
#pragma unroll
            for (int j = 0; j < 4; ++j) { va[j] = xa[(j & 1) + 128 * (j >> 1)]; vb[j] = xb[(j & 1) + 128 * (j >> 1)]; }
#pragma unroll
            for (int j = 0; j < 4; ++j) { sa += (va[j].x * va[j].x + va[j].y * va[j].y) + (va[j].z * va[j].z + va[j].w * va[j].w); sb += (vb[j].x * vb[j].x + vb[j].y * vb[j].y) + (vb[j].z * vb[j].z + vb[j].w * vb[j].w); }
            const float ra = 1.f / sqrtf(wave_sum(sa) * (1.f / DM) + EPS), rb = 1.f / sqrtf(wave_sum(sb) * (1.f / DM) + EPS);
            u32x4* oa = (u32x4*)(XN + (size_t)m * DM) + lane; u32x4* ob = (u32x4*)(XN + (size_t)m2 * DM) + lane;
#pragma unroll
            for (int jj = 0; jj < 2; ++jj) { const f32x4 g0 = gr[128 * jj], g1 = gr[128 * jj + 1]; const f32x4 a0 = va[2 * jj], a1 = va[2 * jj + 1], b0 = vb[2 * jj], b1 = vb[2 * jj + 1];
                u32x4 wa; wa.x = cvt_pk_bf16_asm(a0.x * ra * g0.x, a0.y * ra * g0.y); wa.y = cvt_pk_bf16_asm(a0.z * ra * g0.z, a0.w * ra * g0.w); wa.z = cvt_pk_bf16_asm(a1.x * ra * g1.x, a1.y * ra * g1.y); wa.w = cvt_pk_bf16_asm(a1.z * ra * g1.z, a1.w * ra * g1.w);
                oa[64 * jj] = wa;
                if (m2 < NTOK) { u32x4 wb; wb.x = cvt_pk_bf16_asm(b0.x * rb * g0.x, b0.y * rb * g0.y); wb.y = cvt_pk_bf16_asm(b0.z * rb * g0.z, b0.w * rb * g0.w); wb.z = cvt_pk_bf16_asm(b1.x * rb * g1.x, b1.y * rb * g1.y); wb.w = cvt_pk_bf16_asm(b1.z * rb * g1.z, b1.w * rb * g1.w);
                    ob[64 * jj] = wb; } }
        }
        if (gw < NMETA) rms_row_to_bf16(p.meta + (size_t)gw * DM, p.mix_g, XN + (size_t)(NTOK + gw) * DM, lane);
    }
    GRID_SYNC();
    {
        meta_proj(p, XN, WinT);
        if (G == 256) convert_slot(p, lds, 0);
        pg8::Gemm g{XN, WinT, XN, WinT, NTOK, DIN, DM}; pg8::StaticOrder S; S.init(NTOK, DIN, G, (int)blockIdx.x);
        pg8::EpiProj E{ws};
        pg8::gemm_phase<pg8::EpiProj, pg8::StaticOrder, true>(lds, g, S, E);
    }
    GRID_SYNC();
    for (int rep = 0; rep < 1 + ((REP_MASK >> 1) & 1); ++rep) { swa_phase(lds, p); kvlocal_phase(lds, p); }
    GRID_SYNC();
    scan_phase(p);
    GRID_SYNC();
    for (int rep = 0; rep < 1 + ((REP_MASK >> 2) & 1); ++rep) retout_phase(lds, p);
    GRID_SYNC();
    {
        const bf16_t* YRET = (const bf16_t*)(ws + OFF_YRET); const bf16_t* YSWA = (const bf16_t*)((unsigned char*)p.out + DOUT_YSWA);
        pg8::Gemm g{YRET, WretT, YSWA, WswaT, NTOK, DM, DM}; pg8::PairOrder S; S.s.init(NTOK, DM, G, (int)blockIdx.x);
        pg8::EpiMerged E{(const unsigned char*)(ws + OFF_GR), (const unsigned char*)(ws + OFF_GS), (bf16_t*)(ws + OFF_MERGED)};
        pg8::gemm_phase<pg8::EpiMerged, pg8::PairOrder, true>(lds, g, S, E);
    }
    GRID_SYNC();
    {
        const bf16_t* MG = (const bf16_t*)(ws + OFF_MERGED);
        pg8::Gemm g{MG, WoutT, MG, WoutT, NTOK, DM, DM}; pg8::StaticOrder S; S.init(NTOK, DM, G, (int)blockIdx.x);
        pg8::EpiResStat E{p.x, p.out, (bf16_t*)(ws + OFF_HN2), (float*)(ws + OFF_SS)};
        pg8::gemm_phase<pg8::EpiResStat, pg8::StaticOrder, true>(lds, g, S, E);
    }
    GRID_SYNC();
    {
        const bf16_t* HN2 = (const bf16_t*)(ws + OFF_HN2);
        pg8::Gemm g{HN2, WupT, HN2, WupT, NTOK, FF, DM}; pg8::StaticOrder S; S.init(NTOK, FF, G, (int)blockIdx.x);
        pg8::EpiUp E{(bf16_t*)(ws + OFF_U), (const float*)(ws + OFF_SS)};
        if (G == 256) convert_slot(p, lds, 1);
        pg8::gemm_phase<pg8::EpiUp, pg8::StaticOrder, true>(lds, g, S, E);
    }
    GRID_SYNC();
    {
        const bf16_t* U = (const bf16_t*)(ws + OFF_U);
        pg8::Gemm g{U, WdnT, U, WdnT, NTOK, DM, FF}; pg8::StaticOrder S; S.init(NTOK, DM, G, (int)blockIdx.x);
        pg8::EpiResBf E{(const bf16_t*)(ws + OFF_HN2), p.out};
        pg8::gemm_phase<pg8::EpiResBf, pg8::StaticOrder, true>(lds, g, S, E);
    }
}

extern "C" void kernel_launch(void* const* d_in, const int* in_sizes, int n_in, void* d_out, int out_size, void* d_ws, size_t ws_size, hipStream_t stream) {
    static int grid = 0;
    if (grid == 0) {
        if (n_in != 14 || in_sizes[0] != NTOK * DM || out_size != NTOK * DM || ws_size < WS_NEED) {
            fprintf(stderr, "kernel_launch: unexpected shapes (n_in %d, in0 %d, out %d, ws %zu, need %zu); nothing launched\n", n_in, n_in > 0 ? in_sizes[0] : -1, out_size, ws_size, (size_t)WS_NEED); grid = -1; return; }
        int dev = 0, cus = 0, per_cu = 0;
        (void)hipGetDevice(&dev); (void)hipDeviceGetAttribute(&cus, hipDeviceAttributeMultiprocessorCount, dev);
        if (hipFuncSetAttribute((const void*)fwd_megakernel, hipFuncAttributeMaxDynamicSharedMemorySize, LDS_BYTES) != hipSuccess) { fprintf(stderr, "kernel_launch: hipFuncSetAttribute failed\n"); grid = -1; return; }
        if (hipOccupancyMaxActiveBlocksPerMultiprocessor(&per_cu, (const void*)fwd_megakernel, NTHREADS, LDS_BYTES) != hipSuccess || per_cu < 1) { fprintf(stderr, "kernel_launch: occupancy query gave %d\n", per_cu); per_cu = 1; }
        (void)hipGetLastError();
        grid = cus * per_cu;
    }
    if (grid < 0) return;
    Args a{};
    a.x = (const float*)d_in[0]; a.meta = (const float*)d_in[1]; a.mix_g = (const float*)d_in[2]; a.w_in = (const float*)d_in[3]; a.ret_g = (const float*)d_in[4];
    a.q_g = (const float*)d_in[5]; a.k_g = (const float*)d_in[6]; a.sinks = (const float*)d_in[7]; a.w_ret = (const float*)d_in[8]; a.w_swa = (const float*)d_in[9];
    a.w_out = (const float*)d_in[10]; a.mlp_g = (const float*)d_in[11]; a.w_up = (const float*)d_in[12]; a.w_down = (const float*)d_in[13];
    a.out = (float*)d_out; a.ws = (unsigned char*)d_ws;
    if (hipMemsetAsync((unsigned char*)d_ws + OFF_CTL, 0, CTL_BYTES, stream) != hipSuccess) { fprintf(stderr, "kernel_launch: memset failed\n"); return; }
    void* args[] = {&a};
    hipError_t e = hipLaunchCooperativeKernel((const void*)fwd_megakernel, dim3(grid), dim3(NTHREADS), args, LDS_BYTES, stream);
    if (e != hipSuccess) fprintf(stderr, "kernel_launch: cooperative launch failed: %s (grid %d)\n", hipGetErrorString(e), grid);
}
```

```cpp
#ifndef REP_MASK
#define REP_MASK 0
#endif
#include <hip/hip_runtime.h>
#include <hip/hip_cooperative_groups.h>
#include <cstdio>
#include <cstdint>
namespace cg = cooperative_groups;

#define LAS __attribute__((address_space(3)))
typedef unsigned short bf16_t;
typedef short bf16x8 __attribute__((ext_vector_type(8)));
typedef float f32x4 __attribute__((ext_vector_type(4)));
typedef unsigned u32x4 __attribute__((ext_vector_type(4)));
typedef unsigned u32x2 __attribute__((ext_vector_type(2)));

constexpr int NB = 4, SEQ = 8192, DM = 1024, NTOK = NB * SEQ, NMETA = 16, MROWS = NTOK + NMETA, MPAD = 33024, DIN = 6656, FF = 4096;
constexpr float EPS = 1e-6f;
constexpr int NTHREADS = 512;
constexpr int LDS_BYTES = 135168;

constexpr size_t SZ_WIN = (size_t)DIN * DM * 2, SZ_WSQ = (size_t)DM * DM * 2, SZ_WFF = (size_t)FF * DM * 2;
constexpr size_t OFF_WIN = 0, OFF_WRET = OFF_WIN + SZ_WIN, OFF_WSWA = OFF_WRET + SZ_WSQ, OFF_WOUT = OFF_WSWA + SZ_WSQ, OFF_WUP = OFF_WOUT + SZ_WSQ, OFF_WDN = OFF_WUP + SZ_WFF;
constexpr size_t OFF_RQ = OFF_WDN + SZ_WFF;
constexpr size_t OFF_RK = OFF_RQ + (size_t)MROWS * 512 * 2;
constexpr size_t OFF_RV = OFF_RK + (size_t)MROWS * 512 * 2;
constexpr size_t OFF_RG = OFF_RV + (size_t)MROWS * 1024 * 2;
constexpr size_t OFF_SQ = OFF_RG + (size_t)MROWS * 1024 * 2;
constexpr size_t OFF_SK = OFF_SQ + (size_t)MROWS * 1024 * 2;
constexpr size_t OFF_SV = OFF_SK + (size_t)MROWS * 256 * 2;
constexpr size_t OFF_GR = OFF_SV + (size_t)MROWS * 256 * 2;
constexpr size_t OFF_GS = OFF_GR + (size_t)MROWS * 1024 * 2;
constexpr size_t OFF_CTL = OFF_GS + (size_t)MROWS * 1024 * 2;
constexpr size_t CTL_BYTES = 16384 + (size_t)NTOK * 4;
constexpr size_t OFF_SS = OFF_CTL + 16384;
constexpr size_t WS_NEED = OFF_CTL + CTL_BYTES;
constexpr size_t OFF_MERGED = OFF_RQ, OFF_HN2 = OFF_RV, OFF_YRET = OFF_SQ, OFF_U = OFF_RG;
static_assert(OFF_RK - OFF_RQ + OFF_RV - OFF_RK >= (size_t)NTOK * 1024 * 2, "MERGED fits");
static_assert(OFF_CTL - OFF_RG >= (size_t)NTOK * FF * 2, "U fits");
static_assert((size_t)MPAD * DM * 2 <= (size_t)NTOK * DM * 4, "XN fits d_out");
constexpr size_t DOUT_KVS = 0, DOUT_YSWA = (size_t)NTOK * 1024 * 2;

typedef __bf16 bf16x2_t __attribute__((ext_vector_type(2)));
typedef float f32x2_t __attribute__((ext_vector_type(2)));
__device__ __forceinline__ unsigned cvt_pk_bf16(float lo, float hi) { const f32x2_t v = {lo, hi}; const bf16x2_t b = __builtin_convertvector(v, bf16x2_t); return __builtin_bit_cast(unsigned, b); }
__device__ __forceinline__ unsigned cvt_pk_bf16_asm(float lo, float hi) { unsigned r; asm volatile("v_cvt_pk_bf16_f32 %0, %1, %2" : "=v"(r) : "v"(lo), "v"(hi)); return r; }
__device__ __forceinline__ float bf_lo(unsigned w) { return __uint_as_float(w << 16); }
__device__ __forceinline__ float bf_hi(unsigned w) { return __uint_as_float(w & 0xffff0000u); }
__device__ __forceinline__ float wave_sum(float v) {
#pragma unroll
    for (int o = 1; o < 64; o <<= 1) v += __shfl_xor(v, o);
    return v;
}
__device__ __forceinline__ float sigmoidf_(float x) { return __builtin_amdgcn_rcpf(1.0f + __builtin_amdgcn_exp2f(-1.4426950408889634f * x)); }

namespace pg8 {
constexpr int BM = 256, BK = 64, HALF = 128, HTB = HALF * BK * 2, STAGE_BYTES = 8 * HTB, NXCD = 8, WGM = 8;
__host__ __device__ __forceinline__ int lds_byte(int r, int c) { const int st = (r >> 4) * 2 + (c >> 5), rr = r & 15, cc = c & 31, ob = rr * 64 + cc * 2; return st * 1024 + (ob ^ (((ob >> 9) & 1) << 5)); }
__host__ __device__ __forceinline__ void stage_rc(int b, int& R, int& C) { const int st = b / 1024, sb = b % 1024, swz = sb ^ (((sb >> 9) & 1) << 5); R = (st >> 1) * 16 + swz / 64; C = (st & 1) * 32 + (swz % 64) / 2; }
__host__ __device__ __forceinline__ int perm32(int rho) { const int n = rho >> 4, i = rho & 15; return 8 * (i >> 2) + 4 * n + (i & 3); }

struct Unit { int pm, pn, seg; };
struct Gemm { const bf16_t* A; const bf16_t* Bt; const bf16_t* A2; const bf16_t* Bt2; int M, N, K; };

struct StaticOrder {
    int nM, nN, nwg, G, c;
    __device__ void init(int M, int N, int G_, int c_) { nM = M / BM; nN = N / BM; nwg = nM * nN; G = G_; c = c_; }
    __device__ bool tile(long L, Unit& u) const {
        if (L >= nwg) return false;
        int wgid = (int)L; { const int q = nwg / NXCD, r = nwg % NXCD, xcd = wgid % NXCD, off = wgid / NXCD; wgid = (xcd < r ? xcd * (q + 1) : r * (q + 1) + (xcd - r) * q) + off; }
        const int nig = WGM * nN, gid = wgid / nig, fm = gid * WGM, gsz = (nM - fm) < WGM ? (nM - fm) : WGM;
        u.pm = fm + ((wgid % nig) % gsz); u.pn = (wgid % nig) / gsz; u.seg = 0; return true;
    }
    __device__ bool next(int i, Unit& u) const { return tile((long)i * G + c, u); }
};
struct PairOrder {
    StaticOrder s;
    __device__ bool next(int i, Unit& u) const { const bool ok = s.tile((long)(i >> 1) * s.G + s.c, u); u.seg = i & 1; return ok; }
};

struct EpiProj {
    static constexpr bool PERM = true, HAS_MID = false;
    unsigned char* ws;
    __device__ __forceinline__ void mid(f32x4 (&acc)[2][2][4][2], const Unit& u, int wr, int wc, int fr, int fq) const {}
    __device__ __forceinline__ void operator()(const f32x4 (&acc)[2][2][4][2], const Unit& u, int wr, int wc, int fr, int fq) const {
        const int pn = u.pn; size_t boff; int ld, ct;
        if (pn < 2) { boff = OFF_RQ; ld = 512; ct = pn; }
        else if (pn < 4) { boff = OFF_RK; ld = 512; ct = pn - 2; }
        else if (pn < 8) { boff = OFF_RV; ld = 1024; ct = pn - 4; }
        else if (pn < 12) { boff = OFF_RG; ld = 1024; ct = pn - 8; }
        else if (pn < 16) { boff = OFF_SQ; ld = 1024; ct = pn - 12; }
        else if (pn == 16) { boff = OFF_SK; ld = 256; ct = 0; }
        else if (pn == 17) { boff = OFF_SV; ld = 256; ct = 0; }
        else if (pn < 22) { boff = OFF_GR; ld = 1024; ct = pn - 18; }
        else { boff = OFF_GS; ld = 1024; ct = pn - 22; }
        bf16_t* base = (bf16_t*)(ws + boff);
        const int row0 = u.pm * BM + wr * 64 + fr, col0 = ct * 256 + wc * 32 + 8 * fq;
        if (pn >= 18) {
            unsigned char* gb = ws + boff;
            const int colw = ct * 256 + wc * 32 + ((fq & 1) ? HALF + 8 * (fq - 1) : 8 * fq);
#pragma unroll
            for (int ai = 0; ai < 2; ++ai)
#pragma unroll
                for (int m = 0; m < 4; ++m) {
                    unsigned w[2][2];
#pragma unroll
                    for (int bj = 0; bj < 2; ++bj) { const f32x4 v0 = acc[ai][bj][m][0], v1 = acc[ai][bj][m][1];
                        int w0 = __builtin_amdgcn_cvt_pk_fp8_f32(v0[0], v0[1], 0, false); w0 = __builtin_amdgcn_cvt_pk_fp8_f32(v0[2], v0[3], w0, true);
                        int w1 = __builtin_amdgcn_cvt_pk_fp8_f32(v1[0], v1[1], 0, false); w1 = __builtin_amdgcn_cvt_pk_fp8_f32(v1[2], v1[3], w1, true);
                        w[bj][0] = (unsigned)w0; w[bj][1] = (unsigned)w1; }
                    const u32x2 sx = __builtin_amdgcn_permlane16_swap(w[0][0], w[1][0], false, false), sy = __builtin_amdgcn_permlane16_swap(w[0][1], w[1][1], false, false);
                    *(u32x4*)(gb + (size_t)(row0 + ai * HALF + m * 16) * 1024 + colw) = (u32x4){sx.x, sy.x, sx.y, sy.y};
                }
            return;
        }
#pragma unroll
        for (int ai = 0; ai < 2; ++ai)
#pragma unroll
            for (int m = 0; m < 4; ++m) {
                bf16_t* rowp = base + (size_t)(row0 + ai * HALF + m * 16) * ld + col0;
#pragma unroll
                for (int bj = 0; bj < 2; ++bj) { const f32x4 v0 = acc[ai][bj][m][0], v1 = acc[ai][bj][m][1];
                    u32x4 w; w.x = cvt_pk_bf16_asm(v0[0], v0[1]); w.y = cvt_pk_bf16_asm(v0[2], v0[3]); w.z = cvt_pk_bf16_asm(v1[0], v1[1]); w.w = cvt_pk_bf16_asm(v1[2], v1[3]);
                    *(u32x4*)(rowp + bj * HALF) = w; } }
    }
};
struct EpiMerged {
    static constexpr bool PERM = true, HAS_MID = true;
    const unsigned char *GR, *GS; bf16_t* O;
#define F8(w, k) __builtin_amdgcn_cvt_f32_fp8((int)(w), (k))
    __device__ __forceinline__ void mid(f32x4 (&acc)[2][2][4][2], const Unit& u, int wr, int wc, int fr, int fq) const {
        const int row0 = u.pm * BM + wr * 64 + fr, colw = u.pn * BM + wc * 32 + ((fq & 1) ? HALF + 8 * (fq - 1) : 8 * fq);
#pragma unroll
        for (int ai = 0; ai < 2; ++ai)
#pragma unroll
            for (int m = 0; m < 4; ++m) { const size_t off = (size_t)(row0 + ai * HALF + m * 16) * DM + colw;
                const u32x4 ga = *(const u32x4*)(GR + off), gb = *(const u32x4*)(GS + off);
                const u32x2 ax = __builtin_amdgcn_permlane16_swap(ga.x, ga.z, false, false), ay = __builtin_amdgcn_permlane16_swap(ga.y, ga.w, false, false);
                const u32x2 bx = __builtin_amdgcn_permlane16_swap(gb.x, gb.z, false, false), by = __builtin_amdgcn_permlane16_swap(gb.y, gb.w, false, false);
#define MRG_R(ga_, gb_) ((1.0f + __builtin_amdgcn_exp2f(-1.4426950408889634f * (gb_))) * __builtin_amdgcn_rcpf(1.0f + __builtin_amdgcn_exp2f(-1.4426950408889634f * (ga_))))
#pragma unroll
                for (int bj = 0; bj < 2; ++bj) { const unsigned a0 = bj ? ax.y : ax.x, a1 = bj ? ay.y : ay.x, b0 = bj ? bx.y : bx.x, b1 = bj ? by.y : by.x;
                    f32x4 r0, r1;
                    r0[0] = MRG_R(F8(a0, 0), F8(b0, 0)); r0[1] = MRG_R(F8(a0, 1), F8(b0, 1)); r0[2] = MRG_R(F8(a0, 2), F8(b0, 2)); r0[3] = MRG_R(F8(a0, 3), F8(b0, 3));
                    r1[0] = MRG_R(F8(a1, 0), F8(b1, 0)); r1[1] = MRG_R(F8(a1, 1), F8(b1, 1)); r1[2] = MRG_R(F8(a1, 2), F8(b1, 2)); r1[3] = MRG_R(F8(a1, 3), F8(b1, 3));
                    acc[ai][bj][m][0] = acc[ai][bj][m][0] * r0; acc[ai][bj][m][1] = acc[ai][bj][m][1] * r1; }
#undef MRG_R
            }
    }
    __device__ __forceinline__ void operator()(const f32x4 (&acc)[2][2][4][2], const Unit& u, int wr, int wc, int fr, int fq) const {
        const int row0 = u.pm * BM + wr * 64 + fr, col0 = u.pn * BM + wc * 32 + 8 * fq, colw = u.pn * BM + wc * 32 + ((fq & 1) ? HALF + 8 * (fq - 1) : 8 * fq);
#pragma unroll
        for (int ai = 0; ai < 2; ++ai)
#pragma unroll
            for (int m = 0; m < 4; ++m) { const size_t rowoff = (size_t)(row0 + ai * HALF + m * 16) * DM;
                const u32x4 gb = *(const u32x4*)(GS + rowoff + colw);
                const u32x2 bx = __builtin_amdgcn_permlane16_swap(gb.x, gb.z, false, false), by = __builtin_amdgcn_permlane16_swap(gb.y, gb.w, false, false);
#pragma unroll
                for (int bj = 0; bj < 2; ++bj) { const unsigned b0 = bj ? bx.y : bx.x, b1 = bj ? by.y : by.x; const f32x4 v0 = acc[ai][bj][m][0], v1 = acc[ai][bj][m][1];
                    u32x4 w;
                    w.x = cvt_pk_bf16_asm(v0[0] * sigmoidf_(F8(b0, 0)), v0[1] * sigmoidf_(F8(b0, 1))); w.y = cvt_pk_bf16_asm(v0[2] * sigmoidf_(F8(b0, 2)), v0[3] * sigmoidf_(F8(b0, 3)));
                    w.z = cvt_pk_bf16_asm(v1[0] * sigmoidf_(F8(b1, 0)), v1[1] * sigmoidf_(F8(b1, 1))); w.w = cvt_pk_bf16_asm(v1[2] * sigmoidf_(F8(b1, 2)), v1[3] * sigmoidf_(F8(b1, 3)));
                    *(u32x4*)(O + rowoff + col0 + bj * HALF) = w; }
            }
    }
#undef F8
};
struct EpiRes {
    static constexpr bool PERM = true, HAS_MID = false;
    const float* res; float* out;
    __device__ __forceinline__ void mid(f32x4 (&acc)[2][2][4][2], const Unit& u, int wr, int wc, int fr, int fq) const {}
    __device__ __forceinline__ void operator()(const f32x4 (&acc)[2][2][4][2], const Unit& u, int wr, int wc, int fr, int fq) const {
        const int row0 = u.pm * BM + wr * 64 + fr, col0 = u.pn * BM + wc * 32 + 8 * fq;
#pragma unroll
        for (int ai = 0; ai < 2; ++ai)
#pragma unroll
            for (int m = 0; m < 4; ++m)
#pragma unroll
                for (int bj = 0; bj < 2; ++bj) { const size_t off = (size_t)(row0 + ai * HALF + m * 16) * DM + col0 + bj * HALF;
                    const f32x4 x0 = *(const f32x4*)(res + off), x1 = *(const f32x4*)(res + off + 4);
                    *(f32x4*)(out + off) = x0 + acc[ai][bj][m][0]; *(f32x4*)(out + off + 4) = x1 + acc[ai][bj][m][1]; }
    }
};
struct EpiResStat {
    static constexpr bool PERM = true, HAS_MID = false;
    const float* res; float* out; bf16_t* hb; float* ss;
    __device__ __forceinline__ void mid(f32x4 (&acc)[2][2][4][2], const Unit& u, int wr, int wc, int fr, int fq) const {}
    __device__ __forceinline__ void operator()(const f32x4 (&acc)[2][2][4][2], const Unit& u, int wr, int wc, int fr, int fq) const {
        const int row0 = u.pm * BM + wr * 64 + fr, col0 = u.pn * BM + wc * 32 + 8 * fq;
#pragma unroll
        for (int ai = 0; ai < 2; ++ai)
#pragma unroll
            for (int m = 0; m < 4; ++m) {
                float sq = 0.f;
#pragma unroll
                for (int bj = 0; bj < 2; ++bj) { const size_t off = (size_t)(row0 + ai * HALF + m * 16) * DM + col0 + bj * HALF;
                    const f32x4 h0 = *(const f32x4*)(res + off) + acc[ai][bj][m][0], h1 = *(const f32x4*)(res + off + 4) + acc[ai][bj][m][1];
                    u32x4 w; w.x = cvt_pk_bf16_asm(h0[0], h0[1]); w.y = cvt_pk_bf16_asm(h0[2], h0[3]); w.z = cvt_pk_bf16_asm(h1[0], h1[1]); w.w = cvt_pk_bf16_asm(h1[2], h1[3]);
                    *(u32x4*)(hb + off) = w;
                    sq += (h0[0] * h0[0] + h0[1] * h0[1]) + (h0[2] * h0[2] + h0[3] * h0[3]) + (h1[0] * h1[0] + h1[1] * h1[1]) + (h1[2] * h1[2] + h1[3] * h1[3]); }
                sq += __shfl_xor(sq, 16); sq += __shfl_xor(sq, 32);
                if (fq == 0) atomicAdd(ss + row0 + ai * HALF + m * 16, sq);
            }
    }
};
struct EpiResBf {
    static constexpr bool PERM = true, HAS_MID = false;
    const bf16_t* hb; float* out;
    __device__ __forceinline__ void mid(f32x4 (&acc)[2][2][4][2], const Unit& u, int wr, int wc, int fr, int fq) const {}
    __device__ __forceinline__ void operator()(const f32x4 (&acc)[2][2][4][2], const Unit& u, int wr, int wc, int fr, int fq) const {
        const int row0 = u.pm * BM + wr * 64 + fr, col0 = u.pn * BM + wc * 32 + 8 * fq;
#pragma unroll
        for (int ai = 0; ai < 2; ++ai)
#pragma unroll
            for (int m = 0; m < 4; ++m)
#pragma unroll
                for (int bj = 0; bj < 2; ++bj) { const size_t off = (size_t)(row0 + ai * HALF + m * 16) * DM + col0 + bj * HALF;
                    const u32x4 h = *(const u32x4*)(hb + off);
                    const f32x4 x0 = (f32x4){bf_lo(h.x), bf_hi(h.x), bf_lo(h.y), bf_hi(h.y)}, x1 = (f32x4){bf_lo(h.z), bf_hi(h.z), bf_lo(h.w), bf_hi(h.w)};
                    *(f32x4*)(out + off) = x0 + acc[ai][bj][m][0]; *(f32x4*)(out + off + 4) = x1 + acc[ai][bj][m][1]; }
    }
};
struct EpiUp {
    static constexpr bool PERM = true, HAS_MID = false;
    bf16_t* O; const float* ss;
    __device__ __forceinline__ void mid(f32x4 (&acc)[2][2][4][2], const Unit& u, int wr, int wc, int fr, int fq) const {}
    __device__ __forceinline__ void operator()(const f32x4 (&acc)[2][2][4][2], const Unit& u, int wr, int wc, int fr, int fq) const {
        const int row0 = u.pm * BM + wr * 64 + fr, col0 = u.pn * BM + wc * 32 + 8 * fq;
#pragma unroll
        for (int ai = 0; ai < 2; ++ai)
#pragma unroll
            for (int m = 0; m < 4; ++m) {
                const float rstd = 1.f / sqrtf(ss[row0 + ai * HALF + m * 16] * (1.f / DM) + EPS);
#pragma unroll
                for (int bj = 0; bj < 2; ++bj) { const size_t off = (size_t)(row0 + ai * HALF + m * 16) * FF + col0 + bj * HALF;
                    f32x4 v0 = acc[ai][bj][m][0], v1 = acc[ai][bj][m][1];
#pragma unroll
                    for (int e = 0; e < 4; ++e) { const float a = fmaxf(v0[e] * rstd, 0.f), b = fmaxf(v1[e] * rstd, 0.f); v0[e] = a * a; v1[e] = b * b; }
                    u32x4 w; w.x = cvt_pk_bf16_asm(v0[0], v0[1]); w.y = cvt_pk_bf16_asm(v0[2], v0[3]); w.z = cvt_pk_bf16_asm(v1[0], v1[1]); w.w = cvt_pk_bf16_asm(v1[2], v1[3]);
                    *(u32x4*)(O + off) = w; }
            }
    }
};

template <class Epi, class Sched, bool ALIGN_EPI>
__device__ __forceinline__ void gemm_phase(LAS unsigned char* lds, const Gemm g, const Sched& S, const Epi& E) {
    int tid_ = threadIdx.x; asm volatile("" : "+v"(tid_));
    const int tid = tid_, wid = __builtin_amdgcn_readfirstlane(tid >> 6), lane = tid & 63, wr = wid >> 2, wc = wid & 3, fr = lane & 15, fq = lane >> 4;
    const int K = g.K, nt = K / BK;
    unsigned voffA[2], voffB[2];
#pragma unroll
    for (int i = 0; i < 2; ++i) { int R, C; stage_rc(tid * 16 + i * 8192, R, C); const int Rb = Epi::PERM ? ((R & ~31) + perm32(R & 31)) : R;
        voffA[i] = (unsigned)(R * K + C) * 2u; voffB[i] = (unsigned)(Rb * K + C) * 2u; }
    const size_t kstep = (size_t)(BK * 2);
    const size_t hstep = (size_t)HALF * K * 2;
    const size_t tstep = 2 * hstep;
    const unsigned ldsw = (unsigned)wid * 1024u;
    const int aoff = lds_byte(wr * 64 + fr, fq * 8), boff = lds_byte(wc * 32 + fr, fq * 8);
#define PG8_SA(b, h) (((b) * 2 + (h)) * HTB)
#define PG8_SB(b, h) ((4 + (b) * 2 + (h)) * HTB)
#define PG8_STAGE(bufoff, gbase, voff) do { _Pragma("unroll") for (int _i = 0; _i < 2; ++_i) \
        __builtin_amdgcn_global_load_lds((const unsigned*)((const char*)(gbase) + (voff)[_i]), (LAS unsigned*)(lds + (bufoff) + ldsw + _i * 8192), 16, 0, 0); } while (0)
#define PG8_LDA(dst, b, h) do { _Pragma("unroll") for (int m = 0; m < 4; ++m) _Pragma("unroll") for (int k = 0; k < 2; ++k) dst[m][k] = *(const LAS bf16x8*)(lds + PG8_SA(b, h) + aoff + m * 2048 + k * 1024); } while (0)
#define PG8_LDB(dst, b, h) do { _Pragma("unroll") for (int n = 0; n < 2; ++n) _Pragma("unroll") for (int k = 0; k < 2; ++k) dst[n][k] = *(const LAS bf16x8*)(lds + PG8_SB(b, h) + boff + n * 2048 + k * 1024); } while (0)
#define PG8_MMA(ai, bj, At, Bt) do { __builtin_amdgcn_s_setprio(1); _Pragma("unroll") for (int m = 0; m < 4; ++m) _Pragma("unroll") for (int n = 0; n < 2; ++n) _Pragma("unroll") for (int k = 0; k < 2; ++k) \
        acc[ai][bj][m][n] = __builtin_amdgcn_mfma_f32_16x16x32_bf16(Bt[n][k], At[m][k], acc[ai][bj][m][n], 0, 0, 0); __builtin_amdgcn_s_setprio(0); } while (0)
#define PG8_WAIT_V(n) asm volatile("s_waitcnt vmcnt(" #n ")" ::: "memory")
#define PG8_WAIT_L(n) asm volatile("s_waitcnt lgkmcnt(" #n ")" ::: "memory")
#define PG8_BAR __builtin_amdgcn_s_barrier()
#define PG8_SCHED __builtin_amdgcn_sched_barrier(0)
    Unit cur, nxt; int ui = 0;
    if (!S.next(0, cur)) return;
    f32x4 acc[2][2][4][2];
#pragma unroll
    for (int a = 0; a < 2; ++a)
#pragma unroll
        for (int b = 0; b < 2; ++b)
#pragma unroll
            for (int m = 0; m < 4; ++m)
#pragma unroll
                for (int n = 0; n < 2; ++n) acc[a][b][m][n] = (f32x4){0.f, 0.f, 0.f, 0.f};
    bf16x8 At[4][2], B0[2][2], B1[2][2];
    const char* cA = (const char*)(cur.seg ? g.A2 : g.A) + (size_t)cur.pm * tstep; const char* cB = (const char*)(cur.seg ? g.Bt2 : g.Bt) + (size_t)cur.pn * tstep;
    PG8_STAGE(PG8_SB(0, 0), cB, voffB); PG8_STAGE(PG8_SB(0, 1), cB + hstep, voffB); PG8_STAGE(PG8_SA(0, 0), cA, voffA); PG8_STAGE(PG8_SA(0, 1), cA + hstep, voffA);
    if (wr == 1) PG8_BAR;
    PG8_WAIT_V(2); PG8_BAR;
    PG8_STAGE(PG8_SB(1, 0), cB + kstep, voffB); PG8_STAGE(PG8_SA(1, 0), cA + kstep, voffA); PG8_STAGE(PG8_SB(1, 1), cB + hstep + kstep, voffB);
    PG8_WAIT_V(6); PG8_BAR;
    for (;;) {
        const bool has_next = S.next(ui + 1, nxt);
        const char* nA = has_next ? (const char*)(nxt.seg ? g.A2 : g.A) + (size_t)nxt.pm * tstep : cA; const char* nB = has_next ? (const char*)(nxt.seg ? g.Bt2 : g.Bt) + (size_t)nxt.pn * tstep : cB;
        for (int t = 0; t < nt; t += 2) {
            const bool last = (t == nt - 2);
            const char* a1 = cA + (size_t)(t + 1) * kstep;
            const char* a2 = last ? nA : cA + (size_t)(t + 2) * kstep; const char* b2 = last ? nB : cB + (size_t)(t + 2) * kstep;
            const char* a3 = a2 + kstep; const char* b3 = b2 + kstep;
            PG8_LDB(B0, 0, 0); PG8_LDB(B1, 0, 1); PG8_SCHED; PG8_LDA(At, 0, 0); PG8_STAGE(PG8_SA(1, 1), a1 + hstep, voffA);
            PG8_WAIT_V(8); PG8_WAIT_L(0); PG8_BAR; PG8_MMA(0, 0, At, B0); PG8_MMA(0, 1, At, B1); PG8_BAR; PG8_SCHED;
            PG8_LDA(At, 0, 1); PG8_STAGE(PG8_SB(0, 0), b2, voffB); PG8_STAGE(PG8_SB(0, 1), b2 + hstep, voffB); PG8_STAGE(PG8_SA(0, 0), a2, voffA);
            PG8_WAIT_V(8); PG8_WAIT_L(0); PG8_BAR; PG8_MMA(1, 0, At, B0); PG8_MMA(1, 1, At, B1); PG8_BAR; PG8_SCHED;
            PG8_LDB(B0, 1, 0); PG8_LDB(B1, 1, 1); PG8_SCHED; PG8_LDA(At, 1, 0); PG8_STAGE(PG8_SA(0, 1), a2 + hstep, voffA);
            PG8_WAIT_V(8); PG8_WAIT_L(0); PG8_BAR; PG8_MMA(0, 0, At, B0); PG8_MMA(0, 1, At, B1); PG8_BAR; PG8_SCHED;
            PG8_LDA(At, 1, 1); PG8_STAGE(PG8_SB(1, 0), b3, voffB); PG8_STAGE(PG8_SB(1, 1), b3 + hstep, voffB); PG8_STAGE(PG8_SA(1, 0), a3, voffA);
            PG8_WAIT_V(8); PG8_WAIT_L(0); PG8_BAR; PG8_MMA(1, 0, At, B0); PG8_MMA(1, 1, At, B1); PG8_BAR; PG8_SCHED;
        }
        if constexpr (ALIGN_EPI) { if (wr == 0) PG8_BAR; }
        bool keep = false;
        if constexpr (Epi::HAS_MID) keep = (cur.seg == 0);
        if (keep) E.mid(acc, cur, wr, wc, fr, fq); else E(acc, cur, wr, wc, fr, fq);
        if (!has_next) break;
        if (!keep) {
#pragma unroll
            for (int a = 0; a < 2; ++a)
#pragma unroll
                for (int b = 0; b < 2; ++b)
#pragma unroll
                    for (int m = 0; m < 4; ++m)
#pragma unroll
                        for (int n = 0; n < 2; ++n) acc[a][b][m][n] = (f32x4){0.f, 0.f, 0.f, 0.f};
        }
        cur = nxt; cA = nA; cB = nB; ++ui;
        if constexpr (ALIGN_EPI) { if (wr == 1) PG8_BAR; }
    }
    PG8_WAIT_V(0);
    if constexpr (!ALIGN_EPI) { if (wr == 0) PG8_BAR; }
    PG8_BAR;
#undef PG8_SA
#undef PG8_SB
#undef PG8_STAGE
#undef PG8_LDA
#undef PG8_LDB
#undef PG8_MMA
#undef PG8_WAIT_V
#undef PG8_WAIT_L
#undef PG8_BAR
#undef PG8_SCHED
}
}

struct Args {
    const float *x, *meta, *mix_g, *w_in, *ret_g, *q_g, *k_g, *sinks, *w_ret, *w_swa, *w_out, *mlp_g, *w_up, *w_down;
    float* out; unsigned char* ws;
};

__device__ __forceinline__ void p0_transpose_item(const float* W, int K, int N, bf16_t* WT, LAS float* scr, int item, int lane, const float* kgain = nullptr) {
    const int nblk = N / 32, kb = item / nblk, nb = item % nblk, k0 = 64 * kb, n0 = 32 * nb;
    f32x4 wv[8];
#pragma unroll
    for (int i = 0; i < 8; ++i) wv[i] = *(const f32x4*)(W + (size_t)(k0 + 8 * i + (lane >> 3)) * N + n0 + 4 * (lane & 7));
#pragma unroll
    for (int i = 0; i < 8; ++i) { const int kk = 8 * i + (lane >> 3); f32x4 v = wv[i]; if (kgain) v = v * kgain[k0 + kk];
        LAS float* d = scr + kk * 33 + 4 * (lane & 7); d[0] = v.x; d[1] = v.y; d[2] = v.z; d[3] = v.w; }
    asm volatile("s_waitcnt lgkmcnt(0)" ::: "memory");
    const int c = lane & 7;
#pragma unroll
    for (int j = 0; j < 4; ++j) { const int n = (lane >> 3) + 8 * j; const LAS float* s = scr + (8 * c) * 33 + n;
        u32x4 o; o.x = cvt_pk_bf16_asm(s[0 * 33], s[1 * 33]); o.y = cvt_pk_bf16_asm(s[2 * 33], s[3 * 33]); o.z = cvt_pk_bf16_asm(s[4 * 33], s[5 * 33]); o.w = cvt_pk_bf16_asm(s[6 * 33], s[7 * 33]);
        *(u32x4*)(WT + (size_t)(n0 + n) * K + k0 + 8 * c) = o; }
    asm volatile("s_waitcnt lgkmcnt(0)" ::: "memory");
}
__device__ __forceinline__ void rms_row_to_bf16(const float* xrow, const float* g, bf16_t* orow, int lane) {
    const f32x4* xr = (const f32x4*)xrow + lane; const f32x4* gr = (const f32x4*)g + lane;
    f32x4 v[4]; float s = 0.f;
#pragma unroll
    for (int j = 0; j < 4; ++j) { v[j] = xr[64 * j]; s += (v[j].x * v[j].x + v[j].y * v[j].y) + (v[j].z * v[j].z + v[j].w * v[j].w); }
    const float rstd = 1.f / sqrtf(wave_sum(s) * (1.f / DM) + EPS);
    u32x2* o8 = (u32x2*)orow + lane;
#pragma unroll
    for (int j = 0; j < 4; ++j) { const f32x4 gg = gr[64 * j]; u32x2 w; w.x = cvt_pk_bf16_asm(v[j].x * rstd * gg.x, v[j].y * rstd * gg.y); w.y = cvt_pk_bf16_asm(v[j].z * rstd * gg.z, v[j].w * rstd * gg.w); o8[64 * j] = w; }
}

__device__ __forceinline__ void tr_write8(LAS unsigned char* base, int RS, int col0, int pp, u32x4 r0, u32x4 r1) {
#define TRW(i, w0, w1) *(LAS unsigned*)(base + ((size_t)(col0 + (i)) * RS + 2 * pp) * 2) = ((i) & 1) ? (((w0) >> 16) | ((w1) & 0xffff0000u)) : (((w0) & 0xffffu) | ((w1) << 16))
    TRW(0, r0.x, r1.x); TRW(1, r0.x, r1.x); TRW(2, r0.y, r1.y); TRW(3, r0.y, r1.y); TRW(4, r0.z, r1.z); TRW(5, r0.z, r1.z); TRW(6, r0.w, r1.w); TRW(7, r0.w, r1.w);
#undef TRW
}

__device__ __forceinline__ int tr_off(int col, int RS, int slot) { return col * RS * 2 + ((slot ^ (2 * ((col >> 3) & 15))) << 3); }
__device__ __forceinline__ void tr_write8s(LAS unsigned char* base, int RS, int col0, int pp, u32x4 r0, u32x4 r1) {
    const int sw2 = 2 * ((col0 >> 3) & 15), po = (((pp >> 1) ^ sw2) << 3) + ((pp & 1) << 2);
#define TRW(i, w0, w1) *(LAS unsigned*)(base + (col0 + (i)) * RS * 2 + po) = ((i) & 1) ? (((w0) >> 16) | ((w1) & 0xffff0000u)) : (((w0) & 0xffffu) | ((w1) << 16))
    TRW(0, r0.x, r1.x); TRW(1, r0.x, r1.x); TRW(2, r0.y, r1.y); TRW(3, r0.y, r1.y); TRW(4, r0.z, r1.z); TRW(5, r0.z, r1.z); TRW(6, r0.w, r1.w); TRW(7, r0.w, r1.w);
#undef TRW
}
__device__ __forceinline__ u32x4 scale8(u32x4 r, float f) {
    u32x4 o; o.x = cvt_pk_bf16(bf_lo(r.x) * f, bf_hi(r.x) * f); o.y = cvt_pk_bf16(bf_lo(r.y) * f, bf_hi(r.y) * f); o.z = cvt_pk_bf16(bf_lo(r.z) * f, bf_hi(r.z) * f); o.w = cvt_pk_bf16(bf_lo(r.w) * f, bf_hi(r.w) * f); return o;
}
__device__ __forceinline__ bf16x8 as_frag(u32x4 v) { return __builtin_bit_cast(bf16x8, v); }
#define MFMA16(a, b, c) __builtin_amdgcn_mfma_f32_16x16x32_bf16((a), (b), (c), 0, 0, 0)

__device__ __forceinline__ long swa_key_row(int b, int c, int kk) {
    if (kk < 16) return (long)NTOK + kk;
    if (kk < 272) { const int s = (c - 1) * 128 + (kk - 16); if (s >= 128) return (long)b * SEQ + s - 128; }
    return -1;
}
__device__ __forceinline__ void swa_phase(LAS unsigned char* lds, const Args& p) {
    int tid_ = threadIdx.x; asm volatile("" : "+v"(tid_));
    const int tid = tid_, lane = tid & 63, w = __builtin_amdgcn_readfirstlane(tid >> 6), r = lane & 15, q = lane >> 4;
    const bf16_t* SQ = (const bf16_t*)(p.ws + OFF_SQ); const bf16_t* SK = (const bf16_t*)(p.ws + OFF_SK); const bf16_t* SV = (const bf16_t*)(p.ws + OFF_SV);
    bf16_t* YSWA = (bf16_t*)((unsigned char*)p.out + DOUT_YSWA);
    constexpr int KS = 72, VS = 296, K_OFF = 0, VT_OFF = 288 * KS * 2;
    constexpr float LOG2E = 1.4426950408889634f;
    const int kch = tid & 7, G = gridDim.x;
    const f32x4 kg0 = *(const f32x4*)(p.k_g + kch * 8), kg1 = *(const f32x4*)(p.k_g + kch * 8 + 4);
    u32x4 kraw[5], vraw[6];
#define SWA_LOAD_UNIT(uu) do { const int b_ = (uu) >> 8, c_ = 1 + (((uu) & 255) >> 2), kvh_ = (uu) & 3; \
        _Pragma("unroll") for (int it = 0; it < 5; ++it) { const int kk = (it * NTHREADS + tid) >> 3; const long row = swa_key_row(b_, c_, kk); \
            kraw[it] = (u32x4){0u, 0u, 0u, 0u}; if (row >= 0) kraw[it] = *(const u32x4*)(SK + (size_t)row * 256 + kvh_ * 64 + kch * 8); } \
        _Pragma("unroll") for (int it = 0; it < 3; ++it) { const int id = it * NTHREADS + tid, ch = id / 144, pp = id % 144; \
            _Pragma("unroll") for (int e = 0; e < 2; ++e) { const long row = (id < 1152) ? swa_key_row(b_, c_, 2 * pp + e) : -1; \
                vraw[2 * it + e] = (u32x4){0u, 0u, 0u, 0u}; if (row >= 0) vraw[2 * it + e] = *(const u32x4*)(SV + (size_t)row * 256 + kvh_ * 64 + ch * 8); } } } while (0)
    int u = blockIdx.x;
    if (u >= 1024) return;
    SWA_LOAD_UNIT(u);
    for (; u < 1024; u += G) {
        const int b = u >> 8, c = 1 + ((u & 255) >> 2), kvh = u & 3;
        __syncthreads();
#pragma unroll
        for (int it = 0; it < 5; ++it) {
            const int kk = (it * NTHREADS + tid) >> 3; const u32x4 raw = kraw[it];
            const float f0 = bf_lo(raw.x), f1 = bf_hi(raw.x), f2 = bf_lo(raw.y), f3 = bf_hi(raw.y), f4 = bf_lo(raw.z), f5 = bf_hi(raw.z), f6 = bf_lo(raw.w), f7 = bf_hi(raw.w);
            float ss = (f0 * f0 + f1 * f1) + (f2 * f2 + f3 * f3) + (f4 * f4 + f5 * f5) + (f6 * f6 + f7 * f7);
            ss += __shfl_xor(ss, 1); ss += __shfl_xor(ss, 2); ss += __shfl_xor(ss, 4);
            const float rstd = __builtin_amdgcn_rsqf(ss * (1.f / 64.f) + EPS);
            u32x4 o; o.x = cvt_pk_bf16(f0 * rstd * kg0.x, f1 * rstd * kg0.y); o.y = cvt_pk_bf16(f2 * rstd * kg0.z, f3 * rstd * kg0.w);
            o.z = cvt_pk_bf16(f4 * rstd * kg1.x, f5 * rstd * kg1.y); o.w = cvt_pk_bf16(f6 * rstd * kg1.z, f7 * rstd * kg1.w);
            if (kk < 288) *(LAS u32x4*)(lds + K_OFF + (kk * KS + kch * 8) * 2) = o;
        }
#pragma unroll
        for (int it = 0; it < 3; ++it) { const int id = it * NTHREADS + tid; if (id < 1152) tr_write8(lds + VT_OFF, VS, (id / 144) * 8, id % 144, vraw[2 * it], vraw[2 * it + 1]); }
        __syncthreads();
        const int qt = w, iq = 16 * qt + r;
        const size_t qrow = (size_t)b * SEQ + (size_t)(c - 1) * 128 + iq;
        u32x4 qa = *(const u32x4*)(SQ + qrow * 1024 + (kvh * 4) * 64 + 8 * q), qb = *(const u32x4*)(SQ + qrow * 1024 + (kvh * 4) * 64 + 32 + 8 * q);
        { const int un = (u + G < 1024) ? u + G : u; SWA_LOAD_UNIT(un); }
#pragma unroll 1
        for (int hl = 0; hl < 4; ++hl) {
            const int h = kvh * 4 + hl;
            bf16x8 Qf[2];
            {
                const u32x4 a = qa, bq = qb;
                const int hn = kvh * 4 + ((hl + 1) & 3);
                qa = *(const u32x4*)(SQ + qrow * 1024 + hn * 64 + 8 * q); qb = *(const u32x4*)(SQ + qrow * 1024 + hn * 64 + 32 + 8 * q);
                float fa[8] = {bf_lo(a.x), bf_hi(a.x), bf_lo(a.y), bf_hi(a.y), bf_lo(a.z), bf_hi(a.z), bf_lo(a.w), bf_hi(a.w)};
                float fb[8] = {bf_lo(bq.x), bf_hi(bq.x), bf_lo(bq.y), bf_hi(bq.y), bf_lo(bq.z), bf_hi(bq.z), bf_lo(bq.w), bf_hi(bq.w)};
                float ss = 0.f;
#pragma unroll
                for (int e = 0; e < 8; ++e) ss += fa[e] * fa[e] + fb[e] * fb[e];
                ss += __shfl_xor(ss, 16); ss += __shfl_xor(ss, 32);
                const float rs = (0.125f * LOG2E) * __builtin_amdgcn_rsqf(ss * (1.f / 64.f) + EPS);
                const f32x4 ga0 = *(const f32x4*)(p.q_g + 8 * q), ga1 = *(const f32x4*)(p.q_g + 8 * q + 4), gb0 = *(const f32x4*)(p.q_g + 32 + 8 * q), gb1 = *(const f32x4*)(p.q_g + 32 + 8 * q + 4);
                u32x4 oa, ob;
                oa.x = cvt_pk_bf16(fa[0] * rs * ga0.x, fa[1] * rs * ga0.y); oa.y = cvt_pk_bf16(fa[2] * rs * ga0.z, fa[3] * rs * ga0.w); oa.z = cvt_pk_bf16(fa[4] * rs * ga1.x, fa[5] * rs * ga1.y); oa.w = cvt_pk_bf16(fa[6] * rs * ga1.z, fa[7] * rs * ga1.w);
                ob.x = cvt_pk_bf16(fb[0] * rs * gb0.x, fb[1] * rs * gb0.y); ob.y = cvt_pk_bf16(fb[2] * rs * gb0.z, fb[3] * rs * gb0.w); ob.z = cvt_pk_bf16(fb[4] * rs * gb1.x, fb[5] * rs * gb1.y); ob.w = cvt_pk_bf16(fb[6] * rs * gb1.z, fb[7] * rs * gb1.w);
                Qf[0] = as_frag(oa); Qf[1] = as_frag(ob);
            }
            const float slope2 = exp2f(-0.5f * (float)(h + 1)) * LOG2E, sink2 = p.sinks[h] * LOG2E;
            const float bbase = -slope2 * (float)(144 + r - 4 * q), mbase = -slope2 * (float)(c * 128 + iq - 112 - 4 * q);
            const float sl1 = slope2, sl2 = 2.f * slope2, sl3 = 3.f * slope2;
            const int d0 = 144 + r - 4 * q;
            f32x4 sc[10]; float mx = -1e30f;
#pragma unroll
            for (int t = 0; t < 10; ++t) {
                const int kt = (t == 0) ? 0 : qt + t;
                f32x4 acc = (f32x4){0.f, 0.f, 0.f, 0.f};
#pragma unroll
                for (int ks = 0; ks < 2; ++ks) { const bf16x8 a = *(const LAS bf16x8*)(lds + K_OFF + ((16 * kt + r) * KS + 32 * ks + 8 * q) * 2); acc = MFMA16(a, Qf[ks], acc); }
                const float tb = (t == 0) ? mbase : bbase + slope2 * (float)(16 * t) + ((c == 1 && kt <= 8) ? -1e30f : 0.f);
                acc[0] += tb; acc[1] += tb + sl1; acc[2] += tb + sl2; acc[3] += tb + sl3;
                if (t == 1) {
#pragma unroll
                    for (int i = 0; i < 4; ++i) if (d0 - 16 - i >= 128) acc[i] = -1e30f;
                }
                if (t == 9) {
#pragma unroll
                    for (int i = 0; i < 4; ++i) if (d0 - 144 - i < 0) acc[i] = -1e30f;
                }
                mx = fmaxf(fmaxf(mx, fmaxf(acc[0], acc[1])), fmaxf(acc[2], acc[3]));
                sc[t] = acc;
                if (t == 4) __builtin_amdgcn_sched_barrier(0);
            }
            mx = fmaxf(mx, __shfl_xor(mx, 16)); mx = fmaxf(mx, __shfl_xor(mx, 32)); mx = fmaxf(mx, sink2);
            float sum = 0.f; u32x2 Pk[10];
#pragma unroll
            for (int t = 0; t < 10; ++t) { const float p0 = __builtin_amdgcn_exp2f(sc[t][0] - mx), p1 = __builtin_amdgcn_exp2f(sc[t][1] - mx), p2 = __builtin_amdgcn_exp2f(sc[t][2] - mx), p3 = __builtin_amdgcn_exp2f(sc[t][3] - mx);
                sum += (p0 + p1) + (p2 + p3); Pk[t].x = cvt_pk_bf16(p0, p1); Pk[t].y = cvt_pk_bf16(p2, p3); }
            sum += __shfl_xor(sum, 16); sum += __shfl_xor(sum, 32);
            const float inv = __builtin_amdgcn_rcpf(sum + __builtin_amdgcn_exp2f(sink2 - mx));
#pragma unroll 1
            for (int dtp = 0; dtp < 2; ++dtp) {
                u32x2 ov[2];
#pragma unroll
                for (int e = 0; e < 2; ++e) {
                    const int dt = 2 * dtp + e;
                    f32x4 acc = (f32x4){0.f, 0.f, 0.f, 0.f};
#pragma unroll
                    for (int pr = 0; pr < 5; ++pr) {
                        const int t0 = 2 * pr, t1 = 2 * pr + 1, kt0 = (t0 == 0) ? 0 : qt + t0, kt1 = qt + t1;
                        const LAS unsigned char* vp = lds + VT_OFF + ((16 * dt + r) * VS + 4 * q) * 2;
                        const u32x2 a0 = *(const LAS u32x2*)(vp + 32 * kt0), a1 = *(const LAS u32x2*)(vp + 32 * kt1);
                        const u32x4 a = (u32x4){a0.x, a0.y, a1.x, a1.y}, bb = (u32x4){Pk[t0].x, Pk[t0].y, Pk[t1].x, Pk[t1].y};
                        acc = MFMA16(as_frag(a), as_frag(bb), acc);
                    }
                    ov[e].x = cvt_pk_bf16(acc[0] * inv, acc[1] * inv); ov[e].y = cvt_pk_bf16(acc[2] * inv, acc[3] * inv);
                }
                const int dw = 32 * dtp + ((q & 1) ? 16 + 4 * (q - 1) : 4 * q);
                const u32x2 ox = __builtin_amdgcn_permlane16_swap(ov[0].x, ov[1].x, false, false), oy = __builtin_amdgcn_permlane16_swap(ov[0].y, ov[1].y, false, false);
                *(u32x4*)(YSWA + qrow * 1024 + h * 64 + dw) = (u32x4){ox.x, oy.x, ox.y, oy.y};
            }
        }
    }
#undef SWA_LOAD_UNIT
}

__device__ __forceinline__ size_t kvs_slot(int b, int n, int h) { return ((size_t)((b * 64 + n) * 4 + h)) * 32768; }
__device__ __forceinline__ void kvlocal_phase(LAS unsigned char* lds, const Args& p) {
    int tid_ = threadIdx.x; asm volatile("" : "+v"(tid_));
    const int tid = tid_, lane = tid & 63, w = __builtin_amdgcn_readfirstlane(tid >> 6), r = lane & 15, q = lane >> 4;
    const bf16_t* RK = (const bf16_t*)(p.ws + OFF_RK); const bf16_t* RV = (const bf16_t*)(p.ws + OFF_RV);
    bf16_t* KVS = (bf16_t*)((unsigned char*)p.out + DOUT_KVS);
    constexpr int RS = 136, KT_OFF = 0, VT_OFF = 128 * RS * 2;
    u32x4 kr[2][2], vr[4][2];
#define KV_LOAD_UNIT(uu) do { const int b_ = (uu) >> 8, n_ = ((uu) & 255) >> 2, h_ = (uu) & 3; \
        _Pragma("unroll") for (int it = 0; it < 2; ++it) { const int id = it * NTHREADS + tid, ch = id & 15, pr = id >> 4; \
            _Pragma("unroll") for (int e = 0; e < 2; ++e) { const int i = 2 * pr + e; long row; \
                if (n_ == 0) row = (i < 112) ? -1 : (long)NTOK + i - 112; else row = (long)b_ * SEQ + (n_ - 1) * 128 + i; \
                kr[it][e] = (u32x4){0u, 0u, 0u, 0u}; if (row >= 0) kr[it][e] = *(const u32x4*)(RK + (size_t)row * 512 + h_ * 128 + ch * 8); } } \
        _Pragma("unroll") for (int it = 0; it < 4; ++it) { const int id = it * NTHREADS + tid, ch = id & 31, pr = id >> 5; \
            _Pragma("unroll") for (int e = 0; e < 2; ++e) { const int i = 2 * pr + e; long row; \
                if (n_ == 0) row = (i < 112) ? -1 : (long)NTOK + i - 112; else row = (long)b_ * SEQ + (n_ - 1) * 128 + i; \
                vr[it][e] = (u32x4){0u, 0u, 0u, 0u}; if (row >= 0) vr[it][e] = *(const u32x4*)(RV + (size_t)row * 1024 + h_ * 256 + ch * 8); } } } while (0)
    int u = blockIdx.x;
    if (u >= 1024) return;
    const int G = gridDim.x;
    KV_LOAD_UNIT(u);
    for (; u < 1024; u += G) {
        const int b = u >> 8, n = (u & 255) >> 2, h = u & 3;
        const float lg2 = log2f(1.0f - exp2f(-5.0f - (float)h));
        __syncthreads();
#pragma unroll
        for (int it = 0; it < 2; ++it) { const int id = it * NTHREADS + tid, ch = id & 15, pr = id >> 4;
            const float f0 = 0.08838834764831845f * __builtin_amdgcn_exp2f(lg2 * (float)(127 - 2 * pr)), f1 = 0.08838834764831845f * __builtin_amdgcn_exp2f(lg2 * (float)(126 - 2 * pr));
            tr_write8s(lds + KT_OFF, RS, ch * 8, pr, scale8(kr[it][0], f0), scale8(kr[it][1], f1)); }
#pragma unroll
        for (int it = 0; it < 4; ++it) { const int id = it * NTHREADS + tid, ch = id & 31, pr = id >> 5;
            tr_write8s(lds + VT_OFF, RS, ch * 8, pr, vr[it][0], vr[it][1]); }
        __syncthreads();
        { const int un = (u + G < 1024) ? u + G : u; KV_LOAD_UNIT(un); }
        const int mt = w;
        bf16x8 a[4];
#pragma unroll
        for (int ks = 0; ks < 4; ++ks) a[ks] = *(const LAS bf16x8*)(lds + KT_OFF + tr_off(16 * mt + r, RS, 8 * ks + 2 * q));
        bf16_t* dst = KVS + kvs_slot(b, n, h);
#pragma unroll 2
        for (int ntp = 0; ntp < 8; ++ntp) {
            u32x2 ov[2];
#pragma unroll
            for (int e = 0; e < 2; ++e) {
                const int nt = 2 * ntp + e;
                f32x4 acc = (f32x4){0.f, 0.f, 0.f, 0.f};
#pragma unroll
                for (int ks = 0; ks < 4; ++ks) { const bf16x8 bb = *(const LAS bf16x8*)(lds + VT_OFF + tr_off(16 * nt + r, RS, 8 * ks + 2 * q)); acc = MFMA16(a[ks], bb, acc); }
                ov[e].x = cvt_pk_bf16(acc[0], acc[1]); ov[e].y = cvt_pk_bf16(acc[2], acc[3]);
            }
            const u32x2 ox = __builtin_amdgcn_permlane16_swap(ov[0].x, ov[1].x, false, false), oy = __builtin_amdgcn_permlane16_swap(ov[0].y, ov[1].y, false, false);
            const int row = 16 * (2 * ntp + (q & 1)) + r, dk0 = 16 * mt + 4 * (q & ~1);
            *(u32x4*)(dst + (size_t)row * 128 + dk0) = (u32x4){ox.x, oy.x, ox.y, oy.y};
        }
    }
#undef KV_LOAD_UNIT
}

__device__ __forceinline__ void scan_phase(const Args& p) {
    bf16_t* KVS = (bf16_t*)((unsigned char*)p.out + DOUT_KVS);
    if (threadIdx.x >= 256) return;
    for (int gid = blockIdx.x * 256 + threadIdx.x; gid < 16 * 4096; gid += gridDim.x * 256) {
        const int bh = gid >> 12, b = bh >> 2, h = bh & 3, off = (gid & 4095) * 8;
        const float dec = exp2f(128.0f * log2f(1.0f - exp2f(-5.0f - (float)h)));
        float s0 = 0.f, s1 = 0.f, s2 = 0.f, s3 = 0.f, s4 = 0.f, s5 = 0.f, s6 = 0.f, s7 = 0.f;
        bf16_t* base = KVS + kvs_slot(b, 0, h) + off;
        for (int n0 = 0; n0 < 64; n0 += 16) {
            u32x4 v[16];
#pragma unroll
            for (int j = 0; j < 16; ++j) v[j] = *(const u32x4*)(base + (size_t)(n0 + j) * 4 * 32768);
#pragma unroll
            for (int j = 0; j < 16; ++j) {
                s0 = dec * s0 + bf_lo(v[j].x); s1 = dec * s1 + bf_hi(v[j].x); s2 = dec * s2 + bf_lo(v[j].y); s3 = dec * s3 + bf_hi(v[j].y);
                s4 = dec * s4 + bf_lo(v[j].z); s5 = dec * s5 + bf_hi(v[j].z); s6 = dec * s6 + bf_lo(v[j].w); s7 = dec * s7 + bf_hi(v[j].w);
                u32x4 o; o.x = cvt_pk_bf16(s0, s1); o.y = cvt_pk_bf16(s2, s3); o.z = cvt_pk_bf16(s4, s5); o.w = cvt_pk_bf16(s6, s7);
                *(u32x4*)(base + (size_t)(n0 + j) * 4 * 32768) = o;
            }
        }
    }
}

__device__ __forceinline__ void retout_phase(LAS unsigned char* lds, const Args& p) {
    int tid_ = threadIdx.x; asm volatile("" : "+v"(tid_));
    const int tid = tid_, lane = tid & 63, w = __builtin_amdgcn_readfirstlane(tid >> 6), r = lane & 15, q = lane >> 4;
    const bf16_t* RQ = (const bf16_t*)(p.ws + OFF_RQ); const bf16_t* RK = (const bf16_t*)(p.ws + OFF_RK); const bf16_t* RV = (const bf16_t*)(p.ws + OFF_RV); const bf16_t* RG = (const bf16_t*)(p.ws + OFF_RG);
    const bf16_t* KVS = (const bf16_t*)((unsigned char*)p.out + DOUT_KVS);
    bf16_t* YRET = (bf16_t*)(p.ws + OFF_YRET);
    constexpr int RS = 136, K_OFF = 0, SB = 128 * RS * 2, QSZ = 64 * RS * 2;
    const int G = gridDim.x, vch = tid & 7, vpr = tid >> 3, srow = tid >> 4, sch = tid & 15;
    const LAS unsigned char* vlb = lds + SB + r * RS * 2 + ((q ^ (2 * (r >> 3))) << 3);
    u32x4 kreg[4], vreg[2], sreg[2], qn[4];
#define RO_LOAD_KQ(uu) do { const int b_ = (uu) >> 8, c_ = 1 + (((uu) & 255) >> 2), h_ = (uu) & 3; const size_t tb_ = (size_t)b_ * SEQ + (size_t)(c_ - 1) * 128; \
        _Pragma("unroll") for (int it = 0; it < 4; ++it) kreg[it] = *(const u32x4*)(RK + (tb_ + 32 * it + srow) * 512 + h_ * 128 + sch * 8); } while (0)
#define RO_LOAD_Q(uu) do { const int b_ = (uu) >> 8, c_ = 1 + (((uu) & 255) >> 2), h_ = (uu) & 3; const size_t tb_ = (size_t)b_ * SEQ + (size_t)(c_ - 1) * 128; \
        _Pragma("unroll") for (int ks = 0; ks < 4; ++ks) qn[ks] = *(const u32x4*)(RQ + (tb_ + 16 * w + r) * 512 + h_ * 128 + 32 * ks + 8 * q); } while (0)
#define RO_LOAD_STAGE(uu, sg) do { const int b_ = (uu) >> 8, c_ = 1 + (((uu) & 255) >> 2), h_ = (uu) & 3; const size_t tb_ = (size_t)b_ * SEQ + (size_t)(c_ - 1) * 128; \
        const bf16_t* st_ = KVS + kvs_slot(b_, c_ - 1, h_) + (size_t)(64 * (sg)) * 128; \
        vreg[0] = *(const u32x4*)(RV + (tb_ + 2 * vpr) * 1024 + h_ * 256 + 64 * (sg) + vch * 8); vreg[1] = *(const u32x4*)(RV + (tb_ + 2 * vpr + 1) * 1024 + h_ * 256 + 64 * (sg) + vch * 8); \
        sreg[0] = *(const u32x4*)(st_ + (size_t)srow * 128 + sch * 8); sreg[1] = *(const u32x4*)(st_ + (size_t)(32 + srow) * 128 + sch * 8); } while (0)
#define RO_WRITE_K() do { _Pragma("unroll") for (int it = 0; it < 4; ++it) *(LAS u32x4*)(lds + K_OFF + ((32 * it + srow) * RS + sch * 8) * 2) = kreg[it]; } while (0)
#define RO_WRITE_STAGE(j) do { tr_write8s(lds + SB + 2 * (j) * QSZ, RS, vch * 8, vpr, vreg[0], vreg[1]); \
        *(LAS u32x4*)(lds + SB + (2 * (j) + 1) * QSZ + (srow * RS + sch * 8) * 2) = sreg[0]; *(LAS u32x4*)(lds + SB + (2 * (j) + 1) * QSZ + ((32 + srow) * RS + sch * 8) * 2) = sreg[1]; } while (0)
    int u = blockIdx.x;
    if (u >= 1024) return;
    RO_LOAD_KQ(u); RO_LOAD_Q(u); RO_LOAD_STAGE(u, 0);
    __syncthreads();
    RO_WRITE_K(); RO_WRITE_STAGE(0);
    __syncthreads();
    for (; u < 1024; u += G) {
        const int b = u >> 8, c = 1 + ((u & 255) >> 2), h = u & 3, un = (u + G < 1024) ? u + G : u;
        const size_t tokbase = (size_t)b * SEQ + (size_t)(c - 1) * 128;
        const float lg2 = log2f(1.0f - exp2f(-5.0f - (float)h));
        const int iq = 16 * w + r; const size_t qrow = tokbase + iq;
        bf16x8 Qd[4]; u32x2 Pk[8]; f32x4 o[16];
        {
#pragma unroll
            for (int kt = 0; kt < 8; ++kt) {
                {
                    f32x4 acc = (f32x4){0.f, 0.f, 0.f, 0.f};
#pragma unroll
                    for (int ks = 0; ks < 4; ++ks) { const bf16x8 a = *(const LAS bf16x8*)(lds + K_OFF + ((16 * kt + r) * RS + 32 * ks + 8 * q) * 2); acc = MFMA16(a, as_frag(qn[ks]), acc); }
#pragma unroll
                    for (int i = 0; i < 4; ++i) { const int d = iq - (16 * kt + 4 * q + i); acc[i] = (d >= 0) ? acc[i] * 0.08838834764831845f * __builtin_amdgcn_exp2f(lg2 * (float)d) : 0.f; }
                    Pk[kt].x = cvt_pk_bf16(acc[0], acc[1]); Pk[kt].y = cvt_pk_bf16(acc[2], acc[3]);
                }
                if (kt & 1) __builtin_amdgcn_sched_barrier(0);
            }
            const float qdec = __builtin_amdgcn_exp2f(lg2 * (float)(iq + 1));
#pragma unroll
            for (int ks = 0; ks < 4; ++ks) Qd[ks] = as_frag(scale8(qn[ks], qdec));
        }
#pragma unroll
        for (int sg = 0; sg < 4; ++sg) {
            if (sg < 3) RO_LOAD_STAGE(u, sg + 1); else { RO_LOAD_KQ(un); RO_LOAD_STAGE(un, 0); }
            const int bo = 2 * (sg & 1) * QSZ;
#pragma unroll
            for (int j = 0; j < 4; ++j) {
                f32x4 acc = (f32x4){0.f, 0.f, 0.f, 0.f};
#pragma unroll
                for (int ks = 0; ks < 4; ++ks) { const bf16x8 a = *(const LAS bf16x8*)(lds + SB + bo + QSZ + ((16 * j + r) * RS + 32 * ks + 8 * q) * 2); acc = MFMA16(a, Qd[ks], acc); }
#pragma unroll
                for (int kp = 0; kp < 4; ++kp) {
                    {
                        const u32x2 a0 = *(const LAS u32x2*)(vlb + bo + 16 * j * RS * 2 + ((((kp ^ (j >> 1)) << 3) | ((0 ^ (j & 1)) << 2)) << 3));
                        const u32x2 a1 = *(const LAS u32x2*)(vlb + bo + 16 * j * RS * 2 + ((((kp ^ (j >> 1)) << 3) | ((1 ^ (j & 1)) << 2)) << 3));
                        const u32x4 a = (u32x4){a0.x, a0.y, a1.x, a1.y}, bb = (u32x4){Pk[2 * kp].x, Pk[2 * kp].y, Pk[2 * kp + 1].x, Pk[2 * kp + 1].y};
                        acc = MFMA16(as_frag(a), as_frag(bb), acc);
                    }
                }
                o[sg * 4 + j] = acc;
                if (j & 1) __builtin_amdgcn_sched_barrier(0);
            }
            if (sg == 3) RO_WRITE_K();
            RO_WRITE_STAGE((sg + 1) & 1);
            __syncthreads();
        }
        RO_LOAD_Q(un);
        float ss = 0.f;
#pragma unroll
        for (int t = 0; t < 16; ++t) ss += (o[t][0] * o[t][0] + o[t][1] * o[t][1]) + (o[t][2] * o[t][2] + o[t][3] * o[t][3]);
        ss += __shfl_xor(ss, 16); ss += __shfl_xor(ss, 32);
        const float rstd = 1.f / sqrtf(ss * (1.f / 256.f) + EPS);
        const int qodd = q & 1;
#pragma unroll
        for (int tp = 0; tp < 8; ++tp) {
            const int t0 = 2 * tp, t1 = 2 * tp + 1;
            const int dvw = 32 * tp + (qodd ? 16 + 4 * (q - 1) : 4 * q);
            const u32x4 gw = *(const u32x4*)(RG + qrow * 1024 + h * 256 + dvw);
            const u32x2 sx = __builtin_amdgcn_permlane16_swap(gw.x, gw.z, false, false), sy = __builtin_amdgcn_permlane16_swap(gw.y, gw.w, false, false);
            const f32x4 g0 = *(const f32x4*)(p.ret_g + h * 256 + 16 * t0 + 4 * q), g1 = *(const f32x4*)(p.ret_g + h * 256 + 16 * t1 + 4 * q);
            u32x2 ov0, ov1;
            { const float x0 = bf_lo(sx.x), x1 = bf_hi(sx.x), x2 = bf_lo(sy.x), x3 = bf_hi(sy.x);
              ov0.x = cvt_pk_bf16(o[t0][0] * rstd * g0.x * x0 * sigmoidf_(x0), o[t0][1] * rstd * g0.y * x1 * sigmoidf_(x1));
              ov0.y = cvt_pk_bf16(o[t0][2] * rstd * g0.z * x2 * sigmoidf_(x2), o[t0][3] * rstd * g0.w * x3 * sigmoidf_(x3)); }
            { const float x0 = bf_lo(sx.y), x1 = bf_hi(sx.y), x2 = bf_lo(sy.y), x3 = bf_hi(sy.y);
              ov1.x = cvt_pk_bf16(o[t1][0] * rstd * g1.x * x0 * sigmoidf_(x0), o[t1][1] * rstd * g1.y * x1 * sigmoidf_(x1));
              ov1.y = cvt_pk_bf16(o[t1][2] * rstd * g1.z * x2 * sigmoidf_(x2), o[t1][3] * rstd * g1.w * x3 * sigmoidf_(x3)); }
            const u32x2 ox = __builtin_amdgcn_permlane16_swap(ov0.x, ov1.x, false, false), oy = __builtin_amdgcn_permlane16_swap(ov0.y, ov1.y, false, false);
            *(u32x4*)(YRET + qrow * 1024 + h * 256 + dvw) = (u32x4){ox.x, oy.x, ox.y, oy.y};
        }
    }
#undef RO_LOAD_KQ
#undef RO_LOAD_Q
#undef RO_LOAD_STAGE
#undef RO_WRITE_K
#undef RO_WRITE_STAGE
}

__device__ __forceinline__ void meta_proj(const Args& p, const bf16_t* XN, const bf16_t* WinT) {
    int tid_ = threadIdx.x; asm volatile("" : "+v"(tid_));
    const int tid = tid_, lane = tid & 63, r = lane & 15, q = lane >> 4;
    const bool g256 = (gridDim.x == 256);
    const int wv = tid >> 6, jg = (int)(((blockIdx.x >> 5) << 3) | (blockIdx.x & 7u));
    if (g256 ? (((blockIdx.x >> 3) & 3u) != 0u || wv >= 2) : (wv != 0)) return;
    for (int t = g256 ? jg * 2 + wv : (int)blockIdx.x; t < 128; t += (g256 ? 128 : (int)gridDim.x)) {
        int ncol, ld, cl; size_t boff;
        if (t < 32) { ncol = 512 + 16 * t; boff = OFF_RK; ld = 512; cl = 16 * t; }
        else if (t < 96) { ncol = 1024 + 16 * (t - 32); boff = OFF_RV; ld = 1024; cl = 16 * (t - 32); }
        else if (t < 112) { ncol = 4096 + 16 * (t - 96); boff = OFF_SK; ld = 256; cl = 16 * (t - 96); }
        else { ncol = 4352 + 16 * (t - 112); boff = OFF_SV; ld = 256; cl = 16 * (t - 112); }
        const bf16_t* ap = WinT + (size_t)(ncol + r) * DM + 8 * q; const bf16_t* bp = XN + (size_t)(NTOK + r) * DM + 8 * q;
        f32x4 acc = (f32x4){0.f, 0.f, 0.f, 0.f};
#pragma unroll 8
        for (int ks = 0; ks < 32; ++ks) { const u32x4 a = *(const u32x4*)(ap + 32 * ks), b = *(const u32x4*)(bp + 32 * ks); acc = MFMA16(as_frag(a), as_frag(b), acc); }
        u32x2 o; o.x = cvt_pk_bf16(acc[0], acc[1]); o.y = cvt_pk_bf16(acc[2], acc[3]);
        *(u32x2*)((bf16_t*)(p.ws + boff) + (size_t)(NTOK + r) * ld + cl + 4 * q) = o;
    }
}

#define XB_TMO      128
#define XB_XCNT(j)  (256  + 64 * (j))
#define XB_XSUB(j)  (1280 + 64 * (j))
#define XB_XGEN(j)  (2304 + 64 * (j))
#define XB_TOP      3328
#define XB_TOPGEN   3392
#define XCD_BAR_WORDS 3456
#define XB_SPIN_CAP (1u << 22)
__device__ __forceinline__ unsigned xb_ld(unsigned* p)              { return __hip_atomic_load(p, __ATOMIC_RELAXED, __HIP_MEMORY_SCOPE_AGENT); }
__device__ __forceinline__ unsigned xb_add(unsigned* p, unsigned v) { return __hip_atomic_fetch_add(p, v, __ATOMIC_RELAXED, __HIP_MEMORY_SCOPE_AGENT); }
__device__ __forceinline__ unsigned xb_xcc_id() { return (unsigned)__builtin_amdgcn_s_getreg((3 << 11) | 20) & 0xFu; }
#define XB_SPIN(cond, bar) do { unsigned _sp = 0; while (cond) { __builtin_amdgcn_s_sleep(1); \
    if ((++_sp & 255u) == 0u) { if (xb_ld(&(bar)[XB_TMO])) break; if (_sp > XB_SPIN_CAP) { atomicAdd(&(bar)[XB_TMO], 1u); break; } } } } while (0)
struct XcdBarrier { unsigned* bar; unsigned x; volatile LAS unsigned* st; };
__device__ __forceinline__ XcdBarrier xcd_barrier_post(unsigned* bar, volatile LAS unsigned* st) {
    XcdBarrier b; b.bar = bar; b.x = xb_xcc_id(); b.st = st;
    if (threadIdx.x == 0) (void)xb_add(&bar[XB_XCNT(b.x)], 1u);
    return b;
}
__device__ __forceinline__ void xcd_barrier_complete(unsigned* bar, unsigned x, unsigned& nloc, unsigned& nx) {
    const unsigned G = gridDim.x * gridDim.y * gridDim.z;
    unsigned sum, cnt, mine, sp = 0u;
    for (;;) {
        sum = 0u; cnt = 0u; mine = 0u;
#pragma unroll
        for (unsigned j = 0; j < 16; ++j) { const unsigned c = xb_ld(&bar[XB_XCNT(j)]); sum += c; cnt += (c > 0u) ? 1u : 0u; mine = (j == x) ? c : mine; }
        if (sum == G) break;
        __builtin_amdgcn_s_sleep(1);
        if ((++sp & 255u) == 0u) { if (xb_ld(&bar[XB_TMO])) break; if (sp > XB_SPIN_CAP) { atomicAdd(&bar[XB_TMO], 1u); break; } }
    }
    nloc = mine > 0u ? mine : 1u; nx = cnt > 0u ? cnt : 1u;
}
__device__ __forceinline__ void xcd_barrier(const XcdBarrier& b) {
    asm volatile("s_waitcnt vmcnt(0)" ::: "memory");
    __syncthreads();
    if (threadIdx.x == 0) {
        unsigned* bar = b.bar;
        __builtin_amdgcn_s_waitcnt(0);
        unsigned nloc = b.st[0], nx = b.st[1];
        if (nloc == 0u) { xcd_barrier_complete(bar, b.x, nloc, nx); b.st[0] = nloc; b.st[1] = nx; }
        const unsigned old = xb_add(&bar[XB_XSUB(b.x)], 1u);
        const unsigned gen = old / nloc;
        if (old + 1u == (gen + 1u) * nloc) {
            __builtin_amdgcn_fence(__ATOMIC_RELEASE, "agent");
            asm volatile("s_waitcnt vmcnt(0)" ::: "memory");
            const unsigned og = xb_add(&bar[XB_TOP], 1u);
            const unsigned tg = og / nx;
            if (og + 1u == (tg + 1u) * nx) xb_add(&bar[XB_TOPGEN], 1u);
            else XB_SPIN(xb_ld(&bar[XB_TOPGEN]) == tg, bar);
            __builtin_amdgcn_fence(__ATOMIC_ACQUIRE, "agent");
            xb_add(&bar[XB_XGEN(b.x)], 1u);
            asm volatile("s_waitcnt vmcnt(0)" ::: "memory");
        } else {
            XB_SPIN(xb_ld(&bar[XB_XGEN(b.x)]) == gen, bar);
            __builtin_amdgcn_fence(__ATOMIC_ACQUIRE, "agent");
            asm volatile("s_waitcnt vmcnt(0)" ::: "memory");
        }
    }
    __syncthreads();
}

__device__ __forceinline__ void convert_slot(const Args& p, LAS unsigned char* lds, const int list) {
    const unsigned grp = (blockIdx.x >> 3) & 3u;
    if (grp == 0u) return;
    int tid_ = threadIdx.x; asm volatile("" : "+v"(tid_));
    const int tid = tid_, lane = tid & 63, wave = __builtin_amdgcn_readfirstlane(tid >> 6);
    constexpr int I_SQ = (DM / 64) * (DM / 32), I_UP = (DM / 64) * (FF / 32), I_DN = (FF / 64) * (DM / 32);
    const int total = list == 0 ? 3 * I_SQ + I_UP : I_DN;
    const int lo = grp == 1u ? 0 : (grp == 2u ? total / 6 : total / 2), hi = grp == 1u ? total / 6 : (grp == 2u ? total / 2 : total);
    const int j = (int)(((blockIdx.x >> 5) << 3) | (blockIdx.x & 7u));
    LAS float* scr = (LAS float*)(lds + wave * 16384);
    unsigned char* ws = p.ws;
    for (int it = lo + j * 8 + wave; it < hi; it += 512) {
        if (list == 0) {
            int r = it;
            if (r < I_SQ) { p0_transpose_item(p.w_ret, DM, DM, (bf16_t*)(ws + OFF_WRET), scr, r, lane); continue; } r -= I_SQ;
            if (r < I_SQ) { p0_transpose_item(p.w_swa, DM, DM, (bf16_t*)(ws + OFF_WSWA), scr, r, lane); continue; } r -= I_SQ;
            if (r < I_SQ) { p0_transpose_item(p.w_out, DM, DM, (bf16_t*)(ws + OFF_WOUT), scr, r, lane); continue; } r -= I_SQ;
            p0_transpose_item(p.w_up, DM, FF, (bf16_t*)(ws + OFF_WUP), scr, r, lane, p.mlp_g);
        } else p0_transpose_item(p.w_down, FF, DM, (bf16_t*)(ws + OFF_WDN), scr, it, lane);
    }
    __syncthreads();
}

__global__ void __launch_bounds__(NTHREADS, 2) fwd_megakernel(Args p) {
    extern __shared__ __attribute__((aligned(16))) unsigned char lds_raw[];
    LAS unsigned char* lds = (LAS unsigned char*)lds_raw;
    cg::grid_group grid = cg::this_grid();
    ((LAS unsigned*)(lds + 131072 + 64))[threadIdx.x & 15] = 0u;
    __syncthreads();
    XcdBarrier xbar = xcd_barrier_post((unsigned*)(p.ws + OFF_CTL), (volatile LAS unsigned*)(lds + 131072 + 64));
    grid.sync();
#define GRID_SYNC() xcd_barrier(xbar)
    const int tid = threadIdx.x, lane = tid & 63, wave = __builtin_amdgcn_readfirstlane(tid >> 6);
    const int G = gridDim.x, gw = blockIdx.x * 8 + wave, NGW = G * 8;
    unsigned char* ws = p.ws;
    bf16_t* WinT = (bf16_t*)(ws + OFF_WIN); bf16_t* WretT = (bf16_t*)(ws + OFF_WRET); bf16_t* WswaT = (bf16_t*)(ws + OFF_WSWA); bf16_t* WoutT = (bf16_t*)(ws + OFF_WOUT);
    bf16_t* WupT = (bf16_t*)(ws + OFF_WUP); bf16_t* WdnT = (bf16_t*)(ws + OFF_WDN);
    bf16_t* XN = (bf16_t*)p.out;

    for (int rep = 0; rep < 1 + ((REP_MASK >> 0) & 1); ++rep) {
        LAS float* scr = (LAS float*)(lds + wave * 16384);
        constexpr int I_IN = (DM / 64) * (DIN / 32), I_SQ = (DM / 64) * (DM / 32), I_UP = (DM / 64) * (FF / 32), I_DN = (FF / 64) * (DM / 32);
        constexpr int NITEMS = I_IN + 3 * I_SQ + I_UP + I_DN;
        const bool split = (G == 256);
        for (int it = gw; it < (split ? I_IN : NITEMS); it += NGW) {
            int r = it;
            if (r < I_IN) { p0_transpose_item(p.w_in, DM, DIN, WinT, scr, r, lane); continue; } r -= I_IN;
            if (r < I_SQ) { p0_transpose_item(p.w_ret, DM, DM, WretT, scr, r, lane); continue; } r -= I_SQ;
            if (r < I_SQ) { p0_transpose_item(p.w_swa, DM, DM, WswaT, scr, r, lane); continue; } r -= I_SQ;
            if (r < I_SQ) { p0_transpose_item(p.w_out, DM, DM, WoutT, scr, r, lane); continue; } r -= I_SQ;
            if (r < I_UP) { p0_transpose_item(p.w_up, DM, FF, WupT, scr, r, lane, p.mlp_g); continue; } r -= I_UP;
            p0_transpose_item(p.w_down, FF, DM, WdnT, scr, r, lane);
        }
        for (int m = gw; m < NTOK; m += 2 * NGW) {
            const int m2 = m + NGW;
            const f32x4* xa = (const f32x4*)(p.x + (size_t)m * DM) + 2 * lane; const f32x4* xb = (const f32x4*)(p.x + (size_t)(m2 < NTOK ? m2 : m) * DM) + 2 * lane; const f32x4* gr = (const f32x4*)p.mix_g + 2 * lane;
            f32x4 va[4], vb[4]; float sa = 0.f, sb = 0.f;
#pragma unroll
            for (int j = 0; j < 4; ++j) { va[j] = xa[(j & 1) + 128 * (j >> 1)]; vb[j] = xb[(j & 1) + 128 * (j >> 1)]; }
#pragma unroll
            for (int j = 0; j < 4; ++j) { sa += (va[j].x * va[j].x + va[j].y * va[j].y) + (va[j].z * va[j].z + va[j].w * va[j].w); sb += (vb[j].x * vb[j].x + vb[j].y * vb[j].y) + (vb[j].z * vb[j].z + vb[j].w * vb[j].w); }
            const float ra = 1.f / sqrtf(wave_sum(sa) * (1.f / DM) + EPS), rb = 1.f / sqrtf(wave_sum(sb) * (1.f / DM) + EPS);
            u32x4* oa = (u32x4*)(XN + (size_t)m * DM) + lane; u32x4* ob = (u32x4*)(XN + (size_t)m2 * DM) + lane;
#pragma unroll
            for (int jj = 0; jj < 2; ++jj) { const f32x4 g0 = gr[128 * jj], g1 = gr[128 * jj + 1]; const f32x4 a0 = va[2 * jj], a1 = va[2 * jj + 1], b0 = vb[2 * jj], b1 = vb[2 * jj + 1];
                u32x4 wa; wa.x = cvt_pk_bf16_asm(a0.x * ra * g0.x, a0.y * ra * g0.y); wa.y = cvt_pk_bf16_asm(a0.z * ra * g0.z, a0.w * ra * g0.w); wa.z = cvt_pk_bf16_asm(a1.x * ra * g1.x, a1.y * ra * g1.y); wa.w = cvt_pk_bf16_asm(a1.z * ra * g1.z, a1.w * ra * g1.w);
                oa[64 * jj] = wa;
                if (m2 < NTOK) { u32x4 wb; wb.x = cvt_pk_bf16_asm(b0.x * rb * g0.x, b0.y * rb * g0.y); wb.y = cvt_pk_bf16_asm(b0.z * rb * g0.z, b0.w * rb * g0.w); wb.z = cvt_pk_bf16_asm(b1.x * rb * g1.x, b1.y * rb * g1.y); wb.w = cvt_pk_bf16_asm(b1.z * rb * g1.z, b1.w * rb * g1.w);
                    ob[64 * jj] = wb; } }
        }
        if (gw < NMETA) rms_row_to_bf16(p.meta + (size_t)gw * DM, p.mix_g, XN + (size_t)(NTOK + gw) * DM, lane);
    }
    GRID_SYNC();
    {
        meta_proj(p, XN, WinT);
        if (G == 256) convert_slot(p, lds, 0);
        pg8::Gemm g{XN, WinT, XN, WinT, NTOK, DIN, DM}; pg8::StaticOrder S; S.init(NTOK, DIN, G, (int)blockIdx.x);
        pg8::EpiProj E{ws};
        pg8::gemm_phase<pg8::EpiProj, pg8::StaticOrder, true>(lds, g, S, E);
    }
    GRID_SYNC();
    for (int rep = 0; rep < 1 + ((REP_MASK >> 1) & 1); ++rep) { swa_phase(lds, p); kvlocal_phase(lds, p); }
    GRID_SYNC();
    scan_phase(p);
    GRID_SYNC();
    for (int rep = 0; rep < 1 + ((REP_MASK >> 2) & 1); ++rep) retout_phase(lds, p);
    GRID_SYNC();
    {
        const bf16_t* YRET = (const bf16_t*)(ws + OFF_YRET); const bf16_t* YSWA = (const bf16_t*)((unsigned char*)p.out + DOUT_YSWA);
        pg8::Gemm g{YRET, WretT, YSWA, WswaT, NTOK, DM, DM}; pg8::PairOrder S; S.s.init(NTOK, DM, G, (int)blockIdx.x);
        pg8::EpiMerged E{(const unsigned char*)(ws + OFF_GR), (const unsigned char*)(ws + OFF_GS), (bf16_t*)(ws + OFF_MERGED)};
        pg8::gemm_phase<pg8::EpiMerged, pg8::PairOrder, true>(lds, g, S, E);
    }
    GRID_SYNC();
    {
        const bf16_t* MG = (const bf16_t*)(ws + OFF_MERGED);
        pg8::Gemm g{MG, WoutT, MG, WoutT, NTOK, DM, DM}; pg8::StaticOrder S; S.init(NTOK, DM, G, (int)blockIdx.x);
        pg8::EpiResStat E{p.x, p.out, (bf16_t*)(ws + OFF_HN2), (float*)(ws + OFF_SS)};
        pg8::gemm_phase<pg8::EpiResStat, pg8::StaticOrder, true>(lds, g, S, E);
    }
    GRID_SYNC();
    {
        const bf16_t* HN2 = (const bf16_t*)(ws + OFF_HN2);
        pg8::Gemm g{HN2, WupT, HN2, WupT, NTOK, FF, DM}; pg8::StaticOrder S; S.init(NTOK, FF, G, (int)blockIdx.x);
        pg8::EpiUp E{(bf16_t*)(ws + OFF_U), (const float*)(ws + OFF_SS)};
        if (G == 256) convert_slot(p, lds, 1);
        pg8::gemm_phase<pg8::EpiUp, pg8::StaticOrder, true>(lds, g, S, E);
    }
    GRID_SYNC();
    {
        const bf16_t* U = (const bf16_t*)(ws + OFF_U);
        pg8::Gemm g{U, WdnT, U, WdnT, NTOK, DM, FF}; pg8::StaticOrder S; S.init(NTOK, DM, G, (int)blockIdx.x);
        pg8::EpiResBf E{(const bf16_t*)(ws + OFF_HN2), p.out};
        pg8::gemm_phase<pg8::EpiResBf, pg8::StaticOrder, true>(lds, g, S, E);
    }
}

extern "C" void kernel_launch(void* const* d_in, const int* in_sizes, int n_in, void* d_out, int out_size, void* d_ws, size_t ws_size, hipStream_t stream) {
    static int grid = 0;
    if (grid == 0) {
        if (n_in != 14 || in_sizes[0] != NTOK * DM || out_size != NTOK * DM || ws_size < WS_NEED) {
            fprintf(stderr, "kernel_launch: unexpected shapes (n_in %d, in0 %d, out %d, ws %zu, need %zu); nothing launched\n", n_in, n_in > 0 ? in_sizes[0] : -1, out_size, ws_size, (size_t)WS_NEED); grid = -1; return; }
        int dev = 0, cus = 0, per_cu = 0;
        (void)hipGetDevice(&dev); (void)hipDeviceGetAttribute(&cus, hipDeviceAttributeMultiprocessorCount, dev);
        if (hipFuncSetAttribute((const void*)fwd_megakernel, hipFuncAttributeMaxDynamicSharedMemorySize, LDS_BYTES) != hipSuccess) { fprintf(stderr, "kernel_launch: hipFuncSetAttribute failed\n"); grid = -1; return; }
        if (hipOccupancyMaxActiveBlocksPerMultiprocessor(&per_cu, (const void*)fwd_megakernel, NTHREADS, LDS_BYTES) != hipSuccess || per_cu < 1) { fprintf(stderr, "kernel_launch: occupancy query gave %d\n", per_cu); per_cu = 1; }
        (void)hipGetLastError();
        grid = cus * per_cu;
    }
    if (grid < 0) return;
    Args a{};
    a.x = (const float*)d_in[0]; a.meta = (const float*)d_in[1]; a.mix_g = (const float*)d_in[2]; a.w_in = (const float*)d_in[3]; a.ret_g = (const float*)d_in[4];
    a.q_g = (const float*)d_in[5]; a.k_g = (const float*)d_in[6]; a.sinks = (const float*)d_in[7]; a.w_ret = (const float*)d_in[8]; a.w_swa = (const float*)d_in[9];
    a.w_out = (const float*)d_in[10]; a.mlp_g = (const float*)d_in[11]; a.w_up = (const float*)d_in[12]; a.w_down = (const float*)d_in[13];
    a.out = (float*)d_out; a.ws = (unsigned char*)d_ws;
    if (hipMemsetAsync((unsigned char*)d_ws + OFF_CTL, 0, CTL_BYTES, stream) != hipSuccess) { fprintf(stderr, "kernel_launch: memset failed\n"); return; }
    void* args[] = {&a};
    hipError_t e = hipLaunchCooperativeKernel((const void*)fwd_megakernel, dim3(grid), dim3(NTHREADS), args, LDS_BYTES, stream);
    if (e != hipSuccess) fprintf(stderr, "kernel_launch: cooperative launch failed: %s (grid %d)\n", hipGetErrorString(e), grid);
}
```

```cpp
#ifndef REP_MASK
#define REP_MASK 0
#endif
#include <hip/hip_runtime.h>
#include <hip/hip_cooperative_groups.h>
#include <cstdio>
#include <cstdint>
namespace cg = cooperative_groups;

#define LAS __attribute__((address_space(3)))
typedef unsigned short bf16_t;
typedef short bf16x8 __attribute__((ext_vector_type(8)));
typedef float f32x4 __attribute__((ext_vector_type(4)));
typedef unsigned u32x4 __attribute__((ext_vector_type(4)));
typedef unsigned u32x2 __attribute__((ext_vector_type(2)));

constexpr int NB = 4, SEQ = 8192, DM = 1024, NTOK = NB * SEQ, NMETA = 16, MROWS = NTOK + NMETA, MPAD = 33024, DIN = 6656, FF = 4096;
constexpr float EPS = 1e-6f;
constexpr int NTHREADS = 512;
constexpr int LDS_BYTES = 135168;

constexpr size_t SZ_WIN = (size_t)DIN * DM * 2, SZ_WSQ = (size_t)DM * DM * 2, SZ_WFF = (size_t)FF * DM * 2;
constexpr size_t OFF_WIN = 0, OFF_WRET = OFF_WIN + SZ_WIN, OFF_WSWA = OFF_WRET + SZ_WSQ, OFF_WOUT = OFF_WSWA + SZ_WSQ, OFF_WUP = OFF_WOUT + SZ_WSQ, OFF_WDN = OFF_WUP + SZ_WFF;
constexpr size_t OFF_RQ = OFF_WDN + SZ_WFF;
constexpr size_t OFF_RK = OFF_RQ + (size_t)MROWS * 512 * 2;
constexpr size_t OFF_RV = OFF_RK + (size_t)MROWS * 512 * 2;
constexpr size_t OFF_RG = OFF_RV + (size_t)MROWS * 1024 * 2;
constexpr size_t OFF_SQ = OFF_RG + (size_t)MROWS * 1024 * 2;
constexpr size_t OFF_SK = OFF_SQ + (size_t)MROWS * 1024 * 2;
constexpr size_t OFF_SV = OFF_SK + (size_t)MROWS * 256 * 2;
constexpr size_t OFF_GR = OFF_SV + (size_t)MROWS * 256 * 2;
constexpr size_t OFF_GS = OFF_GR + (size_t)MROWS * 1024 * 2;
constexpr size_t OFF_CTL = OFF_GS + (size_t)MROWS * 1024 * 2;
constexpr size_t CTL_BYTES = 16384 + (size_t)NTOK * 4;
constexpr size_t OFF_SS = OFF_CTL + 16384;
constexpr size_t WS_NEED = OFF_CTL + CTL_BYTES;
constexpr size_t OFF_MERGED = OFF_RQ, OFF_HN2 = OFF_RV, OFF_YRET = OFF_SQ, OFF_U = OFF_RG;
static_assert(OFF_RK - OFF_RQ + OFF_RV - OFF_RK >= (size_t)NTOK * 1024 * 2, "MERGED fits");
static_assert(OFF_CTL - OFF_RG >= (size_t)NTOK * FF * 2, "U fits");
static_assert((size_t)MPAD * DM * 2 <= (size_t)NTOK * DM * 4, "XN fits d_out");
constexpr size_t DOUT_KVS = 0, DOUT_YSWA = (size_t)NTOK * 1024 * 2;

typedef __bf16 bf16x2_t __attribute__((ext_vector_type(2)));
typedef float f32x2_t __attribute__((ext_vector_type(2)));
__device__ __forceinline__ unsigned cvt_pk_bf16(float lo, float hi) { const f32x2_t v = {lo, hi}; const bf16x2_t b = __builtin_convertvector(v, bf16x2_t); return __builtin_bit_cast(unsigned, b); }
__device__ __forceinline__ unsigned cvt_pk_bf16_asm(float lo, float hi) { unsigned r; asm volatile("v_cvt_pk_bf16_f32 %0, %1, %2" : "=v"(r) : "v"(lo), "v"(hi)); return r; }
__device__ __forceinline__ float bf_lo(unsigned w) { return __uint_as_float(w << 16); }
__device__ __forceinline__ float bf_hi(unsigned w) { return __uint_as_float(w & 0xffff0000u); }
__device__ __forceinline__ float wave_sum(float v) {
#pragma unroll
    for (int o = 1; o < 64; o <<= 1) v += __shfl_xor(v, o);
    return v;
}
__device__ __forceinline__ float sigmoidf_(float x) { return __builtin_amdgcn_rcpf(1.0f + __builtin_amdgcn_exp2f(-1.4426950408889634f * x)); }

namespace pg8 {
constexpr int BM = 256, BK = 64, HALF = 128, HTB = HALF * BK * 2, STAGE_BYTES = 8 * HTB, NXCD = 8, WGM = 8;
__host__ __device__ __forceinline__ int lds_byte(int r, int c) { const int st = (r >> 4) * 2 + (c >> 5), rr = r & 15, cc = c & 31, ob = rr * 64 + cc * 2; return st * 1024 + (ob ^ (((ob >> 9) & 1) << 5)); }
__host__ __device__ __forceinline__ void stage_rc(int b, int& R, int& C) { const int st = b / 1024, sb = b % 1024, swz = sb ^ (((sb >> 9) & 1) << 5); R = (st >> 1) * 16 + swz / 64; C = (st & 1) * 32 + (swz % 64) / 2; }
__host__ __device__ __forceinline__ int perm32(int rho) { const int n = rho >> 4, i = rho & 15; return 8 * (i >> 2) + 4 * n + (i & 3); }

struct Unit { int pm, pn, seg; };
struct Gemm { const bf16_t* A; const bf16_t* Bt; const bf16_t* A2; const bf16_t* Bt2; int M, N, K; };

struct StaticOrder {
    int nM, nN, nwg, G, c;
    __device__ void init(int M, int N, int G_, int c_) { nM = M / BM; nN = N / BM; nwg = nM * nN; G = G_; c = c_; }
    __device__ bool tile(long L, Unit& u) const {
        if (L >= nwg) return false;
        int wgid = (int)L; { const int q = nwg / NXCD, r = nwg % NXCD, xcd = wgid % NXCD, off = wgid / NXCD; wgid = (xcd < r ? xcd * (q + 1) : r * (q + 1) + (xcd - r) * q) + off; }
        const int nig = WGM * nN, gid = wgid / nig, fm = gid * WGM, gsz = (nM - fm) < WGM ? (nM - fm) : WGM;
        u.pm = fm + ((wgid % nig) % gsz); u.pn = (wgid % nig) / gsz; u.seg = 0; return true;
    }
    __device__ bool next(int i, Unit& u) const { return tile((long)i * G + c, u); }
};
struct PairOrder {
    StaticOrder s;
    __device__ bool next(int i, Unit& u) const { const bool ok = s.tile((long)(i >> 1) * s.G + s.c, u); u.seg = i & 1; return ok; }
};

struct EpiProj {
    static constexpr bool PERM = true, HAS_MID = false;
    unsigned char* ws;
    __device__ __forceinline__ void mid(f32x4 (&acc)[2][2][4][2], const Unit& u, int wr, int wc, int fr, int fq) const {}
    __device__ __forceinline__ void operator()(const f32x4 (&acc)[2][2][4][2], const Unit& u, int wr, int wc, int fr, int fq) const {
        const int pn = u.pn; size_t boff; int ld, ct;
        if (pn < 2) { boff = OFF_RQ; ld = 512; ct = pn; }
        else if (pn < 4) { boff = OFF_RK; ld = 512; ct = pn - 2; }
        else if (pn < 8) { boff = OFF_RV; ld = 1024; ct = pn - 4; }
        else if (pn < 12) { boff = OFF_RG; ld = 1024; ct = pn - 8; }
        else if (pn < 16) { boff = OFF_SQ; ld = 1024; ct = pn - 12; }
        else if (pn == 16) { boff = OFF_SK; ld = 256; ct = 0; }
        else if (pn == 17) { boff = OFF_SV; ld = 256; ct = 0; }
        else if (pn < 22) { boff = OFF_GR; ld = 1024; ct = pn - 18; }
        else { boff = OFF_GS; ld = 1024; ct = pn - 22; }
        bf16_t* base = (bf16_t*)(ws + boff);
        const int row0 = u.pm * BM + wr * 64 + fr, col0 = ct * 256 + wc * 32 + 8 * fq;
        if (pn >= 18) {
            unsigned char* gb = ws + boff;
            const int colw = ct * 256 + wc * 32 + ((fq & 1) ? HALF + 8 * (fq - 1) : 8 * fq);
#pragma unroll
            for (int ai = 0; ai < 2; ++ai)
#pragma unroll
                for (int m = 0; m < 4; ++m) {
                    unsigned w[2][2];
#pragma unroll
                    for (int bj = 0; bj < 2; ++bj) { const f32x4 v0 = acc[ai][bj][m][0], v1 = acc[ai][bj][m][1];
                        int w0 = __builtin_amdgcn_cvt_pk_fp8_f32(v0[0], v0[1], 0, false); w0 = __builtin_amdgcn_cvt_pk_fp8_f32(v0[2], v0[3], w0, true);
                        int w1 = __builtin_amdgcn_cvt_pk_fp8_f32(v1[0], v1[1], 0, false); w1 = __builtin_amdgcn_cvt_pk_fp8_f32(v1[2], v1[3], w1, true);
                        w[bj][0] = (unsigned)w0; w[bj][1] = (unsigned)w1; }
                    const u32x2 sx = __builtin_amdgcn_permlane16_swap(w[0][0], w[1][0], false, false), sy = __builtin_amdgcn_permlane16_swap(w[0][1], w[1][1], false, false);
                    *(u32x4*)(gb + (size_t)(row0 + ai * HALF + m * 16) * 1024 + colw) = (u32x4){sx.x, sy.x, sx.y, sy.y};
                }
            return;
        }
#pragma unroll
        for (int ai = 0; ai < 2; ++ai)
#pragma unroll
            for (int m = 0; m < 4; ++m) {
                bf16_t* rowp = base + (size_t)(row0 + ai * HALF + m * 16) * ld + col0;
#pragma unroll
                for (int bj = 0; bj < 2; ++bj) { const f32x4 v0 = acc[ai][bj][m][0], v1 = acc[ai][bj][m][1];
                    u32x4 w; w.x = cvt_pk_bf16_asm(v0[0], v0[1]); w.y = cvt_pk_bf16_asm(v0[2], v0[3]); w.z = cvt_pk_bf16_asm(v1[0], v1[1]); w.w = cvt_pk_bf16_asm(v1[2], v1[3]);
                    *(u32x4*)(rowp + bj * HALF) = w; } }
    }
};
struct EpiMerged {
    static constexpr bool PERM = true, HAS_MID = true;
    const unsigned char *GR, *GS; bf16_t* O;
#define F8(w, k) __builtin_amdgcn_cvt_f32_fp8((int)(w), (k))
    __device__ __forceinline__ void mid(f32x4 (&acc)[2][2][4][2], const Unit& u, int wr, int wc, int fr, int fq) const {
        const int row0 = u.pm * BM + wr * 64 + fr, colw = u.pn * BM + wc * 32 + ((fq & 1) ? HALF + 8 * (fq - 1) : 8 * fq);
#pragma unroll
        for (int ai = 0; ai < 2; ++ai)
#pragma unroll
            for (int m = 0; m < 4; ++m) { const size_t off = (size_t)(row0 + ai * HALF + m * 16) * DM + colw;
                const u32x4 ga = *(const u32x4*)(GR + off), gb = *(const u32x4*)(GS + off);
                const u32x2 ax = __builtin_amdgcn_permlane16_swap(ga.x, ga.z, false, false), ay = __builtin_amdgcn_permlane16_swap(ga.y, ga.w, false, false);
                const u32x2 bx = __builtin_amdgcn_permlane16_swap(gb.x, gb.z, false, false), by = __builtin_amdgcn_permlane16_swap(gb.y, gb.w, false, false);
#define MRG_R(ga_, gb_) ((1.0f + __builtin_amdgcn_exp2f(-1.4426950408889634f * (gb_))) * __builtin_amdgcn_rcpf(1.0f + __builtin_amdgcn_exp2f(-1.4426950408889634f * (ga_))))
#pragma unroll
                for (int bj = 0; bj < 2; ++bj) { const unsigned a0 = bj ? ax.y : ax.x, a1 = bj ? ay.y : ay.x, b0 = bj ? bx.y : bx.x, b1 = bj ? by.y : by.x;
                    f32x4 r0, r1;
                    r0[0] = MRG_R(F8(a0, 0), F8(b0, 0)); r0[1] = MRG_R(F8(a0, 1), F8(b0, 1)); r0[2] = MRG_R(F8(a0, 2), F8(b0, 2)); r0[3] = MRG_R(F8(a0, 3), F8(b0, 3));
                    r1[0] = MRG_R(F8(a1, 0), F8(b1, 0)); r1[1] = MRG_R(F8(a1, 1), F8(b1, 1)); r1[2] = MRG_R(F8(a1, 2), F8(b1, 2)); r1[3] = MRG_R(F8(a1, 3), F8(b1, 3));
                    acc[ai][bj][m][0] = acc[ai][bj][m][0] * r0; acc[ai][bj][m][1] = acc[ai][bj][m][1] * r1; }
#undef MRG_R
            }
    }
    __device__ __forceinline__ void operator()(const f32x4 (&acc)[2][2][4][2], const Unit& u, int wr, int wc, int fr, int fq) const {
        const int row0 = u.pm * BM + wr * 64 + fr, col0 = u.pn * BM + wc * 32 + 8 * fq, colw = u.pn * BM + wc * 32 + ((fq & 1) ? HALF + 8 * (fq - 1) : 8 * fq);
        u32x4 gbv[2][4];
#pragma unroll
        for (int ai = 0; ai < 2; ++ai)
#pragma unroll
            for (int m = 0; m < 4; ++m) gbv[ai][m] = *(const u32x4*)(GS + (size_t)(row0 + ai * HALF + m * 16) * DM + colw);
#pragma unroll
        for (int ai = 0; ai < 2; ++ai)
#pragma unroll
            for (int m = 0; m < 4; ++m) { const size_t rowoff = (size_t)(row0 + ai * HALF + m * 16) * DM;
                const u32x4 gb = gbv[ai][m];
                const u32x2 bx = __builtin_amdgcn_permlane16_swap(gb.x, gb.z, false, false), by = __builtin_amdgcn_permlane16_swap(gb.y, gb.w, false, false);
#pragma unroll
                for (int bj = 0; bj < 2; ++bj) { const unsigned b0 = bj ? bx.y : bx.x, b1 = bj ? by.y : by.x; const f32x4 v0 = acc[ai][bj][m][0], v1 = acc[ai][bj][m][1];
                    u32x4 w;
                    w.x = cvt_pk_bf16_asm(v0[0] * sigmoidf_(F8(b0, 0)), v0[1] * sigmoidf_(F8(b0, 1))); w.y = cvt_pk_bf16_asm(v0[2] * sigmoidf_(F8(b0, 2)), v0[3] * sigmoidf_(F8(b0, 3)));
                    w.z = cvt_pk_bf16_asm(v1[0] * sigmoidf_(F8(b1, 0)), v1[1] * sigmoidf_(F8(b1, 1))); w.w = cvt_pk_bf16_asm(v1[2] * sigmoidf_(F8(b1, 2)), v1[3] * sigmoidf_(F8(b1, 3)));
                    *(u32x4*)(O + rowoff + col0 + bj * HALF) = w; }
            }
    }
#undef F8
};
struct EpiRes {
    static constexpr bool PERM = true, HAS_MID = false;
    const float* res; float* out;
    __device__ __forceinline__ void mid(f32x4 (&acc)[2][2][4][2], const Unit& u, int wr, int wc, int fr, int fq) const {}
    __device__ __forceinline__ void operator()(const f32x4 (&acc)[2][2][4][2], const Unit& u, int wr, int wc, int fr, int fq) const {
        const int row0 = u.pm * BM + wr * 64 + fr, col0 = u.pn * BM + wc * 32 + 8 * fq;
#pragma unroll
        for (int ai = 0; ai < 2; ++ai)
#pragma unroll
            for (int m = 0; m < 4; ++m)
#pragma unroll
                for (int bj = 0; bj < 2; ++bj) { const size_t off = (size_t)(row0 + ai * HALF + m * 16) * DM + col0 + bj * HALF;
                    const f32x4 x0 = *(const f32x4*)(res + off), x1 = *(const f32x4*)(res + off + 4);
                    *(f32x4*)(out + off) = x0 + acc[ai][bj][m][0]; *(f32x4*)(out + off + 4) = x1 + acc[ai][bj][m][1]; }
    }
};
struct EpiResStat {
    static constexpr bool PERM = true, HAS_MID = false;
    const float* res; float* out; bf16_t* hb; float* ss;
    __device__ __forceinline__ void mid(f32x4 (&acc)[2][2][4][2], const Unit& u, int wr, int wc, int fr, int fq) const {}
    __device__ __forceinline__ void operator()(const f32x4 (&acc)[2][2][4][2], const Unit& u, int wr, int wc, int fr, int fq) const {
        const int row0 = u.pm * BM + wr * 64 + fr, col0 = u.pn * BM + wc * 32 + 8 * fq;
#pragma unroll
        for (int ai = 0; ai < 2; ++ai) {
          f32x4 xv[4][2][2];
#pragma unroll
          for (int m = 0; m < 4; ++m)
#pragma unroll
            for (int bj = 0; bj < 2; ++bj) { const size_t off = (size_t)(row0 + ai * HALF + m * 16) * DM + col0 + bj * HALF; xv[m][bj][0] = *(const f32x4*)(res + off); xv[m][bj][1] = *(const f32x4*)(res + off + 4); }
#pragma unroll
            for (int m = 0; m < 4; ++m) {
                float sq = 0.f;
#pragma unroll
                for (int bj = 0; bj < 2; ++bj) { const size_t off = (size_t)(row0 + ai * HALF + m * 16) * DM + col0 + bj * HALF;
                    const f32x4 h0 = xv[m][bj][0] + acc[ai][bj][m][0], h1 = xv[m][bj][1] + acc[ai][bj][m][1];
                    u32x4 w; w.x = cvt_pk_bf16_asm(h0[0], h0[1]); w.y = cvt_pk_bf16_asm(h0[2], h0[3]); w.z = cvt_pk_bf16_asm(h1[0], h1[1]); w.w = cvt_pk_bf16_asm(h1[2], h1[3]);
                    *(u32x4*)(hb + off) = w;
                    sq += (h0[0] * h0[0] + h0[1] * h0[1]) + (h0[2] * h0[2] + h0[3] * h0[3]) + (h1[0] * h1[0] + h1[1] * h1[1]) + (h1[2] * h1[2] + h1[3] * h1[3]); }
                sq += __shfl_xor(sq, 16); sq += __shfl_xor(sq, 32);
                if (fq == 0) atomicAdd(ss + row0 + ai * HALF + m * 16, sq);
            }
        }
    }
};
struct EpiResBf {
    static constexpr bool PERM = true, HAS_MID = false;
    const bf16_t* hb; float* out;
    __device__ __forceinline__ void mid(f32x4 (&acc)[2][2][4][2], const Unit& u, int wr, int wc, int fr, int fq) const {}
    __device__ __forceinline__ void operator()(const f32x4 (&acc)[2][2][4][2], const Unit& u, int wr, int wc, int fr, int fq) const {
        const int row0 = u.pm * BM + wr * 64 + fr, col0 = u.pn * BM + wc * 32 + 8 * fq;
#pragma unroll
        for (int ai = 0; ai < 2; ++ai) {
            u32x4 hv[4][2];
#pragma unroll
            for (int m = 0; m < 4; ++m)
#pragma unroll
                for (int bj = 0; bj < 2; ++bj) hv[m][bj] = *(const u32x4*)(hb + (size_t)(row0 + ai * HALF + m * 16) * DM + col0 + bj * HALF);
#pragma unroll
            for (int m = 0; m < 4; ++m)
#pragma unroll
                for (int bj = 0; bj < 2; ++bj) { const size_t off = (size_t)(row0 + ai * HALF + m * 16) * DM + col0 + bj * HALF;
                    const u32x4 h = hv[m][bj];
                    const f32x4 x0 = (f32x4){bf_lo(h.x), bf_hi(h.x), bf_lo(h.y), bf_hi(h.y)}, x1 = (f32x4){bf_lo(h.z), bf_hi(h.z), bf_lo(h.w), bf_hi(h.w)};
                    *(f32x4*)(out + off) = x0 + acc[ai][bj][m][0]; *(f32x4*)(out + off + 4) = x1 + acc[ai][bj][m][1]; }
        }
    }
};
struct EpiUp {
    static constexpr bool PERM = true, HAS_MID = false;
    bf16_t* O; const float* ss;
    __device__ __forceinline__ void mid(f32x4 (&acc)[2][2][4][2], const Unit& u, int wr, int wc, int fr, int fq) const {}
    __device__ __forceinline__ void operator()(const f32x4 (&acc)[2][2][4][2], const Unit& u, int wr, int wc, int fr, int fq) const {
        const int row0 = u.pm * BM + wr * 64 + fr, col0 = u.pn * BM + wc * 32 + 8 * fq;
        float ssv[2][4];
#pragma unroll
        for (int ai = 0; ai < 2; ++ai)
#pragma unroll
            for (int m = 0; m < 4; ++m) ssv[ai][m] = ss[row0 + ai * HALF + m * 16];
#pragma unroll
        for (int ai = 0; ai < 2; ++ai)
#pragma unroll
            for (int m = 0; m < 4; ++m) {
                const float rstd = __builtin_amdgcn_rsqf(ssv[ai][m] * (1.f / DM) + EPS);
#pragma unroll
                for (int bj = 0; bj < 2; ++bj) { const size_t off = (size_t)(row0 + ai * HALF + m * 16) * FF + col0 + bj * HALF;
                    f32x4 v0 = acc[ai][bj][m][0], v1 = acc[ai][bj][m][1];
#pragma unroll
                    for (int e = 0; e < 4; ++e) { const float a = fmaxf(v0[e] * rstd, 0.f), b = fmaxf(v1[e] * rstd, 0.f); v0[e] = a * a; v1[e] = b * b; }
                    u32x4 w; w.x = cvt_pk_bf16_asm(v0[0], v0[1]); w.y = cvt_pk_bf16_asm(v0[2], v0[3]); w.z = cvt_pk_bf16_asm(v1[0], v1[1]); w.w = cvt_pk_bf16_asm(v1[2], v1[3]);
                    *(u32x4*)(O + off) = w; }
            }
    }
};

template <class Epi, class Sched, bool ALIGN_EPI>
__device__ __forceinline__ void gemm_phase(LAS unsigned char* lds, const Gemm g, const Sched& S, const Epi& E) {
    int tid_ = threadIdx.x; asm volatile("" : "+v"(tid_));
    const int tid = tid_, wid = __builtin_amdgcn_readfirstlane(tid >> 6), lane = tid & 63, wr = wid >> 2, wc = wid & 3, fr = lane & 15, fq = lane >> 4;
    const int K = g.K, nt = K / BK;
    unsigned voffA[2], voffB[2];
#pragma unroll
    for (int i = 0; i < 2; ++i) { int R, C; stage_rc(tid * 16 + i * 8192, R, C); const int Rb = Epi::PERM ? ((R & ~31) + perm32(R & 31)) : R;
        voffA[i] = (unsigned)(R * K + C) * 2u; voffB[i] = (unsigned)(Rb * K + C) * 2u; }
    const size_t kstep = (size_t)(BK * 2);
    const size_t hstep = (size_t)HALF * K * 2;
    const size_t tstep = 2 * hstep;
    const unsigned ldsw = (unsigned)wid * 1024u;
    const int aoff = lds_byte(wr * 64 + fr, fq * 8), boff = lds_byte(wc * 32 + fr, fq * 8);
#define PG8_SA(b, h) (((b) * 2 + (h)) * HTB)
#define PG8_SB(b, h) ((4 + (b) * 2 + (h)) * HTB)
#define PG8_STAGE(bufoff, gbase, voff) do { _Pragma("unroll") for (int _i = 0; _i < 2; ++_i) \
        __builtin_amdgcn_global_load_lds((const unsigned*)((const char*)(gbase) + (voff)[_i]), (LAS unsigned*)(lds + (bufoff) + ldsw + _i * 8192), 16, 0, 0); } while (0)
#define PG8_LDA(dst, b, h) do { _Pragma("unroll") for (int m = 0; m < 4; ++m) _Pragma("unroll") for (int k = 0; k < 2; ++k) dst[m][k] = *(const LAS bf16x8*)(lds + PG8_SA(b, h) + aoff + m * 2048 + k * 1024); } while (0)
#define PG8_LDB(dst, b, h) do { _Pragma("unroll") for (int n = 0; n < 2; ++n) _Pragma("unroll") for (int k = 0; k < 2; ++k) dst[n][k] = *(const LAS bf16x8*)(lds + PG8_SB(b, h) + boff + n * 2048 + k * 1024); } while (0)
#define PG8_MMA(ai, bj, At, Bt) do { __builtin_amdgcn_s_setprio(1); _Pragma("unroll") for (int m = 0; m < 4; ++m) _Pragma("unroll") for (int n = 0; n < 2; ++n) _Pragma("unroll") for (int k = 0; k < 2; ++k) \
        acc[ai][bj][m][n] = __builtin_amdgcn_mfma_f32_16x16x32_bf16(Bt[n][k], At[m][k], acc[ai][bj][m][n], 0, 0, 0); __builtin_amdgcn_s_setprio(0); } while (0)
#define PG8_WAIT_V(n) asm volatile("s_waitcnt vmcnt(" #n ")" ::: "memory")
#define PG8_WAIT_L(n) asm volatile("s_waitcnt lgkmcnt(" #n ")" ::: "memory")
#define PG8_BAR __builtin_amdgcn_s_barrier()
#define PG8_SCHED __builtin_amdgcn_sched_barrier(0)
    Unit cur, nxt; int ui = 0;
    if (!S.next(0, cur)) return;
    f32x4 acc[2][2][4][2];
#pragma unroll
    for (int a = 0; a < 2; ++a)
#pragma unroll
        for (int b = 0; b < 2; ++b)
#pragma unroll
            for (int m = 0; m < 4; ++m)
#pragma unroll
                for (int n = 0; n < 2; ++n) acc[a][b][m][n] = (f32x4){0.f, 0.f, 0.f, 0.f};
    bf16x8 At[4][2], B0[2][2], B1[2][2];
    const char* cA = (const char*)(cur.seg ? g.A2 : g.A) + (size_t)cur.pm * tstep; const char* cB = (const char*)(cur.seg ? g.Bt2 : g.Bt) + (size_t)cur.pn * tstep;
    PG8_STAGE(PG8_SB(0, 0), cB, voffB); PG8_STAGE(PG8_SB(0, 1), cB + hstep, voffB); PG8_STAGE(PG8_SA(0, 0), cA, voffA); PG8_STAGE(PG8_SA(0, 1), cA + hstep, voffA);
    if (wr == 1) PG8_BAR;
    PG8_WAIT_V(2); PG8_BAR;
    PG8_STAGE(PG8_SB(1, 0), cB + kstep, voffB); PG8_STAGE(PG8_SA(1, 0), cA + kstep, voffA); PG8_STAGE(PG8_SB(1, 1), cB + hstep + kstep, voffB);
    PG8_WAIT_V(6); PG8_BAR;
    for (;;) {
        const bool has_next = S.next(ui + 1, nxt);
        const char* nA = has_next ? (const char*)(nxt.seg ? g.A2 : g.A) + (size_t)nxt.pm * tstep : cA; const char* nB = has_next ? (const char*)(nxt.seg ? g.Bt2 : g.Bt) + (size_t)nxt.pn * tstep : cB;
        for (int t = 0; t < nt; t += 2) {
            const bool last = (t == nt - 2);
            const char* a1 = cA + (size_t)(t + 1) * kstep;
            const char* a2 = last ? nA : cA + (size_t)(t + 2) * kstep; const char* b2 = last ? nB : cB + (size_t)(t + 2) * kstep;
            const char* a3 = a2 + kstep; const char* b3 = b2 + kstep;
            PG8_LDB(B0, 0, 0); PG8_LDB(B1, 0, 1); PG8_SCHED; PG8_LDA(At, 0, 0); PG8_STAGE(PG8_SA(1, 1), a1 + hstep, voffA);
            PG8_WAIT_V(8); PG8_WAIT_L(0); PG8_BAR; PG8_MMA(0, 0, At, B0); PG8_MMA(0, 1, At, B1); PG8_BAR; PG8_SCHED;
            PG8_LDA(At, 0, 1); PG8_STAGE(PG8_SB(0, 0), b2, voffB); PG8_STAGE(PG8_SB(0, 1), b2 + hstep, voffB); PG8_STAGE(PG8_SA(0, 0), a2, voffA);
            PG8_WAIT_V(8); PG8_WAIT_L(0); PG8_BAR; PG8_MMA(1, 0, At, B0); PG8_MMA(1, 1, At, B1); PG8_BAR; PG8_SCHED;
            PG8_LDB(B0, 1, 0); PG8_LDB(B1, 1, 1); PG8_SCHED; PG8_LDA(At, 1, 0); PG8_STAGE(PG8_SA(0, 1), a2 + hstep, voffA);
            PG8_WAIT_V(8); PG8_WAIT_L(0); PG8_BAR; PG8_MMA(0, 0, At, B0); PG8_MMA(0, 1, At, B1); PG8_BAR; PG8_SCHED;
            PG8_LDA(At, 1, 1); PG8_STAGE(PG8_SB(1, 0), b3, voffB); PG8_STAGE(PG8_SB(1, 1), b3 + hstep, voffB); PG8_STAGE(PG8_SA(1, 0), a3, voffA);
            PG8_WAIT_V(8); PG8_WAIT_L(0); PG8_BAR; PG8_MMA(1, 0, At, B0); PG8_MMA(1, 1, At, B1); PG8_BAR; PG8_SCHED;
        }
        if constexpr (ALIGN_EPI) { if (wr == 0) PG8_BAR; }
        bool keep = false;
        if constexpr (Epi::HAS_MID) keep = (cur.seg == 0);
        if (keep) E.mid(acc, cur, wr, wc, fr, fq); else E(acc, cur, wr, wc, fr, fq);
        if (!has_next) break;
        if (!keep) {
#pragma unroll
            for (int a = 0; a < 2; ++a)
#pragma unroll
                for (int b = 0; b < 2; ++b)
#pragma unroll
                    for (int m = 0; m < 4; ++m)
#pragma unroll
                        for (int n = 0; n < 2; ++n) acc[a][b][m][n] = (f32x4){0.f, 0.f, 0.f, 0.f};
        }
        cur = nxt; cA = nA; cB = nB; ++ui;
        if constexpr (ALIGN_EPI) { if (wr == 1) PG8_BAR; }
    }
    PG8_WAIT_V(0);
    if constexpr (!ALIGN_EPI) { if (wr == 0) PG8_BAR; }
    PG8_BAR;
#undef PG8_SA
#undef PG8_SB
#undef PG8_STAGE
#undef PG8_LDA
#undef PG8_LDB
#undef PG8_MMA
#undef PG8_WAIT_V
#undef PG8_WAIT_L
#undef PG8_BAR
#undef PG8_SCHED
}
}

struct Args {
    const float *x, *meta, *mix_g, *w_in, *ret_g, *q_g, *k_g, *sinks, *w_ret, *w_swa, *w_out, *mlp_g, *w_up, *w_down;
    float* out; unsigned char* ws;
};

__device__ __forceinline__ void p0_transpose_item(const float* W, int K, int N, bf16_t* WT, LAS float* scr, int item, int lane, const float* kgain = nullptr) {
    const int nblk = N / 32, kb = item / nblk, nb = item % nblk, k0 = 64 * kb, n0 = 32 * nb;
    f32x4 wv[8];
#pragma unroll
    for (int i = 0; i < 8; ++i) wv[i] = *(const f32x4*)(W + (size_t)(k0 + 8 * i + (lane >> 3)) * N + n0 + 4 * (lane & 7));
#pragma unroll
    for (int i = 0; i < 8; ++i) { const int kk = 8 * i + (lane >> 3); f32x4 v = wv[i]; if (kgain) v = v * kgain[k0 + kk];
        LAS float* d = scr + kk * 33 + 4 * (lane & 7); d[0] = v.x; d[1] = v.y; d[2] = v.z; d[3] = v.w; }
    asm volatile("s_waitcnt lgkmcnt(0)" ::: "memory");
    const int c = lane & 7;
#pragma unroll
    for (int j = 0; j < 4; ++j) { const int n = (lane >> 3) + 8 * j; const LAS float* s = scr + (8 * c) * 33 + n;
        u32x4 o; o.x = cvt_pk_bf16_asm(s[0 * 33], s[1 * 33]); o.y = cvt_pk_bf16_asm(s[2 * 33], s[3 * 33]); o.z = cvt_pk_bf16_asm(s[4 * 33], s[5 * 33]); o.w = cvt_pk_bf16_asm(s[6 * 33], s[7 * 33]);
        *(u32x4*)(WT + (size_t)(n0 + n) * K + k0 + 8 * c) = o; }
    asm volatile("s_waitcnt lgkmcnt(0)" ::: "memory");
}
__device__ __forceinline__ void rms_row_to_bf16(const float* xrow, const float* g, bf16_t* orow, int lane) {
    const f32x4* xr = (const f32x4*)xrow + lane; const f32x4* gr = (const f32x4*)g + lane;
    f32x4 v[4]; float s = 0.f;
#pragma unroll
    for (int j = 0; j < 4; ++j) { v[j] = xr[64 * j]; s += (v[j].x * v[j].x + v[j].y * v[j].y) + (v[j].z * v[j].z + v[j].w * v[j].w); }
    const float rstd = 1.f / sqrtf(wave_sum(s) * (1.f / DM) + EPS);
    u32x2* o8 = (u32x2*)orow + lane;
#pragma unroll
    for (int j = 0; j < 4; ++j) { const f32x4 gg = gr[64 * j]; u32x2 w; w.x = cvt_pk_bf16_asm(v[j].x * rstd * gg.x, v[j].y * rstd * gg.y); w.y = cvt_pk_bf16_asm(v[j].z * rstd * gg.z, v[j].w * rstd * gg.w); o8[64 * j] = w; }
}

__device__ __forceinline__ void tr_write8(LAS unsigned char* base, int RS, int col0, int pp, u32x4 r0, u32x4 r1) {
#define TRW(i, w0, w1) *(LAS unsigned*)(base + ((size_t)(col0 + (i)) * RS + 2 * pp) * 2) = ((i) & 1) ? (((w0) >> 16) | ((w1) & 0xffff0000u)) : (((w0) & 0xffffu) | ((w1) << 16))
    TRW(0, r0.x, r1.x); TRW(1, r0.x, r1.x); TRW(2, r0.y, r1.y); TRW(3, r0.y, r1.y); TRW(4, r0.z, r1.z); TRW(5, r0.z, r1.z); TRW(6, r0.w, r1.w); TRW(7, r0.w, r1.w);
#undef TRW
}

__device__ __forceinline__ int tr_off(int col, int RS, int slot) { return col * RS * 2 + ((slot ^ (2 * ((col >> 3) & 15))) << 3); }
__device__ __forceinline__ void tr_write8s(LAS unsigned char* base, int RS, int col0, int pp, u32x4 r0, u32x4 r1) {
    const int sw2 = 2 * ((col0 >> 3) & 15), po = (((pp >> 1) ^ sw2) << 3) + ((pp & 1) << 2);
#define TRW(i, w0, w1) *(LAS unsigned*)(base + (col0 + (i)) * RS * 2 + po) = ((i) & 1) ? (((w0) >> 16) | ((w1) & 0xffff0000u)) : (((w0) & 0xffffu) | ((w1) << 16))
    TRW(0, r0.x, r1.x); TRW(1, r0.x, r1.x); TRW(2, r0.y, r1.y); TRW(3, r0.y, r1.y); TRW(4, r0.z, r1.z); TRW(5, r0.z, r1.z); TRW(6, r0.w, r1.w); TRW(7, r0.w, r1.w);
#undef TRW
}
__device__ __forceinline__ u32x4 scale8(u32x4 r, float f) {
    u32x4 o; o.x = cvt_pk_bf16(bf_lo(r.x) * f, bf_hi(r.x) * f); o.y = cvt_pk_bf16(bf_lo(r.y) * f, bf_hi(r.y) * f); o.z = cvt_pk_bf16(bf_lo(r.z) * f, bf_hi(r.z) * f); o.w = cvt_pk_bf16(bf_lo(r.w) * f, bf_hi(r.w) * f); return o;
}
__device__ __forceinline__ bf16x8 as_frag(u32x4 v) { return __builtin_bit_cast(bf16x8, v); }
#define MFMA16(a, b, c) __builtin_amdgcn_mfma_f32_16x16x32_bf16((a), (b), (c), 0, 0, 0)

__device__ __forceinline__ long swa_key_row(int b, int c, int kk) {
    if (kk < 16) return (long)NTOK + kk;
    if (kk < 272) { const int s = (c - 1) * 128 + (kk - 16); if (s >= 128) return (long)b * SEQ + s - 128; }
    return -1;
}
__device__ __forceinline__ void swa_phase(LAS unsigned char* lds, const Args& p) {
    int tid_ = threadIdx.x; asm volatile("" : "+v"(tid_));
    const int tid = tid_, lane = tid & 63, w = __builtin_amdgcn_readfirstlane(tid >> 6), r = lane & 15, q = lane >> 4;
    const bf16_t* SQ = (const bf16_t*)(p.ws + OFF_SQ); const bf16_t* SK = (const bf16_t*)(p.ws + OFF_SK); const bf16_t* SV = (const bf16_t*)(p.ws + OFF_SV);
    bf16_t* YSWA = (bf16_t*)((unsigned char*)p.out + DOUT_YSWA);
    constexpr int KS = 72, VS = 296, K_OFF = 0, VT_OFF = 288 * KS * 2;
    constexpr float LOG2E = 1.4426950408889634f;
    const int kch = tid & 7, G = gridDim.x;
    const f32x4 kg0 = *(const f32x4*)(p.k_g + kch * 8), kg1 = *(const f32x4*)(p.k_g + kch * 8 + 4);
    u32x4 kraw[5], vraw[6];
#define SWA_LOAD_UNIT(uu) do { const int b_ = (uu) >> 8, c_ = 1 + (((uu) & 255) >> 2), kvh_ = (uu) & 3; \
        _Pragma("unroll") for (int it = 0; it < 5; ++it) { const int kk = (it * NTHREADS + tid) >> 3; const long row = swa_key_row(b_, c_, kk); \
            kraw[it] = (u32x4){0u, 0u, 0u, 0u}; if (row >= 0) kraw[it] = *(const u32x4*)(SK + (size_t)row * 256 + kvh_ * 64 + kch * 8); } \
        _Pragma("unroll") for (int it = 0; it < 3; ++it) { const int id = it * NTHREADS + tid, ch = id / 144, pp = id % 144; \
            _Pragma("unroll") for (int e = 0; e < 2; ++e) { const long row = (id < 1152) ? swa_key_row(b_, c_, 2 * pp + e) : -1; \
                vraw[2 * it + e] = (u32x4){0u, 0u, 0u, 0u}; if (row >= 0) vraw[2 * it + e] = *(const u32x4*)(SV + (size_t)row * 256 + kvh_ * 64 + ch * 8); } } } while (0)
    int u = blockIdx.x;
    if (u >= 1024) return;
    SWA_LOAD_UNIT(u);
    for (; u < 1024; u += G) {
        const int b = u >> 8, c = 1 + ((u & 255) >> 2), kvh = u & 3;
        __syncthreads();
#pragma unroll
        for (int it = 0; it < 5; ++it) {
            const int kk = (it * NTHREADS + tid) >> 3; const u32x4 raw = kraw[it];
            const float f0 = bf_lo(raw.x), f1 = bf_hi(raw.x), f2 = bf_lo(raw.y), f3 = bf_hi(raw.y), f4 = bf_lo(raw.z), f5 = bf_hi(raw.z), f6 = bf_lo(raw.w), f7 = bf_hi(raw.w);
            float ss = (f0 * f0 + f1 * f1) + (f2 * f2 + f3 * f3) + (f4 * f4 + f5 * f5) + (f6 * f6 + f7 * f7);
            ss += __shfl_xor(ss, 1); ss += __shfl_xor(ss, 2); ss += __shfl_xor(ss, 4);
            const float rstd = __builtin_amdgcn_rsqf(ss * (1.f / 64.f) + EPS);
            u32x4 o; o.x = cvt_pk_bf16(f0 * rstd * kg0.x, f1 * rstd * kg0.y); o.y = cvt_pk_bf16(f2 * rstd * kg0.z, f3 * rstd * kg0.w);
            o.z = cvt_pk_bf16(f4 * rstd * kg1.x, f5 * rstd * kg1.y); o.w = cvt_pk_bf16(f6 * rstd * kg1.z, f7 * rstd * kg1.w);
            if (kk < 288) *(LAS u32x4*)(lds + K_OFF + (kk * KS + kch * 8) * 2) = o;
        }
#pragma unroll
        for (int it = 0; it < 3; ++it) { const int id = it * NTHREADS + tid; if (id < 1152) tr_write8(lds + VT_OFF, VS, (id / 144) * 8, id % 144, vraw[2 * it], vraw[2 * it + 1]); }
        __syncthreads();
        const int qt = w, iq = 16 * qt + r;
        const size_t qrow = (size_t)b * SEQ + (size_t)(c - 1) * 128 + iq;
        u32x4 qa = *(const u32x4*)(SQ + qrow * 1024 + (kvh * 4) * 64 + 8 * q), qb = *(const u32x4*)(SQ + qrow * 1024 + (kvh * 4) * 64 + 32 + 8 * q);
        { const int un = (u + G < 1024) ? u + G : u; SWA_LOAD_UNIT(un); }
#pragma unroll 1
        for (int hl = 0; hl < 4; ++hl) {
            const int h = kvh * 4 + hl;
            bf16x8 Qf[2];
            {
                const u32x4 a = qa, bq = qb;
                const int hn = kvh * 4 + ((hl + 1) & 3);
                qa = *(const u32x4*)(SQ + qrow * 1024 + hn * 64 + 8 * q); qb = *(const u32x4*)(SQ + qrow * 1024 + hn * 64 + 32 + 8 * q);
                float fa[8] = {bf_lo(a.x), bf_hi(a.x), bf_lo(a.y), bf_hi(a.y), bf_lo(a.z), bf_hi(a.z), bf_lo(a.w), bf_hi(a.w)};
                float fb[8] = {bf_lo(bq.x), bf_hi(bq.x), bf_lo(bq.y), bf_hi(bq.y), bf_lo(bq.z), bf_hi(bq.z), bf_lo(bq.w), bf_hi(bq.w)};
                float ss = 0.f;
#pragma unroll
                for (int e = 0; e < 8; ++e) ss += fa[e] * fa[e] + fb[e] * fb[e];
                ss += __shfl_xor(ss, 16); ss += __shfl_xor(ss, 32);
                const float rs = (0.125f * LOG2E) * __builtin_amdgcn_rsqf(ss * (1.f / 64.f) + EPS);
                const f32x4 ga0 = *(const f32x4*)(p.q_g + 8 * q), ga1 = *(const f32x4*)(p.q_g + 8 * q + 4), gb0 = *(const f32x4*)(p.q_g + 32 + 8 * q), gb1 = *(const f32x4*)(p.q_g + 32 + 8 * q + 4);
                u32x4 oa, ob;
                oa.x = cvt_pk_bf16(fa[0] * rs * ga0.x, fa[1] * rs * ga0.y); oa.y = cvt_pk_bf16(fa[2] * rs * ga0.z, fa[3] * rs * ga0.w); oa.z = cvt_pk_bf16(fa[4] * rs * ga1.x, fa[5] * rs * ga1.y); oa.w = cvt_pk_bf16(fa[6] * rs * ga1.z, fa[7] * rs * ga1.w);
                ob.x = cvt_pk_bf16(fb[0] * rs * gb0.x, fb[1] * rs * gb0.y); ob.y = cvt_pk_bf16(fb[2] * rs * gb0.z, fb[3] * rs * gb0.w); ob.z = cvt_pk_bf16(fb[4] * rs * gb1.x, fb[5] * rs * gb1.y); ob.w = cvt_pk_bf16(fb[6] * rs * gb1.z, fb[7] * rs * gb1.w);
                Qf[0] = as_frag(oa); Qf[1] = as_frag(ob);
            }
            const float slope2 = exp2f(-0.5f * (float)(h + 1)) * LOG2E, sink2 = p.sinks[h] * LOG2E;
            const float bbase = -slope2 * (float)(144 + r - 4 * q), mbase = -slope2 * (float)(c * 128 + iq - 112 - 4 * q);
            const float sl1 = slope2, sl2 = 2.f * slope2, sl3 = 3.f * slope2;
            const int d0 = 144 + r - 4 * q;
            f32x4 sc[10]; float mx = -1e30f;
#pragma unroll
            for (int t = 0; t < 10; ++t) {
                const int kt = (t == 0) ? 0 : qt + t;
                f32x4 acc = (f32x4){0.f, 0.f, 0.f, 0.f};
#pragma unroll
                for (int ks = 0; ks < 2; ++ks) { const bf16x8 a = *(const LAS bf16x8*)(lds + K_OFF + ((16 * kt + r) * KS + 32 * ks + 8 * q) * 2); acc = MFMA16(a, Qf[ks], acc); }
                const float tb = (t == 0) ? mbase : bbase + slope2 * (float)(16 * t) + ((c == 1 && kt <= 8) ? -1e30f : 0.f);
                acc[0] += tb; acc[1] += tb + sl1; acc[2] += tb + sl2; acc[3] += tb + sl3;
                if (t == 1) {
#pragma unroll
                    for (int i = 0; i < 4; ++i) if (d0 - 16 - i >= 128) acc[i] = -1e30f;
                }
                if (t == 9) {
#pragma unroll
                    for (int i = 0; i < 4; ++i) if (d0 - 144 - i < 0) acc[i] = -1e30f;
                }
                mx = fmaxf(fmaxf(mx, fmaxf(acc[0], acc[1])), fmaxf(acc[2], acc[3]));
                sc[t] = acc;
                if (t == 4) __builtin_amdgcn_sched_barrier(0);
            }
            mx = fmaxf(mx, __shfl_xor(mx, 16)); mx = fmaxf(mx, __shfl_xor(mx, 32)); mx = fmaxf(mx, sink2);
            float sum = 0.f; u32x2 Pk[10];
#pragma unroll
            for (int t = 0; t < 10; ++t) { const float p0 = __builtin_amdgcn_exp2f(sc[t][0] - mx), p1 = __builtin_amdgcn_exp2f(sc[t][1] - mx), p2 = __builtin_amdgcn_exp2f(sc[t][2] - mx), p3 = __builtin_amdgcn_exp2f(sc[t][3] - mx);
                sum += (p0 + p1) + (p2 + p3); Pk[t].x = cvt_pk_bf16(p0, p1); Pk[t].y = cvt_pk_bf16(p2, p3); }
            sum += __shfl_xor(sum, 16); sum += __shfl_xor(sum, 32);
            const float inv = __builtin_amdgcn_rcpf(sum + __builtin_amdgcn_exp2f(sink2 - mx));
#pragma unroll 1
            for (int dtp = 0; dtp < 2; ++dtp) {
                u32x2 ov[2];
#pragma unroll
                for (int e = 0; e < 2; ++e) {
                    const int dt = 2 * dtp + e;
                    f32x4 acc = (f32x4){0.f, 0.f, 0.f, 0.f};
#pragma unroll
                    for (int pr = 0; pr < 5; ++pr) {
                        const int t0 = 2 * pr, t1 = 2 * pr + 1, kt0 = (t0 == 0) ? 0 : qt + t0, kt1 = qt + t1;
                        const LAS unsigned char* vp = lds + VT_OFF + ((16 * dt + r) * VS + 4 * q) * 2;
                        const u32x2 a0 = *(const LAS u32x2*)(vp + 32 * kt0), a1 = *(const LAS u32x2*)(vp + 32 * kt1);
                        const u32x4 a = (u32x4){a0.x, a0.y, a1.x, a1.y}, bb = (u32x4){Pk[t0].x, Pk[t0].y, Pk[t1].x, Pk[t1].y};
                        acc = MFMA16(as_frag(a), as_frag(bb), acc);
                    }
                    ov[e].x = cvt_pk_bf16(acc[0] * inv, acc[1] * inv); ov[e].y = cvt_pk_bf16(acc[2] * inv, acc[3] * inv);
                }
                const int dw = 32 * dtp + ((q & 1) ? 16 + 4 * (q - 1) : 4 * q);
                const u32x2 ox = __builtin_amdgcn_permlane16_swap(ov[0].x, ov[1].x, false, false), oy = __builtin_amdgcn_permlane16_swap(ov[0].y, ov[1].y, false, false);
                *(u32x4*)(YSWA + qrow * 1024 + h * 64 + dw) = (u32x4){ox.x, oy.x, ox.y, oy.y};
            }
        }
    }
#undef SWA_LOAD_UNIT
}

__device__ __forceinline__ size_t kvs_slot(int b, int n, int h) { return ((size_t)((b * 64 + n) * 4 + h)) * 32768; }
__device__ __forceinline__ void kvlocal_phase(LAS unsigned char* lds, const Args& p) {
    int tid_ = threadIdx.x; asm volatile("" : "+v"(tid_));
    const int tid = tid_, lane = tid & 63, w = __builtin_amdgcn_readfirstlane(tid >> 6), r = lane & 15, q = lane >> 4;
    const bf16_t* RK = (const bf16_t*)(p.ws + OFF_RK); const bf16_t* RV = (const bf16_t*)(p.ws + OFF_RV);
    bf16_t* KVS = (bf16_t*)((unsigned char*)p.out + DOUT_KVS);
    constexpr int RS = 136, KT_OFF = 0, VT_OFF = 128 * RS * 2;
    u32x4 kr[2][2], vr[4][2];
#define KV_LOAD_UNIT(uu) do { const int b_ = (uu) >> 8, n_ = ((uu) & 255) >> 2, h_ = (uu) & 3; \
        _Pragma("unroll") for (int it = 0; it < 2; ++it) { const int id = it * NTHREADS + tid, ch = id & 15, pr = id >> 4; \
            _Pragma("unroll") for (int e = 0; e < 2; ++e) { const int i = 2 * pr + e; long row; \
                if (n_ == 0) row = (i < 112) ? -1 : (long)NTOK + i - 112; else row = (long)b_ * SEQ + (n_ - 1) * 128 + i; \
                kr[it][e] = (u32x4){0u, 0u, 0u, 0u}; if (row >= 0) kr[it][e] = *(const u32x4*)(RK + (size_t)row * 512 + h_ * 128 + ch * 8); } } \
        _Pragma("unroll") for (int it = 0; it < 4; ++it) { const int id = it * NTHREADS + tid, ch = id & 31, pr = id >> 5; \
            _Pragma("unroll") for (int e = 0; e < 2; ++e) { const int i = 2 * pr + e; long row; \
                if (n_ == 0) row = (i < 112) ? -1 : (long)NTOK + i - 112; else row = (long)b_ * SEQ + (n_ - 1) * 128 + i; \
                vr[it][e] = (u32x4){0u, 0u, 0u, 0u}; if (row >= 0) vr[it][e] = *(const u32x4*)(RV + (size_t)row * 1024 + h_ * 256 + ch * 8); } } } while (0)
    int u = blockIdx.x;
    if (u >= 1024) return;
    const int G = gridDim.x;
    KV_LOAD_UNIT(u);
    for (; u < 1024; u += G) {
        const int b = u >> 8, n = (u & 255) >> 2, h = u & 3;
        const float lg2 = log2f(1.0f - exp2f(-5.0f - (float)h));
        __syncthreads();
#pragma unroll
        for (int it = 0; it < 2; ++it) { const int id = it * NTHREADS + tid, ch = id & 15, pr = id >> 4;
            const float f0 = 0.08838834764831845f * __builtin_amdgcn_exp2f(lg2 * (float)(127 - 2 * pr)), f1 = 0.08838834764831845f * __builtin_amdgcn_exp2f(lg2 * (float)(126 - 2 * pr));
            tr_write8s(lds + KT_OFF, RS, ch * 8, pr, scale8(kr[it][0], f0), scale8(kr[it][1], f1)); }
#pragma unroll
        for (int it = 0; it < 4; ++it) { const int id = it * NTHREADS + tid, ch = id & 31, pr = id >> 5;
            tr_write8s(lds + VT_OFF, RS, ch * 8, pr, vr[it][0], vr[it][1]); }
        __syncthreads();
        { const int un = (u + G < 1024) ? u + G : u; KV_LOAD_UNIT(un); }
        const int mt = w;
        bf16x8 a[4];
#pragma unroll
        for (int ks = 0; ks < 4; ++ks) a[ks] = *(const LAS bf16x8*)(lds + KT_OFF + tr_off(16 * mt + r, RS, 8 * ks + 2 * q));
        bf16_t* dst = KVS + kvs_slot(b, n, h);
#pragma unroll 2
        for (int ntp = 0; ntp < 8; ++ntp) {
            u32x2 ov[2];
#pragma unroll
            for (int e = 0; e < 2; ++e) {
                const int nt = 2 * ntp + e;
                f32x4 acc = (f32x4){0.f, 0.f, 0.f, 0.f};
#pragma unroll
                for (int ks = 0; ks < 4; ++ks) { const bf16x8 bb = *(const LAS bf16x8*)(lds + VT_OFF + tr_off(16 * nt + r, RS, 8 * ks + 2 * q)); acc = MFMA16(a[ks], bb, acc); }
                ov[e].x = cvt_pk_bf16(acc[0], acc[1]); ov[e].y = cvt_pk_bf16(acc[2], acc[3]);
            }
            const u32x2 ox = __builtin_amdgcn_permlane16_swap(ov[0].x, ov[1].x, false, false), oy = __builtin_amdgcn_permlane16_swap(ov[0].y, ov[1].y, false, false);
            const int row = 16 * (2 * ntp + (q & 1)) + r, dk0 = 16 * mt + 4 * (q & ~1);
            *(u32x4*)(dst + (size_t)row * 128 + dk0) = (u32x4){ox.x, oy.x, ox.y, oy.y};
        }
    }
#undef KV_LOAD_UNIT
}

__device__ __forceinline__ void scan_phase(const Args& p) {
    bf16_t* KVS = (bf16_t*)((unsigned char*)p.out + DOUT_KVS);
    if (threadIdx.x >= 256) return;
    for (int gid = blockIdx.x * 256 + threadIdx.x; gid < 16 * 4096; gid += gridDim.x * 256) {
        const int bh = gid >> 12, b = bh >> 2, h = bh & 3, off = (gid & 4095) * 8;
        const float dec = exp2f(128.0f * log2f(1.0f - exp2f(-5.0f - (float)h)));
        float s0 = 0.f, s1 = 0.f, s2 = 0.f, s3 = 0.f, s4 = 0.f, s5 = 0.f, s6 = 0.f, s7 = 0.f;
        bf16_t* base = KVS + kvs_slot(b, 0, h) + off;
        for (int n0 = 0; n0 < 64; n0 += 16) {
            u32x4 v[16];
#pragma unroll
            for (int j = 0; j < 16; ++j) v[j] = *(const u32x4*)(base + (size_t)(n0 + j) * 4 * 32768);
#pragma unroll
            for (int j = 0; j < 16; ++j) {
                s0 = dec * s0 + bf_lo(v[j].x); s1 = dec * s1 + bf_hi(v[j].x); s2 = dec * s2 + bf_lo(v[j].y); s3 = dec * s3 + bf_hi(v[j].y);
                s4 = dec * s4 + bf_lo(v[j].z); s5 = dec * s5 + bf_hi(v[j].z); s6 = dec * s6 + bf_lo(v[j].w); s7 = dec * s7 + bf_hi(v[j].w);
                u32x4 o; o.x = cvt_pk_bf16(s0, s1); o.y = cvt_pk_bf16(s2, s3); o.z = cvt_pk_bf16(s4, s5); o.w = cvt_pk_bf16(s6, s7);
                *(u32x4*)(base + (size_t)(n0 + j) * 4 * 32768) = o;
            }
        }
    }
}

__device__ __forceinline__ void retout_phase(LAS unsigned char* lds, const Args& p) {
    int tid_ = threadIdx.x; asm volatile("" : "+v"(tid_));
    const int tid = tid_, lane = tid & 63, w = __builtin_amdgcn_readfirstlane(tid >> 6), r = lane & 15, q = lane >> 4;
    const bf16_t* RQ = (const bf16_t*)(p.ws + OFF_RQ); const bf16_t* RK = (const bf16_t*)(p.ws + OFF_RK); const bf16_t* RV = (const bf16_t*)(p.ws + OFF_RV); const bf16_t* RG = (const bf16_t*)(p.ws + OFF_RG);
    const bf16_t* KVS = (const bf16_t*)((unsigned char*)p.out + DOUT_KVS);
    bf16_t* YRET = (bf16_t*)(p.ws + OFF_YRET);
    constexpr int RS = 136, K_OFF = 0, SB = 128 * RS * 2, QSZ = 64 * RS * 2;
    const int G = gridDim.x, vch = tid & 7, vpr = tid >> 3, srow = tid >> 4, sch = tid & 15;
    const LAS unsigned char* vlb = lds + SB + r * RS * 2 + ((q ^ (2 * (r >> 3))) << 3);
    u32x4 kreg[4], vreg[2], sreg[2], qn[4];
#define RO_LOAD_KQ(uu) do { const int b_ = (uu) >> 8, c_ = 1 + (((uu) & 255) >> 2), h_ = (uu) & 3; const size_t tb_ = (size_t)b_ * SEQ + (size_t)(c_ - 1) * 128; \
        _Pragma("unroll") for (int it = 0; it < 4; ++it) kreg[it] = *(const u32x4*)(RK + (tb_ + 32 * it + srow) * 512 + h_ * 128 + sch * 8); } while (0)
#define RO_LOAD_Q(uu) do { const int b_ = (uu) >> 8, c_ = 1 + (((uu) & 255) >> 2), h_ = (uu) & 3; const size_t tb_ = (size_t)b_ * SEQ + (size_t)(c_ - 1) * 128; \
        _Pragma("unroll") for (int ks = 0; ks < 4; ++ks) qn[ks] = *(const u32x4*)(RQ + (tb_ + 16 * w + r) * 512 + h_ * 128 + 32 * ks + 8 * q); } while (0)
#define RO_LOAD_STAGE(uu, sg) do { const int b_ = (uu) >> 8, c_ = 1 + (((uu) & 255) >> 2), h_ = (uu) & 3; const size_t tb_ = (size_t)b_ * SEQ + (size_t)(c_ - 1) * 128; \
        const bf16_t* st_ = KVS + kvs_slot(b_, c_ - 1, h_) + (size_t)(64 * (sg)) * 128; \
        vreg[0] = *(const u32x4*)(RV + (tb_ + 2 * vpr) * 1024 + h_ * 256 + 64 * (sg) + vch * 8); vreg[1] = *(const u32x4*)(RV + (tb_ + 2 * vpr + 1) * 1024 + h_ * 256 + 64 * (sg) + vch * 8); \
        sreg[0] = *(const u32x4*)(st_ + (size_t)srow * 128 + sch * 8); sreg[1] = *(const u32x4*)(st_ + (size_t)(32 + srow) * 128 + sch * 8); } while (0)
#define RO_WRITE_K() do { _Pragma("unroll") for (int it = 0; it < 4; ++it) *(LAS u32x4*)(lds + K_OFF + ((32 * it + srow) * RS + sch * 8) * 2) = kreg[it]; } while (0)
#define RO_WRITE_STAGE(j) do { tr_write8s(lds + SB + 2 * (j) * QSZ, RS, vch * 8, vpr, vreg[0], vreg[1]); \
        *(LAS u32x4*)(lds + SB + (2 * (j) + 1) * QSZ + (srow * RS + sch * 8) * 2) = sreg[0]; *(LAS u32x4*)(lds + SB + (2 * (j) + 1) * QSZ + ((32 + srow) * RS + sch * 8) * 2) = sreg[1]; } while (0)
    int u = blockIdx.x;
    if (u >= 1024) return;
    RO_LOAD_KQ(u); RO_LOAD_Q(u); RO_LOAD_STAGE(u, 0);
    __syncthreads();
    RO_WRITE_K(); RO_WRITE_STAGE(0);
    __syncthreads();
    for (; u < 1024; u += G) {
        const int b = u >> 8, c = 1 + ((u & 255) >> 2), h = u & 3, un = (u + G < 1024) ? u + G : u;
        const size_t tokbase = (size_t)b * SEQ + (size_t)(c - 1) * 128;
        const float lg2 = log2f(1.0f - exp2f(-5.0f - (float)h));
        const int iq = 16 * w + r; const size_t qrow = tokbase + iq;
        bf16x8 Qd[4]; u32x2 Pk[8]; f32x4 o[16];
        {
#pragma unroll
            for (int kt = 0; kt < 8; ++kt) {
                {
                    f32x4 acc = (f32x4){0.f, 0.f, 0.f, 0.f};
#pragma unroll
                    for (int ks = 0; ks < 4; ++ks) { const bf16x8 a = *(const LAS bf16x8*)(lds + K_OFF + ((16 * kt + r) * RS + 32 * ks + 8 * q) * 2); acc = MFMA16(a, as_frag(qn[ks]), acc); }
#pragma unroll
                    for (int i = 0; i < 4; ++i) { const int d = iq - (16 * kt + 4 * q + i); acc[i] = (d >= 0) ? acc[i] * 0.08838834764831845f * __builtin_amdgcn_exp2f(lg2 * (float)d) : 0.f; }
                    Pk[kt].x = cvt_pk_bf16(acc[0], acc[1]); Pk[kt].y = cvt_pk_bf16(acc[2], acc[3]);
                }
                if (kt & 1) __builtin_amdgcn_sched_barrier(0);
            }
            const float qdec = __builtin_amdgcn_exp2f(lg2 * (float)(iq + 1));
#pragma unroll
            for (int ks = 0; ks < 4; ++ks) Qd[ks] = as_frag(scale8(qn[ks], qdec));
        }
#pragma unroll
        for (int sg = 0; sg < 4; ++sg) {
            if (sg < 3) RO_LOAD_STAGE(u, sg + 1); else { RO_LOAD_KQ(un); RO_LOAD_STAGE(un, 0); }
            const int bo = 2 * (sg & 1) * QSZ;
#pragma unroll
            for (int j = 0; j < 4; ++j) {
                f32x4 acc = (f32x4){0.f, 0.f, 0.f, 0.f};
#pragma unroll
                for (int ks = 0; ks < 4; ++ks) { const bf16x8 a = *(const LAS bf16x8*)(lds + SB + bo + QSZ + ((16 * j + r) * RS + 32 * ks + 8 * q) * 2); acc = MFMA16(a, Qd[ks], acc); }
#pragma unroll
                for (int kp = 0; kp < 4; ++kp) {
                    {
                        const u32x2 a0 = *(const LAS u32x2*)(vlb + bo + 16 * j * RS * 2 + ((((kp ^ (j >> 1)) << 3) | ((0 ^ (j & 1)) << 2)) << 3));
                        const u32x2 a1 = *(const LAS u32x2*)(vlb + bo + 16 * j * RS * 2 + ((((kp ^ (j >> 1)) << 3) | ((1 ^ (j & 1)) << 2)) << 3));
                        const u32x4 a = (u32x4){a0.x, a0.y, a1.x, a1.y}, bb = (u32x4){Pk[2 * kp].x, Pk[2 * kp].y, Pk[2 * kp + 1].x, Pk[2 * kp + 1].y};
                        acc = MFMA16(as_frag(a), as_frag(bb), acc);
                    }
                }
                o[sg * 4 + j] = acc;
                if (j & 1) __builtin_amdgcn_sched_barrier(0);
            }
            if (sg == 3) RO_WRITE_K();
            RO_WRITE_STAGE((sg + 1) & 1);
            __syncthreads();
        }
        RO_LOAD_Q(un);
        float ss = 0.f;
#pragma unroll
        for (int t = 0; t < 16; ++t) ss += (o[t][0] * o[t][0] + o[t][1] * o[t][1]) + (o[t][2] * o[t][2] + o[t][3] * o[t][3]);
        ss += __shfl_xor(ss, 16); ss += __shfl_xor(ss, 32);
        const float rstd = 1.f / sqrtf(ss * (1.f / 256.f) + EPS);
        const int qodd = q & 1;
#pragma unroll
        for (int tp = 0; tp < 8; ++tp) {
            const int t0 = 2 * tp, t1 = 2 * tp + 1;
            const int dvw = 32 * tp + (qodd ? 16 + 4 * (q - 1) : 4 * q);
            const u32x4 gw = *(const u32x4*)(RG + qrow * 1024 + h * 256 + dvw);
            const u32x2 sx = __builtin_amdgcn_permlane16_swap(gw.x, gw.z, false, false), sy = __builtin_amdgcn_permlane16_swap(gw.y, gw.w, false, false);
            const f32x4 g0 = *(const f32x4*)(p.ret_g + h * 256 + 16 * t0 + 4 * q), g1 = *(const f32x4*)(p.ret_g + h * 256 + 16 * t1 + 4 * q);
            u32x2 ov0, ov1;
            { const float x0 = bf_lo(sx.x), x1 = bf_hi(sx.x), x2 = bf_lo(sy.x), x3 = bf_hi(sy.x);
              ov0.x = cvt_pk_bf16(o[t0][0] * rstd * g0.x * x0 * sigmoidf_(x0), o[t0][1] * rstd * g0.y * x1 * sigmoidf_(x1));
              ov0.y = cvt_pk_bf16(o[t0][2] * rstd * g0.z * x2 * sigmoidf_(x2), o[t0][3] * rstd * g0.w * x3 * sigmoidf_(x3)); }
            { const float x0 = bf_lo(sx.y), x1 = bf_hi(sx.y), x2 = bf_lo(sy.y), x3 = bf_hi(sy.y);
              ov1.x = cvt_pk_bf16(o[t1][0] * rstd * g1.x * x0 * sigmoidf_(x0), o[t1][1] * rstd * g1.y * x1 * sigmoidf_(x1));
              ov1.y = cvt_pk_bf16(o[t1][2] * rstd * g1.z * x2 * sigmoidf_(x2), o[t1][3] * rstd * g1.w * x3 * sigmoidf_(x3)); }
            const u32x2 ox = __builtin_amdgcn_permlane16_swap(ov0.x, ov1.x, false, false), oy = __builtin_amdgcn_permlane16_swap(ov0.y, ov1.y, false, false);
            *(u32x4*)(YRET + qrow * 1024 + h * 256 + dvw) = (u32x4){ox.x, oy.x, ox.y, oy.y};
        }
    }
#undef RO_LOAD_KQ
#undef RO_LOAD_Q
#undef RO_LOAD_STAGE
#undef RO_WRITE_K
#undef RO_WRITE_STAGE
}

__device__ __forceinline__ void meta_proj(const Args& p, const bf16_t* XN, const bf16_t* WinT) {
    int tid_ = threadIdx.x; asm volatile("" : "+v"(tid_));
    const int tid = tid_, lane = tid & 63, r = lane & 15, q = lane >> 4;
    const bool g256 = (gridDim.x == 256);
    const int wv = tid >> 6, jg = (int)(((blockIdx.x >> 5) << 3) | (blockIdx.x & 7u));
    if (g256 ? (((blockIdx.x >> 3) & 3u) != 0u || wv >= 2) : (wv != 0)) return;
    for (int t = g256 ? jg * 2 + wv : (int)blockIdx.x; t < 128; t += (g256 ? 128 : (int)gridDim.x)) {
        int ncol, ld, cl; size_t boff;
        if (t < 32) { ncol = 512 + 16 * t; boff = OFF_RK; ld = 512; cl = 16 * t; }
        else if (t < 96) { ncol = 1024 + 16 * (t - 32); boff = OFF_RV; ld = 1024; cl = 16 * (t - 32); }
        else if (t < 112) { ncol = 4096 + 16 * (t - 96); boff = OFF_SK; ld = 256; cl = 16 * (t - 96); }
        else { ncol = 4352 + 16 * (t - 112); boff = OFF_SV; ld = 256; cl = 16 * (t - 112); }
        const bf16_t* ap = WinT + (size_t)(ncol + r) * DM + 8 * q; const bf16_t* bp = XN + (size_t)(NTOK + r) * DM + 8 * q;
        f32x4 acc = (f32x4){0.f, 0.f, 0.f, 0.f};
#pragma unroll 8
        for (int ks = 0; ks < 32; ++ks) { const u32x4 a = *(const u32x4*)(ap + 32 * ks), b = *(const u32x4*)(bp + 32 * ks); acc = MFMA16(as_frag(a), as_frag(b), acc); }
        u32x2 o; o.x = cvt_pk_bf16(acc[0], acc[1]); o.y = cvt_pk_bf16(acc[2], acc[3]);
        *(u32x2*)((bf16_t*)(p.ws + boff) + (size_t)(NTOK + r) * ld + cl + 4 * q) = o;
    }
}

#define XB_TMO      128
#define XB_XCNT(j)  (256  + 64 * (j))
#define XB_XSUB(j)  (1280 + 64 * (j))
#define XB_XGEN(j)  (2304 + 64 * (j))
#define XB_TOP      3328
#define XB_TOPGEN   3392
#define XCD_BAR_WORDS 3456
#define XB_SPIN_CAP (1u << 22)
__device__ __forceinline__ unsigned xb_ld(unsigned* p)              { return __hip_atomic_load(p, __ATOMIC_RELAXED, __HIP_MEMORY_SCOPE_AGENT); }
__device__ __forceinline__ unsigned xb_add(unsigned* p, unsigned v) { return __hip_atomic_fetch_add(p, v, __ATOMIC_RELAXED, __HIP_MEMORY_SCOPE_AGENT); }
__device__ __forceinline__ unsigned xb_xcc_id() { return (unsigned)__builtin_amdgcn_s_getreg((3 << 11) | 20) & 0xFu; }
#define XB_SPIN(cond, bar) do { unsigned _sp = 0; while (cond) { __builtin_amdgcn_s_sleep(1); \
    if ((++_sp & 255u) == 0u) { if (xb_ld(&(bar)[XB_TMO])) break; if (_sp > XB_SPIN_CAP) { atomicAdd(&(bar)[XB_TMO], 1u); break; } } } } while (0)
struct XcdBarrier { unsigned* bar; unsigned x; volatile LAS unsigned* st; };
__device__ __forceinline__ XcdBarrier xcd_barrier_post(unsigned* bar, volatile LAS unsigned* st) {
    XcdBarrier b; b.bar = bar; b.x = xb_xcc_id(); b.st = st;
    if (threadIdx.x == 0) (void)xb_add(&bar[XB_XCNT(b.x)], 1u);
    return b;
}
__device__ __forceinline__ void xcd_barrier_complete(unsigned* bar, unsigned x, unsigned& nloc, unsigned& nx) {
    const unsigned G = gridDim.x * gridDim.y * gridDim.z;
    unsigned sum, cnt, mine, sp = 0u;
    for (;;) {
        sum = 0u; cnt = 0u; mine = 0u;
#pragma unroll
        for (unsigned j = 0; j < 16; ++j) { const unsigned c = xb_ld(&bar[XB_XCNT(j)]); sum += c; cnt += (c > 0u) ? 1u : 0u; mine = (j == x) ? c : mine; }
        if (sum == G) break;
        __builtin_amdgcn_s_sleep(1);
        if ((++sp & 255u) == 0u) { if (xb_ld(&bar[XB_TMO])) break; if (sp > XB_SPIN_CAP) { atomicAdd(&bar[XB_TMO], 1u); break; } }
    }
    nloc = mine > 0u ? mine : 1u; nx = cnt > 0u ? cnt : 1u;
}
__device__ __forceinline__ void xcd_barrier(const XcdBarrier& b) {
    asm volatile("s_waitcnt vmcnt(0)" ::: "memory");
    __syncthreads();
    if (threadIdx.x == 0) {
        unsigned* bar = b.bar;
        __builtin_amdgcn_s_waitcnt(0);
        unsigned nloc = b.st[0], nx = b.st[1];
        if (nloc == 0u) { xcd_barrier_complete(bar, b.x, nloc, nx); b.st[0] = nloc; b.st[1] = nx; }
        const unsigned old = xb_add(&bar[XB_XSUB(b.x)], 1u);
        const unsigned gen = old / nloc;
        if (old + 1u == (gen + 1u) * nloc) {
            __builtin_amdgcn_fence(__ATOMIC_RELEASE, "agent");
            asm volatile("s_waitcnt vmcnt(0)" ::: "memory");
            const unsigned og = xb_add(&bar[XB_TOP], 1u);
            const unsigned tg = og / nx;
            if (og + 1u == (tg + 1u) * nx) xb_add(&bar[XB_TOPGEN], 1u);
            else XB_SPIN(xb_ld(&bar[XB_TOPGEN]) == tg, bar);
            __builtin_amdgcn_fence(__ATOMIC_ACQUIRE, "agent");
            xb_add(&bar[XB_XGEN(b.x)], 1u);
            asm volatile("s_waitcnt vmcnt(0)" ::: "memory");
        } else {
            XB_SPIN(xb_ld(&bar[XB_XGEN(b.x)]) == gen, bar);
            __builtin_amdgcn_fence(__ATOMIC_ACQUIRE, "agent");
            asm volatile("s_waitcnt vmcnt(0)" ::: "memory");
        }
    }
    __syncthreads();
}

__device__ __forceinline__ void convert_slot(const Args& p, LAS unsigned char* lds, const int list) {
    const unsigned grp = (blockIdx.x >> 3) & 3u;
    if (grp == 0u) return;
    int tid_ = threadIdx.x; asm volatile("" : "+v"(tid_));
    const int tid = tid_, lane = tid & 63, wave = __builtin_amdgcn_readfirstlane(tid >> 6);
    constexpr int I_SQ = (DM / 64) * (DM / 32), I_UP = (DM / 64) * (FF / 32), I_DN = (FF / 64) * (DM / 32);
    const int total = list == 0 ? 3 * I_SQ + I_UP : I_DN;
    const int lo = grp == 1u ? 0 : (grp == 2u ? total / 6 : total / 2), hi = grp == 1u ? total / 6 : (grp == 2u ? total / 2 : total);
    const int j = (int)(((blockIdx.x >> 5) << 3) | (blockIdx.x & 7u));
    LAS float* scr = (LAS float*)(lds + wave * 16384);
    unsigned char* ws = p.ws;
    for (int it = lo + j * 8 + wave; it < hi; it += 512) {
        if (list == 0) {
            int r = it;
            if (r < I_SQ) { p0_transpose_item(p.w_ret, DM, DM, (bf16_t*)(ws + OFF_WRET), scr, r, lane); continue; } r -= I_SQ;
            if (r < I_SQ) { p0_transpose_item(p.w_swa, DM, DM, (bf16_t*)(ws + OFF_WSWA), scr, r, lane); continue; } r -= I_SQ;
            if (r < I_SQ) { p0_transpose_item(p.w_out, DM, DM, (bf16_t*)(ws + OFF_WOUT), scr, r, lane); continue; } r -= I_SQ;
            p0_transpose_item(p.w_up, DM, FF, (bf16_t*)(ws + OFF_WUP), scr, r, lane, p.mlp_g);
        } else p0_transpose_item(p.w_down, FF, DM, (bf16_t*)(ws + OFF_WDN), scr, it, lane);
    }
    __syncthreads();
}

__global__ void __launch_bounds__(NTHREADS, 2) fwd_megakernel(Args p) {
    extern __shared__ __attribute__((aligned(16))) unsigned char lds_raw[];
    LAS unsigned char* lds = (LAS unsigned char*)lds_raw;
    cg::grid_group grid = cg::this_grid();
    ((LAS unsigned*)(lds + 131072 + 64))[threadIdx.x & 15] = 0u;
    __syncthreads();
    XcdBarrier xbar = xcd_barrier_post((unsigned*)(p.ws + OFF_CTL), (volatile LAS unsigned*)(lds + 131072 + 64));
    grid.sync();
#define GRID_SYNC() xcd_barrier(xbar)
    const int tid = threadIdx.x, lane = tid & 63, wave = __builtin_amdgcn_readfirstlane(tid >> 6);
    const int G = gridDim.x, gw = blockIdx.x * 8 + wave, NGW = G * 8;
    unsigned char* ws = p.ws;
    bf16_t* WinT = (bf16_t*)(ws + OFF_WIN); bf16_t* WretT = (bf16_t*)(ws + OFF_WRET); bf16_t* WswaT = (bf16_t*)(ws + OFF_WSWA); bf16_t* WoutT = (bf16_t*)(ws + OFF_WOUT);
    bf16_t* WupT = (bf16_t*)(ws + OFF_WUP); bf16_t* WdnT = (bf16_t*)(ws + OFF_WDN);
    bf16_t* XN = (bf16_t*)p.out;

    for (int rep = 0; rep < 1 + ((REP_MASK >> 0) & 1); ++rep) {
        LAS float* scr = (LAS float*)(lds + wave * 16384);
        constexpr int I_IN = (DM / 64) * (DIN / 32), I_SQ = (DM / 64) * (DM / 32), I_UP = (DM / 64) * (FF / 32), I_DN = (FF / 64) * (DM / 32);
        constexpr int NITEMS = I_IN + 3 * I_SQ + I_UP + I_DN;
        const bool split = (G == 256);
        for (int it = gw; it < (split ? I_IN : NITEMS); it += NGW) {
            int r = it;
            if (r < I_IN) { p0_transpose_item(p.w_in, DM, DIN, WinT, scr, r, lane); continue; } r -= I_IN;
            if (r < I_SQ) { p0_transpose_item(p.w_ret, DM, DM, WretT, scr, r, lane); continue; } r -= I_SQ;
            if (r < I_SQ) { p0_transpose_item(p.w_swa, DM, DM, WswaT, scr, r, lane); continue; } r -= I_SQ;
            if (r < I_SQ) { p0_transpose_item(p.w_out, DM, DM, WoutT, scr, r, lane); continue; } r -= I_SQ;
            if (r < I_UP) { p0_transpose_item(p.w_up, DM, FF, WupT, scr, r, lane, p.mlp_g); continue; } r -= I_UP;
            p0_transpose_item(p.w_down, FF, DM, WdnT, scr, r, lane);
        }
        for (int m = gw; m < NTOK; m += 2 * NGW) {
            const int m2 = m + NGW;
            const f32x4* xa = (const f32x4*)(p.x + (size_t)m * DM) + 2 * lane; const f32x4* xb = (const f32x4*)(p.x + (size_t)(m2 < NTOK ? m2 : m) * DM) + 2 * lane; const f32x4* gr = (const f32x4*)p.mix_g + 2 * lane;
            f32x4 va[4], vb[4]; float sa = 0.f, sb = 0.f;
#pragma unroll
            for (int j = 0; j < 4; ++j) { va[j] = xa[(j & 1) + 128 * (j >> 1)]; vb[j] = xb[(j & 1) + 128 * (j >> 1)]; }
#pragma unroll
            for (int j = 0; j < 4; ++j) { sa += (va[j].x * va[j].x + va[j].y * va[j].y) + (va[j].z * va[j].z + va[j].w * va[j].w); sb += (vb[j].x * vb[j].x + vb[j].y * vb[j].y) + (vb[j].z * vb[j].z + vb[j].w * vb[j].w); }
            const float ra = 1.f / sqrtf(wave_sum(sa) * (1.f / DM) + EPS), rb = 1.f / sqrtf(wave_sum(sb) * (1.f / DM) + EPS);
            u32x4* oa = (u32x4*)(XN + (size_t)m * DM) + lane; u32x4* ob = (u32x4*)(XN + (size_t)m2 * DM) + lane;
#pragma unroll
            for (int jj = 0; jj < 2; ++jj) { const f32x4 g0 = gr[128 * jj], g1 = gr[128 * jj + 1]; const f32x4 a0 = va[2 * jj], a1 = va[2 * jj + 1], b0 = vb[2 * jj], b1 = vb[2 * jj + 1];
                u32x4 wa; wa.x = cvt_pk_bf16_asm(a0.x * ra * g0.x, a0.y * ra * g0.y); wa.y = cvt_pk_bf16_asm(a0.z * ra * g0.z, a0.w * ra * g0.w); wa.z = cvt_pk_bf16_asm(a1.x * ra * g1.x, a1.y * ra * g1.y); wa.w = cvt_pk_bf16_asm(a1.z * ra * g1.z, a1.w * ra * g1.w);
                oa[64 * jj] = wa;
                if (m2 < NTOK) { u32x4 wb; wb.x = cvt_pk_bf16_asm(b0.x * rb * g0.x, b0.y * rb * g0.y); wb.y = cvt_pk_bf16_asm(b0.z * rb * g0.z, b0.w * rb * g0.w); wb.z = cvt_pk_bf16_asm(b1.x * rb * g1.x, b1.y * rb * g1.y); wb.w = cvt_pk_bf16_asm(b1.z * rb * g1.z, b1.w * rb * g1.w);
                    ob[64 * jj] = wb; } }
        }
        if (gw < NMETA) rms_row_to_bf16(p.meta + (size_t)gw * DM, p.mix_g, XN + (size_t)(NTOK + gw) * DM, lane);
    }
    GRID_SYNC();
    {
        meta_proj(p, XN, WinT);
        if (G == 256) convert_slot(p, lds, 0);
        pg8::Gemm g{XN, WinT, XN, WinT, NTOK, DIN, DM}; pg8::StaticOrder S; S.init(NTOK, DIN, G, (int)blockIdx.x);
        pg8::EpiProj E{ws};
        pg8::gemm_phase<pg8::EpiProj, pg8::StaticOrder, true>(lds, g, S, E);
    }
    GRID_SYNC();
    for (int rep = 0; rep < 1 + ((REP_MASK >> 1) & 1); ++rep) { swa_phase(lds, p); kvlocal_phase(lds, p); }
    GRID_SYNC();
    scan_phase(p);
    GRID_SYNC();
    for (int rep = 0; rep < 1 + ((REP_MASK >> 2) & 1); ++rep) retout_phase(lds, p);
    GRID_SYNC();
    {
        const bf16_t* YRET = (const bf16_t*)(ws + OFF_YRET); const bf16_t* YSWA = (const bf16_t*)((unsigned char*)p.out + DOUT_YSWA);
        pg8::Gemm g{YRET, WretT, YSWA, WswaT, NTOK, DM, DM}; pg8::PairOrder S; S.s.init(NTOK, DM, G, (int)blockIdx.x);
        pg8::EpiMerged E{(const unsigned char*)(ws + OFF_GR), (const unsigned char*)(ws + OFF_GS), (bf16_t*)(ws + OFF_MERGED)};
        pg8::gemm_phase<pg8::EpiMerged, pg8::PairOrder, true>(lds, g, S, E);
    }
    GRID_SYNC();
    {
        const bf16_t* MG = (const bf16_t*)(ws + OFF_MERGED);
        pg8::Gemm g{MG, WoutT, MG, WoutT, NTOK, DM, DM}; pg8::StaticOrder S; S.init(NTOK, DM, G, (int)blockIdx.x);
        pg8::EpiResStat E{p.x, p.out, (bf16_t*)(ws + OFF_HN2), (float*)(ws + OFF_SS)};
        pg8::gemm_phase<pg8::EpiResStat, pg8::StaticOrder, true>(lds, g, S, E);
    }
    GRID_SYNC();
    {
        const bf16_t* HN2 = (const bf16_t*)(ws + OFF_HN2);
        pg8::Gemm g{HN2, WupT, HN2, WupT, NTOK, FF, DM}; pg8::StaticOrder S; S.init(NTOK, FF, G, (int)blockIdx.x);
        pg8::EpiUp E{(bf16_t*)(ws + OFF_U), (const float*)(ws + OFF_SS)};
        if (G == 256) convert_slot(p, lds, 1);
        pg8::gemm_phase<pg8::EpiUp, pg8::StaticOrder, true>(lds, g, S, E);
    }
    GRID_SYNC();
    {
        const bf16_t* U = (const bf16_t*)(ws + OFF_U);
        pg8::Gemm g{U, WdnT, U, WdnT, NTOK, DM, FF}; pg8::StaticOrder S; S.init(NTOK, DM, G, (int)blockIdx.x);
        pg8::EpiResBf E{(const bf16_t*)(ws + OFF_HN2), p.out};
        pg8::gemm_phase<pg8::EpiResBf, pg8::StaticOrder, true>(lds, g, S, E);
    }
}

extern "C" void kernel_launch(void* const* d_in, const int* in_sizes, int n_in, void* d_out, int out_size, void* d_ws, size_t ws_size, hipStream_t stream) {
    static int grid = 0;
    if (grid == 0) {
        if (n_in != 14 || in_sizes[0] != NTOK * DM || out_size != NTOK * DM || ws_size < WS_NEED) {
            fprintf(stderr, "kernel_launch: unexpected shapes (n_in %d, in0 %d, out %d, ws %zu, need %zu); nothing launched\n", n_in, n_in > 0 ? in_sizes[0] : -1, out_size, ws_size, (size_t)WS_NEED); grid = -1; return; }
        int dev = 0, cus = 0, per_cu = 0;
        (void)hipGetDevice(&dev); (void)hipDeviceGetAttribute(&cus, hipDeviceAttributeMultiprocessorCount, dev);
        if (hipFuncSetAttribute((const void*)fwd_megakernel, hipFuncAttributeMaxDynamicSharedMemorySize, LDS_BYTES) != hipSuccess) { fprintf(stderr, "kernel_launch: hipFuncSetAttribute failed\n"); grid = -1; return; }
        if (hipOccupancyMaxActiveBlocksPerMultiprocessor(&per_cu, (const void*)fwd_megakernel, NTHREADS, LDS_BYTES) != hipSuccess || per_cu < 1) { fprintf(stderr, "kernel_launch: occupancy query gave %d\n", per_cu); per_cu = 1; }
        (void)hipGetLastError();
        grid = cus * per_cu;
    }
    if (grid < 0) return;
    Args a{};
    a.x = (const float*)d_in[0]; a.meta = (const float*)d_in[1]; a.mix_g = (const float*)d_in[2]; a.w_in = (const float*)d_in[3]; a.ret_g = (const float*)d_in[4];
    a.q_g = (const float*)d_in[5]; a.k_g = (const float*)d_in[6]; a.sinks = (const float*)d_in[7]; a.w_ret = (const float*)d_in[8]; a.w_swa = (const float*)d_in[9];
    a.w_out = (const float*)d_in[10]; a.mlp_g = (const float*)d_in[11]; a.w_up = (const float*)d_in[12]; a.w_down = (const float*)d_in[13];
    a.out = (float*)d_out; a.ws = (unsigned char*)d_ws;
    if (hipMemsetAsync((unsigned char*)d_ws + OFF_CTL, 0, CTL_BYTES, stream) != hipSuccess) { fprintf(stderr, "kernel_launch: memset failed\n"); return; }
    void* args[] = {&a};
    hipError_t e = hipLaunchCooperativeKernel((const void*)fwd_megakernel, dim3(grid), dim3(NTHREADS), args, LDS_BYTES, stream);
    if (e != hipSuccess) fprintf(stderr, "kernel_launch: cooperative launch failed: %s (grid %d)\n", hipGetErrorString(e), grid);
}
```

```cpp
#ifndef REP_MASK
#define REP_MASK 0
#endif
#include <hip/hip_runtime.h>
#include <hip/hip_cooperative_groups.h>
#include <cstdio>
#include <cstdint>
namespace cg = cooperative_groups;

#define LAS __attribute__((address_space(3)))
typedef unsigned short bf16_t;
typedef short bf16x8 __attribute__((ext_vector_type(8)));
typedef float f32x4 __attribute__((ext_vector_type(4)));
typedef unsigned u32x4 __attribute__((ext_vector_type(4)));
typedef unsigned u32x2 __attribute__((ext_vector_type(2)));

constexpr int NB = 4, SEQ = 8192, DM = 1024, NTOK = NB * SEQ, NMETA = 16, MROWS = NTOK + NMETA, MPAD = 33024, DIN = 6656, FF = 4096;
constexpr float EPS = 1e-6f;
constexpr int NTHREADS = 512;
constexpr int LDS_BYTES = 135168;

constexpr size_t SZ_WIN = (size_t)DIN * DM * 2, SZ_WSQ = (size_t)DM * DM * 2, SZ_WFF = (size_t)FF * DM * 2;
constexpr size_t OFF_WIN = 0, OFF_WRET = OFF_WIN + SZ_WIN, OFF_WSWA = OFF_WRET + SZ_WSQ, OFF_WOUT = OFF_WSWA + SZ_WSQ, OFF_WUP = OFF_WOUT + SZ_WSQ, OFF_WDN = OFF_WUP + SZ_WFF;
constexpr size_t OFF_RQ = OFF_WDN + SZ_WFF;
constexpr size_t OFF_RK = OFF_RQ + (size_t)MROWS * 512 * 2;
constexpr size_t OFF_RV = OFF_RK + (size_t)MROWS * 512 * 2;
constexpr size_t OFF_RG = OFF_RV + (size_t)MROWS * 1024 * 2;
constexpr size_t OFF_SQ = OFF_RG + (size_t)MROWS * 1024 * 2;
constexpr size_t OFF_SK = OFF_SQ + (size_t)MROWS * 1024 * 2;
constexpr size_t OFF_SV = OFF_SK + (size_t)MROWS * 256 * 2;
constexpr size_t OFF_GR = OFF_SV + (size_t)MROWS * 256 * 2;
constexpr size_t OFF_GS = OFF_GR + (size_t)MROWS * 1024 * 2;
constexpr size_t OFF_CTL = OFF_GS + (size_t)MROWS * 1024 * 2;
constexpr size_t CTL_BYTES = 16384 + (size_t)NTOK * 4;
constexpr size_t OFF_SS = OFF_CTL + 16384;
constexpr size_t WS_NEED = OFF_CTL + CTL_BYTES;
constexpr size_t OFF_MERGED = OFF_RQ, OFF_HN2 = OFF_RV, OFF_YRET = OFF_SQ, OFF_U = OFF_RG;
static_assert(OFF_RK - OFF_RQ + OFF_RV - OFF_RK >= (size_t)NTOK * 1024 * 2, "MERGED fits");
static_assert(OFF_CTL - OFF_RG >= (size_t)NTOK * FF * 2, "U fits");
static_assert((size_t)MPAD * DM * 2 <= (size_t)NTOK * DM * 4, "XN fits d_out");
constexpr size_t DOUT_KVS = 0, DOUT_YSWA = (size_t)NTOK * 1024 * 2;

typedef __bf16 bf16x2_t __attribute__((ext_vector_type(2)));
typedef float f32x2_t __attribute__((ext_vector_type(2)));
__device__ __forceinline__ unsigned cvt_pk_bf16(float lo, float hi) { const f32x2_t v = {lo, hi}; const bf16x2_t b = __builtin_convertvector(v, bf16x2_t); return __builtin_bit_cast(unsigned, b); }
__device__ __forceinline__ unsigned cvt_pk_bf16_asm(float lo, float hi) { unsigned r; asm volatile("v_cvt_pk_bf16_f32 %0, %1, %2" : "=v"(r) : "v"(lo), "v"(hi)); return r; }
__device__ __forceinline__ float bf_lo(unsigned w) { return __uint_as_float(w << 16); }
__device__ __forceinline__ float bf_hi(unsigned w) { return __uint_as_float(w & 0xffff0000u); }
__device__ __forceinline__ float wave_sum(float v) {
#pragma unroll
    for (int o = 1; o < 64; o <<= 1) v += __shfl_xor(v, o);
    return v;
}
__device__ __forceinline__ float sigmoidf_(float x) { return __builtin_amdgcn_rcpf(1.0f + __builtin_amdgcn_exp2f(-1.4426950408889634f * x)); }

namespace pg8 {
constexpr int BM = 256, BK = 64, HALF = 128, HTB = HALF * BK * 2, STAGE_BYTES = 8 * HTB, NXCD = 8, WGM = 8;
__host__ __device__ __forceinline__ int lds_byte(int r, int c) { const int st = (r >> 4) * 2 + (c >> 5), rr = r & 15, cc = c & 31, ob = rr * 64 + cc * 2; return st * 1024 + (ob ^ (((ob >> 9) & 1) << 5)); }
__host__ __device__ __forceinline__ void stage_rc(int b, int& R, int& C) { const int st = b / 1024, sb = b % 1024, swz = sb ^ (((sb >> 9) & 1) << 5); R = (st >> 1) * 16 + swz / 64; C = (st & 1) * 32 + (swz % 64) / 2; }
__host__ __device__ __forceinline__ int perm32(int rho) { const int n = rho >> 4, i = rho & 15; return 8 * (i >> 2) + 4 * n + (i & 3); }

struct Unit { int pm, pn, seg; };
struct Gemm { const bf16_t* A; const bf16_t* Bt; const bf16_t* A2; const bf16_t* Bt2; int M, N, K; };

struct StaticOrder {
    int nM, nN, nwg, G, c;
    __device__ void init(int M, int N, int G_, int c_) { nM = M / BM; nN = N / BM; nwg = nM * nN; G = G_; c = c_; }
    __device__ bool tile(long L, Unit& u) const {
        if (L >= nwg) return false;
        int wgid = (int)L; { const int q = nwg / NXCD, r = nwg % NXCD, xcd = wgid % NXCD, off = wgid / NXCD; wgid = (xcd < r ? xcd * (q + 1) : r * (q + 1) + (xcd - r) * q) + off; }
        const int nig = WGM * nN, gid = wgid / nig, fm = gid * WGM, gsz = (nM - fm) < WGM ? (nM - fm) : WGM;
        u.pm = fm + ((wgid % nig) % gsz); u.pn = (wgid % nig) / gsz; u.seg = 0; return true;
    }
    __device__ bool next(int i, Unit& u) const { return tile((long)i * G + c, u); }
};
struct PairOrder {
    StaticOrder s;
    __device__ bool next(int i, Unit& u) const { const bool ok = s.tile((long)(i >> 1) * s.G + s.c, u); u.seg = i & 1; return ok; }
};

struct EpiProj {
    static constexpr bool PERM = true, HAS_MID = false;
    unsigned char* ws;
    __device__ __forceinline__ void mid(f32x4 (&acc)[2][2][4][2], const Unit& u, int wr, int wc, int fr, int fq) const {}
    __device__ __forceinline__ void operator()(const f32x4 (&acc)[2][2][4][2], const Unit& u, int wr, int wc, int fr, int fq) const {
        const int pn = u.pn; size_t boff; int ld, ct;
        if (pn < 2) { boff = OFF_RQ; ld = 512; ct = pn; }
        else if (pn < 4) { boff = OFF_RK; ld = 512; ct = pn - 2; }
        else if (pn < 8) { boff = OFF_RV; ld = 1024; ct = pn - 4; }
        else if (pn < 12) { boff = OFF_RG; ld = 1024; ct = pn - 8; }
        else if (pn < 16) { boff = OFF_SQ; ld = 1024; ct = pn - 12; }
        else if (pn == 16) { boff = OFF_SK; ld = 256; ct = 0; }
        else if (pn == 17) { boff = OFF_SV; ld = 256; ct = 0; }
        else if (pn < 22) { boff = OFF_GR; ld = 1024; ct = pn - 18; }
        else { boff = OFF_GS; ld = 1024; ct = pn - 22; }
        bf16_t* base = (bf16_t*)(ws + boff);
        const int row0 = u.pm * BM + wr * 64 + fr, col0 = ct * 256 + wc * 32 + 8 * fq;
        if (pn >= 18) {
            unsigned char* gb = ws + boff;
            const int colw = ct * 256 + wc * 32 + ((fq & 1) ? HALF + 8 * (fq - 1) : 8 * fq);
#pragma unroll
            for (int ai = 0; ai < 2; ++ai)
#pragma unroll
                for (int m = 0; m < 4; ++m) {
                    unsigned w[2][2];
#pragma unroll
                    for (int bj = 0; bj < 2; ++bj) { const f32x4 v0 = acc[ai][bj][m][0], v1 = acc[ai][bj][m][1];
                        int w0 = __builtin_amdgcn_cvt_pk_fp8_f32(v0[0], v0[1], 0, false); w0 = __builtin_amdgcn_cvt_pk_fp8_f32(v0[2], v0[3], w0, true);
                        int w1 = __builtin_amdgcn_cvt_pk_fp8_f32(v1[0], v1[1], 0, false); w1 = __builtin_amdgcn_cvt_pk_fp8_f32(v1[2], v1[3], w1, true);
                        w[bj][0] = (unsigned)w0; w[bj][1] = (unsigned)w1; }
                    const u32x2 sx = __builtin_amdgcn_permlane16_swap(w[0][0], w[1][0], false, false), sy = __builtin_amdgcn_permlane16_swap(w[0][1], w[1][1], false, false);
                    *(u32x4*)(gb + (size_t)(row0 + ai * HALF + m * 16) * 1024 + colw) = (u32x4){sx.x, sy.x, sx.y, sy.y};
                }
            return;
        }
#pragma unroll
        for (int ai = 0; ai < 2; ++ai)
#pragma unroll
            for (int m = 0; m < 4; ++m) {
                bf16_t* rowp = base + (size_t)(row0 + ai * HALF + m * 16) * ld + col0;
#pragma unroll
                for (int bj = 0; bj < 2; ++bj) { const f32x4 v0 = acc[ai][bj][m][0], v1 = acc[ai][bj][m][1];
                    u32x4 w; w.x = cvt_pk_bf16_asm(v0[0], v0[1]); w.y = cvt_pk_bf16_asm(v0[2], v0[3]); w.z = cvt_pk_bf16_asm(v1[0], v1[1]); w.w = cvt_pk_bf16_asm(v1[2], v1[3]);
                    *(u32x4*)(rowp + bj * HALF) = w; } }
    }
};
struct EpiMerged {
    static constexpr bool PERM = true, HAS_MID = true;
    const unsigned char *GR, *GS; bf16_t* O;
#define F8(w, k) __builtin_amdgcn_cvt_f32_fp8((int)(w), (k))
    __device__ __forceinline__ void mid(f32x4 (&acc)[2][2][4][2], const Unit& u, int wr, int wc, int fr, int fq) const {
        const int row0 = u.pm * BM + wr * 64 + fr, colw = u.pn * BM + wc * 32 + ((fq & 1) ? HALF + 8 * (fq - 1) : 8 * fq);
#pragma unroll
        for (int ai = 0; ai < 2; ++ai)
#pragma unroll
            for (int m = 0; m < 4; ++m) { const size_t off = (size_t)(row0 + ai * HALF + m * 16) * DM + colw;
                const u32x4 ga = *(const u32x4*)(GR + off), gb = *(const u32x4*)(GS + off);
                const u32x2 ax = __builtin_amdgcn_permlane16_swap(ga.x, ga.z, false, false), ay = __builtin_amdgcn_permlane16_swap(ga.y, ga.w, false, false);
                const u32x2 bx = __builtin_amdgcn_permlane16_swap(gb.x, gb.z, false, false), by = __builtin_amdgcn_permlane16_swap(gb.y, gb.w, false, false);
#define MRG_R(ga_, gb_) ((1.0f + __builtin_amdgcn_exp2f(-1.4426950408889634f * (gb_))) * __builtin_amdgcn_rcpf(1.0f + __builtin_amdgcn_exp2f(-1.4426950408889634f * (ga_))))
#pragma unroll
                for (int bj = 0; bj < 2; ++bj) { const unsigned a0 = bj ? ax.y : ax.x, a1 = bj ? ay.y : ay.x, b0 = bj ? bx.y : bx.x, b1 = bj ? by.y : by.x;
                    f32x4 r0, r1;
                    r0[0] = MRG_R(F8(a0, 0), F8(b0, 0)); r0[1] = MRG_R(F8(a0, 1), F8(b0, 1)); r0[2] = MRG_R(F8(a0, 2), F8(b0, 2)); r0[3] = MRG_R(F8(a0, 3), F8(b0, 3));
                    r1[0] = MRG_R(F8(a1, 0), F8(b1, 0)); r1[1] = MRG_R(F8(a1, 1), F8(b1, 1)); r1[2] = MRG_R(F8(a1, 2), F8(b1, 2)); r1[3] = MRG_R(F8(a1, 3), F8(b1, 3));
                    acc[ai][bj][m][0] = acc[ai][bj][m][0] * r0; acc[ai][bj][m][1] = acc[ai][bj][m][1] * r1; }
#undef MRG_R
            }
    }
    __device__ __forceinline__ void operator()(const f32x4 (&acc)[2][2][4][2], const Unit& u, int wr, int wc, int fr, int fq) const {
        const int row0 = u.pm * BM + wr * 64 + fr, col0 = u.pn * BM + wc * 32 + 8 * fq, colw = u.pn * BM + wc * 32 + ((fq & 1) ? HALF + 8 * (fq - 1) : 8 * fq);
        u32x4 gbv[2][4];
#pragma unroll
        for (int ai = 0; ai < 2; ++ai)
#pragma unroll
            for (int m = 0; m < 4; ++m) gbv[ai][m] = *(const u32x4*)(GS + (size_t)(row0 + ai * HALF + m * 16) * DM + colw);
#pragma unroll
        for (int ai = 0; ai < 2; ++ai)
#pragma unroll
            for (int m = 0; m < 4; ++m) { const size_t rowoff = (size_t)(row0 + ai * HALF + m * 16) * DM;
                const u32x4 gb = gbv[ai][m];
                const u32x2 bx = __builtin_amdgcn_permlane16_swap(gb.x, gb.z, false, false), by = __builtin_amdgcn_permlane16_swap(gb.y, gb.w, false, false);
#pragma unroll
                for (int bj = 0; bj < 2; ++bj) { const unsigned b0 = bj ? bx.y : bx.x, b1 = bj ? by.y : by.x; const f32x4 v0 = acc[ai][bj][m][0], v1 = acc[ai][bj][m][1];
                    u32x4 w;
                    w.x = cvt_pk_bf16_asm(v0[0] * sigmoidf_(F8(b0, 0)), v0[1] * sigmoidf_(F8(b0, 1))); w.y = cvt_pk_bf16_asm(v0[2] * sigmoidf_(F8(b0, 2)), v0[3] * sigmoidf_(F8(b0, 3)));
                    w.z = cvt_pk_bf16_asm(v1[0] * sigmoidf_(F8(b1, 0)), v1[1] * sigmoidf_(F8(b1, 1))); w.w = cvt_pk_bf16_asm(v1[2] * sigmoidf_(F8(b1, 2)), v1[3] * sigmoidf_(F8(b1, 3)));
                    *(u32x4*)(O + rowoff + col0 + bj * HALF) = w; }
            }
    }
#undef F8
};
struct EpiRes {
    static constexpr bool PERM = true, HAS_MID = false;
    const float* res; float* out;
    __device__ __forceinline__ void mid(f32x4 (&acc)[2][2][4][2], const Unit& u, int wr, int wc, int fr, int fq) const {}
    __device__ __forceinline__ void operator()(const f32x4 (&acc)[2][2][4][2], const Unit& u, int wr, int wc, int fr, int fq) const {
        const int row0 = u.pm * BM + wr * 64 + fr, col0 = u.pn * BM + wc * 32 + 8 * fq;
#pragma unroll
        for (int ai = 0; ai < 2; ++ai)
#pragma unroll
            for (int m = 0; m < 4; ++m)
#pragma unroll
                for (int bj = 0; bj < 2; ++bj) { const size_t off = (size_t)(row0 + ai * HALF + m * 16) * DM + col0 + bj * HALF;
                    const f32x4 x0 = *(const f32x4*)(res + off), x1 = *(const f32x4*)(res + off + 4);
                    *(f32x4*)(out + off) = x0 + acc[ai][bj][m][0]; *(f32x4*)(out + off + 4) = x1 + acc[ai][bj][m][1]; }
    }
};
struct EpiResStat {
    static constexpr bool PERM = true, HAS_MID = false;
    const float* res; float* out; bf16_t* hb; float* ss;
    __device__ __forceinline__ void mid(f32x4 (&acc)[2][2][4][2], const Unit& u, int wr, int wc, int fr, int fq) const {}
    __device__ __forceinline__ void operator()(const f32x4 (&acc)[2][2][4][2], const Unit& u, int wr, int wc, int fr, int fq) const {
        const int row0 = u.pm * BM + wr * 64 + fr, col0 = u.pn * BM + wc * 32 + 8 * fq;
#pragma unroll
        for (int ai = 0; ai < 2; ++ai) {
          f32x4 xv[4][2][2];
#pragma unroll
          for (int m = 0; m < 4; ++m)
#pragma unroll
            for (int bj = 0; bj < 2; ++bj) { const size_t off = (size_t)(row0 + ai * HALF + m * 16) * DM + col0 + bj * HALF; xv[m][bj][0] = *(const f32x4*)(res + off); xv[m][bj][1] = *(const f32x4*)(res + off + 4); }
#pragma unroll
            for (int m = 0; m < 4; ++m) {
                float sq = 0.f;
#pragma unroll
                for (int bj = 0; bj < 2; ++bj) { const size_t off = (size_t)(row0 + ai * HALF + m * 16) * DM + col0 + bj * HALF;
                    const f32x4 h0 = xv[m][bj][0] + acc[ai][bj][m][0], h1 = xv[m][bj][1] + acc[ai][bj][m][1];
                    u32x4 w; w.x = cvt_pk_bf16_asm(h0[0], h0[1]); w.y = cvt_pk_bf16_asm(h0[2], h0[3]); w.z = cvt_pk_bf16_asm(h1[0], h1[1]); w.w = cvt_pk_bf16_asm(h1[2], h1[3]);
                    *(u32x4*)(hb + off) = w;
                    sq += (h0[0] * h0[0] + h0[1] * h0[1]) + (h0[2] * h0[2] + h0[3] * h0[3]) + (h1[0] * h1[0] + h1[1] * h1[1]) + (h1[2] * h1[2] + h1[3] * h1[3]); }
                sq += __shfl_xor(sq, 16); sq += __shfl_xor(sq, 32);
                if (fq == 0) atomicAdd(ss + row0 + ai * HALF + m * 16, sq);
            }
        }
    }
};
struct EpiResBf {
    static constexpr bool PERM = true, HAS_MID = false;
    const bf16_t* hb; float* out;
    __device__ __forceinline__ void mid(f32x4 (&acc)[2][2][4][2], const Unit& u, int wr, int wc, int fr, int fq) const {}
    __device__ __forceinline__ void operator()(const f32x4 (&acc)[2][2][4][2], const Unit& u, int wr, int wc, int fr, int fq) const {
        const int row0 = u.pm * BM + wr * 64 + fr, col0 = u.pn * BM + wc * 32 + 8 * fq;
#pragma unroll
        for (int ai = 0; ai < 2; ++ai) {
            u32x4 hv[4][2];
#pragma unroll
            for (int m = 0; m < 4; ++m)
#pragma unroll
                for (int bj = 0; bj < 2; ++bj) hv[m][bj] = *(const u32x4*)(hb + (size_t)(row0 + ai * HALF + m * 16) * DM + col0 + bj * HALF);
#pragma unroll
            for (int m = 0; m < 4; ++m)
#pragma unroll
                for (int bj = 0; bj < 2; ++bj) { const size_t off = (size_t)(row0 + ai * HALF + m * 16) * DM + col0 + bj * HALF;
                    const u32x4 h = hv[m][bj];
                    const f32x4 x0 = (f32x4){bf_lo(h.x), bf_hi(h.x), bf_lo(h.y), bf_hi(h.y)}, x1 = (f32x4){bf_lo(h.z), bf_hi(h.z), bf_lo(h.w), bf_hi(h.w)};
                    *(f32x4*)(out + off) = x0 + acc[ai][bj][m][0]; *(f32x4*)(out + off + 4) = x1 + acc[ai][bj][m][1]; }
        }
    }
};
struct EpiUp {
    static constexpr bool PERM = true, HAS_MID = false;
    bf16_t* O; const float* ss;
    __device__ __forceinline__ void mid(f32x4 (&acc)[2][2][4][2], const Unit& u, int wr, int wc, int fr, int fq) const {}
    __device__ __forceinline__ void operator()(const f32x4 (&acc)[2][2][4][2], const Unit& u, int wr, int wc, int fr, int fq) const {
        const int row0 = u.pm * BM + wr * 64 + fr, col0 = u.pn * BM + wc * 32 + 8 * fq;
        float ssv[2][4];
#pragma unroll
        for (int ai = 0; ai < 2; ++ai)
#pragma unroll
            for (int m = 0; m < 4; ++m) ssv[ai][m] = ss[row0 + ai * HALF + m * 16];
#pragma unroll
        for (int ai = 0; ai < 2; ++ai)
#pragma unroll
            for (int m = 0; m < 4; ++m) {
                const float rstd = __builtin_amdgcn_rsqf(ssv[ai][m] * (1.f / DM) + EPS);
#pragma unroll
                for (int bj = 0; bj < 2; ++bj) { const size_t off = (size_t)(row0 + ai * HALF + m * 16) * FF + col0 + bj * HALF;
                    f32x4 v0 = acc[ai][bj][m][0], v1 = acc[ai][bj][m][1];
#pragma unroll
                    for (int e = 0; e < 4; ++e) { const float a = fmaxf(v0[e] * rstd, 0.f), b = fmaxf(v1[e] * rstd, 0.f); v0[e] = a * a; v1[e] = b * b; }
                    u32x4 w; w.x = cvt_pk_bf16_asm(v0[0], v0[1]); w.y = cvt_pk_bf16_asm(v0[2], v0[3]); w.z = cvt_pk_bf16_asm(v1[0], v1[1]); w.w = cvt_pk_bf16_asm(v1[2], v1[3]);
                    *(u32x4*)(O + off) = w; }
            }
    }
};

template <class Epi, class Sched, bool ALIGN_EPI>
__device__ __forceinline__ void gemm_phase(LAS unsigned char* lds, const Gemm g, const Sched& S, const Epi& E) {
    int tid_ = threadIdx.x; asm volatile("" : "+v"(tid_));
    const int tid = tid_, wid = __builtin_amdgcn_readfirstlane(tid >> 6), lane = tid & 63, wr = wid >> 2, wc = wid & 3, fr = lane & 15, fq = lane >> 4;
    const int K = g.K, nt = K / BK;
    unsigned voffA[2], voffB[2];
#pragma unroll
    for (int i = 0; i < 2; ++i) { int R, C; stage_rc(tid * 16 + i * 8192, R, C); const int Rb = Epi::PERM ? ((R & ~31) + perm32(R & 31)) : R;
        voffA[i] = (unsigned)(R * K + C) * 2u; voffB[i] = (unsigned)(Rb * K + C) * 2u; }
    const size_t kstep = (size_t)(BK * 2);
    const size_t hstep = (size_t)HALF * K * 2;
    const size_t tstep = 2 * hstep;
    const unsigned ldsw = (unsigned)wid * 1024u;
    const int aoff = lds_byte(wr * 64 + fr, fq * 8), boff = lds_byte(wc * 32 + fr, fq * 8);
#define PG8_SA(b, h) (((b) * 2 + (h)) * HTB)
#define PG8_SB(b, h) ((4 + (b) * 2 + (h)) * HTB)
#define PG8_STAGE(bufoff, gbase, voff) do { _Pragma("unroll") for (int _i = 0; _i < 2; ++_i) \
        __builtin_amdgcn_global_load_lds((const unsigned*)((const char*)(gbase) + (voff)[_i]), (LAS unsigned*)(lds + (bufoff) + ldsw + _i * 8192), 16, 0, 0); } while (0)
#define PG8_LDA(dst, b, h) do { _Pragma("unroll") for (int m = 0; m < 4; ++m) _Pragma("unroll") for (int k = 0; k < 2; ++k) dst[m][k] = *(const LAS bf16x8*)(lds + PG8_SA(b, h) + aoff + m * 2048 + k * 1024); } while (0)
#define PG8_LDB(dst, b, h) do { _Pragma("unroll") for (int n = 0; n < 2; ++n) _Pragma("unroll") for (int k = 0; k < 2; ++k) dst[n][k] = *(const LAS bf16x8*)(lds + PG8_SB(b, h) + boff + n * 2048 + k * 1024); } while (0)
#define PG8_MMA(ai, bj, At, Bt) do { __builtin_amdgcn_s_setprio(1); _Pragma("unroll") for (int m = 0; m < 4; ++m) _Pragma("unroll") for (int n = 0; n < 2; ++n) _Pragma("unroll") for (int k = 0; k < 2; ++k) \
        acc[ai][bj][m][n] = __builtin_amdgcn_mfma_f32_16x16x32_bf16(Bt[n][k], At[m][k], acc[ai][bj][m][n], 0, 0, 0); __builtin_amdgcn_s_setprio(0); } while (0)
#define PG8_WAIT_V(n) asm volatile("s_waitcnt vmcnt(" #n ")" ::: "memory")
#define PG8_WAIT_L(n) asm volatile("s_waitcnt lgkmcnt(" #n ")" ::: "memory")
#define PG8_BAR __builtin_amdgcn_s_barrier()
#define PG8_SCHED __builtin_amdgcn_sched_barrier(0)
    Unit cur, nxt; int ui = 0;
    if (!S.next(0, cur)) return;
    f32x4 acc[2][2][4][2];
#pragma unroll
    for (int a = 0; a < 2; ++a)
#pragma unroll
        for (int b = 0; b < 2; ++b)
#pragma unroll
            for (int m = 0; m < 4; ++m)
#pragma unroll
                for (int n = 0; n < 2; ++n) acc[a][b][m][n] = (f32x4){0.f, 0.f, 0.f, 0.f};
    bf16x8 At[4][2], B0[2][2], B1[2][2];
    const char* cA = (const char*)(cur.seg ? g.A2 : g.A) + (size_t)cur.pm * tstep; const char* cB = (const char*)(cur.seg ? g.Bt2 : g.Bt) + (size_t)cur.pn * tstep;
    PG8_STAGE(PG8_SB(0, 0), cB, voffB); PG8_STAGE(PG8_SB(0, 1), cB + hstep, voffB); PG8_STAGE(PG8_SA(0, 0), cA, voffA); PG8_STAGE(PG8_SA(0, 1), cA + hstep, voffA);
    if (wr == 1) PG8_BAR;
    PG8_WAIT_V(2); PG8_BAR;
    PG8_STAGE(PG8_SB(1, 0), cB + kstep, voffB); PG8_STAGE(PG8_SA(1, 0), cA + kstep, voffA); PG8_STAGE(PG8_SB(1, 1), cB + hstep + kstep, voffB);
    PG8_WAIT_V(6); PG8_BAR;
    for (;;) {
        const bool has_next = S.next(ui + 1, nxt);
        const char* nA = has_next ? (const char*)(nxt.seg ? g.A2 : g.A) + (size_t)nxt.pm * tstep : cA; const char* nB = has_next ? (const char*)(nxt.seg ? g.Bt2 : g.Bt) + (size_t)nxt.pn * tstep : cB;
        for (int t = 0; t < nt; t += 2) {
            const bool last = (t == nt - 2);
            const char* a1 = cA + (size_t)(t + 1) * kstep;
            const char* a2 = last ? nA : cA + (size_t)(t + 2) * kstep; const char* b2 = last ? nB : cB + (size_t)(t + 2) * kstep;
            const char* a3 = a2 + kstep; const char* b3 = b2 + kstep;
            PG8_LDB(B0, 0, 0); PG8_LDB(B1, 0, 1); PG8_SCHED; PG8_LDA(At, 0, 0); PG8_STAGE(PG8_SA(1, 1), a1 + hstep, voffA);
            PG8_WAIT_V(8); PG8_WAIT_L(0); PG8_BAR; PG8_MMA(0, 0, At, B0); PG8_MMA(0, 1, At, B1); PG8_BAR; PG8_SCHED;
            PG8_LDA(At, 0, 1); PG8_STAGE(PG8_SB(0, 0), b2, voffB); PG8_STAGE(PG8_SB(0, 1), b2 + hstep, voffB); PG8_STAGE(PG8_SA(0, 0), a2, voffA);
            PG8_WAIT_V(8); PG8_WAIT_L(0); PG8_BAR; PG8_MMA(1, 0, At, B0); PG8_MMA(1, 1, At, B1); PG8_BAR; PG8_SCHED;
            PG8_LDB(B0, 1, 0); PG8_LDB(B1, 1, 1); PG8_SCHED; PG8_LDA(At, 1, 0); PG8_STAGE(PG8_SA(0, 1), a2 + hstep, voffA);
            PG8_WAIT_V(8); PG8_WAIT_L(0); PG8_BAR; PG8_MMA(0, 0, At, B0); PG8_MMA(0, 1, At, B1); PG8_BAR; PG8_SCHED;
            PG8_LDA(At, 1, 1); PG8_STAGE(PG8_SB(1, 0), b3, voffB); PG8_STAGE(PG8_SB(1, 1), b3 + hstep, voffB); PG8_STAGE(PG8_SA(1, 0), a3, voffA);
            PG8_WAIT_V(8); PG8_WAIT_L(0); PG8_BAR; PG8_MMA(1, 0, At, B0); PG8_MMA(1, 1, At, B1); PG8_BAR; PG8_SCHED;
        }
        if constexpr (ALIGN_EPI) { if (wr == 0) PG8_BAR; }
        bool keep = false;
        if constexpr (Epi::HAS_MID) keep = (cur.seg == 0);
        if (keep) E.mid(acc, cur, wr, wc, fr, fq); else E(acc, cur, wr, wc, fr, fq);
        if (!has_next) break;
        if (!keep) {
#pragma unroll
            for (int a = 0; a < 2; ++a)
#pragma unroll
                for (int b = 0; b < 2; ++b)
#pragma unroll
                    for (int m = 0; m < 4; ++m)
#pragma unroll
                        for (int n = 0; n < 2; ++n) acc[a][b][m][n] = (f32x4){0.f, 0.f, 0.f, 0.f};
        }
        cur = nxt; cA = nA; cB = nB; ++ui;
        if constexpr (ALIGN_EPI) { if (wr == 1) PG8_BAR; }
    }
    PG8_WAIT_V(0);
    if constexpr (!ALIGN_EPI) { if (wr == 0) PG8_BAR; }
    PG8_BAR;
#undef PG8_SA
#undef PG8_SB
#undef PG8_STAGE
#undef PG8_LDA
#undef PG8_LDB
#undef PG8_MMA
#undef PG8_WAIT_V
#undef PG8_WAIT_L
#undef PG8_BAR
#undef PG8_SCHED
}
}

struct Args {
    const float *x, *meta, *mix_g, *w_in, *ret_g, *q_g, *k_g, *sinks, *w_ret, *w_swa, *w_out, *mlp_g, *w_up, *w_down;
    float* out; unsigned char* ws;
};

__device__ __forceinline__ void p0_transpose_item(const float* W, int K, int N, bf16_t* WT, LAS float* scr, int item, int lane, const float* kgain = nullptr) {
    const int nblk = N / 32, kb = item / nblk, nb = item % nblk, k0 = 64 * kb, n0 = 32 * nb;
    f32x4 wv[8];
#pragma unroll
    for (int i = 0; i < 8; ++i) wv[i] = *(const f32x4*)(W + (size_t)(k0 + 8 * i + (lane >> 3)) * N + n0 + 4 * (lane & 7));
#pragma unroll
    for (int i = 0; i < 8; ++i) { const int kk = 8 * i + (lane >> 3); f32x4 v = wv[i]; if (kgain) v = v * kgain[k0 + kk];
        LAS float* d = scr + kk * 33 + 4 * (lane & 7); d[0] = v.x; d[1] = v.y; d[2] = v.z; d[3] = v.w; }
    asm volatile("s_waitcnt lgkmcnt(0)" ::: "memory");
    const int c = lane & 7;
#pragma unroll
    for (int j = 0; j < 4; ++j) { const int n = (lane >> 3) + 8 * j; const LAS float* s = scr + (8 * c) * 33 + n;
        u32x4 o; o.x = cvt_pk_bf16_asm(s[0 * 33], s[1 * 33]); o.y = cvt_pk_bf16_asm(s[2 * 33], s[3 * 33]); o.z = cvt_pk_bf16_asm(s[4 * 33], s[5 * 33]); o.w = cvt_pk_bf16_asm(s[6 * 33], s[7 * 33]);
        *(u32x4*)(WT + (size_t)(n0 + n) * K + k0 + 8 * c) = o; }
    asm volatile("s_waitcnt lgkmcnt(0)" ::: "memory");
}
__device__ __forceinline__ void rms_row_to_bf16(const float* xrow, const float* g, bf16_t* orow, int lane) {
    const f32x4* xr = (const f32x4*)xrow + lane; const f32x4* gr = (const f32x4*)g + lane;
    f32x4 v[4]; float s = 0.f;
#pragma unroll
    for (int j = 0; j < 4; ++j) { v[j] = xr[64 * j]; s += (v[j].x * v[j].x + v[j].y * v[j].y) + (v[j].z * v[j].z + v[j].w * v[j].w); }
    const float rstd = 1.f / sqrtf(wave_sum(s) * (1.f / DM) + EPS);
    u32x2* o8 = (u32x2*)orow + lane;
#pragma unroll
    for (int j = 0; j < 4; ++j) { const f32x4 gg = gr[64 * j]; u32x2 w; w.x = cvt_pk_bf16_asm(v[j].x * rstd * gg.x, v[j].y * rstd * gg.y); w.y = cvt_pk_bf16_asm(v[j].z * rstd * gg.z, v[j].w * rstd * gg.w); o8[64 * j] = w; }
}

__device__ __forceinline__ void tr_write8(LAS unsigned char* base, int RS, int col0, int pp, u32x4 r0, u32x4 r1) {
#define TRW(i, w0, w1) *(LAS unsigned*)(base + ((size_t)(col0 + (i)) * RS + 2 * pp) * 2) = ((i) & 1) ? (((w0) >> 16) | ((w1) & 0xffff0000u)) : (((w0) & 0xffffu) | ((w1) << 16))
    TRW(0, r0.x, r1.x); TRW(1, r0.x, r1.x); TRW(2, r0.y, r1.y); TRW(3, r0.y, r1.y); TRW(4, r0.z, r1.z); TRW(5, r0.z, r1.z); TRW(6, r0.w, r1.w); TRW(7, r0.w, r1.w);
#undef TRW
}

__device__ __forceinline__ int tr_off(int col, int RS, int slot) { return col * RS * 2 + ((slot ^ (2 * ((col >> 3) & 15))) << 3); }
__device__ __forceinline__ void tr_write8s(LAS unsigned char* base, int RS, int col0, int pp, u32x4 r0, u32x4 r1) {
    const int sw2 = 2 * ((col0 >> 3) & 15), po = (((pp >> 1) ^ sw2) << 3) + ((pp & 1) << 2);
#define TRW(i, w0, w1) *(LAS unsigned*)(base + (col0 + (i)) * RS * 2 + po) = ((i) & 1) ? (((w0) >> 16) | ((w1) & 0xffff0000u)) : (((w0) & 0xffffu) | ((w1) << 16))
    TRW(0, r0.x, r1.x); TRW(1, r0.x, r1.x); TRW(2, r0.y, r1.y); TRW(3, r0.y, r1.y); TRW(4, r0.z, r1.z); TRW(5, r0.z, r1.z); TRW(6, r0.w, r1.w); TRW(7, r0.w, r1.w);
#undef TRW
}
__device__ __forceinline__ u32x4 scale8(u32x4 r, float f) {
    u32x4 o; o.x = cvt_pk_bf16(bf_lo(r.x) * f, bf_hi(r.x) * f); o.y = cvt_pk_bf16(bf_lo(r.y) * f, bf_hi(r.y) * f); o.z = cvt_pk_bf16(bf_lo(r.z) * f, bf_hi(r.z) * f); o.w = cvt_pk_bf16(bf_lo(r.w) * f, bf_hi(r.w) * f); return o;
}
__device__ __forceinline__ bf16x8 as_frag(u32x4 v) { return __builtin_bit_cast(bf16x8, v); }
#define MFMA16(a, b, c) __builtin_amdgcn_mfma_f32_16x16x32_bf16((a), (b), (c), 0, 0, 0)

__device__ __forceinline__ long swa_key_row(int b, int c, int kk) {
    if (kk < 16) return (long)NTOK + kk;
    if (kk < 272) { const int s = (c - 1) * 128 + (kk - 16); if (s >= 128) return (long)b * SEQ + s - 128; }
    return -1;
}
__device__ __forceinline__ void swa_phase(LAS unsigned char* lds, const Args& p) {
    int tid_ = threadIdx.x; asm volatile("" : "+v"(tid_));
    const int tid = tid_, lane = tid & 63, w = __builtin_amdgcn_readfirstlane(tid >> 6), r = lane & 15, q = lane >> 4;
    const bf16_t* SQ = (const bf16_t*)(p.ws + OFF_SQ); const bf16_t* SK = (const bf16_t*)(p.ws + OFF_SK); const bf16_t* SV = (const bf16_t*)(p.ws + OFF_SV);
    bf16_t* YSWA = (bf16_t*)((unsigned char*)p.out + DOUT_YSWA);
    constexpr int KS = 72, VS = 296, K_OFF = 0, VT_OFF = 288 * KS * 2;
    constexpr float LOG2E = 1.4426950408889634f;
    const int kch = tid & 7, G = gridDim.x;
    const f32x4 kg0 = *(const f32x4*)(p.k_g + kch * 8), kg1 = *(const f32x4*)(p.k_g + kch * 8 + 4);
    u32x4 kraw[5], vraw[6];
    const f32x4 ga0 = *(const f32x4*)(p.q_g + 8 * q), ga1 = *(const f32x4*)(p.q_g + 8 * q + 4), gb0 = *(const f32x4*)(p.q_g + 32 + 8 * q), gb1 = *(const f32x4*)(p.q_g + 32 + 8 * q + 4);
#define SWA_LOAD_UNIT(uu) do { const int b_ = (uu) >> 8, c_ = 1 + (((uu) & 255) >> 2), kvh_ = (uu) & 3; \
        _Pragma("unroll") for (int it = 0; it < 5; ++it) { const int kk = (it * NTHREADS + tid) >> 3; const long row = swa_key_row(b_, c_, kk); \
            kraw[it] = (u32x4){0u, 0u, 0u, 0u}; if (row >= 0) kraw[it] = *(const u32x4*)(SK + (size_t)row * 256 + kvh_ * 64 + kch * 8); } \
        _Pragma("unroll") for (int it = 0; it < 3; ++it) { const int id = it * NTHREADS + tid, ch = id / 144, pp = id % 144; \
            _Pragma("unroll") for (int e = 0; e < 2; ++e) { const long row = (id < 1152) ? swa_key_row(b_, c_, 2 * pp + e) : -1; \
                vraw[2 * it + e] = (u32x4){0u, 0u, 0u, 0u}; if (row >= 0) vraw[2 * it + e] = *(const u32x4*)(SV + (size_t)row * 256 + kvh_ * 64 + ch * 8); } } } while (0)
    int u = blockIdx.x;
    if (u >= 1024) return;
    SWA_LOAD_UNIT(u);
    for (; u < 1024; u += G) {
        const int b = u >> 8, c = 1 + ((u & 255) >> 2), kvh = u & 3;
        __syncthreads();
#pragma unroll
        for (int it = 0; it < 5; ++it) {
            const int kk = (it * NTHREADS + tid) >> 3; const u32x4 raw = kraw[it];
            const float f0 = bf_lo(raw.x), f1 = bf_hi(raw.x), f2 = bf_lo(raw.y), f3 = bf_hi(raw.y), f4 = bf_lo(raw.z), f5 = bf_hi(raw.z), f6 = bf_lo(raw.w), f7 = bf_hi(raw.w);
            float ss = (f0 * f0 + f1 * f1) + (f2 * f2 + f3 * f3) + (f4 * f4 + f5 * f5) + (f6 * f6 + f7 * f7);
            ss += __shfl_xor(ss, 1); ss += __shfl_xor(ss, 2); ss += __shfl_xor(ss, 4);
            const float rstd = __builtin_amdgcn_rsqf(ss * (1.f / 64.f) + EPS);
            u32x4 o; o.x = cvt_pk_bf16(f0 * rstd * kg0.x, f1 * rstd * kg0.y); o.y = cvt_pk_bf16(f2 * rstd * kg0.z, f3 * rstd * kg0.w);
            o.z = cvt_pk_bf16(f4 * rstd * kg1.x, f5 * rstd * kg1.y); o.w = cvt_pk_bf16(f6 * rstd * kg1.z, f7 * rstd * kg1.w);
            if (kk < 288) *(LAS u32x4*)(lds + K_OFF + (kk * KS + kch * 8) * 2) = o;
        }
#pragma unroll
        for (int it = 0; it < 3; ++it) { const int id = it * NTHREADS + tid; if (id < 1152) tr_write8(lds + VT_OFF, VS, (id / 144) * 8, id % 144, vraw[2 * it], vraw[2 * it + 1]); }
        __syncthreads();
        const int qt = w, iq = 16 * qt + r;
        const size_t qrow = (size_t)b * SEQ + (size_t)(c - 1) * 128 + iq;
        u32x4 qa = *(const u32x4*)(SQ + qrow * 1024 + (kvh * 4) * 64 + 8 * q), qb = *(const u32x4*)(SQ + qrow * 1024 + (kvh * 4) * 64 + 32 + 8 * q);
        { const int un = (u + G < 1024) ? u + G : u; SWA_LOAD_UNIT(un); }
#pragma unroll 1
        for (int hl = 0; hl < 4; ++hl) {
            const int h = kvh * 4 + hl;
            bf16x8 Qf[2];
            {
                const u32x4 a = qa, bq = qb;
                const int hn = kvh * 4 + ((hl + 1) & 3);
                qa = *(const u32x4*)(SQ + qrow * 1024 + hn * 64 + 8 * q); qb = *(const u32x4*)(SQ + qrow * 1024 + hn * 64 + 32 + 8 * q);
                float fa[8] = {bf_lo(a.x), bf_hi(a.x), bf_lo(a.y), bf_hi(a.y), bf_lo(a.z), bf_hi(a.z), bf_lo(a.w), bf_hi(a.w)};
                float fb[8] = {bf_lo(bq.x), bf_hi(bq.x), bf_lo(bq.y), bf_hi(bq.y), bf_lo(bq.z), bf_hi(bq.z), bf_lo(bq.w), bf_hi(bq.w)};
                float ss = 0.f;
#pragma unroll
                for (int e = 0; e < 8; ++e) ss += fa[e] * fa[e] + fb[e] * fb[e];
                ss += __shfl_xor(ss, 16); ss += __shfl_xor(ss, 32);
                const float rs = (0.125f * LOG2E) * __builtin_amdgcn_rsqf(ss * (1.f / 64.f) + EPS);
                u32x4 oa, ob;
                oa.x = cvt_pk_bf16(fa[0] * rs * ga0.x, fa[1] * rs * ga0.y); oa.y = cvt_pk_bf16(fa[2] * rs * ga0.z, fa[3] * rs * ga0.w); oa.z = cvt_pk_bf16(fa[4] * rs * ga1.x, fa[5] * rs * ga1.y); oa.w = cvt_pk_bf16(fa[6] * rs * ga1.z, fa[7] * rs * ga1.w);
                ob.x = cvt_pk_bf16(fb[0] * rs * gb0.x, fb[1] * rs * gb0.y); ob.y = cvt_pk_bf16(fb[2] * rs * gb0.z, fb[3] * rs * gb0.w); ob.z = cvt_pk_bf16(fb[4] * rs * gb1.x, fb[5] * rs * gb1.y); ob.w = cvt_pk_bf16(fb[6] * rs * gb1.z, fb[7] * rs * gb1.w);
                Qf[0] = as_frag(oa); Qf[1] = as_frag(ob);
            }
            const float slope2 = exp2f(-0.5f * (float)(h + 1)) * LOG2E, sink2 = p.sinks[h] * LOG2E;
            const float bbase = -slope2 * (float)(144 + r - 4 * q), mbase = -slope2 * (float)(c * 128 + iq - 112 - 4 * q);
            const float sl1 = slope2, sl2 = 2.f * slope2, sl3 = 3.f * slope2;
            const int d0 = 144 + r - 4 * q;
            f32x4 sc[10]; float mx = -1e30f;
#pragma unroll
            for (int t = 0; t < 10; ++t) {
                const int kt = (t == 0) ? 0 : qt + t;
                f32x4 acc = (f32x4){0.f, 0.f, 0.f, 0.f};
#pragma unroll
                for (int ks = 0; ks < 2; ++ks) { const bf16x8 a = *(const LAS bf16x8*)(lds + K_OFF + ((16 * kt + r) * KS + 32 * ks + 8 * q) * 2); acc = MFMA16(a, Qf[ks], acc); }
                const float tb = (t == 0) ? mbase : bbase + slope2 * (float)(16 * t) + ((c == 1 && kt <= 8) ? -1e30f : 0.f);
                acc[0] += tb; acc[1] += tb + sl1; acc[2] += tb + sl2; acc[3] += tb + sl3;
                if (t == 1) {
#pragma unroll
                    for (int i = 0; i < 4; ++i) if (d0 - 16 - i >= 128) acc[i] = -1e30f;
                }
                if (t == 9) {
#pragma unroll
                    for (int i = 0; i < 4; ++i) if (d0 - 144 - i < 0) acc[i] = -1e30f;
                }
                mx = fmaxf(fmaxf(mx, fmaxf(acc[0], acc[1])), fmaxf(acc[2], acc[3]));
                sc[t] = acc;
                if (t == 4) __builtin_amdgcn_sched_barrier(0);
            }
            mx = fmaxf(mx, __shfl_xor(mx, 16)); mx = fmaxf(mx, __shfl_xor(mx, 32)); mx = fmaxf(mx, sink2);
            float sum = 0.f; u32x2 Pk[10];
#pragma unroll
            for (int t = 0; t < 10; ++t) { const float p0 = __builtin_amdgcn_exp2f(sc[t][0] - mx), p1 = __builtin_amdgcn_exp2f(sc[t][1] - mx), p2 = __builtin_amdgcn_exp2f(sc[t][2] - mx), p3 = __builtin_amdgcn_exp2f(sc[t][3] - mx);
                sum += (p0 + p1) + (p2 + p3); Pk[t].x = cvt_pk_bf16(p0, p1); Pk[t].y = cvt_pk_bf16(p2, p3); }
            sum += __shfl_xor(sum, 16); sum += __shfl_xor(sum, 32);
            const float inv = __builtin_amdgcn_rcpf(sum + __builtin_amdgcn_exp2f(sink2 - mx));
#pragma unroll 1
            for (int dtp = 0; dtp < 2; ++dtp) {
                u32x2 ov[2];
#pragma unroll
                for (int e = 0; e < 2; ++e) {
                    const int dt = 2 * dtp + e;
                    f32x4 acc = (f32x4){0.f, 0.f, 0.f, 0.f};
#pragma unroll
                    for (int pr = 0; pr < 5; ++pr) {
                        const int t0 = 2 * pr, t1 = 2 * pr + 1, kt0 = (t0 == 0) ? 0 : qt + t0, kt1 = qt + t1;
                        const LAS unsigned char* vp = lds + VT_OFF + ((16 * dt + r) * VS + 4 * q) * 2;
                        const u32x2 a0 = *(const LAS u32x2*)(vp + 32 * kt0), a1 = *(const LAS u32x2*)(vp + 32 * kt1);
                        const u32x4 a = (u32x4){a0.x, a0.y, a1.x, a1.y}, bb = (u32x4){Pk[t0].x, Pk[t0].y, Pk[t1].x, Pk[t1].y};
                        acc = MFMA16(as_frag(a), as_frag(bb), acc);
                    }
                    ov[e].x = cvt_pk_bf16(acc[0] * inv, acc[1] * inv); ov[e].y = cvt_pk_bf16(acc[2] * inv, acc[3] * inv);
                }
                const int dw = 32 * dtp + ((q & 1) ? 16 + 4 * (q - 1) : 4 * q);
                const u32x2 ox = __builtin_amdgcn_permlane16_swap(ov[0].x, ov[1].x, false, false), oy = __builtin_amdgcn_permlane16_swap(ov[0].y, ov[1].y, false, false);
                *(u32x4*)(YSWA + qrow * 1024 + h * 64 + dw) = (u32x4){ox.x, oy.x, ox.y, oy.y};
            }
        }
    }
#undef SWA_LOAD_UNIT
}

__device__ __forceinline__ size_t kvs_slot(int b, int n, int h) { return ((size_t)((b * 64 + n) * 4 + h)) * 32768; }
__device__ __forceinline__ void kvlocal_phase(LAS unsigned char* lds, const Args& p) {
    int tid_ = threadIdx.x; asm volatile("" : "+v"(tid_));
    const int tid = tid_, lane = tid & 63, w = __builtin_amdgcn_readfirstlane(tid >> 6), r = lane & 15, q = lane >> 4;
    const bf16_t* RK = (const bf16_t*)(p.ws + OFF_RK); const bf16_t* RV = (const bf16_t*)(p.ws + OFF_RV);
    bf16_t* KVS = (bf16_t*)((unsigned char*)p.out + DOUT_KVS);
    constexpr int RS = 136, KT_OFF = 0, VT_OFF = 128 * RS * 2;
    u32x4 kr[2][2], vr[4][2];
#define KV_LOAD_UNIT(uu) do { const int b_ = (uu) >> 8, n_ = ((uu) & 255) >> 2, h_ = (uu) & 3; \
        _Pragma("unroll") for (int it = 0; it < 2; ++it) { const int id = it * NTHREADS + tid, ch = id & 15, pr = id >> 4; \
            _Pragma("unroll") for (int e = 0; e < 2; ++e) { const int i = 2 * pr + e; long row; \
                if (n_ == 0) row = (i < 112) ? -1 : (long)NTOK + i - 112; else row = (long)b_ * SEQ + (n_ - 1) * 128 + i; \
                kr[it][e] = (u32x4){0u, 0u, 0u, 0u}; if (row >= 0) kr[it][e] = *(const u32x4*)(RK + (size_t)row * 512 + h_ * 128 + ch * 8); } } \
        _Pragma("unroll") for (int it = 0; it < 4; ++it) { const int id = it * NTHREADS + tid, ch = id & 31, pr = id >> 5; \
            _Pragma("unroll") for (int e = 0; e < 2; ++e) { const int i = 2 * pr + e; long row; \
                if (n_ == 0) row = (i < 112) ? -1 : (long)NTOK + i - 112; else row = (long)b_ * SEQ + (n_ - 1) * 128 + i; \
                vr[it][e] = (u32x4){0u, 0u, 0u, 0u}; if (row >= 0) vr[it][e] = *(const u32x4*)(RV + (size_t)row * 1024 + h_ * 256 + ch * 8); } } } while (0)
    int u = blockIdx.x;
    if (u >= 1024) return;
    const int G = gridDim.x;
    KV_LOAD_UNIT(u);
    for (; u < 1024; u += G) {
        const int b = u >> 8, n = (u & 255) >> 2, h = u & 3;
        const float lg2 = log2f(1.0f - exp2f(-5.0f - (float)h));
        __syncthreads();
#pragma unroll
        for (int it = 0; it < 2; ++it) { const int id = it * NTHREADS + tid, ch = id & 15, pr = id >> 4;
            const float f0 = 0.08838834764831845f * __builtin_amdgcn_exp2f(lg2 * (float)(127 - 2 * pr)), f1 = 0.08838834764831845f * __builtin_amdgcn_exp2f(lg2 * (float)(126 - 2 * pr));
            tr_write8s(lds + KT_OFF, RS, ch * 8, pr, scale8(kr[it][0], f0), scale8(kr[it][1], f1)); }
#pragma unroll
        for (int it = 0; it < 4; ++it) { const int id = it * NTHREADS + tid, ch = id & 31, pr = id >> 5;
            tr_write8s(lds + VT_OFF, RS, ch * 8, pr, vr[it][0], vr[it][1]); }
        __syncthreads();
        { const int un = (u + G < 1024) ? u + G : u; KV_LOAD_UNIT(un); }
        const int mt = w;
        bf16x8 a[4];
#pragma unroll
        for (int ks = 0; ks < 4; ++ks) a[ks] = *(const LAS bf16x8*)(lds + KT_OFF + tr_off(16 * mt + r, RS, 8 * ks + 2 * q));
        bf16_t* dst = KVS + kvs_slot(b, n, h);
#pragma unroll 2
        for (int ntp = 0; ntp < 8; ++ntp) {
            u32x2 ov[2];
#pragma unroll
            for (int e = 0; e < 2; ++e) {
                const int nt = 2 * ntp + e;
                f32x4 acc = (f32x4){0.f, 0.f, 0.f, 0.f};
#pragma unroll
                for (int ks = 0; ks < 4; ++ks) { const bf16x8 bb = *(const LAS bf16x8*)(lds + VT_OFF + tr_off(16 * nt + r, RS, 8 * ks + 2 * q)); acc = MFMA16(a[ks], bb, acc); }
                ov[e].x = cvt_pk_bf16(acc[0], acc[1]); ov[e].y = cvt_pk_bf16(acc[2], acc[3]);
            }
            const u32x2 ox = __builtin_amdgcn_permlane16_swap(ov[0].x, ov[1].x, false, false), oy = __builtin_amdgcn_permlane16_swap(ov[0].y, ov[1].y, false, false);
            const int row = 16 * (2 * ntp + (q & 1)) + r, dk0 = 16 * mt + 4 * (q & ~1);
            *(u32x4*)(dst + (size_t)row * 128 + dk0) = (u32x4){ox.x, oy.x, ox.y, oy.y};
        }
    }
#undef KV_LOAD_UNIT
}

__device__ __forceinline__ void scan_phase(const Args& p) {
    bf16_t* KVS = (bf16_t*)((unsigned char*)p.out + DOUT_KVS);
    if (threadIdx.x >= 256) return;
    for (int gid = blockIdx.x * 256 + threadIdx.x; gid < 16 * 4096; gid += gridDim.x * 256) {
        const int bh = gid >> 12, b = bh >> 2, h = bh & 3, off = (gid & 4095) * 8;
        const float dec = exp2f(128.0f * log2f(1.0f - exp2f(-5.0f - (float)h)));
        float s0 = 0.f, s1 = 0.f, s2 = 0.f, s3 = 0.f, s4 = 0.f, s5 = 0.f, s6 = 0.f, s7 = 0.f;
        bf16_t* base = KVS + kvs_slot(b, 0, h) + off;
        for (int n0 = 0; n0 < 64; n0 += 16) {
            u32x4 v[16];
#pragma unroll
            for (int j = 0; j < 16; ++j) v[j] = *(const u32x4*)(base + (size_t)(n0 + j) * 4 * 32768);
#pragma unroll
            for (int j = 0; j < 16; ++j) {
                s0 = dec * s0 + bf_lo(v[j].x); s1 = dec * s1 + bf_hi(v[j].x); s2 = dec * s2 + bf_lo(v[j].y); s3 = dec * s3 + bf_hi(v[j].y);
                s4 = dec * s4 + bf_lo(v[j].z); s5 = dec * s5 + bf_hi(v[j].z); s6 = dec * s6 + bf_lo(v[j].w); s7 = dec * s7 + bf_hi(v[j].w);
                u32x4 o; o.x = cvt_pk_bf16(s0, s1); o.y = cvt_pk_bf16(s2, s3); o.z = cvt_pk_bf16(s4, s5); o.w = cvt_pk_bf16(s6, s7);
                *(u32x4*)(base + (size_t)(n0 + j) * 4 * 32768) = o;
            }
        }
    }
}

__device__ __forceinline__ void retout_phase(LAS unsigned char* lds, const Args& p) {
    int tid_ = threadIdx.x; asm volatile("" : "+v"(tid_));
    const int tid = tid_, lane = tid & 63, w = __builtin_amdgcn_readfirstlane(tid >> 6), r = lane & 15, q = lane >> 4;
    const bf16_t* RQ = (const bf16_t*)(p.ws + OFF_RQ); const bf16_t* RK = (const bf16_t*)(p.ws + OFF_RK); const bf16_t* RV = (const bf16_t*)(p.ws + OFF_RV); const bf16_t* RG = (const bf16_t*)(p.ws + OFF_RG);
    const bf16_t* KVS = (const bf16_t*)((unsigned char*)p.out + DOUT_KVS);
    bf16_t* YRET = (bf16_t*)(p.ws + OFF_YRET);
    constexpr int RS = 136, K_OFF = 0, SB = 128 * RS * 2, QSZ = 64 * RS * 2;
    const int G = gridDim.x, vch = tid & 7, vpr = tid >> 3, srow = tid >> 4, sch = tid & 15;
    const LAS unsigned char* vlb = lds + SB + r * RS * 2 + ((q ^ (2 * (r >> 3))) << 3);
    u32x4 kreg[4], vreg[2], sreg[2], qn[4];
#define RO_LOAD_KQ(uu) do { const int b_ = (uu) >> 8, c_ = 1 + (((uu) & 255) >> 2), h_ = (uu) & 3; const size_t tb_ = (size_t)b_ * SEQ + (size_t)(c_ - 1) * 128; \
        _Pragma("unroll") for (int it = 0; it < 4; ++it) kreg[it] = *(const u32x4*)(RK + (tb_ + 32 * it + srow) * 512 + h_ * 128 + sch * 8); } while (0)
#define RO_LOAD_Q(uu) do { const int b_ = (uu) >> 8, c_ = 1 + (((uu) & 255) >> 2), h_ = (uu) & 3; const size_t tb_ = (size_t)b_ * SEQ + (size_t)(c_ - 1) * 128; \
        _Pragma("unroll") for (int ks = 0; ks < 4; ++ks) qn[ks] = *(const u32x4*)(RQ + (tb_ + 16 * w + r) * 512 + h_ * 128 + 32 * ks + 8 * q); } while (0)
#define RO_LOAD_STAGE(uu, sg) do { const int b_ = (uu) >> 8, c_ = 1 + (((uu) & 255) >> 2), h_ = (uu) & 3; const size_t tb_ = (size_t)b_ * SEQ + (size_t)(c_ - 1) * 128; \
        const bf16_t* st_ = KVS + kvs_slot(b_, c_ - 1, h_) + (size_t)(64 * (sg)) * 128; \
        vreg[0] = *(const u32x4*)(RV + (tb_ + 2 * vpr) * 1024 + h_ * 256 + 64 * (sg) + vch * 8); vreg[1] = *(const u32x4*)(RV + (tb_ + 2 * vpr + 1) * 1024 + h_ * 256 + 64 * (sg) + vch * 8); \
        sreg[0] = *(const u32x4*)(st_ + (size_t)srow * 128 + sch * 8); sreg[1] = *(const u32x4*)(st_ + (size_t)(32 + srow) * 128 + sch * 8); } while (0)
#define RO_WRITE_K() do { _Pragma("unroll") for (int it = 0; it < 4; ++it) *(LAS u32x4*)(lds + K_OFF + ((32 * it + srow) * RS + sch * 8) * 2) = kreg[it]; } while (0)
#define RO_WRITE_STAGE(j) do { tr_write8s(lds + SB + 2 * (j) * QSZ, RS, vch * 8, vpr, vreg[0], vreg[1]); \
        *(LAS u32x4*)(lds + SB + (2 * (j) + 1) * QSZ + (srow * RS + sch * 8) * 2) = sreg[0]; *(LAS u32x4*)(lds + SB + (2 * (j) + 1) * QSZ + ((32 + srow) * RS + sch * 8) * 2) = sreg[1]; } while (0)
    int u = blockIdx.x;
    if (u >= 1024) return;
    RO_LOAD_KQ(u); RO_LOAD_Q(u); RO_LOAD_STAGE(u, 0);
    __syncthreads();
    RO_WRITE_K(); RO_WRITE_STAGE(0);
    __syncthreads();
    int upar = 0;
    for (; u < 1024; u += G, upar ^= 1) {
        const int b = u >> 8, c = 1 + ((u & 255) >> 2), h = u & 3, un = (u + G < 1024) ? u + G : u;
        LAS unsigned char* xg = lds + SB + 4 * QSZ + upar * 1024;
        if (tid < 64) *(LAS f32x4*)(xg + tid * 16) = *(const f32x4*)(p.ret_g + h * 256 + 4 * tid);
        const size_t tokbase = (size_t)b * SEQ + (size_t)(c - 1) * 128;
        const float lg2 = log2f(1.0f - exp2f(-5.0f - (float)h));
        const int iq = 16 * w + r; const size_t qrow = tokbase + iq;
        bf16x8 Qd[4]; u32x2 Pk[8]; f32x4 o[16];
        {
#pragma unroll
            for (int kt = 0; kt < 8; ++kt) {
                {
                    f32x4 acc = (f32x4){0.f, 0.f, 0.f, 0.f};
#pragma unroll
                    for (int ks = 0; ks < 4; ++ks) { const bf16x8 a = *(const LAS bf16x8*)(lds + K_OFF + ((16 * kt + r) * RS + 32 * ks + 8 * q) * 2); acc = MFMA16(a, as_frag(qn[ks]), acc); }
#pragma unroll
                    for (int i = 0; i < 4; ++i) { const int d = iq - (16 * kt + 4 * q + i); acc[i] = (d >= 0) ? acc[i] * 0.08838834764831845f * __builtin_amdgcn_exp2f(lg2 * (float)d) : 0.f; }
                    Pk[kt].x = cvt_pk_bf16(acc[0], acc[1]); Pk[kt].y = cvt_pk_bf16(acc[2], acc[3]);
                }
                if (kt & 1) __builtin_amdgcn_sched_barrier(0);
            }
            const float qdec = __builtin_amdgcn_exp2f(lg2 * (float)(iq + 1));
#pragma unroll
            for (int ks = 0; ks < 4; ++ks) Qd[ks] = as_frag(scale8(qn[ks], qdec));
        }
#pragma unroll
        for (int sg = 0; sg < 4; ++sg) {
            if (sg < 3) RO_LOAD_STAGE(u, sg + 1); else { RO_LOAD_KQ(un); RO_LOAD_STAGE(un, 0); }
            const int bo = 2 * (sg & 1) * QSZ;
#pragma unroll
            for (int j = 0; j < 4; ++j) {
                f32x4 acc = (f32x4){0.f, 0.f, 0.f, 0.f};
#pragma unroll
                for (int ks = 0; ks < 4; ++ks) { const bf16x8 a = *(const LAS bf16x8*)(lds + SB + bo + QSZ + ((16 * j + r) * RS + 32 * ks + 8 * q) * 2); acc = MFMA16(a, Qd[ks], acc); }
#pragma unroll
                for (int kp = 0; kp < 4; ++kp) {
                    {
                        const u32x2 a0 = *(const LAS u32x2*)(vlb + bo + 16 * j * RS * 2 + ((((kp ^ (j >> 1)) << 3) | ((0 ^ (j & 1)) << 2)) << 3));
                        const u32x2 a1 = *(const LAS u32x2*)(vlb + bo + 16 * j * RS * 2 + ((((kp ^ (j >> 1)) << 3) | ((1 ^ (j & 1)) << 2)) << 3));
                        const u32x4 a = (u32x4){a0.x, a0.y, a1.x, a1.y}, bb = (u32x4){Pk[2 * kp].x, Pk[2 * kp].y, Pk[2 * kp + 1].x, Pk[2 * kp + 1].y};
                        acc = MFMA16(as_frag(a), as_frag(bb), acc);
                    }
                }
                o[sg * 4 + j] = acc;
                if (j & 1) __builtin_amdgcn_sched_barrier(0);
            }
            if (sg == 3) RO_WRITE_K();
            RO_WRITE_STAGE((sg + 1) & 1);
            __syncthreads();
        }
        RO_LOAD_Q(un);
        float ss = 0.f;
#pragma unroll
        for (int t = 0; t < 16; ++t) ss += (o[t][0] * o[t][0] + o[t][1] * o[t][1]) + (o[t][2] * o[t][2] + o[t][3] * o[t][3]);
        ss += __shfl_xor(ss, 16); ss += __shfl_xor(ss, 32);
        const float rstd = 1.f / sqrtf(ss * (1.f / 256.f) + EPS);
        const int qodd = q & 1;
        u32x4 gwv[8];
#pragma unroll
        for (int tp = 0; tp < 8; ++tp) gwv[tp] = *(const u32x4*)(RG + qrow * 1024 + h * 256 + 32 * tp + (qodd ? 16 + 4 * (q - 1) : 4 * q));
#pragma unroll
        for (int tp = 0; tp < 8; ++tp) {
            const int t0 = 2 * tp, t1 = 2 * tp + 1;
            const int dvw = 32 * tp + (qodd ? 16 + 4 * (q - 1) : 4 * q);
            const u32x4 gw = gwv[tp];
            const u32x2 sx = __builtin_amdgcn_permlane16_swap(gw.x, gw.z, false, false), sy = __builtin_amdgcn_permlane16_swap(gw.y, gw.w, false, false);
            const f32x4 g0 = *(const LAS f32x4*)(xg + (16 * t0 + 4 * q) * 4), g1 = *(const LAS f32x4*)(xg + (16 * t1 + 4 * q) * 4);
            u32x2 ov0, ov1;
            { const float x0 = bf_lo(sx.x), x1 = bf_hi(sx.x), x2 = bf_lo(sy.x), x3 = bf_hi(sy.x);
              ov0.x = cvt_pk_bf16(o[t0][0] * rstd * g0.x * x0 * sigmoidf_(x0), o[t0][1] * rstd * g0.y * x1 * sigmoidf_(x1));
              ov0.y = cvt_pk_bf16(o[t0][2] * rstd * g0.z * x2 * sigmoidf_(x2), o[t0][3] * rstd * g0.w * x3 * sigmoidf_(x3)); }
            { const float x0 = bf_lo(sx.y), x1 = bf_hi(sx.y), x2 = bf_lo(sy.y), x3 = bf_hi(sy.y);
              ov1.x = cvt_pk_bf16(o[t1][0] * rstd * g1.x * x0 * sigmoidf_(x0), o[t1][1] * rstd * g1.y * x1 * sigmoidf_(x1));
              ov1.y = cvt_pk_bf16(o[t1][2] * rstd * g1.z * x2 * sigmoidf_(x2), o[t1][3] * rstd * g1.w * x3 * sigmoidf_(x3)); }
            const u32x2 ox = __builtin_amdgcn_permlane16_swap(ov0.x, ov1.x, false, false), oy = __builtin_amdgcn_permlane16_swap(ov0.y, ov1.y, false, false);
            *(u32x4*)(YRET + qrow * 1024 + h * 256 + dvw) = (u32x4){ox.x, oy.x, ox.y, oy.y};
        }
    }
#undef RO_LOAD_KQ
#undef RO_LOAD_Q
#undef RO_LOAD_STAGE
#undef RO_WRITE_K
#undef RO_WRITE_STAGE
}

__device__ __forceinline__ void meta_proj(const Args& p, const bf16_t* XN, const bf16_t* WinT) {
    int tid_ = threadIdx.x; asm volatile("" : "+v"(tid_));
    const int tid = tid_, lane = tid & 63, r = lane & 15, q = lane >> 4;
    const bool g256 = (gridDim.x == 256);
    const int wv = tid >> 6, jg = (int)(((blockIdx.x >> 5) << 3) | (blockIdx.x & 7u));
    if (g256 ? (((blockIdx.x >> 3) & 3u) != 0u || wv >= 2) : (wv != 0)) return;
    for (int t = g256 ? jg * 2 + wv : (int)blockIdx.x; t < 128; t += (g256 ? 128 : (int)gridDim.x)) {
        int ncol, ld, cl; size_t boff;
        if (t < 32) { ncol = 512 + 16 * t; boff = OFF_RK; ld = 512; cl = 16 * t; }
        else if (t < 96) { ncol = 1024 + 16 * (t - 32); boff = OFF_RV; ld = 1024; cl = 16 * (t - 32); }
        else if (t < 112) { ncol = 4096 + 16 * (t - 96); boff = OFF_SK; ld = 256; cl = 16 * (t - 96); }
        else { ncol = 4352 + 16 * (t - 112); boff = OFF_SV; ld = 256; cl = 16 * (t - 112); }
        const bf16_t* ap = WinT + (size_t)(ncol + r) * DM + 8 * q; const bf16_t* bp = XN + (size_t)(NTOK + r) * DM + 8 * q;
        f32x4 acc = (f32x4){0.f, 0.f, 0.f, 0.f};
#pragma unroll 8
        for (int ks = 0; ks < 32; ++ks) { const u32x4 a = *(const u32x4*)(ap + 32 * ks), b = *(const u32x4*)(bp + 32 * ks); acc = MFMA16(as_frag(a), as_frag(b), acc); }
        u32x2 o; o.x = cvt_pk_bf16(acc[0], acc[1]); o.y = cvt_pk_bf16(acc[2], acc[3]);
        *(u32x2*)((bf16_t*)(p.ws + boff) + (size_t)(NTOK + r) * ld + cl + 4 * q) = o;
    }
}

#define XB_TMO      128
#define XB_XCNT(j)  (256  + 64 * (j))
#define XB_XSUB(j)  (1280 + 64 * (j))
#define XB_XGEN(j)  (2304 + 64 * (j))
#define XB_TOP      3328
#define XB_TOPGEN   3392
#define XCD_BAR_WORDS 3456
#define XB_SPIN_CAP (1u << 22)
__device__ __forceinline__ unsigned xb_ld(unsigned* p)              { return __hip_atomic_load(p, __ATOMIC_RELAXED, __HIP_MEMORY_SCOPE_AGENT); }
__device__ __forceinline__ unsigned xb_add(unsigned* p, unsigned v) { return __hip_atomic_fetch_add(p, v, __ATOMIC_RELAXED, __HIP_MEMORY_SCOPE_AGENT); }
__device__ __forceinline__ unsigned xb_xcc_id() { return (unsigned)__builtin_amdgcn_s_getreg((3 << 11) | 20) & 0xFu; }
#define XB_SPIN(cond, bar) do { unsigned _sp = 0; while (cond) { __builtin_amdgcn_s_sleep(1); \
    if ((++_sp & 255u) == 0u) { if (xb_ld(&(bar)[XB_TMO])) break; if (_sp > XB_SPIN_CAP) { atomicAdd(&(bar)[XB_TMO], 1u); break; } } } } while (0)
struct XcdBarrier { unsigned* bar; unsigned x; volatile LAS unsigned* st; };
__device__ __forceinline__ XcdBarrier xcd_barrier_post(unsigned* bar, volatile LAS unsigned* st) {
    XcdBarrier b; b.bar = bar; b.x = xb_xcc_id(); b.st = st;
    if (threadIdx.x == 0) (void)xb_add(&bar[XB_XCNT(b.x)], 1u);
    return b;
}
__device__ __forceinline__ void xcd_barrier_complete(unsigned* bar, unsigned x, unsigned& nloc, unsigned& nx) {
    const unsigned G = gridDim.x * gridDim.y * gridDim.z;
    unsigned sum, cnt, mine, sp = 0u;
    for (;;) {
        sum = 0u; cnt = 0u; mine = 0u;
#pragma unroll
        for (unsigned j = 0; j < 16; ++j) { const unsigned c = xb_ld(&bar[XB_XCNT(j)]); sum += c; cnt += (c > 0u) ? 1u : 0u; mine = (j == x) ? c : mine; }
        if (sum == G) break;
        __builtin_amdgcn_s_sleep(1);
        if ((++sp & 255u) == 0u) { if (xb_ld(&bar[XB_TMO])) break; if (sp > XB_SPIN_CAP) { atomicAdd(&bar[XB_TMO], 1u); break; } }
    }
    nloc = mine > 0u ? mine : 1u; nx = cnt > 0u ? cnt : 1u;
}
__device__ __forceinline__ void xcd_barrier(const XcdBarrier& b) {
    asm volatile("s_waitcnt vmcnt(0)" ::: "memory");
    __syncthreads();
    if (threadIdx.x == 0) {
        unsigned* bar = b.bar;
        __builtin_amdgcn_s_waitcnt(0);
        unsigned nloc = b.st[0], nx = b.st[1];
        if (nloc == 0u) { xcd_barrier_complete(bar, b.x, nloc, nx); b.st[0] = nloc; b.st[1] = nx; }
        const unsigned old = xb_add(&bar[XB_XSUB(b.x)], 1u);
        const unsigned gen = old / nloc;
        if (old + 1u == (gen + 1u) * nloc) {
            __builtin_amdgcn_fence(__ATOMIC_RELEASE, "agent");
            asm volatile("s_waitcnt vmcnt(0)" ::: "memory");
            const unsigned og = xb_add(&bar[XB_TOP], 1u);
            const unsigned tg = og / nx;
            if (og + 1u == (tg + 1u) * nx) xb_add(&bar[XB_TOPGEN], 1u);
            else XB_SPIN(xb_ld(&bar[XB_TOPGEN]) == tg, bar);
            __builtin_amdgcn_fence(__ATOMIC_ACQUIRE, "agent");
            xb_add(&bar[XB_XGEN(b.x)], 1u);
            asm volatile("s_waitcnt vmcnt(0)" ::: "memory");
        } else {
            XB_SPIN(xb_ld(&bar[XB_XGEN(b.x)]) == gen, bar);
            __builtin_amdgcn_fence(__ATOMIC_ACQUIRE, "agent");
            asm volatile("s_waitcnt vmcnt(0)" ::: "memory");
        }
    }
    __syncthreads();
}

__device__ __forceinline__ void convert_slot(const Args& p, LAS unsigned char* lds, const int list) {
    const unsigned grp = (blockIdx.x >> 3) & 3u;
    if (grp == 0u) return;
    int tid_ = threadIdx.x; asm volatile("" : "+v"(tid_));
    const int tid = tid_, lane = tid & 63, wave = __builtin_amdgcn_readfirstlane(tid >> 6);
    constexpr int I_SQ = (DM / 64) * (DM / 32), I_UP = (DM / 64) * (FF / 32), I_DN = (FF / 64) * (DM / 32);
    const int total = list == 0 ? 3 * I_SQ + I_UP : I_DN;
    const int lo = grp == 1u ? 0 : (grp == 2u ? total / 6 : total / 2), hi = grp == 1u ? total / 6 : (grp == 2u ? total / 2 : total);
    const int j = (int)(((blockIdx.x >> 5) << 3) | (blockIdx.x & 7u));
    LAS float* scr = (LAS float*)(lds + wave * 16384);
    unsigned char* ws = p.ws;
    for (int it = lo + j * 8 + wave; it < hi; it += 512) {
        if (list == 0) {
            int r = it;
            if (r < I_SQ) { p0_transpose_item(p.w_ret, DM, DM, (bf16_t*)(ws + OFF_WRET), scr, r, lane); continue; } r -= I_SQ;
            if (r < I_SQ) { p0_transpose_item(p.w_swa, DM, DM, (bf16_t*)(ws + OFF_WSWA), scr, r, lane); continue; } r -= I_SQ;
            if (r < I_SQ) { p0_transpose_item(p.w_out, DM, DM, (bf16_t*)(ws + OFF_WOUT), scr, r, lane); continue; } r -= I_SQ;
            p0_transpose_item(p.w_up, DM, FF, (bf16_t*)(ws + OFF_WUP), scr, r, lane, p.mlp_g);
        } else p0_transpose_item(p.w_down, FF, DM, (bf16_t*)(ws + OFF_WDN), scr, it, lane);
    }
    __syncthreads();
}

__global__ void __launch_bounds__(NTHREADS, 2) fwd_megakernel(Args p) {
    extern __shared__ __attribute__((aligned(16))) unsigned char lds_raw[];
    LAS unsigned char* lds = (LAS unsigned char*)lds_raw;
    cg::grid_group grid = cg::this_grid();
    ((LAS unsigned*)(lds + 131072 + 64))[threadIdx.x & 15] = 0u;
    __syncthreads();
    XcdBarrier xbar = xcd_barrier_post((unsigned*)(p.ws + OFF_CTL), (volatile LAS unsigned*)(lds + 131072 + 64));
    grid.sync();
#define GRID_SYNC() xcd_barrier(xbar)
    const int tid = threadIdx.x, lane = tid & 63, wave = __builtin_amdgcn_readfirstlane(tid >> 6);
    const int G = gridDim.x, gw = blockIdx.x * 8 + wave, NGW = G * 8;
    unsigned char* ws = p.ws;
    bf16_t* WinT = (bf16_t*)(ws + OFF_WIN); bf16_t* WretT = (bf16_t*)(ws + OFF_WRET); bf16_t* WswaT = (bf16_t*)(ws + OFF_WSWA); bf16_t* WoutT = (bf16_t*)(ws + OFF_WOUT);
    bf16_t* WupT = (bf16_t*)(ws + OFF_WUP); bf16_t* WdnT = (bf16_t*)(ws + OFF_WDN);
    bf16_t* XN = (bf16_t*)p.out;

    for (int rep = 0; rep < 1 + ((REP_MASK >> 0) & 1); ++rep) {
        LAS float* scr = (LAS float*)(lds + wave * 16384);
        constexpr int I_IN = (DM / 64) * (DIN / 32), I_SQ = (DM / 64) * (DM / 32), I_UP = (DM / 64) * (FF / 32), I_DN = (FF / 64) * (DM / 32);
        constexpr int NITEMS = I_IN + 3 * I_SQ + I_UP + I_DN;
        const bool split = (G == 256);
        for (int it = gw; it < (split ? I_IN : NITEMS); it += NGW) {
            int r = it;
            if (r < I_IN) { p0_transpose_item(p.w_in, DM, DIN, WinT, scr, r, lane); continue; } r -= I_IN;
            if (r < I_SQ) { p0_transpose_item(p.w_ret, DM, DM, WretT, scr, r, lane); continue; } r -= I_SQ;
            if (r < I_SQ) { p0_transpose_item(p.w_swa, DM, DM, WswaT, scr, r, lane); continue; } r -= I_SQ;
            if (r < I_SQ) { p0_transpose_item(p.w_out, DM, DM, WoutT, scr, r, lane); continue; } r -= I_SQ;
            if (r < I_UP) { p0_transpose_item(p.w_up, DM, FF, WupT, scr, r, lane, p.mlp_g); continue; } r -= I_UP;
            p0_transpose_item(p.w_down, FF, DM, WdnT, scr, r, lane);
        }
        for (int m = gw; m < NTOK; m += 2 * NGW) {
            const int m2 = m + NGW;
            const f32x4* xa = (const f32x4*)(p.x + (size_t)m * DM) + 2 * lane; const f32x4* xb = (const f32x4*)(p.x + (size_t)(m2 < NTOK ? m2 : m) * DM) + 2 * lane; const f32x4* gr = (const f32x4*)p.mix_g + 2 * lane;
            f32x4 va[4], vb[4]; float sa = 0.f, sb = 0.f;
#pragma unroll
            for (int j = 0; j < 4; ++j) { va[j] = xa[(j & 1) + 128 * (j >> 1)]; vb[j] = xb[(j & 1) + 128 * (j >> 1)]; }
#pragma unroll
            for (int j = 0; j < 4; ++j) { sa += (va[j].x * va[j].x + va[j].y * va[j].y) + (va[j].z * va[j].z + va[j].w * va[j].w); sb += (vb[j].x * vb[j].x + vb[j].y * vb[j].y) + (vb[j].z * vb[j].z + vb[j].w * vb[j].w); }
            const float ra = 1.f / sqrtf(wave_sum(sa) * (1.f / DM) + EPS), rb = 1.f / sqrtf(wave_sum(sb) * (1.f / DM) + EPS);
            u32x4* oa = (u32x4*)(XN + (size_t)m * DM) + lane; u32x4* ob = (u32x4*)(XN + (size_t)m2 * DM) + lane;
#pragma unroll
            for (int jj = 0; jj < 2; ++jj) { const f32x4 g0 = gr[128 * jj], g1 = gr[128 * jj + 1]; const f32x4 a0 = va[2 * jj], a1 = va[2 * jj + 1], b0 = vb[2 * jj], b1 = vb[2 * jj + 1];
                u32x4 wa; wa.x = cvt_pk_bf16_asm(a0.x * ra * g0.x, a0.y * ra * g0.y); wa.y = cvt_pk_bf16_asm(a0.z * ra * g0.z, a0.w * ra * g0.w); wa.z = cvt_pk_bf16_asm(a1.x * ra * g1.x, a1.y * ra * g1.y); wa.w = cvt_pk_bf16_asm(a1.z * ra * g1.z, a1.w * ra * g1.w);
                oa[64 * jj] = wa;
                if (m2 < NTOK) { u32x4 wb; wb.x = cvt_pk_bf16_asm(b0.x * rb * g0.x, b0.y * rb * g0.y); wb.y = cvt_pk_bf16_asm(b0.z * rb * g0.z, b0.w * rb * g0.w); wb.z = cvt_pk_bf16_asm(b1.x * rb * g1.x, b1.y * rb * g1.y); wb.w = cvt_pk_bf16_asm(b1.z * rb * g1.z, b1.w * rb * g1.w);
                    ob[64 * jj] = wb; } }
        }
        if (gw < NMETA) rms_row_to_bf16(p.meta + (size_t)gw * DM, p.mix_g, XN + (size_t)(NTOK + gw) * DM, lane);
    }
    GRID_SYNC();
    {
        meta_proj(p, XN, WinT);
        if (G == 256) convert_slot(p, lds, 0);
        pg8::Gemm g{XN, WinT, XN, WinT, NTOK, DIN, DM}; pg8::StaticOrder S; S.init(NTOK, DIN, G, (int)blockIdx.x);
        pg8::EpiProj E{ws};
        pg8::gemm_phase<pg8::EpiProj, pg8::StaticOrder, true>(lds, g, S, E);
    }
    GRID_SYNC();
    for (int rep = 0; rep < 1 + ((REP_MASK >> 1) & 1); ++rep) { swa_phase(lds, p); kvlocal_phase(lds, p); }
    GRID_SYNC();
    scan_phase(p);
    GRID_SYNC();
    for (int rep = 0; rep < 1 + ((REP_MASK >> 2) & 1); ++rep) retout_phase(lds, p);
    GRID_SYNC();
    {
        const bf16_t* YRET = (const bf16_t*)(ws + OFF_YRET); const bf16_t* YSWA = (const bf16_t*)((unsigned char*)p.out + DOUT_YSWA);
        pg8::Gemm g{YRET, WretT, YSWA, WswaT, NTOK, DM, DM}; pg8::PairOrder S; S.s.init(NTOK, DM, G, (int)blockIdx.x);
        pg8::EpiMerged E{(const unsigned char*)(ws + OFF_GR), (const unsigned char*)(ws + OFF_GS), (bf16_t*)(ws + OFF_MERGED)};
        pg8::gemm_phase<pg8::EpiMerged, pg8::PairOrder, true>(lds, g, S, E);
    }
    GRID_SYNC();
    {
        const bf16_t* MG = (const bf16_t*)(ws + OFF_MERGED);
        pg8::Gemm g{MG, WoutT, MG, WoutT, NTOK, DM, DM}; pg8::StaticOrder S; S.init(NTOK, DM, G, (int)blockIdx.x);
        pg8::EpiResStat E{p.x, p.out, (bf16_t*)(ws + OFF_HN2), (float*)(ws + OFF_SS)};
        pg8::gemm_phase<pg8::EpiResStat, pg8::StaticOrder, true>(lds, g, S, E);
    }
    GRID_SYNC();
    {
        const bf16_t* HN2 = (const bf16_t*)(ws + OFF_HN2);
        pg8::Gemm g{HN2, WupT, HN2, WupT, NTOK, FF, DM}; pg8::StaticOrder S; S.init(NTOK, FF, G, (int)blockIdx.x);
        pg8::EpiUp E{(bf16_t*)(ws + OFF_U), (const float*)(ws + OFF_SS)};
        if (G == 256) convert_slot(p, lds, 1);
        pg8::gemm_phase<pg8::EpiUp, pg8::StaticOrder, true>(lds, g, S, E);
    }
    GRID_SYNC();
    {
        const bf16_t* U = (const bf16_t*)(ws + OFF_U);
        pg8::Gemm g{U, WdnT, U, WdnT, NTOK, DM, FF}; pg8::StaticOrder S; S.init(NTOK, DM, G, (int)blockIdx.x);
        pg8::EpiResBf E{(const bf16_t*)(ws + OFF_HN2), p.out};
        pg8::gemm_phase<pg8::EpiResBf, pg8::StaticOrder, true>(lds, g, S, E);
    }
}

extern "C" void kernel_launch(void* const* d_in, const int* in_sizes, int n_in, void* d_out, int out_size, void* d_ws, size_t ws_size, hipStream_t stream) {
    static int grid = 0;
    if (grid == 0) {
        if (n_in != 14 || in_sizes[0] != NTOK * DM || out_size != NTOK * DM || ws_size < WS_NEED) {
            fprintf(stderr, "kernel_launch: unexpected shapes (n_in %d, in0 %d, out %d, ws %zu, need %zu); nothing launched\n", n_in, n_in > 0 ? in_sizes[0] : -1, out_size, ws_size, (size_t)WS_NEED); grid = -1; return; }
        int dev = 0, cus = 0, per_cu = 0;
        (void)hipGetDevice(&dev); (void)hipDeviceGetAttribute(&cus, hipDeviceAttributeMultiprocessorCount, dev);
        if (hipFuncSetAttribute((const void*)fwd_megakernel, hipFuncAttributeMaxDynamicSharedMemorySize, LDS_BYTES) != hipSuccess) { fprintf(stderr, "kernel_launch: hipFuncSetAttribute failed\n"); grid = -1; return; }
        if (hipOccupancyMaxActiveBlocksPerMultiprocessor(&per_cu, (const void*)fwd_megakernel, NTHREADS, LDS_BYTES) != hipSuccess || per_cu < 1) { fprintf(stderr, "kernel_launch: occupancy query gave %d\n", per_cu); per_cu = 1; }
        (void)hipGetLastError();
        grid = cus * per_cu;
    }
    if (grid < 0) return;
    Args a{};
    a.x = (const float*)d_in[0]; a.meta = (const float*)d_in[1]; a.mix_g = (const float*)d_in[2]; a.w_in = (const float*)d_in[3]; a.ret_g = (const float*)d_in[4];
    a.q_g = (const float*)d_in[5]; a.k_g = (const float*)d_in[6]; a.sinks = (const float*)d_in[7]; a.w_ret = (const float*)d_in[8]; a.w_swa = (const float*)d_in[9];
    a.w_out = (const float*)d_in[10]; a.mlp_g = (const float*)d_in[11]; a.w_up = (const float*)d_in[12]; a.w_down = (const float*)d_in[13];
    a.out = (float*)d_out; a.ws = (unsigned char*)d_ws;
    if (hipMemsetAsync((unsigned char*)d_ws + OFF_CTL, 0, CTL_BYTES, stream) != hipSuccess) { fprintf(stderr, "kernel_launch: memset failed\n"); return; }
    void* args[] = {&a};
    hipError_t e = hipLaunchCooperativeKernel((const void*)fwd_megakernel, dim3(grid), dim3(NTHREADS), args, LDS_BYTES, stream);
    if (e != hipSuccess) fprintf(stderr, "kernel_launch: cooperative launch failed: %s (grid %d)\n", hipGetErrorString(e), grid);
}
```

```cpp
#ifndef REP_MASK
#define REP_MASK 0
#endif
#include <hip/hip_runtime.h>
#include <hip/hip_cooperative_groups.h>
#include <cstdio>
#include <cstdint>
namespace cg = cooperative_groups;

#define LAS __attribute__((address_space(3)))
typedef unsigned short bf16_t;
typedef short bf16x8 __attribute__((ext_vector_type(8)));
typedef float f32x4 __attribute__((ext_vector_type(4)));
typedef unsigned u32x4 __attribute__((ext_vector_type(4)));
typedef unsigned u32x2 __attribute__((ext_vector_type(2)));

constexpr int NB = 4, SEQ = 8192, DM = 1024, NTOK = NB * SEQ, NMETA = 16, MROWS = NTOK + NMETA, MPAD = 33024, DIN = 6656, FF = 4096;
constexpr float EPS = 1e-6f;
constexpr int NTHREADS = 512;
constexpr int LDS_BYTES = 135168;

constexpr size_t SZ_WIN = (size_t)DIN * DM * 2, SZ_WSQ = (size_t)DM * DM * 2, SZ_WFF = (size_t)FF * DM * 2;
constexpr size_t OFF_WIN = 0, OFF_WRET = OFF_WIN + SZ_WIN, OFF_WSWA = OFF_WRET + SZ_WSQ, OFF_WOUT = OFF_WSWA + SZ_WSQ, OFF_WUP = OFF_WOUT + SZ_WSQ, OFF_WDN = OFF_WUP + SZ_WFF;
constexpr size_t OFF_RQ = OFF_WDN + SZ_WFF;
constexpr size_t OFF_RK = OFF_RQ + (size_t)MROWS * 512 * 2;
constexpr size_t OFF_RV = OFF_RK + (size_t)MROWS * 512 * 2;
constexpr size_t OFF_RG = OFF_RV + (size_t)MROWS * 1024 * 2;
constexpr size_t OFF_SQ = OFF_RG + (size_t)MROWS * 1024 * 2;
constexpr size_t OFF_SK = OFF_SQ + (size_t)MROWS * 1024 * 2;
constexpr size_t OFF_SV = OFF_SK + (size_t)MROWS * 256 * 2;
constexpr size_t OFF_GR = OFF_SV + (size_t)MROWS * 256 * 2;
constexpr size_t OFF_GS = OFF_GR + (size_t)MROWS * 1024 * 2;
constexpr size_t OFF_CTL = OFF_GS + (size_t)MROWS * 1024 * 2;
constexpr size_t CTL_BYTES = 16384 + (size_t)NTOK * 4;
constexpr size_t OFF_SS = OFF_CTL + 16384;
constexpr size_t WS_NEED = OFF_CTL + CTL_BYTES;
constexpr size_t OFF_MERGED = OFF_RQ, OFF_HN2 = OFF_RV, OFF_YRET = OFF_SQ, OFF_U = OFF_RG;
static_assert(OFF_RK - OFF_RQ + OFF_RV - OFF_RK >= (size_t)NTOK * 1024 * 2, "MERGED fits");
static_assert(OFF_CTL - OFF_RG >= (size_t)NTOK * FF * 2, "U fits");
static_assert((size_t)MPAD * DM * 2 <= (size_t)NTOK * DM * 4, "XN fits d_out");
constexpr size_t DOUT_KVS = 0, DOUT_YSWA = (size_t)NTOK * 1024 * 2;

typedef __bf16 bf16x2_t __attribute__((ext_vector_type(2)));
typedef float f32x2_t __attribute__((ext_vector_type(2)));
__device__ __forceinline__ unsigned cvt_pk_bf16(float lo, float hi) { const f32x2_t v = {lo, hi}; const bf16x2_t b = __builtin_convertvector(v, bf16x2_t); return __builtin_bit_cast(unsigned, b); }
__device__ __forceinline__ unsigned cvt_pk_bf16_asm(float lo, float hi) { unsigned r; asm volatile("v_cvt_pk_bf16_f32 %0, %1, %2" : "=v"(r) : "v"(lo), "v"(hi)); return r; }
__device__ __forceinline__ float bf_lo(unsigned w) { return __uint_as_float(w << 16); }
__device__ __forceinline__ float bf_hi(unsigned w) { return __uint_as_float(w & 0xffff0000u); }
__device__ __forceinline__ float wave_sum(float v) {
#pragma unroll
    for (int o = 1; o < 64; o <<= 1) v += __shfl_xor(v, o);
    return v;
}
__device__ __forceinline__ float sigmoidf_(float x) { return __builtin_amdgcn_rcpf(1.0f + __builtin_amdgcn_exp2f(-1.4426950408889634f * x)); }

namespace pg8 {
constexpr int BM = 256, BK = 64, HALF = 128, HTB = HALF * BK * 2, STAGE_BYTES = 8 * HTB, NXCD = 8, WGM = 8;
__host__ __device__ __forceinline__ int lds_byte(int r, int c) { const int st = (r >> 4) * 2 + (c >> 5), rr = r & 15, cc = c & 31, ob = rr * 64 + cc * 2; return st * 1024 + (ob ^ (((ob >> 9) & 1) << 5)); }
__host__ __device__ __forceinline__ void stage_rc(int b, int& R, int& C) { const int st = b / 1024, sb = b % 1024, swz = sb ^ (((sb >> 9) & 1) << 5); R = (st >> 1) * 16 + swz / 64; C = (st & 1) * 32 + (swz % 64) / 2; }
__host__ __device__ __forceinline__ int perm32(int rho) { const int n = rho >> 4, i = rho & 15; return 8 * (i >> 2) + 4 * n + (i & 3); }

struct Unit { int pm, pn, seg; };
struct Gemm { const bf16_t* A; const bf16_t* Bt; const bf16_t* A2; const bf16_t* Bt2; int M, N, K; };

struct StaticOrder {
    int nM, nN, nwg, G, c;
    __device__ void init(int M, int N, int G_, int c_) { nM = M / BM; nN = N / BM; nwg = nM * nN; G = G_; c = c_; }
    __device__ bool tile(long L, Unit& u) const {
        if (L >= nwg) return false;
        int wgid = (int)L; { const int q = nwg / NXCD, r = nwg % NXCD, xcd = wgid % NXCD, off = wgid / NXCD; wgid = (xcd < r ? xcd * (q + 1) : r * (q + 1) + (xcd - r) * q) + off; }
        const int nig = WGM * nN, gid = wgid / nig, fm = gid * WGM, gsz = (nM - fm) < WGM ? (nM - fm) : WGM;
        u.pm = fm + ((wgid % nig) % gsz); u.pn = (wgid % nig) / gsz; u.seg = 0; return true;
    }
    __device__ bool next(int i, Unit& u) const { return tile((long)i * G + c, u); }
};
struct PairOrder {
    StaticOrder s;
    __device__ bool next(int i, Unit& u) const { const bool ok = s.tile((long)(i >> 1) * s.G + s.c, u); u.seg = i & 1; return ok; }
};

struct EpiProj {
    static constexpr bool PERM = true, HAS_MID = false;
    unsigned char* ws;
    __device__ __forceinline__ void mid(f32x4 (&acc)[2][2][4][2], const Unit& u, int wr, int wc, int fr, int fq) const {}
    __device__ __forceinline__ void operator()(const f32x4 (&acc)[2][2][4][2], const Unit& u, int wr, int wc, int fr, int fq) const {
        const int pn = u.pn; size_t boff; int ld, ct;
        if (pn < 2) { boff = OFF_RQ; ld = 512; ct = pn; }
        else if (pn < 4) { boff = OFF_RK; ld = 512; ct = pn - 2; }
        else if (pn < 8) { boff = OFF_RV; ld = 1024; ct = pn - 4; }
        else if (pn < 12) { boff = OFF_RG; ld = 1024; ct = pn - 8; }
        else if (pn < 16) { boff = OFF_SQ; ld = 1024; ct = pn - 12; }
        else if (pn == 16) { boff = OFF_SK; ld = 256; ct = 0; }
        else if (pn == 17) { boff = OFF_SV; ld = 256; ct = 0; }
        else if (pn < 22) { boff = OFF_GR; ld = 1024; ct = pn - 18; }
        else { boff = OFF_GS; ld = 1024; ct = pn - 22; }
        bf16_t* base = (bf16_t*)(ws + boff);
        const int row0 = u.pm * BM + wr * 64 + fr, col0 = ct * 256 + wc * 32 + 8 * fq;
        if (pn >= 18) {
            unsigned char* gb = ws + boff;
            const int colw = ct * 256 + wc * 32 + ((fq & 1) ? HALF + 8 * (fq - 1) : 8 * fq);
#pragma unroll
            for (int ai = 0; ai < 2; ++ai)
#pragma unroll
                for (int m = 0; m < 4; ++m) {
                    unsigned w[2][2];
#pragma unroll
                    for (int bj = 0; bj < 2; ++bj) { const f32x4 v0 = acc[ai][bj][m][0], v1 = acc[ai][bj][m][1];
                        int w0 = __builtin_amdgcn_cvt_pk_fp8_f32(v0[0], v0[1], 0, false); w0 = __builtin_amdgcn_cvt_pk_fp8_f32(v0[2], v0[3], w0, true);
                        int w1 = __builtin_amdgcn_cvt_pk_fp8_f32(v1[0], v1[1], 0, false); w1 = __builtin_amdgcn_cvt_pk_fp8_f32(v1[2], v1[3], w1, true);
                        w[bj][0] = (unsigned)w0; w[bj][1] = (unsigned)w1; }
                    const u32x2 sx = __builtin_amdgcn_permlane16_swap(w[0][0], w[1][0], false, false), sy = __builtin_amdgcn_permlane16_swap(w[0][1], w[1][1], false, false);
                    *(u32x4*)(gb + (size_t)(row0 + ai * HALF + m * 16) * 1024 + colw) = (u32x4){sx.x, sy.x, sx.y, sy.y};
                }
            return;
        }
#pragma unroll
        for (int ai = 0; ai < 2; ++ai)
#pragma unroll
            for (int m = 0; m < 4; ++m) {
                bf16_t* rowp = base + (size_t)(row0 + ai * HALF + m * 16) * ld + col0;
#pragma unroll
                for (int bj = 0; bj < 2; ++bj) { const f32x4 v0 = acc[ai][bj][m][0], v1 = acc[ai][bj][m][1];
                    u32x4 w; w.x = cvt_pk_bf16_asm(v0[0], v0[1]); w.y = cvt_pk_bf16_asm(v0[2], v0[3]); w.z = cvt_pk_bf16_asm(v1[0], v1[1]); w.w = cvt_pk_bf16_asm(v1[2], v1[3]);
                    *(u32x4*)(rowp + bj * HALF) = w; } }
    }
};
struct EpiMerged {
    static constexpr bool PERM = true, HAS_MID = true;
    const unsigned char *GR, *GS; bf16_t* O;
#define F8(w, k) __builtin_amdgcn_cvt_f32_fp8((int)(w), (k))
    __device__ __forceinline__ void mid(f32x4 (&acc)[2][2][4][2], const Unit& u, int wr, int wc, int fr, int fq) const {
        const int row0 = u.pm * BM + wr * 64 + fr, colw = u.pn * BM + wc * 32 + ((fq & 1) ? HALF + 8 * (fq - 1) : 8 * fq);
#pragma unroll
        for (int ai = 0; ai < 2; ++ai)
#pragma unroll
            for (int m = 0; m < 4; ++m) { const size_t off = (size_t)(row0 + ai * HALF + m * 16) * DM + colw;
                const u32x4 ga = *(const u32x4*)(GR + off), gb = *(const u32x4*)(GS + off);
                const u32x2 ax = __builtin_amdgcn_permlane16_swap(ga.x, ga.z, false, false), ay = __builtin_amdgcn_permlane16_swap(ga.y, ga.w, false, false);
                const u32x2 bx = __builtin_amdgcn_permlane16_swap(gb.x, gb.z, false, false), by = __builtin_amdgcn_permlane16_swap(gb.y, gb.w, false, false);
#define MRG_R(ga_, gb_) ((1.0f + __builtin_amdgcn_exp2f(-1.4426950408889634f * (gb_))) * __builtin_amdgcn_rcpf(1.0f + __builtin_amdgcn_exp2f(-1.4426950408889634f * (ga_))))
#pragma unroll
                for (int bj = 0; bj < 2; ++bj) { const unsigned a0 = bj ? ax.y : ax.x, a1 = bj ? ay.y : ay.x, b0 = bj ? bx.y : bx.x, b1 = bj ? by.y : by.x;
                    f32x4 r0, r1;
                    r0[0] = MRG_R(F8(a0, 0), F8(b0, 0)); r0[1] = MRG_R(F8(a0, 1), F8(b0, 1)); r0[2] = MRG_R(F8(a0, 2), F8(b0, 2)); r0[3] = MRG_R(F8(a0, 3), F8(b0, 3));
                    r1[0] = MRG_R(F8(a1, 0), F8(b1, 0)); r1[1] = MRG_R(F8(a1, 1), F8(b1, 1)); r1[2] = MRG_R(F8(a1, 2), F8(b1, 2)); r1[3] = MRG_R(F8(a1, 3), F8(b1, 3));
                    acc[ai][bj][m][0] = acc[ai][bj][m][0] * r0; acc[ai][bj][m][1] = acc[ai][bj][m][1] * r1; }
#undef MRG_R
            }
    }
    __device__ __forceinline__ void operator()(const f32x4 (&acc)[2][2][4][2], const Unit& u, int wr, int wc, int fr, int fq) const {
        const int row0 = u.pm * BM + wr * 64 + fr, col0 = u.pn * BM + wc * 32 + 8 * fq, colw = u.pn * BM + wc * 32 + ((fq & 1) ? HALF + 8 * (fq - 1) : 8 * fq);
        u32x4 gbv[2][4];
#pragma unroll
        for (int ai = 0; ai < 2; ++ai)
#pragma unroll
            for (int m = 0; m < 4; ++m) gbv[ai][m] = *(const u32x4*)(GS + (size_t)(row0 + ai * HALF + m * 16) * DM + colw);
#pragma unroll
        for (int ai = 0; ai < 2; ++ai)
#pragma unroll
            for (int m = 0; m < 4; ++m) { const size_t rowoff = (size_t)(row0 + ai * HALF + m * 16) * DM;
                const u32x4 gb = gbv[ai][m];
                const u32x2 bx = __builtin_amdgcn_permlane16_swap(gb.x, gb.z, false, false), by = __builtin_amdgcn_permlane16_swap(gb.y, gb.w, false, false);
#pragma unroll
                for (int bj = 0; bj < 2; ++bj) { const unsigned b0 = bj ? bx.y : bx.x, b1 = bj ? by.y : by.x; const f32x4 v0 = acc[ai][bj][m][0], v1 = acc[ai][bj][m][1];
                    u32x4 w;
                    w.x = cvt_pk_bf16_asm(v0[0] * sigmoidf_(F8(b0, 0)), v0[1] * sigmoidf_(F8(b0, 1))); w.y = cvt_pk_bf16_asm(v0[2] * sigmoidf_(F8(b0, 2)), v0[3] * sigmoidf_(F8(b0, 3)));
                    w.z = cvt_pk_bf16_asm(v1[0] * sigmoidf_(F8(b1, 0)), v1[1] * sigmoidf_(F8(b1, 1))); w.w = cvt_pk_bf16_asm(v1[2] * sigmoidf_(F8(b1, 2)), v1[3] * sigmoidf_(F8(b1, 3)));
                    *(u32x4*)(O + rowoff + col0 + bj * HALF) = w; }
            }
    }
#undef F8
};
struct EpiRes {
    static constexpr bool PERM = true, HAS_MID = false;
    const float* res; float* out;
    __device__ __forceinline__ void mid(f32x4 (&acc)[2][2][4][2], const Unit& u, int wr, int wc, int fr, int fq) const {}
    __device__ __forceinline__ void operator()(const f32x4 (&acc)[2][2][4][2], const Unit& u, int wr, int wc, int fr, int fq) const {
        const int row0 = u.pm * BM + wr * 64 + fr, col0 = u.pn * BM + wc * 32 + 8 * fq;
#pragma unroll
        for (int ai = 0; ai < 2; ++ai)
#pragma unroll
            for (int m = 0; m < 4; ++m)
#pragma unroll
                for (int bj = 0; bj < 2; ++bj) { const size_t off = (size_t)(row0 + ai * HALF + m * 16) * DM + col0 + bj * HALF;
                    const f32x4 x0 = *(const f32x4*)(res + off), x1 = *(const f32x4*)(res + off + 4);
                    *(f32x4*)(out + off) = x0 + acc[ai][bj][m][0]; *(f32x4*)(out + off + 4) = x1 + acc[ai][bj][m][1]; }
    }
};
struct EpiResStat {
    static constexpr bool PERM = true, HAS_MID = false;
    const float* res; float* out; bf16_t* hb; float* ss;
    __device__ __forceinline__ void mid(f32x4 (&acc)[2][2][4][2], const Unit& u, int wr, int wc, int fr, int fq) const {}
    __device__ __forceinline__ void operator()(const f32x4 (&acc)[2][2][4][2], const Unit& u, int wr, int wc, int fr, int fq) const {
        const int row0 = u.pm * BM + wr * 64 + fr, col0 = u.pn * BM + wc * 32 + 8 * fq;
#pragma unroll
        for (int ai = 0; ai < 2; ++ai) {
          f32x4 xv[4][2][2];
#pragma unroll
          for (int m = 0; m < 4; ++m)
#pragma unroll
            for (int bj = 0; bj < 2; ++bj) { const size_t off = (size_t)(row0 + ai * HALF + m * 16) * DM + col0 + bj * HALF; xv[m][bj][0] = *(const f32x4*)(res + off); xv[m][bj][1] = *(const f32x4*)(res + off + 4); }
#pragma unroll
            for (int m = 0; m < 4; ++m) {
                float sq = 0.f;
#pragma unroll
                for (int bj = 0; bj < 2; ++bj) { const size_t off = (size_t)(row0 + ai * HALF + m * 16) * DM + col0 + bj * HALF;
                    const f32x4 h0 = xv[m][bj][0] + acc[ai][bj][m][0], h1 = xv[m][bj][1] + acc[ai][bj][m][1];
                    u32x4 w; w.x = cvt_pk_bf16_asm(h0[0], h0[1]); w.y = cvt_pk_bf16_asm(h0[2], h0[3]); w.z = cvt_pk_bf16_asm(h1[0], h1[1]); w.w = cvt_pk_bf16_asm(h1[2], h1[3]);
                    *(u32x4*)(hb + off) = w;
                    sq += (h0[0] * h0[0] + h0[1] * h0[1]) + (h0[2] * h0[2] + h0[3] * h0[3]) + (h1[0] * h1[0] + h1[1] * h1[1]) + (h1[2] * h1[2] + h1[3] * h1[3]); }
                sq += __shfl_xor(sq, 16); sq += __shfl_xor(sq, 32);
                if (fq == 0) atomicAdd(ss + row0 + ai * HALF + m * 16, sq);
            }
        }
    }
};
struct EpiResBf {
    static constexpr bool PERM = true, HAS_MID = false;
    const bf16_t* hb; float* out;
    __device__ __forceinline__ void mid(f32x4 (&acc)[2][2][4][2], const Unit& u, int wr, int wc, int fr, int fq) const {}
    __device__ __forceinline__ void operator()(const f32x4 (&acc)[2][2][4][2], const Unit& u, int wr, int wc, int fr, int fq) const {
        const int row0 = u.pm * BM + wr * 64 + fr, col0 = u.pn * BM + wc * 32 + 8 * fq;
#pragma unroll
        for (int ai = 0; ai < 2; ++ai) {
            u32x4 hv[4][2];
#pragma unroll
            for (int m = 0; m < 4; ++m)
#pragma unroll
                for (int bj = 0; bj < 2; ++bj) hv[m][bj] = *(const u32x4*)(hb + (size_t)(row0 + ai * HALF + m * 16) * DM + col0 + bj * HALF);
#pragma unroll
            for (int m = 0; m < 4; ++m)
#pragma unroll
                for (int bj = 0; bj < 2; ++bj) { const size_t off = (size_t)(row0 + ai * HALF + m * 16) * DM + col0 + bj * HALF;
                    const u32x4 h = hv[m][bj];
                    const f32x4 x0 = (f32x4){bf_lo(h.x), bf_hi(h.x), bf_lo(h.y), bf_hi(h.y)}, x1 = (f32x4){bf_lo(h.z), bf_hi(h.z), bf_lo(h.w), bf_hi(h.w)};
                    *(f32x4*)(out + off) = x0 + acc[ai][bj][m][0]; *(f32x4*)(out + off + 4) = x1 + acc[ai][bj][m][1]; }
        }
    }
};
struct EpiUp {
    static constexpr bool PERM = true, HAS_MID = false;
    bf16_t* O; const float* ss;
    __device__ __forceinline__ void mid(f32x4 (&acc)[2][2][4][2], const Unit& u, int wr, int wc, int fr, int fq) const {}
    __device__ __forceinline__ void operator()(const f32x4 (&acc)[2][2][4][2], const Unit& u, int wr, int wc, int fr, int fq) const {
        const int row0 = u.pm * BM + wr * 64 + fr, col0 = u.pn * BM + wc * 32 + 8 * fq;
        float ssv[2][4];
#pragma unroll
        for (int ai = 0; ai < 2; ++ai)
#pragma unroll
            for (int m = 0; m < 4; ++m) ssv[ai][m] = ss[row0 + ai * HALF + m * 16];
#pragma unroll
        for (int ai = 0; ai < 2; ++ai)
#pragma unroll
            for (int m = 0; m < 4; ++m) {
                const float rstd = __builtin_amdgcn_rsqf(ssv[ai][m] * (1.f / DM) + EPS);
#pragma unroll
                for (int bj = 0; bj < 2; ++bj) { const size_t off = (size_t)(row0 + ai * HALF + m * 16) * FF + col0 + bj * HALF;
                    f32x4 v0 = acc[ai][bj][m][0], v1 = acc[ai][bj][m][1];
#pragma unroll
                    for (int e = 0; e < 4; ++e) { const float a = fmaxf(v0[e] * rstd, 0.f), b = fmaxf(v1[e] * rstd, 0.f); v0[e] = a * a; v1[e] = b * b; }
                    u32x4 w; w.x = cvt_pk_bf16_asm(v0[0], v0[1]); w.y = cvt_pk_bf16_asm(v0[2], v0[3]); w.z = cvt_pk_bf16_asm(v1[0], v1[1]); w.w = cvt_pk_bf16_asm(v1[2], v1[3]);
                    *(u32x4*)(O + off) = w; }
            }
    }
};

template <class Epi, class Sched, bool ALIGN_EPI>
__device__ __forceinline__ void gemm_phase(LAS unsigned char* lds, const Gemm g, const Sched& S, const Epi& E) {
    int tid_ = threadIdx.x; asm volatile("" : "+v"(tid_));
    const int tid = tid_, wid = __builtin_amdgcn_readfirstlane(tid >> 6), lane = tid & 63, wr = wid >> 2, wc = wid & 3, fr = lane & 15, fq = lane >> 4;
    const int K = g.K, nt = K / BK;
    unsigned voffA[2], voffB[2];
#pragma unroll
    for (int i = 0; i < 2; ++i) { int R, C; stage_rc(tid * 16 + i * 8192, R, C); const int Rb = Epi::PERM ? ((R & ~31) + perm32(R & 31)) : R;
        voffA[i] = (unsigned)(R * K + C) * 2u; voffB[i] = (unsigned)(Rb * K + C) * 2u; }
    const size_t kstep = (size_t)(BK * 2);
    const size_t hstep = (size_t)HALF * K * 2;
    const size_t tstep = 2 * hstep;
    const unsigned ldsw = (unsigned)wid * 1024u;
    const int aoff = lds_byte(wr * 64 + fr, fq * 8), boff = lds_byte(wc * 32 + fr, fq * 8);
#define PG8_SA(b, h) (((b) * 2 + (h)) * HTB)
#define PG8_SB(b, h) ((4 + (b) * 2 + (h)) * HTB)
#define PG8_STAGE(bufoff, gbase, voff) do { _Pragma("unroll") for (int _i = 0; _i < 2; ++_i) \
        __builtin_amdgcn_global_load_lds((const unsigned*)((const char*)(gbase) + (voff)[_i]), (LAS unsigned*)(lds + (bufoff) + ldsw + _i * 8192), 16, 0, 0); } while (0)
#define PG8_LDA(dst, b, h) do { _Pragma("unroll") for (int m = 0; m < 4; ++m) _Pragma("unroll") for (int k = 0; k < 2; ++k) dst[m][k] = *(const LAS bf16x8*)(lds + PG8_SA(b, h) + aoff + m * 2048 + k * 1024); } while (0)
#define PG8_LDB(dst, b, h) do { _Pragma("unroll") for (int n = 0; n < 2; ++n) _Pragma("unroll") for (int k = 0; k < 2; ++k) dst[n][k] = *(const LAS bf16x8*)(lds + PG8_SB(b, h) + boff + n * 2048 + k * 1024); } while (0)
#define PG8_MMA(ai, bj, At, Bt) do { __builtin_amdgcn_s_setprio(1); _Pragma("unroll") for (int m = 0; m < 4; ++m) _Pragma("unroll") for (int n = 0; n < 2; ++n) _Pragma("unroll") for (int k = 0; k < 2; ++k) \
        acc[ai][bj][m][n] = __builtin_amdgcn_mfma_f32_16x16x32_bf16(Bt[n][k], At[m][k], acc[ai][bj][m][n], 0, 0, 0); __builtin_amdgcn_s_setprio(0); } while (0)
#define PG8_WAIT_V(n) asm volatile("s_waitcnt vmcnt(" #n ")" ::: "memory")
#define PG8_WAIT_L(n) asm volatile("s_waitcnt lgkmcnt(" #n ")" ::: "memory")
#define PG8_BAR __builtin_amdgcn_s_barrier()
#define PG8_SCHED __builtin_amdgcn_sched_barrier(0)
    Unit cur, nxt; int ui = 0;
    if (!S.next(0, cur)) return;
    f32x4 acc[2][2][4][2];
#pragma unroll
    for (int a = 0; a < 2; ++a)
#pragma unroll
        for (int b = 0; b < 2; ++b)
#pragma unroll
            for (int m = 0; m < 4; ++m)
#pragma unroll
                for (int n = 0; n < 2; ++n) acc[a][b][m][n] = (f32x4){0.f, 0.f, 0.f, 0.f};
    bf16x8 At[4][2], B0[2][2], B1[2][2];
    const char* cA = (const char*)(cur.seg ? g.A2 : g.A) + (size_t)cur.pm * tstep; const char* cB = (const char*)(cur.seg ? g.Bt2 : g.Bt) + (size_t)cur.pn * tstep;
    PG8_STAGE(PG8_SB(0, 0), cB, voffB); PG8_STAGE(PG8_SB(0, 1), cB + hstep, voffB); PG8_STAGE(PG8_SA(0, 0), cA, voffA); PG8_STAGE(PG8_SA(0, 1), cA + hstep, voffA);
    if (wr == 1) PG8_BAR;
    PG8_WAIT_V(2); PG8_BAR;
    PG8_STAGE(PG8_SB(1, 0), cB + kstep, voffB); PG8_STAGE(PG8_SA(1, 0), cA + kstep, voffA); PG8_STAGE(PG8_SB(1, 1), cB + hstep + kstep, voffB);
    PG8_WAIT_V(6); PG8_BAR;
    for (;;) {
        const bool has_next = S.next(ui + 1, nxt);
        const char* nA = has_next ? (const char*)(nxt.seg ? g.A2 : g.A) + (size_t)nxt.pm * tstep : cA; const char* nB = has_next ? (const char*)(nxt.seg ? g.Bt2 : g.Bt) + (size_t)nxt.pn * tstep : cB;
        for (int t = 0; t < nt; t += 2) {
            const bool last = (t == nt - 2);
            const char* a1 = cA + (size_t)(t + 1) * kstep;
            const char* a2 = last ? nA : cA + (size_t)(t + 2) * kstep; const char* b2 = last ? nB : cB + (size_t)(t + 2) * kstep;
            const char* a3 = a2 + kstep; const char* b3 = b2 + kstep;
            PG8_LDB(B0, 0, 0); PG8_LDB(B1, 0, 1); PG8_SCHED; PG8_LDA(At, 0, 0); PG8_STAGE(PG8_SA(1, 1), a1 + hstep, voffA);
            PG8_WAIT_V(8); PG8_WAIT_L(0); PG8_BAR; PG8_MMA(0, 0, At, B0); PG8_MMA(0, 1, At, B1); PG8_BAR; PG8_SCHED;
            PG8_LDA(At, 0, 1); PG8_STAGE(PG8_SB(0, 0), b2, voffB); PG8_STAGE(PG8_SB(0, 1), b2 + hstep, voffB); PG8_STAGE(PG8_SA(0, 0), a2, voffA);
            PG8_WAIT_V(8); PG8_WAIT_L(0); PG8_BAR; PG8_MMA(1, 0, At, B0); PG8_MMA(1, 1, At, B1); PG8_BAR; PG8_SCHED;
            PG8_LDB(B0, 1, 0); PG8_LDB(B1, 1, 1); PG8_SCHED; PG8_LDA(At, 1, 0); PG8_STAGE(PG8_SA(0, 1), a2 + hstep, voffA);
            PG8_WAIT_V(8); PG8_WAIT_L(0); PG8_BAR; PG8_MMA(0, 0, At, B0); PG8_MMA(0, 1, At, B1); PG8_BAR; PG8_SCHED;
            PG8_LDA(At, 1, 1); PG8_STAGE(PG8_SB(1, 0), b3, voffB); PG8_STAGE(PG8_SB(1, 1), b3 + hstep, voffB); PG8_STAGE(PG8_SA(1, 0), a3, voffA);
            PG8_WAIT_V(8); PG8_WAIT_L(0); PG8_BAR; PG8_MMA(1, 0, At, B0); PG8_MMA(1, 1, At, B1); PG8_BAR; PG8_SCHED;
        }
        if constexpr (ALIGN_EPI) { if (wr == 0) PG8_BAR; }
        bool keep = false;
        if constexpr (Epi::HAS_MID) keep = (cur.seg == 0);
        if (keep) E.mid(acc, cur, wr, wc, fr, fq); else E(acc, cur, wr, wc, fr, fq);
        if (!has_next) break;
        if (!keep) {
#pragma unroll
            for (int a = 0; a < 2; ++a)
#pragma unroll
                for (int b = 0; b < 2; ++b)
#pragma unroll
                    for (int m = 0; m < 4; ++m)
#pragma unroll
                        for (int n = 0; n < 2; ++n) acc[a][b][m][n] = (f32x4){0.f, 0.f, 0.f, 0.f};
        }
        cur = nxt; cA = nA; cB = nB; ++ui;
        if constexpr (ALIGN_EPI) { if (wr == 1) PG8_BAR; }
    }
    PG8_WAIT_V(0);
    if constexpr (!ALIGN_EPI) { if (wr == 0) PG8_BAR; }
    PG8_BAR;
#undef PG8_SA
#undef PG8_SB
#undef PG8_STAGE
#undef PG8_LDA
#undef PG8_LDB
#undef PG8_MMA
#undef PG8_WAIT_V
#undef PG8_WAIT_L
#undef PG8_BAR
#undef PG8_SCHED
}
}

struct Args {
    const float *x, *meta, *mix_g, *w_in, *ret_g, *q_g, *k_g, *sinks, *w_ret, *w_swa, *w_out, *mlp_g, *w_up, *w_down;
    float* out; unsigned char* ws;
};

__device__ __forceinline__ void p0_transpose_item(const float* W, int K, int N, bf16_t* WT, LAS float* scr, int item, int lane, const float* kgain = nullptr) {
    const int nblk = N / 32, kb = item / nblk, nb = item % nblk, k0 = 64 * kb, n0 = 32 * nb;
    f32x4 wv[8];
#pragma unroll
    for (int i = 0; i < 8; ++i) wv[i] = *(const f32x4*)(W + (size_t)(k0 + 8 * i + (lane >> 3)) * N + n0 + 4 * (lane & 7));
#pragma unroll
    for (int i = 0; i < 8; ++i) { const int kk = 8 * i + (lane >> 3); f32x4 v = wv[i]; if (kgain) v = v * kgain[k0 + kk];
        LAS float* d = scr + kk * 33 + 4 * (lane & 7); d[0] = v.x; d[1] = v.y; d[2] = v.z; d[3] = v.w; }
    asm volatile("s_waitcnt lgkmcnt(0)" ::: "memory");
    const int c = lane & 7;
#pragma unroll
    for (int j = 0; j < 4; ++j) { const int n = (lane >> 3) + 8 * j; const LAS float* s = scr + (8 * c) * 33 + n;
        u32x4 o; o.x = cvt_pk_bf16_asm(s[0 * 33], s[1 * 33]); o.y = cvt_pk_bf16_asm(s[2 * 33], s[3 * 33]); o.z = cvt_pk_bf16_asm(s[4 * 33], s[5 * 33]); o.w = cvt_pk_bf16_asm(s[6 * 33], s[7 * 33]);
        *(u32x4*)(WT + (size_t)(n0 + n) * K + k0 + 8 * c) = o; }
    asm volatile("s_waitcnt lgkmcnt(0)" ::: "memory");
}
__device__ __forceinline__ void rms_row_to_bf16(const float* xrow, const float* g, bf16_t* orow, int lane) {
    const f32x4* xr = (const f32x4*)xrow + lane; const f32x4* gr = (const f32x4*)g + lane;
    f32x4 v[4]; float s = 0.f;
#pragma unroll
    for (int j = 0; j < 4; ++j) { v[j] = xr[64 * j]; s += (v[j].x * v[j].x + v[j].y * v[j].y) + (v[j].z * v[j].z + v[j].w * v[j].w); }
    const float rstd = 1.f / sqrtf(wave_sum(s) * (1.f / DM) + EPS);
    u32x2* o8 = (u32x2*)orow + lane;
#pragma unroll
    for (int j = 0; j < 4; ++j) { const f32x4 gg = gr[64 * j]; u32x2 w; w.x = cvt_pk_bf16_asm(v[j].x * rstd * gg.x, v[j].y * rstd * gg.y); w.y = cvt_pk_bf16_asm(v[j].z * rstd * gg.z, v[j].w * rstd * gg.w); o8[64 * j] = w; }
}

__device__ __forceinline__ void tr_write8(LAS unsigned char* base, int RS, int col0, int pp, u32x4 r0, u32x4 r1) {
#define TRW(i, w0, w1) *(LAS unsigned*)(base + ((size_t)(col0 + (i)) * RS + 2 * pp) * 2) = ((i) & 1) ? (((w0) >> 16) | ((w1) & 0xffff0000u)) : (((w0) & 0xffffu) | ((w1) << 16))
    TRW(0, r0.x, r1.x); TRW(1, r0.x, r1.x); TRW(2, r0.y, r1.y); TRW(3, r0.y, r1.y); TRW(4, r0.z, r1.z); TRW(5, r0.z, r1.z); TRW(6, r0.w, r1.w); TRW(7, r0.w, r1.w);
#undef TRW
}

__device__ __forceinline__ int tr_off(int col, int RS, int slot) { return col * RS * 2 + ((slot ^ (2 * ((col >> 3) & 15))) << 3); }
__device__ __forceinline__ void tr_write8s(LAS unsigned char* base, int RS, int col0, int pp, u32x4 r0, u32x4 r1) {
    const int sw2 = 2 * ((col0 >> 3) & 15), po = (((pp >> 1) ^ sw2) << 3) + ((pp & 1) << 2);
#define TRW(i, w0, w1) *(LAS unsigned*)(base + (col0 + (i)) * RS * 2 + po) = ((i) & 1) ? (((w0) >> 16) | ((w1) & 0xffff0000u)) : (((w0) & 0xffffu) | ((w1) << 16))
    TRW(0, r0.x, r1.x); TRW(1, r0.x, r1.x); TRW(2, r0.y, r1.y); TRW(3, r0.y, r1.y); TRW(4, r0.z, r1.z); TRW(5, r0.z, r1.z); TRW(6, r0.w, r1.w); TRW(7, r0.w, r1.w);
#undef TRW
}
__device__ __forceinline__ u32x4 scale8(u32x4 r, float f) {
    u32x4 o; o.x = cvt_pk_bf16(bf_lo(r.x) * f, bf_hi(r.x) * f); o.y = cvt_pk_bf16(bf_lo(r.y) * f, bf_hi(r.y) * f); o.z = cvt_pk_bf16(bf_lo(r.z) * f, bf_hi(r.z) * f); o.w = cvt_pk_bf16(bf_lo(r.w) * f, bf_hi(r.w) * f); return o;
}
__device__ __forceinline__ bf16x8 as_frag(u32x4 v) { return __builtin_bit_cast(bf16x8, v); }
#define MFMA16(a, b, c) __builtin_amdgcn_mfma_f32_16x16x32_bf16((a), (b), (c), 0, 0, 0)

__device__ __forceinline__ long swa_key_row(int b, int c, int kk) {
    if (kk < 16) return (long)NTOK + kk;
    if (kk < 272) { const int s = (c - 1) * 128 + (kk - 16); if (s >= 128) return (long)b * SEQ + s - 128; }
    return -1;
}
__device__ __forceinline__ void swa_phase(LAS unsigned char* lds, const Args& p) {
    int tid_ = threadIdx.x; asm volatile("" : "+v"(tid_));
    const int tid = tid_, lane = tid & 63, w = __builtin_amdgcn_readfirstlane(tid >> 6), r = lane & 15, q = lane >> 4;
    const bf16_t* SQ = (const bf16_t*)(p.ws + OFF_SQ); const bf16_t* SK = (const bf16_t*)(p.ws + OFF_SK); const bf16_t* SV = (const bf16_t*)(p.ws + OFF_SV);
    bf16_t* YSWA = (bf16_t*)((unsigned char*)p.out + DOUT_YSWA);
    constexpr int KS = 72, VS = 296, K_OFF = 0, VT_OFF = 288 * KS * 2;
    constexpr float LOG2E = 1.4426950408889634f;
    const int kch = tid & 7, G = gridDim.x;
    const f32x4 kg0 = *(const f32x4*)(p.k_g + kch * 8), kg1 = *(const f32x4*)(p.k_g + kch * 8 + 4);
    u32x4 kraw[5], vraw[6];
    const f32x4 ga0 = *(const f32x4*)(p.q_g + 8 * q), ga1 = *(const f32x4*)(p.q_g + 8 * q + 4), gb0 = *(const f32x4*)(p.q_g + 32 + 8 * q), gb1 = *(const f32x4*)(p.q_g + 32 + 8 * q + 4);
#define SWA_LOAD_UNIT(uu) do { const int b_ = (uu) >> 8, c_ = 1 + (((uu) & 255) >> 2), kvh_ = (uu) & 3; \
        _Pragma("unroll") for (int it = 0; it < 5; ++it) { const int kk = (it * NTHREADS + tid) >> 3; const long row = swa_key_row(b_, c_, kk); \
            kraw[it] = (u32x4){0u, 0u, 0u, 0u}; if (row >= 0) kraw[it] = *(const u32x4*)(SK + (size_t)row * 256 + kvh_ * 64 + kch * 8); } \
        _Pragma("unroll") for (int it = 0; it < 3; ++it) { const int id = it * NTHREADS + tid, ch = id / 144, pp = id % 144; \
            _Pragma("unroll") for (int e = 0; e < 2; ++e) { const long row = (id < 1152) ? swa_key_row(b_, c_, 2 * pp + e) : -1; \
                vraw[2 * it + e] = (u32x4){0u, 0u, 0u, 0u}; if (row >= 0) vraw[2 * it + e] = *(const u32x4*)(SV + (size_t)row * 256 + kvh_ * 64 + ch * 8); } } } while (0)
    int u = blockIdx.x;
    if (u >= 1024) return;
    SWA_LOAD_UNIT(u);
    u32x4 qa, qb;
    { const size_t qr0 = (size_t)(u >> 8) * SEQ + (size_t)((u & 255) >> 2) * 128 + 16 * w + r; const int h0 = (u & 3) * 4;
      qa = *(const u32x4*)(SQ + qr0 * 1024 + h0 * 64 + 8 * q); qb = *(const u32x4*)(SQ + qr0 * 1024 + h0 * 64 + 32 + 8 * q); }
    for (; u < 1024; u += G) {
        const int b = u >> 8, c = 1 + ((u & 255) >> 2), kvh = u & 3;
        __syncthreads();
#pragma unroll
        for (int it = 0; it < 5; ++it) {
            const int kk = (it * NTHREADS + tid) >> 3; const u32x4 raw = kraw[it];
            const float f0 = bf_lo(raw.x), f1 = bf_hi(raw.x), f2 = bf_lo(raw.y), f3 = bf_hi(raw.y), f4 = bf_lo(raw.z), f5 = bf_hi(raw.z), f6 = bf_lo(raw.w), f7 = bf_hi(raw.w);
            float ss = (f0 * f0 + f1 * f1) + (f2 * f2 + f3 * f3) + (f4 * f4 + f5 * f5) + (f6 * f6 + f7 * f7);
            ss += __shfl_xor(ss, 1); ss += __shfl_xor(ss, 2); ss += __shfl_xor(ss, 4);
            const float rstd = __builtin_amdgcn_rsqf(ss * (1.f / 64.f) + EPS);
            u32x4 o; o.x = cvt_pk_bf16(f0 * rstd * kg0.x, f1 * rstd * kg0.y); o.y = cvt_pk_bf16(f2 * rstd * kg0.z, f3 * rstd * kg0.w);
            o.z = cvt_pk_bf16(f4 * rstd * kg1.x, f5 * rstd * kg1.y); o.w = cvt_pk_bf16(f6 * rstd * kg1.z, f7 * rstd * kg1.w);
            if (kk < 288) *(LAS u32x4*)(lds + K_OFF + (kk * KS + kch * 8) * 2) = o;
        }
#pragma unroll
        for (int it = 0; it < 3; ++it) { const int id = it * NTHREADS + tid; if (id < 1152) tr_write8(lds + VT_OFF, VS, (id / 144) * 8, id % 144, vraw[2 * it], vraw[2 * it + 1]); }
        __syncthreads();
        const int qt = w, iq = 16 * qt + r;
        const size_t qrow = (size_t)b * SEQ + (size_t)(c - 1) * 128 + iq;
        const int un = (u + G < 1024) ? u + G : u; const size_t qrow_n = (size_t)(un >> 8) * SEQ + (size_t)((un & 255) >> 2) * 128 + iq;
        SWA_LOAD_UNIT(un);
#pragma unroll 1
        for (int hl = 0; hl < 4; ++hl) {
            const int h = kvh * 4 + hl;
            bf16x8 Qf[2];
            {
                const u32x4 a = qa, bq = qb;
                const int hn = (hl == 3) ? (un & 3) * 4 : kvh * 4 + hl + 1; const size_t qr2 = (hl == 3) ? qrow_n : qrow;
                qa = *(const u32x4*)(SQ + qr2 * 1024 + hn * 64 + 8 * q); qb = *(const u32x4*)(SQ + qr2 * 1024 + hn * 64 + 32 + 8 * q);
                float fa[8] = {bf_lo(a.x), bf_hi(a.x), bf_lo(a.y), bf_hi(a.y), bf_lo(a.z), bf_hi(a.z), bf_lo(a.w), bf_hi(a.w)};
                float fb[8] = {bf_lo(bq.x), bf_hi(bq.x), bf_lo(bq.y), bf_hi(bq.y), bf_lo(bq.z), bf_hi(bq.z), bf_lo(bq.w), bf_hi(bq.w)};
                float ss = 0.f;
#pragma unroll
                for (int e = 0; e < 8; ++e) ss += fa[e] * fa[e] + fb[e] * fb[e];
                ss += __shfl_xor(ss, 16); ss += __shfl_xor(ss, 32);
                const float rs = (0.125f * LOG2E) * __builtin_amdgcn_rsqf(ss * (1.f / 64.f) + EPS);
                u32x4 oa, ob;
                oa.x = cvt_pk_bf16(fa[0] * rs * ga0.x, fa[1] * rs * ga0.y); oa.y = cvt_pk_bf16(fa[2] * rs * ga0.z, fa[3] * rs * ga0.w); oa.z = cvt_pk_bf16(fa[4] * rs * ga1.x, fa[5] * rs * ga1.y); oa.w = cvt_pk_bf16(fa[6] * rs * ga1.z, fa[7] * rs * ga1.w);
                ob.x = cvt_pk_bf16(fb[0] * rs * gb0.x, fb[1] * rs * gb0.y); ob.y = cvt_pk_bf16(fb[2] * rs * gb0.z, fb[3] * rs * gb0.w); ob.z = cvt_pk_bf16(fb[4] * rs * gb1.x, fb[5] * rs * gb1.y); ob.w = cvt_pk_bf16(fb[6] * rs * gb1.z, fb[7] * rs * gb1.w);
                Qf[0] = as_frag(oa); Qf[1] = as_frag(ob);
            }
            const float slope2 = exp2f(-0.5f * (float)(h + 1)) * LOG2E, sink2 = p.sinks[h] * LOG2E;
            const float bbase = -slope2 * (float)(144 + r - 4 * q), mbase = -slope2 * (float)(c * 128 + iq - 112 - 4 * q);
            const float sl1 = slope2, sl2 = 2.f * slope2, sl3 = 3.f * slope2;
            const int d0 = 144 + r - 4 * q;
            f32x4 sc[10]; float mx = -1e30f;
#pragma unroll
            for (int t = 0; t < 10; ++t) {
                const int kt = (t == 0) ? 0 : qt + t;
                f32x4 acc = (f32x4){0.f, 0.f, 0.f, 0.f};
#pragma unroll
                for (int ks = 0; ks < 2; ++ks) { const bf16x8 a = *(const LAS bf16x8*)(lds + K_OFF + ((16 * kt + r) * KS + 32 * ks + 8 * q) * 2); acc = MFMA16(a, Qf[ks], acc); }
                const float tb = (t == 0) ? mbase : bbase + slope2 * (float)(16 * t) + ((c == 1 && kt <= 8) ? -1e30f : 0.f);
                acc[0] += tb; acc[1] += tb + sl1; acc[2] += tb + sl2; acc[3] += tb + sl3;
                if (t == 1) {
#pragma unroll
                    for (int i = 0; i < 4; ++i) if (d0 - 16 - i >= 128) acc[i] = -1e30f;
                }
                if (t == 9) {
#pragma unroll
                    for (int i = 0; i < 4; ++i) if (d0 - 144 - i < 0) acc[i] = -1e30f;
                }
                mx = fmaxf(fmaxf(mx, fmaxf(acc[0], acc[1])), fmaxf(acc[2], acc[3]));
                sc[t] = acc;
                if (t == 4) __builtin_amdgcn_sched_barrier(0);
            }
            mx = fmaxf(mx, __shfl_xor(mx, 16)); mx = fmaxf(mx, __shfl_xor(mx, 32)); mx = fmaxf(mx, sink2);
            float sum = 0.f; u32x2 Pk[10];
#pragma unroll
            for (int t = 0; t < 10; ++t) { const float p0 = __builtin_amdgcn_exp2f(sc[t][0] - mx), p1 = __builtin_amdgcn_exp2f(sc[t][1] - mx), p2 = __builtin_amdgcn_exp2f(sc[t][2] - mx), p3 = __builtin_amdgcn_exp2f(sc[t][3] - mx);
                sum += (p0 + p1) + (p2 + p3); Pk[t].x = cvt_pk_bf16(p0, p1); Pk[t].y = cvt_pk_bf16(p2, p3); }
            sum += __shfl_xor(sum, 16); sum += __shfl_xor(sum, 32);
            const float inv = __builtin_amdgcn_rcpf(sum + __builtin_amdgcn_exp2f(sink2 - mx));
#pragma unroll 1
            for (int dtp = 0; dtp < 2; ++dtp) {
                u32x2 ov[2];
#pragma unroll
                for (int e = 0; e < 2; ++e) {
                    const int dt = 2 * dtp + e;
                    f32x4 acc = (f32x4){0.f, 0.f, 0.f, 0.f};
#pragma unroll
                    for (int pr = 0; pr < 5; ++pr) {
                        const int t0 = 2 * pr, t1 = 2 * pr + 1, kt0 = (t0 == 0) ? 0 : qt + t0, kt1 = qt + t1;
                        const LAS unsigned char* vp = lds + VT_OFF + ((16 * dt + r) * VS + 4 * q) * 2;
                        const u32x2 a0 = *(const LAS u32x2*)(vp + 32 * kt0), a1 = *(const LAS u32x2*)(vp + 32 * kt1);
                        const u32x4 a = (u32x4){a0.x, a0.y, a1.x, a1.y}, bb = (u32x4){Pk[t0].x, Pk[t0].y, Pk[t1].x, Pk[t1].y};
                        acc = MFMA16(as_frag(a), as_frag(bb), acc);
                    }
                    ov[e].x = cvt_pk_bf16(acc[0] * inv, acc[1] * inv); ov[e].y = cvt_pk_bf16(acc[2] * inv, acc[3] * inv);
                }
                const int dw = 32 * dtp + ((q & 1) ? 16 + 4 * (q - 1) : 4 * q);
                const u32x2 ox = __builtin_amdgcn_permlane16_swap(ov[0].x, ov[1].x, false, false), oy = __builtin_amdgcn_permlane16_swap(ov[0].y, ov[1].y, false, false);
                *(u32x4*)(YSWA + qrow * 1024 + h * 64 + dw) = (u32x4){ox.x, oy.x, ox.y, oy.y};
            }
        }
    }
#undef SWA_LOAD_UNIT
}

__device__ __forceinline__ size_t kvs_slot(int b, int n, int h) { return ((size_t)((b * 64 + n) * 4 + h)) * 32768; }
__device__ __forceinline__ void kvlocal_phase(LAS unsigned char* lds, const Args& p) {
    int tid_ = threadIdx.x; asm volatile("" : "+v"(tid_));
    const int tid = tid_, lane = tid & 63, w = __builtin_amdgcn_readfirstlane(tid >> 6), r = lane & 15, q = lane >> 4;
    const bf16_t* RK = (const bf16_t*)(p.ws + OFF_RK); const bf16_t* RV = (const bf16_t*)(p.ws + OFF_RV);
    bf16_t* KVS = (bf16_t*)((unsigned char*)p.out + DOUT_KVS);
    constexpr int RS = 136, KT_OFF = 0, VT_OFF = 128 * RS * 2;
    u32x4 kr[2][2], vr[4][2];
#define KV_LOAD_UNIT(uu) do { const int b_ = (uu) >> 8, n_ = ((uu) & 255) >> 2, h_ = (uu) & 3; \
        _Pragma("unroll") for (int it = 0; it < 2; ++it) { const int id = it * NTHREADS + tid, ch = id & 15, pr = id >> 4; \
            _Pragma("unroll") for (int e = 0; e < 2; ++e) { const int i = 2 * pr + e; long row; \
                if (n_ == 0) row = (i < 112) ? -1 : (long)NTOK + i - 112; else row = (long)b_ * SEQ + (n_ - 1) * 128 + i; \
                kr[it][e] = (u32x4){0u, 0u, 0u, 0u}; if (row >= 0) kr[it][e] = *(const u32x4*)(RK + (size_t)row * 512 + h_ * 128 + ch * 8); } } \
        _Pragma("unroll") for (int it = 0; it < 4; ++it) { const int id = it * NTHREADS + tid, ch = id & 31, pr = id >> 5; \
            _Pragma("unroll") for (int e = 0; e < 2; ++e) { const int i = 2 * pr + e; long row; \
                if (n_ == 0) row = (i < 112) ? -1 : (long)NTOK + i - 112; else row = (long)b_ * SEQ + (n_ - 1) * 128 + i; \
                vr[it][e] = (u32x4){0u, 0u, 0u, 0u}; if (row >= 0) vr[it][e] = *(const u32x4*)(RV + (size_t)row * 1024 + h_ * 256 + ch * 8); } } } while (0)
    int u = blockIdx.x;
    if (u >= 1024) return;
    const int G = gridDim.x;
    KV_LOAD_UNIT(u);
    for (; u < 1024; u += G) {
        const int b = u >> 8, n = (u & 255) >> 2, h = u & 3;
        const float lg2 = log2f(1.0f - exp2f(-5.0f - (float)h));
        __syncthreads();
#pragma unroll
        for (int it = 0; it < 2; ++it) { const int id = it * NTHREADS + tid, ch = id & 15, pr = id >> 4;
            const float f0 = 0.08838834764831845f * __builtin_amdgcn_exp2f(lg2 * (float)(127 - 2 * pr)), f1 = 0.08838834764831845f * __builtin_amdgcn_exp2f(lg2 * (float)(126 - 2 * pr));
            tr_write8s(lds + KT_OFF, RS, ch * 8, pr, scale8(kr[it][0], f0), scale8(kr[it][1], f1)); }
#pragma unroll
        for (int it = 0; it < 4; ++it) { const int id = it * NTHREADS + tid, ch = id & 31, pr = id >> 5;
            tr_write8s(lds + VT_OFF, RS, ch * 8, pr, vr[it][0], vr[it][1]); }
        __syncthreads();
        { const int un = (u + G < 1024) ? u + G : u; KV_LOAD_UNIT(un); }
        const int mt = w;
        bf16x8 a[4];
#pragma unroll
        for (int ks = 0; ks < 4; ++ks) a[ks] = *(const LAS bf16x8*)(lds + KT_OFF + tr_off(16 * mt + r, RS, 8 * ks + 2 * q));
        bf16_t* dst = KVS + kvs_slot(b, n, h);
#pragma unroll 2
        for (int ntp = 0; ntp < 8; ++ntp) {
            u32x2 ov[2];
#pragma unroll
            for (int e = 0; e < 2; ++e) {
                const int nt = 2 * ntp + e;
                f32x4 acc = (f32x4){0.f, 0.f, 0.f, 0.f};
#pragma unroll
                for (int ks = 0; ks < 4; ++ks) { const bf16x8 bb = *(const LAS bf16x8*)(lds + VT_OFF + tr_off(16 * nt + r, RS, 8 * ks + 2 * q)); acc = MFMA16(a[ks], bb, acc); }
                ov[e].x = cvt_pk_bf16(acc[0], acc[1]); ov[e].y = cvt_pk_bf16(acc[2], acc[3]);
            }
            const u32x2 ox = __builtin_amdgcn_permlane16_swap(ov[0].x, ov[1].x, false, false), oy = __builtin_amdgcn_permlane16_swap(ov[0].y, ov[1].y, false, false);
            const int row = 16 * (2 * ntp + (q & 1)) + r, dk0 = 16 * mt + 4 * (q & ~1);
            *(u32x4*)(dst + (size_t)row * 128 + dk0) = (u32x4){ox.x, oy.x, ox.y, oy.y};
        }
    }
#undef KV_LOAD_UNIT
}

__device__ __forceinline__ void scan_phase(const Args& p) {
    bf16_t* KVS = (bf16_t*)((unsigned char*)p.out + DOUT_KVS);
    if (threadIdx.x >= 256) return;
    for (int gid = blockIdx.x * 256 + threadIdx.x; gid < 16 * 4096; gid += gridDim.x * 256) {
        const int bh = gid >> 12, b = bh >> 2, h = bh & 3, off = (gid & 4095) * 8;
        const float dec = exp2f(128.0f * log2f(1.0f - exp2f(-5.0f - (float)h)));
        float s0 = 0.f, s1 = 0.f, s2 = 0.f, s3 = 0.f, s4 = 0.f, s5 = 0.f, s6 = 0.f, s7 = 0.f;
        bf16_t* base = KVS + kvs_slot(b, 0, h) + off;
        for (int n0 = 0; n0 < 64; n0 += 16) {
            u32x4 v[16];
#pragma unroll
            for (int j = 0; j < 16; ++j) v[j] = *(const u32x4*)(base + (size_t)(n0 + j) * 4 * 32768);
#pragma unroll
            for (int j = 0; j < 16; ++j) {
                s0 = dec * s0 + bf_lo(v[j].x); s1 = dec * s1 + bf_hi(v[j].x); s2 = dec * s2 + bf_lo(v[j].y); s3 = dec * s3 + bf_hi(v[j].y);
                s4 = dec * s4 + bf_lo(v[j].z); s5 = dec * s5 + bf_hi(v[j].z); s6 = dec * s6 + bf_lo(v[j].w); s7 = dec * s7 + bf_hi(v[j].w);
                u32x4 o; o.x = cvt_pk_bf16(s0, s1); o.y = cvt_pk_bf16(s2, s3); o.z = cvt_pk_bf16(s4, s5); o.w = cvt_pk_bf16(s6, s7);
                *(u32x4*)(base + (size_t)(n0 + j) * 4 * 32768) = o;
            }
        }
    }
}

__device__ __forceinline__ void retout_phase(LAS unsigned char* lds, const Args& p) {
    int tid_ = threadIdx.x; asm volatile("" : "+v"(tid_));
    const int tid = tid_, lane = tid & 63, w = __builtin_amdgcn_readfirstlane(tid >> 6), r = lane & 15, q = lane >> 4;
    const bf16_t* RQ = (const bf16_t*)(p.ws + OFF_RQ); const bf16_t* RK = (const bf16_t*)(p.ws + OFF_RK); const bf16_t* RV = (const bf16_t*)(p.ws + OFF_RV); const bf16_t* RG = (const bf16_t*)(p.ws + OFF_RG);
    const bf16_t* KVS = (const bf16_t*)((unsigned char*)p.out + DOUT_KVS);
    bf16_t* YRET = (bf16_t*)(p.ws + OFF_YRET);
    constexpr int RS = 136, K_OFF = 0, SB = 128 * RS * 2, QSZ = 64 * RS * 2;
    const int G = gridDim.x, vch = tid & 7, vpr = tid >> 3, srow = tid >> 4, sch = tid & 15;
    const LAS unsigned char* vlb = lds + SB + r * RS * 2 + ((q ^ (2 * (r >> 3))) << 3);
    u32x4 kreg[4], vreg[2], sreg[2], qn[4];
#define RO_LOAD_KQ(uu) do { const int b_ = (uu) >> 8, c_ = 1 + (((uu) & 255) >> 2), h_ = (uu) & 3; const size_t tb_ = (size_t)b_ * SEQ + (size_t)(c_ - 1) * 128; \
        _Pragma("unroll") for (int it = 0; it < 4; ++it) kreg[it] = *(const u32x4*)(RK + (tb_ + 32 * it + srow) * 512 + h_ * 128 + sch * 8); } while (0)
#define RO_LOAD_Q(uu) do { const int b_ = (uu) >> 8, c_ = 1 + (((uu) & 255) >> 2), h_ = (uu) & 3; const size_t tb_ = (size_t)b_ * SEQ + (size_t)(c_ - 1) * 128; \
        _Pragma("unroll") for (int ks = 0; ks < 4; ++ks) qn[ks] = *(const u32x4*)(RQ + (tb_ + 16 * w + r) * 512 + h_ * 128 + 32 * ks + 8 * q); } while (0)
#define RO_LOAD_STAGE(uu, sg) do { const int b_ = (uu) >> 8, c_ = 1 + (((uu) & 255) >> 2), h_ = (uu) & 3; const size_t tb_ = (size_t)b_ * SEQ + (size_t)(c_ - 1) * 128; \
        const bf16_t* st_ = KVS + kvs_slot(b_, c_ - 1, h_) + (size_t)(64 * (sg)) * 128; \
        vreg[0] = *(const u32x4*)(RV + (tb_ + 2 * vpr) * 1024 + h_ * 256 + 64 * (sg) + vch * 8); vreg[1] = *(const u32x4*)(RV + (tb_ + 2 * vpr + 1) * 1024 + h_ * 256 + 64 * (sg) + vch * 8); \
        sreg[0] = *(const u32x4*)(st_ + (size_t)srow * 128 + sch * 8); sreg[1] = *(const u32x4*)(st_ + (size_t)(32 + srow) * 128 + sch * 8); } while (0)
#define RO_WRITE_K() do { _Pragma("unroll") for (int it = 0; it < 4; ++it) *(LAS u32x4*)(lds + K_OFF + ((32 * it + srow) * RS + sch * 8) * 2) = kreg[it]; } while (0)
#define RO_WRITE_STAGE(j) do { tr_write8s(lds + SB + 2 * (j) * QSZ, RS, vch * 8, vpr, vreg[0], vreg[1]); \
        *(LAS u32x4*)(lds + SB + (2 * (j) + 1) * QSZ + (srow * RS + sch * 8) * 2) = sreg[0]; *(LAS u32x4*)(lds + SB + (2 * (j) + 1) * QSZ + ((32 + srow) * RS + sch * 8) * 2) = sreg[1]; } while (0)
    int u = blockIdx.x;
    if (u >= 1024) return;
    RO_LOAD_KQ(u); RO_LOAD_Q(u); RO_LOAD_STAGE(u, 0);
    __syncthreads();
    RO_WRITE_K(); RO_WRITE_STAGE(0);
    __syncthreads();
    int upar = 0;
    for (; u < 1024; u += G, upar ^= 1) {
        const int b = u >> 8, c = 1 + ((u & 255) >> 2), h = u & 3, un = (u + G < 1024) ? u + G : u;
        LAS unsigned char* xg = lds + SB + 4 * QSZ + upar * 1024;
        if (tid < 64) *(LAS f32x4*)(xg + tid * 16) = *(const f32x4*)(p.ret_g + h * 256 + 4 * tid);
        const size_t tokbase = (size_t)b * SEQ + (size_t)(c - 1) * 128;
        const float lg2 = log2f(1.0f - exp2f(-5.0f - (float)h));
        const int iq = 16 * w + r; const size_t qrow = tokbase + iq;
        bf16x8 Qd[4]; u32x2 Pk[8]; f32x4 o[16];
        {
#pragma unroll
            for (int kt = 0; kt < 8; ++kt) {
                {
                    f32x4 acc = (f32x4){0.f, 0.f, 0.f, 0.f};
#pragma unroll
                    for (int ks = 0; ks < 4; ++ks) { const bf16x8 a = *(const LAS bf16x8*)(lds + K_OFF + ((16 * kt + r) * RS + 32 * ks + 8 * q) * 2); acc = MFMA16(a, as_frag(qn[ks]), acc); }
#pragma unroll
                    for (int i = 0; i < 4; ++i) { const int d = iq - (16 * kt + 4 * q + i); acc[i] = (d >= 0) ? acc[i] * 0.08838834764831845f * __builtin_amdgcn_exp2f(lg2 * (float)d) : 0.f; }
                    Pk[kt].x = cvt_pk_bf16(acc[0], acc[1]); Pk[kt].y = cvt_pk_bf16(acc[2], acc[3]);
                }
                if (kt & 1) __builtin_amdgcn_sched_barrier(0);
            }
            const float qdec = __builtin_amdgcn_exp2f(lg2 * (float)(iq + 1));
#pragma unroll
            for (int ks = 0; ks < 4; ++ks) Qd[ks] = as_frag(scale8(qn[ks], qdec));
        }
#pragma unroll
        for (int sg = 0; sg < 4; ++sg) {
            if (sg < 3) RO_LOAD_STAGE(u, sg + 1); else { RO_LOAD_KQ(un); RO_LOAD_STAGE(un, 0); }
            const int bo = 2 * (sg & 1) * QSZ;
#pragma unroll
            for (int j = 0; j < 4; ++j) {
                f32x4 acc = (f32x4){0.f, 0.f, 0.f, 0.f};
#pragma unroll
                for (int ks = 0; ks < 4; ++ks) { const bf16x8 a = *(const LAS bf16x8*)(lds + SB + bo + QSZ + ((16 * j + r) * RS + 32 * ks + 8 * q) * 2); acc = MFMA16(a, Qd[ks], acc); }
#pragma unroll
                for (int kp = 0; kp < 4; ++kp) {
                    {
                        const u32x2 a0 = *(const LAS u32x2*)(vlb + bo + 16 * j * RS * 2 + ((((kp ^ (j >> 1)) << 3) | ((0 ^ (j & 1)) << 2)) << 3));
                        const u32x2 a1 = *(const LAS u32x2*)(vlb + bo + 16 * j * RS * 2 + ((((kp ^ (j >> 1)) << 3) | ((1 ^ (j & 1)) << 2)) << 3));
                        const u32x4 a = (u32x4){a0.x, a0.y, a1.x, a1.y}, bb = (u32x4){Pk[2 * kp].x, Pk[2 * kp].y, Pk[2 * kp + 1].x, Pk[2 * kp + 1].y};
                        acc = MFMA16(as_frag(a), as_frag(bb), acc);
                    }
                }
                o[sg * 4 + j] = acc;
                if (j & 1) __builtin_amdgcn_sched_barrier(0);
            }
            if (sg == 3) RO_WRITE_K();
            RO_WRITE_STAGE((sg + 1) & 1);
            __syncthreads();
        }
        RO_LOAD_Q(un);
        float ss = 0.f;
#pragma unroll
        for (int t = 0; t < 16; ++t) ss += (o[t][0] * o[t][0] + o[t][1] * o[t][1]) + (o[t][2] * o[t][2] + o[t][3] * o[t][3]);
        ss += __shfl_xor(ss, 16); ss += __shfl_xor(ss, 32);
        const float rstd = 1.f / sqrtf(ss * (1.f / 256.f) + EPS);
        const int qodd = q & 1;
        u32x4 gwv[8];
#pragma unroll
        for (int tp = 0; tp < 8; ++tp) gwv[tp] = *(const u32x4*)(RG + qrow * 1024 + h * 256 + 32 * tp + (qodd ? 16 + 4 * (q - 1) : 4 * q));
#pragma unroll
        for (int tp = 0; tp < 8; ++tp) {
            const int t0 = 2 * tp, t1 = 2 * tp + 1;
            const int dvw = 32 * tp + (qodd ? 16 + 4 * (q - 1) : 4 * q);
            const u32x4 gw = gwv[tp];
            const u32x2 sx = __builtin_amdgcn_permlane16_swap(gw.x, gw.z, false, false), sy = __builtin_amdgcn_permlane16_swap(gw.y, gw.w, false, false);
            const f32x4 g0 = *(const LAS f32x4*)(xg + (16 * t0 + 4 * q) * 4), g1 = *(const LAS f32x4*)(xg + (16 * t1 + 4 * q) * 4);
            u32x2 ov0, ov1;
            { const float x0 = bf_lo(sx.x), x1 = bf_hi(sx.x), x2 = bf_lo(sy.x), x3 = bf_hi(sy.x);
              ov0.x = cvt_pk_bf16(o[t0][0] * rstd * g0.x * x0 * sigmoidf_(x0), o[t0][1] * rstd * g0.y * x1 * sigmoidf_(x1));
              ov0.y = cvt_pk_bf16(o[t0][2] * rstd * g0.z * x2 * sigmoidf_(x2), o[t0][3] * rstd * g0.w * x3 * sigmoidf_(x3)); }
            { const float x0 = bf_lo(sx.y), x1 = bf_hi(sx.y), x2 = bf_lo(sy.y), x3 = bf_hi(sy.y);
              ov1.x = cvt_pk_bf16(o[t1][0] * rstd * g1.x * x0 * sigmoidf_(x0), o[t1][1] * rstd * g1.y * x1 * sigmoidf_(x1));
              ov1.y = cvt_pk_bf16(o[t1][2] * rstd * g1.z * x2 * sigmoidf_(x2), o[t1][3] * rstd * g1.w * x3 * sigmoidf_(x3)); }
            const u32x2 ox = __builtin_amdgcn_permlane16_swap(ov0.x, ov1.x, false, false), oy = __builtin_amdgcn_permlane16_swap(ov0.y, ov1.y, false, false);
            *(u32x4*)(YRET + qrow * 1024 + h * 256 + dvw) = (u32x4){ox.x, oy.x, ox.y, oy.y};
        }
    }
#undef RO_LOAD_KQ
#undef RO_LOAD_Q
#undef RO_LOAD_STAGE
#undef RO_WRITE_K
#undef RO_WRITE_STAGE
}

__device__ __forceinline__ void meta_proj(const Args& p, const bf16_t* XN, const bf16_t* WinT) {
    int tid_ = threadIdx.x; asm volatile("" : "+v"(tid_));
    const int tid = tid_, lane = tid & 63, r = lane & 15, q = lane >> 4;
    const bool g256 = (gridDim.x == 256);
    const int wv = tid >> 6, jg = (int)(((blockIdx.x >> 5) << 3) | (blockIdx.x & 7u));
    if (g256 ? (((blockIdx.x >> 3) & 3u) != 0u || wv >= 2) : (wv != 0)) return;
    for (int t = g256 ? jg * 2 + wv : (int)blockIdx.x; t < 128; t += (g256 ? 128 : (int)gridDim.x)) {
        int ncol, ld, cl; size_t boff;
        if (t < 32) { ncol = 512 + 16 * t; boff = OFF_RK; ld = 512; cl = 16 * t; }
        else if (t < 96) { ncol = 1024 + 16 * (t - 32); boff = OFF_RV; ld = 1024; cl = 16 * (t - 32); }
        else if (t < 112) { ncol = 4096 + 16 * (t - 96); boff = OFF_SK; ld = 256; cl = 16 * (t - 96); }
        else { ncol = 4352 + 16 * (t - 112); boff = OFF_SV; ld = 256; cl = 16 * (t - 112); }
        const bf16_t* ap = WinT + (size_t)(ncol + r) * DM + 8 * q; const bf16_t* bp = XN + (size_t)(NTOK + r) * DM + 8 * q;
        f32x4 acc = (f32x4){0.f, 0.f, 0.f, 0.f};
#pragma unroll 8
        for (int ks = 0; ks < 32; ++ks) { const u32x4 a = *(const u32x4*)(ap + 32 * ks), b = *(const u32x4*)(bp + 32 * ks); acc = MFMA16(as_frag(a), as_frag(b), acc); }
        u32x2 o; o.x = cvt_pk_bf16(acc[0], acc[1]); o.y = cvt_pk_bf16(acc[2], acc[3]);
        *(u32x2*)((bf16_t*)(p.ws + boff) + (size_t)(NTOK + r) * ld + cl + 4 * q) = o;
    }
}

#define XB_TMO      128
#define XB_XCNT(j)  (256  + 64 * (j))
#define XB_XSUB(j)  (1280 + 64 * (j))
#define XB_XGEN(j)  (2304 + 64 * (j))
#define XB_TOP      3328
#define XB_TOPGEN   3392
#define XCD_BAR_WORDS 3456
#define XB_SPIN_CAP (1u << 22)
__device__ __forceinline__ unsigned xb_ld(unsigned* p)              { return __hip_atomic_load(p, __ATOMIC_RELAXED, __HIP_MEMORY_SCOPE_AGENT); }
__device__ __forceinline__ unsigned xb_add(unsigned* p, unsigned v) { return __hip_atomic_fetch_add(p, v, __ATOMIC_RELAXED, __HIP_MEMORY_SCOPE_AGENT); }
__device__ __forceinline__ unsigned xb_xcc_id() { return (unsigned)__builtin_amdgcn_s_getreg((3 << 11) | 20) & 0xFu; }
#define XB_SPIN(cond, bar) do { unsigned _sp = 0; while (cond) { __builtin_amdgcn_s_sleep(1); \
    if ((++_sp & 255u) == 0u) { if (xb_ld(&(bar)[XB_TMO])) break; if (_sp > XB_SPIN_CAP) { atomicAdd(&(bar)[XB_TMO], 1u); break; } } } } while (0)
struct XcdBarrier { unsigned* bar; unsigned x; volatile LAS unsigned* st; };
__device__ __forceinline__ XcdBarrier xcd_barrier_post(unsigned* bar, volatile LAS unsigned* st) {
    XcdBarrier b; b.bar = bar; b.x = xb_xcc_id(); b.st = st;
    if (threadIdx.x == 0) (void)xb_add(&bar[XB_XCNT(b.x)], 1u);
    return b;
}
__device__ __forceinline__ void xcd_barrier_complete(unsigned* bar, unsigned x, unsigned& nloc, unsigned& nx) {
    const unsigned G = gridDim.x * gridDim.y * gridDim.z;
    unsigned sum, cnt, mine, sp = 0u;
    for (;;) {
        sum = 0u; cnt = 0u; mine = 0u;
#pragma unroll
        for (unsigned j = 0; j < 16; ++j) { const unsigned c = xb_ld(&bar[XB_XCNT(j)]); sum += c; cnt += (c > 0u) ? 1u : 0u; mine = (j == x) ? c : mine; }
        if (sum == G) break;
        __builtin_amdgcn_s_sleep(1);
        if ((++sp & 255u) == 0u) { if (xb_ld(&bar[XB_TMO])) break; if (sp > XB_SPIN_CAP) { atomicAdd(&bar[XB_TMO], 1u); break; } }
    }
    nloc = mine > 0u ? mine : 1u; nx = cnt > 0u ? cnt : 1u;
}
__device__ __forceinline__ void xcd_barrier(const XcdBarrier& b) {
    asm volatile("s_waitcnt vmcnt(0)" ::: "memory");
    __syncthreads();
    if (threadIdx.x == 0) {
        unsigned* bar = b.bar;
        __builtin_amdgcn_s_waitcnt(0);
        unsigned nloc = b.st[0], nx = b.st[1];
        if (nloc == 0u) { xcd_barrier_complete(bar, b.x, nloc, nx); b.st[0] = nloc; b.st[1] = nx; }
        const unsigned old = xb_add(&bar[XB_XSUB(b.x)], 1u);
        const unsigned gen = old / nloc;
        if (old + 1u == (gen + 1u) * nloc) {
            __builtin_amdgcn_fence(__ATOMIC_RELEASE, "agent");
            asm volatile("s_waitcnt vmcnt(0)" ::: "memory");
            const unsigned og = xb_add(&bar[XB_TOP], 1u);
            const unsigned tg = og / nx;
            if (og + 1u == (tg + 1u) * nx) xb_add(&bar[XB_TOPGEN], 1u);
            else XB_SPIN(xb_ld(&bar[XB_TOPGEN]) == tg, bar);
            __builtin_amdgcn_fence(__ATOMIC_ACQUIRE, "agent");
            xb_add(&bar[XB_XGEN(b.x)], 1u);
            asm volatile("s_waitcnt vmcnt(0)" ::: "memory");
        } else {
            XB_SPIN(xb_ld(&bar[XB_XGEN(b.x)]) == gen, bar);
            __builtin_amdgcn_fence(__ATOMIC_ACQUIRE, "agent");
            asm volatile("s_waitcnt vmcnt(0)" ::: "memory");
        }
    }
    __syncthreads();
}

__device__ __forceinline__ void convert_slot(const Args& p, LAS unsigned char* lds, const int list) {
    const unsigned grp = (blockIdx.x >> 3) & 3u;
    if (grp == 0u) return;
    int tid_ = threadIdx.x; asm volatile("" : "+v"(tid_));
    const int tid = tid_, lane = tid & 63, wave = __builtin_amdgcn_readfirstlane(tid >> 6);
    constexpr int I_SQ = (DM / 64) * (DM / 32), I_UP = (DM / 64) * (FF / 32), I_DN = (FF / 64) * (DM / 32);
    const int total = list == 0 ? 3 * I_SQ + I_UP : I_DN;
    const int lo = grp == 1u ? 0 : (grp == 2u ? total / 6 : total / 2), hi = grp == 1u ? total / 6 : (grp == 2u ? total / 2 : total);
    const int j = (int)(((blockIdx.x >> 5) << 3) | (blockIdx.x & 7u));
    LAS float* scr = (LAS float*)(lds + wave * 16384);
    unsigned char* ws = p.ws;
    for (int it = lo + j * 8 + wave; it < hi; it += 512) {
        if (list == 0) {
            int r = it;
            if (r < I_SQ) { p0_transpose_item(p.w_ret, DM, DM, (bf16_t*)(ws + OFF_WRET), scr, r, lane); continue; } r -= I_SQ;
            if (r < I_SQ) { p0_transpose_item(p.w_swa, DM, DM, (bf16_t*)(ws + OFF_WSWA), scr, r, lane); continue; } r -= I_SQ;
            if (r < I_SQ) { p0_transpose_item(p.w_out, DM, DM, (bf16_t*)(ws + OFF_WOUT), scr, r, lane); continue; } r -= I_SQ;
            p0_transpose_item(p.w_up, DM, FF, (bf16_t*)(ws + OFF_WUP), scr, r, lane, p.mlp_g);
        } else p0_transpose_item(p.w_down, FF, DM, (bf16_t*)(ws + OFF_WDN), scr, it, lane);
    }
    __syncthreads();
}

__global__ void __launch_bounds__(NTHREADS, 2) fwd_megakernel(Args p) {
    extern __shared__ __attribute__((aligned(16))) unsigned char lds_raw[];
    LAS unsigned char* lds = (LAS unsigned char*)lds_raw;
    cg::grid_group grid = cg::this_grid();
    ((LAS unsigned*)(lds + 131072 + 64))[threadIdx.x & 15] = 0u;
    __syncthreads();
    XcdBarrier xbar = xcd_barrier_post((unsigned*)(p.ws + OFF_CTL), (volatile LAS unsigned*)(lds + 131072 + 64));
    grid.sync();
#define GRID_SYNC() xcd_barrier(xbar)
    const int tid = threadIdx.x, lane = tid & 63, wave = __builtin_amdgcn_readfirstlane(tid >> 6);
    const int G = gridDim.x, gw = blockIdx.x * 8 + wave, NGW = G * 8;
    unsigned char* ws = p.ws;
    bf16_t* WinT = (bf16_t*)(ws + OFF_WIN); bf16_t* WretT = (bf16_t*)(ws + OFF_WRET); bf16_t* WswaT = (bf16_t*)(ws + OFF_WSWA); bf16_t* WoutT = (bf16_t*)(ws + OFF_WOUT);
    bf16_t* WupT = (bf16_t*)(ws + OFF_WUP); bf16_t* WdnT = (bf16_t*)(ws + OFF_WDN);
    bf16_t* XN = (bf16_t*)p.out;

    for (int rep = 0; rep < 1 + ((REP_MASK >> 0) & 1); ++rep) {
        LAS float* scr = (LAS float*)(lds + wave * 16384);
        constexpr int I_IN = (DM / 64) * (DIN / 32), I_SQ = (DM / 64) * (DM / 32), I_UP = (DM / 64) * (FF / 32), I_DN = (FF / 64) * (DM / 32);
        constexpr int NITEMS = I_IN + 3 * I_SQ + I_UP + I_DN;
        const bool split = (G == 256);
        for (int it = gw; it < (split ? I_IN : NITEMS); it += NGW) {
            int r = it;
            if (r < I_IN) { p0_transpose_item(p.w_in, DM, DIN, WinT, scr, r, lane); continue; } r -= I_IN;
            if (r < I_SQ) { p0_transpose_item(p.w_ret, DM, DM, WretT, scr, r, lane); continue; } r -= I_SQ;
            if (r < I_SQ) { p0_transpose_item(p.w_swa, DM, DM, WswaT, scr, r, lane); continue; } r -= I_SQ;
            if (r < I_SQ) { p0_transpose_item(p.w_out, DM, DM, WoutT, scr, r, lane); continue; } r -= I_SQ;
            if (r < I_UP) { p0_transpose_item(p.w_up, DM, FF, WupT, scr, r, lane, p.mlp_g); continue; } r -= I_UP;
            p0_transpose_item(p.w_down, FF, DM, WdnT, scr, r, lane);
        }
        for (int m = gw; m < NTOK; m += 2 * NGW) {
            const int m2 = m + NGW;
            const f32x4* xa = (const f32x4*)(p.x + (size_t)m * DM) + 2 * lane; const f32x4* xb = (const f32x4*)(p.x + (size_t)(m2 < NTOK ? m2 : m) * DM) + 2 * lane; const f32x4* gr = (const f32x4*)p.mix_g + 2 * lane;
            f32x4 va[4], vb[4]; float sa = 0.f, sb = 0.f;
#pragma unroll
            for (int j = 0; j < 4; ++j) { va[j] = xa[(j & 1) + 128 * (j >> 1)]; vb[j] = xb[(j & 1) + 128 * (j >> 1)]; }
#pragma unroll
            for (int j = 0; j < 4; ++j) { sa += (va[j].x * va[j].x + va[j].y * va[j].y) + (va[j].z * va[j].z + va[j].w * va[j].w); sb += (vb[j].x * vb[j].x + vb[j].y * vb[j].y) + (vb[j].z * vb[j].z + vb[j].w * vb[j].w); }
            const float ra = 1.f / sqrtf(wave_sum(sa) * (1.f / DM) + EPS), rb = 1.f / sqrtf(wave_sum(sb) * (1.f / DM) + EPS);
            u32x4* oa = (u32x4*)(XN + (size_t)m * DM) + lane; u32x4* ob = (u32x4*)(XN + (size_t)m2 * DM) + lane;
#pragma unroll
            for (int jj = 0; jj < 2; ++jj) { const f32x4 g0 = gr[128 * jj], g1 = gr[128 * jj + 1]; const f32x4 a0 = va[2 * jj], a1 = va[2 * jj + 1], b0 = vb[2 * jj], b1 = vb[2 * jj + 1];
                u32x4 wa; wa.x = cvt_pk_bf16_asm(a0.x * ra * g0.x, a0.y * ra * g0.y); wa.y = cvt_pk_bf16_asm(a0.z * ra * g0.z, a0.w * ra * g0.w); wa.z = cvt_pk_bf16_asm(a1.x * ra * g1.x, a1.y * ra * g1.y); wa.w = cvt_pk_bf16_asm(a1.z * ra * g1.z, a1.w * ra * g1.w);
                oa[64 * jj] = wa;
                if (m2 < NTOK) { u32x4 wb; wb.x = cvt_pk_bf16_asm(b0.x * rb * g0.x, b0.y * rb * g0.y); wb.y = cvt_pk_bf16_asm(b0.z * rb * g0.z, b0.w * rb * g0.w); wb.z = cvt_pk_bf16_asm(b1.x * rb * g1.x, b1.y * rb * g1.y); wb.w = cvt_pk_bf16_asm(b1.z * rb * g1.z, b1.w * rb * g1.w);
                    ob[64 * jj] = wb; } }
        }
        if (gw < NMETA) rms_row_to_bf16(p.meta + (size_t)gw * DM, p.mix_g, XN + (size_t)(NTOK + gw) * DM, lane);
    }
    GRID_SYNC();
    {
        meta_proj(p, XN, WinT);
        if (G == 256) convert_slot(p, lds, 0);
        pg8::Gemm g{XN, WinT, XN, WinT, NTOK, DIN, DM}; pg8::StaticOrder S; S.init(NTOK, DIN, G, (int)blockIdx.x);
        pg8::EpiProj E{ws};
        pg8::gemm_phase<pg8::EpiProj, pg8::StaticOrder, true>(lds, g, S, E);
    }
    GRID_SYNC();
    for (int rep = 0; rep < 1 + ((REP_MASK >> 1) & 1); ++rep) { swa_phase(lds, p); kvlocal_phase(lds, p); }
    GRID_SYNC();
    scan_phase(p);
    GRID_SYNC();
    for (int rep = 0; rep < 1 + ((REP_MASK >> 2) & 1); ++rep) retout_phase(lds, p);
    GRID_SYNC();
    {
        const bf16_t* YRET = (const bf16_t*)(ws + OFF_YRET); const bf16_t* YSWA = (const bf16_t*)((unsigned char*)p.out + DOUT_YSWA);
        pg8::Gemm g{YRET, WretT, YSWA, WswaT, NTOK, DM, DM}; pg8::PairOrder S; S.s.init(NTOK, DM, G, (int)blockIdx.x);
        pg8::EpiMerged E{(const unsigned char*)(ws + OFF_GR), (const unsigned char*)(ws + OFF_GS), (bf16_t*)(ws + OFF_MERGED)};
        pg8::gemm_phase<pg8::EpiMerged, pg8::PairOrder, true>(lds, g, S, E);
    }
    GRID_SYNC();
    {
        const bf16_t* MG = (const bf16_t*)(ws + OFF_MERGED);
        pg8::Gemm g{MG, WoutT, MG, WoutT, NTOK, DM, DM}; pg8::StaticOrder S; S.init(NTOK, DM, G, (int)blockIdx.x);
        pg8::EpiResStat E{p.x, p.out, (bf16_t*)(ws + OFF_HN2), (float*)(ws + OFF_SS)};
        pg8::gemm_phase<pg8::EpiResStat, pg8::StaticOrder, true>(lds, g, S, E);
    }
    GRID_SYNC();
    {
        const bf16_t* HN2 = (const bf16_t*)(ws + OFF_HN2);
        pg8::Gemm g{HN2, WupT, HN2, WupT, NTOK, FF, DM}; pg8::StaticOrder S; S.init(NTOK, FF, G, (int)blockIdx.x);
        pg8::EpiUp E{(bf16_t*)(ws + OFF_U), (const float*)(ws + OFF_SS)};
        if (G == 256) convert_slot(p, lds, 1);
        pg8::gemm_phase<pg8::EpiUp, pg8::StaticOrder, true>(lds, g, S, E);
    }
    GRID_SYNC();
    {
        const bf16_t* U = (const bf16_t*)(ws + OFF_U);
        pg8::Gemm g{U, WdnT, U, WdnT, NTOK, DM, FF}; pg8::StaticOrder S; S.init(NTOK, DM, G, (int)blockIdx.x);
        pg8::EpiResBf E{(const bf16_t*)(ws + OFF_HN2), p.out};
        pg8::gemm_phase<pg8::EpiResBf, pg8::StaticOrder, true>(lds, g, S, E);
    }
}

extern "C" void kernel_launch(void* const* d_in, const int* in_sizes, int n_in, void* d_out, int out_size, void* d_ws, size_t ws_size, hipStream_t stream) {
    static int grid = 0;
    if (grid == 0) {
        if (n_in != 14 || in_sizes[0] != NTOK * DM || out_size != NTOK * DM || ws_size < WS_NEED) {
            fprintf(stderr, "kernel_launch: unexpected shapes (n_in %d, in0 %d, out %d, ws %zu, need %zu); nothing launched\n", n_in, n_in > 0 ? in_sizes[0] : -1, out_size, ws_size, (size_t)WS_NEED); grid = -1; return; }
        int dev = 0, cus = 0, per_cu = 0;
        (void)hipGetDevice(&dev); (void)hipDeviceGetAttribute(&cus, hipDeviceAttributeMultiprocessorCount, dev);
        if (hipFuncSetAttribute((const void*)fwd_megakernel, hipFuncAttributeMaxDynamicSharedMemorySize, LDS_BYTES) != hipSuccess) { fprintf(stderr, "kernel_launch: hipFuncSetAttribute failed\n"); grid = -1; return; }
        if (hipOccupancyMaxActiveBlocksPerMultiprocessor(&per_cu, (const void*)fwd_megakernel, NTHREADS, LDS_BYTES) != hipSuccess || per_cu < 1) { fprintf(stderr, "kernel_launch: occupancy query gave %d\n", per_cu); per_cu = 1; }
        (void)hipGetLastError();
        grid = cus * per_cu;
    }
    if (grid < 0) return;
    Args a{};
    a.x = (const float*)d_in[0]; a.meta = (const float*)d_in[1]; a.mix_g = (const float*)d_in[2]; a.w_in = (const float*)d_in[3]; a.ret_g = (const float*)d_in[4];
    a.q_g = (const float*)d_in[5]; a.k_g = (const float*)d_in[6]; a.sinks = (const float*)d_in[7]; a.w_ret = (const float*)d_in[8]; a.w_swa = (const float*)d_in[9];
    a.w_out = (const float*)d_in[10]; a.mlp_g = (const float*)d_in[11]; a.w_up = (const float*)d_in[12]; a.w_down = (const float*)d_in[13];
    a.out = (float*)d_out; a.ws = (unsigned char*)d_ws;
    if (hipMemsetAsync((unsigned char*)d_ws + OFF_CTL, 0, CTL_BYTES, stream) != hipSuccess) { fprintf(stderr, "kernel_launch: memset failed\n"); return; }
    void* args[] = {&a};
    hipError_t e = hipLaunchCooperativeKernel((const void*)fwd_megakernel, dim3(grid), dim3(NTHREADS), args, LDS_BYTES, stream);
    if (e != hipSuccess) fprintf(stderr, "kernel_launch: cooperative launch failed: %s (grid %d)\n", hipGetErrorString(e), grid);
}
```
